# Optimizing an MI355X kernel written in HIP

```python
import math
import jax
import jax.numpy as jnp
from jax import lax
import numpy as np

D_MODEL = 1024
BATCH = 4
SEQ = 8192
DEPTH = 2

CHUNK = 64
HG_HEADS = 4
HG_WIDTH = D_MODEL // 2
HG_DK = HG_WIDTH // HG_HEADS
RET_HEADS = 4
RET_WIDTH = D_MODEL // 4
RET_DK = RET_WIDTH // RET_HEADS
GDN_HEADS = 4
GDN_WIDTH = D_MODEL // 4
GDN_DK = GDN_WIDTH // GDN_HEADS
MIX_WIDTH = HG_WIDTH + RET_WIDTH + GDN_WIDTH
N_IN = 4 * HG_WIDTH + 4 * RET_WIDTH + 4 * GDN_WIDTH + 2 * GDN_HEADS
CONV_K = 4
ROPE_BASE = 10000.0
N_EXPERTS = 32
TOP_K = 4
D_FF_EXPERT = D_MODEL
SWIGLU_ALPHA = 1.702
SWIGLU_LIMIT = 7.0
EXPERT_BLOCK = 512
NORM_EPS = 1e-6
L2_EPS = 1e-6

kernel_name = 'hybrid_hgrn2_retnet_gdn_moe_adaln'


def rmsnorm(x, g):
    x32 = x.astype(jnp.float32)
    y = x32 * lax.rsqrt(jnp.mean(x32 * x32, axis=-1, keepdims=True) + NORM_EPS)
    return (y * g.astype(jnp.float32)).astype(x.dtype)


def l2norm(t):
    return t * lax.rsqrt(jnp.sum(t * t, axis=-1, keepdims=True) + L2_EPS)


def to_chunks(t):
    B, S, H = t.shape[:3]
    t = t.reshape((B, S // CHUNK, CHUNK, H) + t.shape[3:])
    return jnp.moveaxis(t, (1, 3), (0, 2))


def from_chunks(t):
    nC, B, H, C, d = t.shape
    return jnp.moveaxis(t, (0, 2), (1, 3)).reshape(B, nC * C, H, d)


def hgrn2_mix(q, f_logit, v, lb):
    log_f = jnp.logaddexp(jnp.log(lb), jnp.log1p(-lb) + jax.nn.log_sigmoid(f_logit))
    k = (1.0 - lb) * jax.nn.sigmoid(-f_logit)
    q = jax.nn.silu(q)
    qc, kc, vc, lfc = to_chunks(q), to_chunks(k), to_chunks(v), to_chunks(log_f)
    bc = jnp.cumsum(lfc, axis=-2)
    causal = jnp.tril(jnp.ones((CHUNK, CHUNK), bool))[:, :, None]

    def step(state, inp):
        q_, k_, v_, b_ = inp
        rel = jnp.exp(jnp.where(causal, b_[..., :, None, :] - b_[..., None, :, :], -jnp.inf))
        scores = jnp.einsum('bhtd,bhsd,bhtsd->bhts', q_, k_, rel)
        b_last = b_[..., -1:, :]
        o = scores @ v_ + jnp.einsum('bhtd,bhde->bhte', q_ * jnp.exp(b_), state)
        state = jnp.exp(b_last[..., 0, :])[..., None] * state + jnp.einsum('bhsd,bhse->bhde', k_ * jnp.exp(b_last - b_), v_)
        return state, o

    B, _, H, dk = q.shape
    s0 = jnp.zeros((B, H, dk, v.shape[-1]), jnp.float32)
    _, o = lax.scan(step, s0, (qc, kc, vc, bc))
    return from_chunks(o)


def rotary(t):
    S, d = t.shape[1], t.shape[-1]
    half = d // 2
    inv = ROPE_BASE ** (-jnp.linspace(0.0, 1.0, half, dtype=jnp.float32))
    ang = jnp.arange(S, dtype=jnp.float32)[:, None] * inv[None, :]
    cos, sin = jnp.cos(ang)[:, None, :], jnp.sin(ang)[:, None, :]
    t1, t2 = t[..., :half], t[..., half:]
    return jnp.concatenate([t1 * cos - t2 * sin, t1 * sin + t2 * cos], axis=-1)


def retention_mix(q, k, v):
    B, _, H, dk = q.shape
    q = rotary(q)
    k = rotary(k) * (dk ** -0.5)
    log_g = jnp.log1p(-jnp.exp2(-5.0 - jnp.arange(H, dtype=jnp.float32)))
    qc, kc, vc = to_chunks(q), to_chunks(k), to_chunks(v)
    j = jnp.arange(CHUNK, dtype=jnp.float32)
    causal = jnp.tril(jnp.ones((CHUNK, CHUNK), bool))
    decay = jnp.exp(jnp.where(causal, (j[:, None] - j[None, :])[None] * log_g[:, None, None], -jnp.inf))
    intra = jnp.einsum('nbhts,nbhse->nbhte', jnp.einsum('nbhtd,nbhsd->nbhts', qc, kc) * decay, vc)
    k_w = jnp.exp(log_g[:, None] * (CHUNK - 1.0 - j)[None, :])[:, :, None]
    kv = jnp.einsum('nbhsd,nbhse->nbhde', kc * k_w, vc)
    chunk_decay = jnp.exp(CHUNK * log_g)[:, None, None]

    def step(state, kv_n):
        return chunk_decay * state + kv_n, state

    _, s_prev = lax.scan(step, jnp.zeros((B, H, dk, v.shape[-1]), jnp.float32), kv)
    q_w = jnp.exp(log_g[:, None] * (j + 1.0)[None, :])[:, :, None]
    inter = jnp.einsum('nbhtd,nbhde->nbhte', qc * q_w, s_prev)
    return from_chunks(intra + inter)


def causal_depthwise_conv(u, w):
    return lax.conv_general_dilated(u, w[:, None, :], window_strides=(1,), padding=[(CONV_K - 1, 0)],
                                    dimension_numbers=('NWC', 'WIO', 'NWC'), feature_group_count=u.shape[-1])


def gated_delta_mix(qkv, a_logit, b_logit, A_log, dt_bias):
    B, S, _ = qkv.shape
    q, k, v = jnp.split(qkv, 3, axis=-1)
    q = l2norm(q.reshape(B, S, GDN_HEADS, GDN_DK)) * (GDN_DK ** -0.5)
    k = l2norm(k.reshape(B, S, GDN_HEADS, GDN_DK))
    v = v.reshape(B, S, GDN_HEADS, GDN_DK)
    beta = jax.nn.sigmoid(b_logit)
    g = -jnp.exp(A_log) * jax.nn.softplus(a_logit + dt_bias)
    qc, kc, vc = to_chunks(q), to_chunks(k), to_chunks(v)
    bc = to_chunks(beta)
    gc = jnp.cumsum(to_chunks(g), axis=-1)
    incl = jnp.tril(jnp.ones((CHUNK, CHUNK), bool))
    strict = jnp.tril(jnp.ones((CHUNK, CHUNK), bool), k=-1)
    rel = jnp.exp(jnp.where(incl, gc[..., :, None] - gc[..., None, :], -jnp.inf))
    kk = jnp.einsum('nbhtd,nbhsd->nbhts', kc, kc)
    m = jnp.where(strict, bc[..., :, None] * kk * rel, 0.0)
    rhs = jnp.concatenate([vc * bc[..., None], kc * (bc * jnp.exp(gc))[..., None]], axis=-1)
    sol = lax.linalg.triangular_solve(m, rhs, left_side=True, lower=True, unit_diagonal=True)
    w_val, k_cum = sol[..., :GDN_DK], sol[..., GDN_DK:]
    qk = jnp.einsum('nbhtd,nbhsd->nbhts', qc, kc) * rel
    q_dec = qc * jnp.exp(gc)[..., None]
    k_dec = kc * jnp.exp(gc[..., -1:] - gc)[..., None]
    last = jnp.exp(gc[..., -1])[..., None, None]

    def step(state, inp):
        w_, kcum_, qk_, qdec_, kdec_, last_ = inp
        v_new = w_ - kcum_ @ state
        o = qdec_ @ state + qk_ @ v_new
        state = last_ * state + jnp.swapaxes(kdec_, -1, -2) @ v_new
        return state, o

    s0 = jnp.zeros((B, GDN_HEADS, GDN_DK, GDN_DK), jnp.float32)
    _, o = lax.scan(step, s0, (w_val, k_cum, qk, q_dec, k_dec, last))
    return from_chunks(o)


def hybrid_mixer(h, w_in, w_out, hg_lb, hg_norm_g, ret_norm_g, gdn_conv_w, gdn_A_log, gdn_dt_bias, gdn_norm_g):
    B, S, _ = h.shape
    f32 = jnp.float32
    sizes = [HG_WIDTH] * 4 + [RET_WIDTH] * 4 + [3 * GDN_WIDTH, GDN_WIDTH, GDN_HEADS, GDN_HEADS]
    z = (h @ w_in).astype(f32)
    (hq, hf, hv, hgt, rq, rk, rv, rgt, gqkv, ggt, ga, gb) = jnp.split(z, np.cumsum(sizes)[:-1].tolist(), axis=-1)

    def heads(t, n):
        return t.reshape(B, S, n, -1)

    o_hg = hgrn2_mix(heads(hq, HG_HEADS), heads(hf, HG_HEADS), heads(hv, HG_HEADS), hg_lb)
    o_hg = rmsnorm(o_hg, hg_norm_g) * jax.nn.silu(heads(hgt, HG_HEADS))
    o_ret = retention_mix(heads(rq, RET_HEADS), heads(rk, RET_HEADS), heads(rv, RET_HEADS))
    o_ret = rmsnorm(o_ret, ret_norm_g) * jax.nn.silu(heads(rgt, RET_HEADS))
    qkv = jax.nn.silu(causal_depthwise_conv(gqkv, gdn_conv_w.astype(f32)))
    o_gdn = gated_delta_mix(qkv, ga, gb, gdn_A_log.astype(f32), gdn_dt_bias.astype(f32))
    o_gdn = rmsnorm(o_gdn, gdn_norm_g) * jax.nn.silu(heads(ggt, GDN_HEADS))
    o = jnp.concatenate([o_hg.reshape(B, S, HG_WIDTH), o_ret.reshape(B, S, RET_WIDTH),
                         o_gdn.reshape(B, S, GDN_WIDTH)], axis=-1)
    return o.astype(h.dtype) @ w_out


def moe_ffn(h, router_w, router_b, w1, b1, w2, b2):
    B, S, D = h.shape
    N = B * S
    NK = N * TOP_K
    xf = h.reshape(N, D)
    logits = (xf @ router_w + router_b).astype(jnp.float32)
    top_v, top_e = lax.top_k(logits, TOP_K)
    gates = jax.nn.softmax(top_v, axis=-1).astype(h.dtype)
    flat_e = top_e.reshape(NK)
    flat_tok = jnp.repeat(jnp.arange(N, dtype=jnp.int32), TOP_K)
    order = jnp.argsort(flat_e)
    se, stok, sg = flat_e[order], flat_tok[order], gates.reshape(NK)[order]
    counts = jax.ops.segment_sum(jnp.ones((NK,), jnp.int32), flat_e, num_segments=N_EXPERTS)
    padded = (counts + EXPERT_BLOCK - 1) // EXPERT_BLOCK * EXPERT_BLOCK
    pend = jnp.cumsum(padded)
    pstart = pend - padded
    cstart = jnp.cumsum(counts) - counts
    dest = pstart[se] + jnp.arange(NK, dtype=jnp.int32) - cstart[se]
    n_blocks = -(-NK // EXPERT_BLOCK) + N_EXPERTS
    P = n_blocks * EXPERT_BLOCK
    buf_tok = jnp.full((P,), N, jnp.int32).at[dest].set(stok)
    buf_gate = jnp.zeros((P,), h.dtype).at[dest].set(sg)
    block_e = jnp.minimum(jnp.searchsorted(pend, jnp.arange(n_blocks, dtype=jnp.int32) * EXPERT_BLOCK, side='right'),
                          N_EXPERTS - 1)
    xpad = jnp.concatenate([xf, jnp.zeros((1, D), xf.dtype)], axis=0)

    def expert_block(args):
        tok, e = args
        hid = xpad[tok] @ w1[e] + b1[e]
        x_glu = jnp.minimum(hid[:, :D_FF_EXPERT], SWIGLU_LIMIT)
        x_lin = jnp.clip(hid[:, D_FF_EXPERT:], -SWIGLU_LIMIT, SWIGLU_LIMIT)
        act = x_glu * jax.nn.sigmoid(SWIGLU_ALPHA * x_glu) * (x_lin + 1.0)
        return act @ w2[e] + b2[e]

    y = lax.map(expert_block, (buf_tok.reshape(n_blocks, EXPERT_BLOCK), block_e))
    y = y.reshape(P, D) * buf_gate[:, None]
    out = jax.ops.segment_sum(y, buf_tok, num_segments=N + 1)[:N]
    return out.reshape(B, S, D)


def setup_inputs(seed: int = 0) -> dict:
    key = jax.random.key(seed)
    ks = jax.random.split(key, 24)
    f32 = jnp.float32
    D = D_MODEL

    def nrm(k, shape, s):
        return jax.random.normal(k, shape, f32) * s

    dt = jnp.exp(jax.random.uniform(ks[13], (DEPTH, GDN_HEADS), f32, math.log(1e-3), math.log(1e-1)))
    return {
        'x': nrm(ks[0], (BATCH, SEQ, D), 1.0),
        'c': nrm(ks[1], (BATCH, D), 1.0),
        'ada_w': nrm(ks[2], (DEPTH, D, 6 * D), 0.5 * D ** -0.5),
        'ada_b': nrm(ks[3], (DEPTH, 6 * D), 0.02),
        'norm1_g': 1.0 + nrm(ks[4], (DEPTH, D), 0.02),
        'norm2_g': 1.0 + nrm(ks[5], (DEPTH, D), 0.02),
        'w_in': nrm(ks[6], (DEPTH, D, N_IN), D ** -0.5),
        'w_out': nrm(ks[7], (DEPTH, MIX_WIDTH, D), MIX_WIDTH ** -0.5),
        'hg_lb_logits': nrm(ks[8], (DEPTH, HG_WIDTH), 0.5),
        'hg_norm_g': 1.0 + nrm(ks[9], (DEPTH, HG_HEADS, HG_DK), 0.02),
        'ret_norm_g': 1.0 + nrm(ks[10], (DEPTH, RET_HEADS, RET_DK), 0.02),
        'gdn_conv_w': nrm(ks[11], (DEPTH, CONV_K, 3 * GDN_WIDTH), CONV_K ** -0.5),
        'gdn_A_log': jnp.log(jax.random.uniform(ks[12], (DEPTH, GDN_HEADS), f32, 1.0, 16.0)),
        'gdn_dt_bias': dt + jnp.log(-jnp.expm1(-dt)),
        'gdn_norm_g': 1.0 + nrm(ks[14], (DEPTH, GDN_HEADS, GDN_DK), 0.02),
        'router_w': nrm(ks[15], (DEPTH, D, N_EXPERTS), D ** -0.5),
        'router_b': nrm(ks[16], (DEPTH, N_EXPERTS), 0.01),
        'exp_w1': nrm(ks[17], (DEPTH, N_EXPERTS, D, 2 * D_FF_EXPERT), D ** -0.5),
        'exp_b1': nrm(ks[18], (DEPTH, N_EXPERTS, 2 * D_FF_EXPERT), 0.01),
        'exp_w2': nrm(ks[19], (DEPTH, N_EXPERTS, D_FF_EXPERT, D), D_FF_EXPERT ** -0.5),
        'exp_b2': nrm(ks[20], (DEPTH, N_EXPERTS, D), 0.01),
        'final_norm_g': 1.0 + nrm(ks[21], (D,), 0.02),
    }


def reference(x, c, ada_w, ada_b, norm1_g, norm2_g, w_in, w_out, hg_lb_logits, hg_norm_g, ret_norm_g,
              gdn_conv_w, gdn_A_log, gdn_dt_bias, gdn_norm_g, router_w, router_b, exp_w1, exp_b1, exp_w2,
              exp_b2, final_norm_g):
    lb = jnp.cumsum(jax.nn.softmax(hg_lb_logits.astype(jnp.float32), axis=0), axis=0)
    lb = jnp.maximum(lb - lb[0], 0.0)
    cond = jax.nn.silu(c)
    for l in range(DEPTH):
        mod = cond @ ada_w[l] + ada_b[l]
        sh1, sc1, gt1, sh2, sc2, gt2 = jnp.split(mod[:, None, :], 6, axis=-1)
        hn = rmsnorm(x, norm1_g[l]) * (1.0 + sc1) + sh1
        x = x + gt1 * hybrid_mixer(hn, w_in[l], w_out[l], lb[l].reshape(HG_HEADS, HG_DK), hg_norm_g[l],
                                   ret_norm_g[l], gdn_conv_w[l], gdn_A_log[l], gdn_dt_bias[l], gdn_norm_g[l])
        hn = rmsnorm(x, norm2_g[l]) * (1.0 + sc2) + sh2
        x = x + gt2 * moe_ffn(hn, router_w[l], router_b[l], exp_w1[l], exp_b1[l], exp_w2[l], exp_b2[l])
    return rmsnorm(x, final_norm_g)
```

```cpp
#include <hip/hip_runtime.h>
#include <cstdio>
#include <cstdint>

#define GAS __attribute__((address_space(1)))
#define LAS __attribute__((address_space(3)))
typedef unsigned short bf16;
typedef short bf16x8 __attribute__((ext_vector_type(8)));
typedef float f32x4 __attribute__((ext_vector_type(4)));
typedef float f32x2 __attribute__((ext_vector_type(2)));
typedef unsigned u32x4 __attribute__((ext_vector_type(4)));
typedef unsigned u32x2 __attribute__((ext_vector_type(2)));

constexpr int D = 1024, BATCH = 4, SEQ = 8192, NTOK = BATCH * SEQ, DEPTH = 2;
constexpr int NIN = 4104, NZ = 4096, NE = 32, TOPK = 4, FF = 1024;
constexpr int NROWS_S = NTOK * TOPK + NE * 256;
constexpr float NORM_EPS = 1e-6f;

constexpr size_t MiB = 1u << 20;
constexpr size_t WS_CTL = 0, CTL_ZERO_BYTES = 1 * MiB;
constexpr size_t WS_MOD = 1 * MiB;
constexpr size_t WS_LB = WS_MOD + 256 * 1024;
constexpr size_t WS_ROPE = WS_LB + 8192;
constexpr size_t WS_WIN = 2 * MiB;
constexpr size_t WS_WOUT = WS_WIN + 16 * MiB;
constexpr size_t WS_W1 = WS_WOUT + 4 * MiB;
constexpr size_t WS_W2 = WS_W1 + 256 * MiB;
constexpr size_t WS_XA = WS_W2 + 128 * MiB;
constexpr size_t WS_HN = WS_XA + 128 * MiB;
constexpr size_t WS_OMIX = WS_HN + 64 * MiB;
constexpr size_t WS_GAB = WS_OMIX + 64 * MiB;
constexpr size_t WS_RE = WS_GAB + 1 * MiB;
constexpr size_t WS_RS = WS_RE + 512 * 1024;
constexpr size_t WS_RG = WS_RS + 512 * 1024;
constexpr size_t WS_TOK = WS_RG + 512 * 1024;
constexpr size_t WS_R1 = WS_TOK + 1 * MiB;
constexpr size_t WS_R2 = WS_R1 + 272 * MiB;
constexpr size_t WS_HKV = WS_R2 + 272 * MiB;
constexpr size_t WS_HDEC = WS_HKV + 128 * MiB;
constexpr size_t WS_HSP = WS_HDEC + 1 * MiB;
constexpr size_t WS_RKV = WS_HSP + 64 * MiB;
constexpr size_t WS_RSP = WS_RKV + 32 * MiB;
constexpr size_t WS_GT = WS_RSP + 16 * MiB;
constexpr size_t WS_GUT = WS_GT + 16 * MiB;
constexpr size_t WS_GKC = WS_GUT + 32 * MiB;
constexpr size_t WS_GWT = WS_GKC + 16 * MiB;
constexpr size_t WS_GQK = WS_GWT + 16 * MiB;
constexpr size_t WS_GQD = WS_GQK + 16 * MiB;
constexpr size_t WS_GSP = WS_GQD + 16 * MiB;
constexpr size_t WS_TOKE = WS_GSP;
constexpr size_t WS_GPG = WS_GSP + 16 * MiB;
constexpr size_t WS_GQG = WS_GPG + 2 * MiB;
constexpr size_t WS_GSS = WS_GQG + 2 * MiB;
constexpr size_t WS_END = WS_GSS + 4 * MiB;
constexpr int CW_BAR = 4096;
constexpr int CW_CNT = 16384;

constexpr int RING_BYTES = 131072;
constexpr int LDSCTL_OFF = RING_BYTES, MISC_OFF = LDSCTL_OFF + 320;
constexpr int LDS_RT = LDSCTL_OFF + 1024;
constexpr int LDS_SM = LDSCTL_OFF + 4096;
constexpr int LDS_BYTES = 147456;

#define LDS_WAIT() asm volatile("s_waitcnt lgkmcnt(0)" ::: "memory")
__device__ __forceinline__ void lds_barrier() { asm volatile("s_waitcnt lgkmcnt(0)" ::: "memory"); __builtin_amdgcn_s_barrier(); asm volatile("" ::: "memory"); }
#define VM_WAIT() asm volatile("s_waitcnt vmcnt(0)" ::: "memory")
__device__ __forceinline__ unsigned f2bf(float f) { unsigned u = __builtin_bit_cast(unsigned, f); return (u + 0x7fffu + ((u >> 16) & 1u)) >> 16; }
typedef __bf16 bf16x2_t __attribute__((ext_vector_type(2)));
__device__ __forceinline__ unsigned pk2(float lo, float hi) { return __builtin_bit_cast(unsigned, __builtin_convertvector((f32x2){lo, hi}, bf16x2_t)); }
__device__ __forceinline__ unsigned pk2m(float lo, float hi) { return pk2(lo, hi); }
typedef int i32x8 __attribute__((ext_vector_type(8)));
__device__ __forceinline__ unsigned pk4_fp8(float a, float b, float c, float d) {
    int w = __builtin_amdgcn_cvt_pk_fp8_f32(a, b, 0, false); w = __builtin_amdgcn_cvt_pk_fp8_f32(c, d, w, true); return (unsigned)w; }
constexpr float W8_SCALE = 64.0f, W8_INV = 1.0f / 64.0f;
__device__ __forceinline__ float bf2f(bf16 v) { return __builtin_bit_cast(float, ((unsigned)v) << 16); }
__device__ __forceinline__ float bflo(unsigned w) { return __builtin_bit_cast(float, w << 16); }
__device__ __forceinline__ float bfhi(unsigned w) { return __builtin_bit_cast(float, w & 0xffff0000u); }
#define DPP_ADD(x, ctrl, rmask) x += __builtin_bit_cast(float, __builtin_amdgcn_update_dpp(0, __builtin_bit_cast(int, x), ctrl, rmask, 0xf, false))
__device__ __forceinline__ float wave_scan_incl(float x, int lane) {
    (void)lane;
    DPP_ADD(x, 0x111, 0xf); DPP_ADD(x, 0x112, 0xf); DPP_ADD(x, 0x114, 0xf); DPP_ADD(x, 0x118, 0xf);
    DPP_ADD(x, 0x142, 0xa); DPP_ADD(x, 0x143, 0xc);
    return x;
}
__device__ __forceinline__ float wave_sum(float v) {
    return __builtin_bit_cast(float, __builtin_amdgcn_readlane(__builtin_bit_cast(int, wave_scan_incl(v, 0)), 63));
}
__device__ __forceinline__ float shx(float v, int o, int lane) { return __builtin_bit_cast(float, __builtin_amdgcn_ds_bpermute((lane ^ o) << 2, __builtin_bit_cast(int, v))); }
__device__ __forceinline__ int shxi(int v, int o, int lane) { return __builtin_amdgcn_ds_bpermute((lane ^ o) << 2, v); }
__device__ __forceinline__ float sigm(float x) { return __builtin_amdgcn_rcpf(1.0f + __expf(-x)); }
__device__ __forceinline__ float siluf(float x) { return x * sigm(x); }

#define XB_TMO      128
#define XB_XCNT(j)  (256  + 64 * (j))
#define XB_XSUB(j)  (1280 + 64 * (j))
#define XB_XGEN(j)  (2304 + 64 * (j))
#define XB_TOP      3328
#define XB_TOPGEN   3392
#define XCD_BAR_WORDS 3456
#define XB_SPIN_CAP (1u << 20)

__device__ __forceinline__ unsigned xb_ld(unsigned* p)              { return __hip_atomic_load(p, __ATOMIC_RELAXED, __HIP_MEMORY_SCOPE_AGENT); }
__device__ __forceinline__ unsigned xb_add(unsigned* p, unsigned v) { return __hip_atomic_fetch_add(p, v, __ATOMIC_RELAXED, __HIP_MEMORY_SCOPE_AGENT); }
__device__ __forceinline__ unsigned xb_xcc_id() { return (unsigned)__builtin_amdgcn_s_getreg((3 << 11) | 20) & 0xFu; }
#define XB_SPIN(cond, bar) do { unsigned _sp = 0; while (cond) { __builtin_amdgcn_s_sleep(1); \
    if ((++_sp & 255u) == 0u) { if (xb_ld(&(bar)[XB_TMO])) break; if (_sp > XB_SPIN_CAP) { atomicAdd(&(bar)[XB_TMO], 1u); break; } } } } while (0)

struct XcdBarrier { unsigned* bar; unsigned x; volatile LAS unsigned* st; };

__device__ __forceinline__ XcdBarrier xcd_barrier_post(unsigned* bar, volatile LAS unsigned* st) {
    XcdBarrier b; b.bar = bar; b.x = xb_xcc_id(); b.st = st;
    if (threadIdx.x == 0) (void)xb_add(&bar[XB_XCNT(b.x)], 1u);
    return b;
}
__device__ __forceinline__ void xcd_barrier_complete(unsigned* bar, unsigned x, unsigned& nloc, unsigned& nx) {
    const unsigned G = gridDim.x * gridDim.y * gridDim.z;
    unsigned sum, cnt, mine, sp = 0u;
    for (;;) {
        sum = 0u; cnt = 0u; mine = 0u;
#pragma unroll
        for (unsigned j = 0; j < 16; ++j) { const unsigned c = xb_ld(&bar[XB_XCNT(j)]); sum += c; cnt += (c > 0u) ? 1u : 0u; mine = (j == x) ? c : mine; }
        if (sum == G) break;
        __builtin_amdgcn_s_sleep(1);
        if ((++sp & 255u) == 0u) { if (xb_ld(&bar[XB_TMO])) break; if (sp > XB_SPIN_CAP) { atomicAdd(&bar[XB_TMO], 1u); break; } }
    }
    nloc = mine > 0u ? mine : 1u; nx = cnt > 0u ? cnt : 1u;
}
__device__ __forceinline__ void xcd_barrier(const XcdBarrier& b) {
    asm volatile("s_waitcnt vmcnt(0)" ::: "memory");
    __syncthreads();
    if (threadIdx.x == 0) {
        unsigned* bar = b.bar;
        __builtin_amdgcn_s_waitcnt(0);
        unsigned nloc = b.st[0], nx = b.st[1];
        if (nloc == 0u) { xcd_barrier_complete(bar, b.x, nloc, nx); b.st[0] = nloc; b.st[1] = nx; }
        const unsigned old = xb_add(&bar[XB_XSUB(b.x)], 1u);
        const unsigned gen = old / nloc;
        if (old + 1u == (gen + 1u) * nloc) {
            __builtin_amdgcn_fence(__ATOMIC_RELEASE, "agent");
            asm volatile("s_waitcnt vmcnt(0)" ::: "memory");
            const unsigned og = xb_add(&bar[XB_TOP], 1u);
            const unsigned tg = og / nx;
            if (og + 1u == (tg + 1u) * nx) xb_add(&bar[XB_TOPGEN], 1u);
            else XB_SPIN(xb_ld(&bar[XB_TOPGEN]) == tg, bar);
            __builtin_amdgcn_fence(__ATOMIC_ACQUIRE, "agent");
            xb_add(&bar[XB_XGEN(b.x)], 1u);
            asm volatile("s_waitcnt vmcnt(0)" ::: "memory");
        } else {
            XB_SPIN(xb_ld(&bar[XB_XGEN(b.x)]) == gen, bar);
            __builtin_amdgcn_fence(__ATOMIC_ACQUIRE, "agent");
            asm volatile("s_waitcnt vmcnt(0)" ::: "memory");
        }
    }
    __syncthreads();
}

namespace pg8 {
typedef int i32x4_ __attribute__((ext_vector_type(4)));
constexpr int BM = 256, BK = 64, HALF = 128, HTB = HALF * BK * 2, STAGE_BYTES = 8 * HTB, NXCD = 8, WGM = 8, KD = 1024;
constexpr size_t HSTEP = (size_t)HALF * KD * 2, TSTEP = 2 * HSTEP;
__host__ __device__ __forceinline__ int lds_byte(int r, int c) { const int st = (r >> 4) * 2 + (c >> 5), rr = r & 15, cc = c & 31, ob = rr * 64 + cc * 2; return st * 1024 + (ob ^ (((ob >> 9) & 1) << 5)); }
__host__ __device__ __forceinline__ void stage_rc(int b, int& R, int& C) { const int st = b / 1024, sb = b % 1024, swz = sb ^ (((sb >> 9) & 1) << 5); R = (st >> 1) * 16 + swz / 64; C = (st & 1) * 32 + (swz % 64) / 2; }
__host__ __device__ __forceinline__ int perm32(int rho) { const int n = rho >> 4, i = rho & 15; return 8 * (i >> 2) + 4 * n + (i & 3); }

struct Unit { int pm, pn, e, tb; const char* a; const char* b; };

struct DenseOrder {
    const char* A; const char* Bt; int nM, nN, nwg, G, c;
    __device__ void init(const void* A_, const void* Bt_, int M, int N, int G_, int c_) { A = (const char*)A_; Bt = (const char*)Bt_; nM = M / BM; nN = N / BM; nwg = nM * nN; G = G_; c = c_; }
    __device__ __forceinline__ bool next(int i, Unit& u) const {
        const long L = (long)i * G + c; if (L >= nwg) return false;
        int wgid = (int)L; { const int q = nwg / NXCD, r = nwg % NXCD, xcd = wgid % NXCD, off = wgid / NXCD; wgid = (xcd < r ? xcd * (q + 1) : r * (q + 1) + (xcd - r) * q) + off; }
        const int nig = WGM * nN, gid = wgid / nig, fm = gid * WGM, gsz = (nM - fm) < WGM ? (nM - fm) : WGM;
        u.pm = fm + ((wgid % nig) % gsz); u.pn = (wgid % nig) / gsz; u.e = 0; u.tb = 0;
        u.a = A + (size_t)u.pm * TSTEP; u.b = Bt + (size_t)u.pn * TSTEP; return true;
    }
};
struct MoeOrder {
    const char* A; const char* Bt; int nct, nrt, ntot, G, c; size_t estride, ctstep, atstep; const LAS int* rt_e; bool gather;
    __device__ __forceinline__ bool next(int i, Unit& u) const {
        const int L = i * G + c; if (L >= ntot) return false;
        const int per = 8 * nct, grp = L / per, rem = L % per, fm = grp * 8, gsz = (nrt - fm) < 8 ? (nrt - fm) : 8;
        const int rt = fm + rem % gsz, ct = rem / gsz;
        const int e = __builtin_amdgcn_readfirstlane(rt_e[rt]);
        u.pm = rt; u.pn = ct; u.e = e; u.tb = e * 32768 + rt * 256 - __builtin_amdgcn_readfirstlane(rt_e[608 + e]);
        u.a = gather ? A : A + (size_t)rt * atstep; u.b = Bt + (size_t)e * estride + (size_t)ct * ctstep; return true;
    }
};

template <class Epi, class Sched, bool GATHER = false, bool FP8 = false>
__device__ __forceinline__ void gemm_phase(LAS unsigned char* lds, const Sched& S, const Epi& E, const size_t hstepB, const int wave0, const int* tok = nullptr) {
    int ln_; asm volatile("v_mbcnt_lo_u32_b32 %0, -1, 0\n\tv_mbcnt_hi_u32_b32 %0, -1, %0" : "=v"(ln_));
    int wid_ = wave0; asm volatile("" : "+s"(wid_));
    const int wid = wid_, lane = ln_, tid = wid * 64 + lane, wr = wid >> 2, wc = wid & 3, fr = lane & 15, fq = lane >> 4;
    constexpr int K = KD, ROWB = FP8 ? K : 2 * K, nt = FP8 ? K / 128 : K / BK;
    unsigned voffA[2], voffB[2]; int RA[2];
#pragma unroll
    for (int i = 0; i < 2; ++i) { int R, C; stage_rc(tid * 16 + i * 8192, R, C); const int Rb = Epi::PERM ? ((R & ~31) + perm32(R & 31)) : R;
        voffA[i] = GATHER ? 0u : (unsigned)(R * ROWB + C * 2); voffB[i] = (unsigned)(Rb * ROWB + C * 2); RA[i] = R; }
    unsigned va[2] = {0u, 0u}, vn[2] = {0u, 0u};
#define PG8_GOFF(dst, tb_) do { int t2_; asm volatile("v_mbcnt_lo_u32_b32 %0, -1, 0\n\tv_mbcnt_hi_u32_b32 %0, -1, %0" : "=v"(t2_)); t2_ += wid * 64; int R0_, C0_, R1_, C1_; stage_rc(t2_ * 16, R0_, C0_); stage_rc(t2_ * 16 + 8192, R1_, C1_); \
        _Pragma("unroll") for (int _h = 0; _h < 2; ++_h) dst[_h] = ((unsigned)tok[(tb_) + 128 * _h + R0_] & 32767u) | (((unsigned)tok[(tb_) + 128 * _h + R1_] & 32767u) << 16); } while (0)
#define PG8_GVOFF(p, _i) ({ int t3_; asm volatile("v_mbcnt_lo_u32_b32 %0, -1, 0\n\tv_mbcnt_hi_u32_b32 %0, -1, %0" : "=v"(t3_)); t3_ += wid * 64; int R3_, C3_; stage_rc(t3_ * 16 + (_i) * 8192, R3_, C3_); \
        (int)((((p) >> (16 * (_i))) & 0xffffu) * (unsigned)ROWB + (unsigned)C3_ * 2u); })
    const size_t kstep = (size_t)(BK * 2);
    const size_t hstep = (size_t)HALF * ROWB;
    const unsigned ldsw = (unsigned)wid * 1024u;
    const int aoff = lds_byte(wr * 64 + fr, fq * 8), boff = lds_byte(wc * 32 + fr, fq * 8);
#define PG8_SA(b, h) (((b) * 2 + (h)) * HTB)
#define PG8_SB(b, h) ((4 + (b) * 2 + (h)) * HTB)
    __amdgpu_buffer_rsrc_t rsA = __builtin_amdgcn_make_buffer_rsrc((void*)S.A, 0, 0x7fffffff, 0x00020000), rsB = __builtin_amdgcn_make_buffer_rsrc((void*)S.Bt, 0, 0x7fffffff, 0x00020000);
#define PG8_STAGE_X(bufoff, gbase, voff, RS, BASE) do { if constexpr (FP8) { _Pragma("unroll") for (int _i = 0; _i < 2; ++_i) \
        __builtin_amdgcn_raw_ptr_buffer_load_lds(RS, (LAS void*)(lds + (bufoff) + ldsw + _i * 8192), 16, (int)(voff)[_i], (int)(unsigned)((const char*)(gbase) - (BASE)), 0, 0); } \
        else { _Pragma("unroll") for (int _i = 0; _i < 2; ++_i) \
        __builtin_amdgcn_global_load_lds((const unsigned*)((const char*)(gbase) + (voff)[_i]), (LAS unsigned*)(lds + (bufoff) + ldsw + _i * 8192), 16, 0, 0); } } while (0)
#define PG8_STAGE(bufoff, gbase, voff) PG8_STAGE_X(bufoff, gbase, voff, rsB, S.Bt)
#define PG8_STAGE_A(bufoff, gbase, hh, nx) do { if constexpr (GATHER && FP8) { _Pragma("unroll") for (int _i = 0; _i < 2; ++_i) \
        __builtin_amdgcn_raw_ptr_buffer_load_lds(rsA, (LAS void*)(lds + (bufoff) + ldsw + _i * 8192), 16, PG8_GVOFF((nx) ? vn[hh] : va[hh], _i), (int)(unsigned)((const char*)(gbase) - S.A), 0, 0); } \
        else if constexpr (GATHER) { _Pragma("unroll") for (int _i = 0; _i < 2; ++_i) \
        __builtin_amdgcn_global_load_lds((const unsigned*)((const char*)(gbase) + (unsigned)PG8_GVOFF((nx) ? vn[hh] : va[hh], _i)), (LAS unsigned*)(lds + (bufoff) + ldsw + _i * 8192), 16, 0, 0); } \
        else { PG8_STAGE_X(bufoff, (gbase) + (hh) * hstep, voffA, rsA, S.A); } } while (0)
#define PG8_LDA(dst, b, h) do { if constexpr (FP8) { _Pragma("unroll") for (int m = 0; m < 4; ++m) dst##8[m] = __builtin_shufflevector(*(const LAS i32x4_*)(lds + PG8_SA(b, h) + aoff + m * 2048), *(const LAS i32x4_*)(lds + PG8_SA(b, h) + aoff + m * 2048 + 1024), 0, 1, 2, 3, 4, 5, 6, 7); } \
        else { _Pragma("unroll") for (int m = 0; m < 4; ++m) _Pragma("unroll") for (int k = 0; k < 2; ++k) dst[m][k] = *(const LAS bf16x8*)(lds + PG8_SA(b, h) + aoff + m * 2048 + k * 1024); } } while (0)
#define PG8_LDB(dst, b, h) do { if constexpr (FP8) { _Pragma("unroll") for (int n = 0; n < 2; ++n) dst##8[n] = __builtin_shufflevector(*(const LAS i32x4_*)(lds + PG8_SB(b, h) + boff + n * 2048), *(const LAS i32x4_*)(lds + PG8_SB(b, h) + boff + n * 2048 + 1024), 0, 1, 2, 3, 4, 5, 6, 7); } \
        else { _Pragma("unroll") for (int n = 0; n < 2; ++n) _Pragma("unroll") for (int k = 0; k < 2; ++k) dst[n][k] = *(const LAS bf16x8*)(lds + PG8_SB(b, h) + boff + n * 2048 + k * 1024); } } while (0)
#define PG8_MMA(ai, bj, At, Bt) do { __builtin_amdgcn_s_setprio(1); if constexpr (FP8) { _Pragma("unroll") for (int m = 0; m < 4; ++m) _Pragma("unroll") for (int n = 0; n < 2; ++n) \
        acc[ai][bj][m][n] = __builtin_amdgcn_mfma_scale_f32_16x16x128_f8f6f4(Bt##8[n], At##8[m], acc[ai][bj][m][n], 0, 0, 0, 0, 0, 0); } \
        else { _Pragma("unroll") for (int m = 0; m < 4; ++m) _Pragma("unroll") for (int n = 0; n < 2; ++n) _Pragma("unroll") for (int k = 0; k < 2; ++k) \
        acc[ai][bj][m][n] = __builtin_amdgcn_mfma_f32_16x16x32_bf16(Bt[n][k], At[m][k], acc[ai][bj][m][n], 0, 0, 0); } __builtin_amdgcn_s_setprio(0); } while (0)
#define PG8_WAIT_V(n) asm volatile("s_waitcnt vmcnt(" #n ")" ::: "memory")
#define PG8_WAIT_L(n) asm volatile("s_waitcnt lgkmcnt(" #n ")" ::: "memory")
#define PG8_BAR __builtin_amdgcn_s_barrier()
#define PG8_SCHED __builtin_amdgcn_sched_barrier(0)
    Unit cur, nxt; int ui = 0;
    if (!S.next(0, cur)) return;
    f32x4 acc[2][2][4][2];
    { f32x4 ib[2][2]; E.init(ib, cur, wc, fq);
#pragma unroll
      for (int a = 0; a < 2; ++a)
#pragma unroll
        for (int b = 0; b < 2; ++b)
#pragma unroll
            for (int m = 0; m < 4; ++m)
#pragma unroll
                for (int n = 0; n < 2; ++n) acc[a][b][m][n] = ib[b][n]; }
    bf16x8 At[4][2], B0[2][2], B1[2][2]; i32x8 At8[4], B08[2], B18[2];
    const char* cA = cur.a; const char* cB = cur.b;
    if constexpr (GATHER) { PG8_GOFF(va, cur.tb); }
    PG8_STAGE(PG8_SB(0, 0), cB, voffB); PG8_STAGE(PG8_SB(0, 1), cB + hstepB, voffB); PG8_STAGE_A(PG8_SA(0, 0), cA, 0, false); PG8_STAGE_A(PG8_SA(0, 1), cA, 1, false);
    if (wr == 1) PG8_BAR;
    PG8_WAIT_V(2); PG8_BAR;
    PG8_STAGE(PG8_SB(1, 0), cB + kstep, voffB); PG8_STAGE_A(PG8_SA(1, 0), cA + kstep, 0, false); PG8_STAGE(PG8_SB(1, 1), cB + hstepB + kstep, voffB);
    PG8_WAIT_V(6); PG8_BAR;
    for (;;) {
        const bool has_next = S.next(ui + 1, nxt);
        const char* nA = has_next ? nxt.a : cA; const char* nB = has_next ? nxt.b : cB;
        if constexpr (GATHER) { if (has_next) { PG8_GOFF(vn, nxt.tb); } else { vn[0] = va[0]; vn[1] = va[1]; } }
#pragma unroll 1
        for (int t = 0; t < nt; t += 2) {
            const bool last = (t == nt - 2);
            const char* a1 = cA + (size_t)(t + 1) * kstep;
            const char* a2 = last ? nA : cA + (size_t)(t + 2) * kstep; const char* b2 = last ? nB : cB + (size_t)(t + 2) * kstep;
            const char* a3 = a2 + kstep; const char* b3 = b2 + kstep;
            PG8_LDB(B0, 0, 0); PG8_LDB(B1, 0, 1); PG8_SCHED; PG8_LDA(At, 0, 0); PG8_STAGE_A(PG8_SA(1, 1), a1, 1, false);
            PG8_WAIT_V(8); PG8_WAIT_L(0); PG8_BAR; PG8_MMA(0, 0, At, B0); PG8_MMA(0, 1, At, B1); PG8_BAR; PG8_SCHED;
            PG8_LDA(At, 0, 1); PG8_STAGE(PG8_SB(0, 0), b2, voffB); PG8_STAGE(PG8_SB(0, 1), b2 + hstepB, voffB); PG8_STAGE_A(PG8_SA(0, 0), a2, 0, last);
            PG8_WAIT_V(8); PG8_WAIT_L(0); PG8_BAR; PG8_MMA(1, 0, At, B0); PG8_MMA(1, 1, At, B1); PG8_BAR; PG8_SCHED;
            PG8_LDB(B0, 1, 0); PG8_LDB(B1, 1, 1); PG8_SCHED; PG8_LDA(At, 1, 0); PG8_STAGE_A(PG8_SA(0, 1), a2, 1, last);
            PG8_WAIT_V(8); PG8_WAIT_L(0); PG8_BAR; PG8_MMA(0, 0, At, B0); PG8_MMA(0, 1, At, B1); PG8_BAR; PG8_SCHED;
            PG8_LDA(At, 1, 1); PG8_STAGE(PG8_SB(1, 0), b3, voffB); PG8_STAGE(PG8_SB(1, 1), b3 + hstepB, voffB); PG8_STAGE_A(PG8_SA(1, 0), a3, 0, last);
            PG8_WAIT_V(8); PG8_WAIT_L(0); PG8_BAR; PG8_MMA(1, 0, At, B0); PG8_MMA(1, 1, At, B1); PG8_BAR; PG8_SCHED;
        }
        if (wr == 0) PG8_BAR;
        f32x4 nb[2][2];
        { int l2_; asm volatile("v_mbcnt_lo_u32_b32 %0, -1, 0\n\tv_mbcnt_hi_u32_b32 %0, -1, %0" : "=v"(l2_)); E.init(nb, has_next ? nxt : cur, wc, l2_ >> 4); E(acc, cur, wr, wc, l2_ & 15, l2_ >> 4); }
        if (!has_next) break;
#pragma unroll
        for (int a = 0; a < 2; ++a)
#pragma unroll
            for (int b = 0; b < 2; ++b)
#pragma unroll
                for (int m = 0; m < 4; ++m)
#pragma unroll
                    for (int n = 0; n < 2; ++n) acc[a][b][m][n] = nb[b][n];
        cur = nxt; cA = nA; cB = nB; ++ui;
        if constexpr (GATHER) { va[0] = vn[0]; va[1] = vn[1]; }
        if (wr == 1) PG8_BAR;
    }
    PG8_WAIT_V(0);
    PG8_BAR;
#undef PG8_SA
#undef PG8_SB
#undef PG8_STAGE
#undef PG8_STAGE_X
#undef PG8_STAGE_A
#undef PG8_GOFF
#undef PG8_GVOFF
#undef PG8_LDA
#undef PG8_LDB
#undef PG8_MMA
#undef PG8_WAIT_V
#undef PG8_WAIT_L
#undef PG8_BAR
#undef PG8_SCHED
}

struct EpiZ {
    static constexpr bool PERM = true;
    bf16* O; int ldc;
    __device__ __forceinline__ void init(f32x4 (&ib)[2][2], const Unit&, int, int) const { ib[0][0] = ib[0][1] = ib[1][0] = ib[1][1] = (f32x4){0.f, 0.f, 0.f, 0.f}; }
    __device__ __forceinline__ void operator()(const f32x4 (&acc)[2][2][4][2], const Unit& u, int wr, int wc, int fr, int fq) const {
        const int row0 = u.pm * BM + wr * 64 + fr, col0 = u.pn * BM + wc * 32 + 8 * fq;
#pragma unroll
        for (int ai = 0; ai < 2; ++ai)
#pragma unroll
            for (int m = 0; m < 4; ++m) { bf16* rowp = O + (size_t)(row0 + ai * HALF + m * 16) * ldc + col0;
#pragma unroll
                for (int bj = 0; bj < 2; ++bj) { const f32x4 v0 = acc[ai][bj][m][0], v1 = acc[ai][bj][m][1];
                    u32x4 w; w.x = pk2(v0[0], v0[1]); w.y = pk2(v0[2], v0[3]); w.z = pk2(v1[0], v1[1]); w.w = pk2(v1[2], v1[3]);
                    *(u32x4*)(rowp + bj * HALF) = w; } }
    }
};
template <bool BASE_BF16>
struct EpiXres {
    static constexpr bool PERM = true;
    const void* base; bf16* out; const float* gate;
    __device__ __forceinline__ void init(f32x4 (&ib)[2][2], const Unit&, int, int) const { ib[0][0] = ib[0][1] = ib[1][0] = ib[1][1] = (f32x4){0.f, 0.f, 0.f, 0.f}; }
    __device__ __forceinline__ void operator()(const f32x4 (&acc)[2][2][4][2], const Unit& u, int wr, int wc, int fr, int fq) const {
        const int row0 = u.pm * BM + wr * 64 + fr, col0 = u.pn * BM + wc * 32 + 8 * fq;
        const float* gp = gate + (size_t)((u.pm * BM) >> 13) * 6144 + col0;
        f32x4 gv[2][2];
#pragma unroll
        for (int bj = 0; bj < 2; ++bj)
#pragma unroll
            for (int n = 0; n < 2; ++n) gv[bj][n] = *(const f32x4*)(gp + bj * HALF + 4 * n);
#pragma unroll
        for (int ai = 0; ai < 2; ++ai)
#pragma unroll
            for (int m = 0; m < 4; ++m) { const size_t off = (size_t)(row0 + ai * HALF + m * 16) * 1024 + col0;
#pragma unroll
                for (int bj = 0; bj < 2; ++bj) { f32x4 b0, b1;
                    if constexpr (BASE_BF16) { const u32x4 w = *(const u32x4*)((const bf16*)base + off + bj * HALF); b0 = (f32x4){bflo(w.x), bfhi(w.x), bflo(w.y), bfhi(w.y)}; b1 = (f32x4){bflo(w.z), bfhi(w.z), bflo(w.w), bfhi(w.w)}; }
                    else { b0 = *(const f32x4*)((const float*)base + off + bj * HALF); b1 = *(const f32x4*)((const float*)base + off + bj * HALF + 4); }
                    const f32x4 v0 = b0 + gv[bj][0] * acc[ai][bj][m][0], v1 = b1 + gv[bj][1] * acc[ai][bj][m][1];
                    u32x4 w; w.x = pk2(v0[0], v0[1]); w.y = pk2(v0[2], v0[3]); w.z = pk2(v1[0], v1[1]); w.w = pk2(v1[2], v1[3]);
                    *(u32x4*)(out + off + bj * HALF) = w; } }
    }
};
struct EpiAct {
    static constexpr bool PERM = true;
    unsigned char* O; const float* b1;
    __device__ __forceinline__ void init(f32x4 (&ib)[2][2], const Unit& u, int wc, int fq) const {
        const float* bp = b1 + (size_t)u.e * 2048 + u.pn * HALF + wc * 32 + 8 * fq;
#pragma unroll
        for (int n = 0; n < 2; ++n) { ib[0][n] = *(const f32x4*)(bp + 4 * n) * W8_SCALE; ib[1][n] = *(const f32x4*)(bp + 1024 + 4 * n) * W8_SCALE; } }
    __device__ __forceinline__ void operator()(const f32x4 (&acc)[2][2][4][2], const Unit& u, int wr, int wc, int fr, int fq) const {
        const int row0 = u.pm * BM + wr * 64 + fr, cc0 = u.pn * HALF + wc * 32 + 8 * fq;
#pragma unroll
        for (int ai = 0; ai < 2; ++ai)
#pragma unroll
            for (int m = 0; m < 4; ++m) { unsigned char* rowp = O + (size_t)(row0 + ai * HALF + m * 16) * 1024 + cc0;
                float r[8];
#pragma unroll
                for (int n = 0; n < 2; ++n)
#pragma unroll
                    for (int p = 0; p < 2; ++p) {
                        const f32x2 a2 = (f32x2){acc[ai][0][m][n][2 * p], acc[ai][0][m][n][2 * p + 1]}, c2 = (f32x2){acc[ai][1][m][n][2 * p], acc[ai][1][m][n][2 * p + 1]};
                        f32x2 m2, lc;
                        m2[0] = fminf(a2[0], 448.0f); m2[1] = fminf(a2[1], 448.0f);
                        lc[0] = __builtin_amdgcn_fmed3f(c2[0], -448.0f, 448.0f); lc[1] = __builtin_amdgcn_fmed3f(c2[1], -448.0f, 448.0f);
                        const f32x2 ea = m2 * (-1.702f * 1.4426950408889634f * W8_INV); f32x2 d;
                        d[0] = __builtin_amdgcn_exp2f(ea[0]); d[1] = __builtin_amdgcn_exp2f(ea[1]);
                        d = d + 1.0f; f32x2 rc; rc[0] = __builtin_amdgcn_rcpf(d[0]); rc[1] = __builtin_amdgcn_rcpf(d[1]);
                        const f32x2 o2 = (m2 * rc) * (lc * (W8_INV * W8_INV) + W8_INV);
                        r[4 * n + 2 * p] = o2[0]; r[4 * n + 2 * p + 1] = o2[1]; }
                u32x2 w; w.x = pk4_fp8(r[0], r[1], r[2], r[3]); w.y = pk4_fp8(r[4], r[5], r[6], r[7]);
                __builtin_nontemporal_store(w, (u32x2*)rowp); }
    }
};
struct EpiY {
    static constexpr bool PERM = true;
    unsigned char* O; const float* b2;
    __device__ __forceinline__ void init(f32x4 (&ib)[2][2], const Unit& u, int wc, int fq) const {
        const float* bp = b2 + (size_t)u.e * 1024 + u.pn * BM + wc * 32 + 8 * fq;
#pragma unroll
        for (int bj = 0; bj < 2; ++bj)
#pragma unroll
            for (int n = 0; n < 2; ++n) ib[bj][n] = *(const f32x4*)(bp + bj * HALF + 4 * n) * W8_SCALE; }
    __device__ __forceinline__ void operator()(const f32x4 (&acc)[2][2][4][2], const Unit& u, int wr, int wc, int fr, int fq) const {
        const int row0 = u.pm * BM + wr * 64 + fr, col0 = u.pn * BM + wc * 32 + 8 * fq;
#pragma unroll
        for (int ai = 0; ai < 2; ++ai)
#pragma unroll
            for (int m = 0; m < 4; ++m) { unsigned char* rowp = O + (size_t)(row0 + ai * HALF + m * 16) * 1024 + col0;
#pragma unroll
                for (int bj = 0; bj < 2; ++bj) { const f32x4 v0 = acc[ai][bj][m][0] * W8_INV, v1 = acc[ai][bj][m][1] * W8_INV;
                    u32x2 w; w.x = pk4_fp8(v0[0], v0[1], v0[2], v0[3]); w.y = pk4_fp8(v1[0], v1[1], v1[2], v1[3]);
                    *(u32x2*)(rowp + bj * HALF) = w; } }
    }
};
}

struct Params { const float* in[22]; float* out; unsigned char* ws; };
enum { I_X = 0, I_C, I_ADAW, I_ADAB, I_N1G, I_N2G, I_WIN, I_WOUT, I_LBL, I_HGG, I_RETG, I_CONVW, I_ALOG, I_DTB, I_GDNG, I_RW, I_RB, I_W1, I_B1, I_W2, I_B2, I_FNG };

struct Frame {
    LAS unsigned char* lds;
    int tid, lane, wave, wave0, G, bid;
    unsigned char* ws;
    unsigned* ctl;
};
extern __shared__ __attribute__((aligned(16))) unsigned char lds_raw[];
constexpr int LDS_PAR = LDSCTL_OFF + 512;
__device__ __forceinline__ unsigned long long ldpar(LAS unsigned char* lds, int i) {
    const u32x2 v = *(const LAS u32x2*)(lds + LDS_PAR + 8 * i);
    return ((unsigned long long)(unsigned)__builtin_amdgcn_readfirstlane((int)v.y) << 32) | (unsigned)__builtin_amdgcn_readfirstlane((int)v.x);
}
__device__ __forceinline__ const float* pin(const Frame& F, int i) { return (const float*)(const GAS float*)ldpar(F.lds, i); }
__device__ __forceinline__ float* pout(const Frame& F) { return (float*)(GAS float*)ldpar(F.lds, 22); }
__device__ __forceinline__ int lane_id_opaque() { int ln; asm volatile("v_mbcnt_lo_u32_b32 %0, -1, 0\n\tv_mbcnt_hi_u32_b32 %0, -1, %0" : "=v"(ln)); return ln; }
__device__ __forceinline__ Frame make_frame(int wave0) {
    Frame F; F.lds = (LAS unsigned char*)lds_raw;
    const int ln = lane_id_opaque();
    int w = wave0; asm volatile("" : "+s"(w));
    F.tid = w * 64 + ln; F.lane = ln; F.wave = w; F.wave0 = w;
    int g = gridDim.x, bi = blockIdx.x; asm volatile("" : "+s"(g), "+s"(bi));
    unsigned long long wsp = ldpar(F.lds, 23); asm volatile("" : "+s"(wsp));
    F.G = g; F.bid = bi; F.ws = (unsigned char*)(GAS unsigned char*)wsp; F.ctl = (unsigned*)(F.ws + WS_CTL);
    return F;
}

template <bool F8>
__device__ __forceinline__ void p0_transpose_item(const float* W, int ld, int ncol, void* WTv, LAS float* scr, int item, int lane) {
    const int nblk = ncol / 32, kb = item / nblk, nb = item % nblk, k0 = 64 * kb, n0 = 32 * nb;
    f32x4 v[8];
#pragma unroll
    for (int i = 0; i < 8; ++i) v[i] = __builtin_nontemporal_load((const f32x4*)(W + (size_t)(k0 + 8 * i + (lane >> 3)) * ld + n0 + 4 * (lane & 7)));
#pragma unroll
    for (int i = 0; i < 8; ++i) { LAS float* d = scr + (8 * i + (lane >> 3)) * 33 + 4 * (lane & 7); d[0] = v[i][0]; d[1] = v[i][1]; d[2] = v[i][2]; d[3] = v[i][3]; }
    LDS_WAIT(); asm volatile("" ::: "memory");
    const int c = lane & 7;
#pragma unroll
    for (int j = 0; j < 4; ++j) { const int n = (lane >> 3) + 8 * j; const LAS float* s = scr + (8 * c) * 33 + n;
        if constexpr (F8) { u32x2 o; o.x = pk4_fp8(s[0 * 33] * W8_SCALE, s[1 * 33] * W8_SCALE, s[2 * 33] * W8_SCALE, s[3 * 33] * W8_SCALE); o.y = pk4_fp8(s[4 * 33] * W8_SCALE, s[5 * 33] * W8_SCALE, s[6 * 33] * W8_SCALE, s[7 * 33] * W8_SCALE);
            *(u32x2*)((unsigned char*)WTv + (size_t)(n0 + n) * 1024 + k0 + 8 * c) = o; }
        else { u32x4 o; o.x = pk2(s[0 * 33], s[1 * 33]); o.y = pk2(s[2 * 33], s[3 * 33]); o.z = pk2(s[4 * 33], s[5 * 33]); o.w = pk2(s[6 * 33], s[7 * 33]);
            *(u32x4*)((bf16*)WTv + (size_t)(n0 + n) * 1024 + k0 + 8 * c) = o; } }
    LDS_WAIT(); asm volatile("" ::: "memory");
}
__device__ __forceinline__ void phase0(Frame& F) {
    if (F.bid < 96) {
        LAS float* cs = (LAS float*)(F.lds);
        LAS float* part = (LAS float*)(F.lds + 16384);
        const float* c = pin(F, I_C);
        for (int i = F.tid; i < 4096; i += 512) cs[i] = siluf(c[i]);
        __syncthreads();
        const int cb = F.bid * 128, l = cb / 6144, j0 = cb % 6144;
        const int cg = F.wave & 1, kq = F.wave >> 1, j = j0 + cg * 64 + F.lane;
        const float* aw = pin(F, I_ADAW) + (size_t)l * 1024 * 6144 + j;
        float a0 = 0.f, a1 = 0.f, a2 = 0.f, a3 = 0.f;
#pragma unroll 8
        for (int k = kq * 256; k < kq * 256 + 256; ++k) { const float w = aw[(size_t)k * 6144]; a0 += cs[k] * w; a1 += cs[1024 + k] * w; a2 += cs[2048 + k] * w; a3 += cs[3072 + k] * w; }
        part[(kq * 4 + 0) * 128 + cg * 64 + F.lane] = a0; part[(kq * 4 + 1) * 128 + cg * 64 + F.lane] = a1;
        part[(kq * 4 + 2) * 128 + cg * 64 + F.lane] = a2; part[(kq * 4 + 3) * 128 + cg * 64 + F.lane] = a3;
        __syncthreads();
        { const int b = F.tid >> 7, jj = F.tid & 127;
          const float s = part[(0 * 4 + b) * 128 + jj] + part[(1 * 4 + b) * 128 + jj] + part[(2 * 4 + b) * 128 + jj] + part[(3 * 4 + b) * 128 + jj] + pin(F, I_ADAB)[l * 6144 + j0 + jj];
          ((float*)(F.ws + WS_MOD))[(size_t)(l * 4 + b) * 6144 + j0 + jj] = s; }
        __syncthreads();
    }
    if (F.bid == 96) {
        const float* lg = pin(F, I_LBL); float* lb = (float*)(F.ws + WS_LB);
        { const int i = F.tid; const float l0 = lg[i], l1 = lg[512 + i]; lb[i] = 0.f; lb[512 + i] = fmaxf(1.0f / (1.0f + __expf(l0 - l1)), 0.f); }
    }
    if (F.bid == 97 && F.tid < 32) ((double*)(F.ws + WS_ROPE))[F.tid] = exp(-(double)F.tid / 31.0 * 9.210340371976184) * 0.15915494309189535;
    LAS float* scr = (LAS float*)(F.lds + 32768 + F.wave * 12288);
    const int gw = F.bid * 8 + F.wave, NGW = F.G * 8;
    constexpr int I_IN = 16 * 128, I_OUT = 16 * 32, I_1 = 16 * 64, I_2 = 16 * 32;
    constexpr int N_IN = 2 * I_IN, N_OUT = 2 * I_OUT, N_1 = 64 * I_1, N_2 = 64 * I_2;
    const int NMOD = 96 * 8, NFREE = NGW - NMOD, X = (NGW > NMOD) ? 6 * NFREE : 0, N_TOT = N_IN + N_OUT + N_1 + N_2;
    const int nrounds = (F.bid >= 96 ? 6 : 0) + (N_TOT - X + NGW - 1) / NGW;
    for (int q = 0; q < nrounds; ++q) {
        int it;
        if (F.bid >= 96) it = (q < 6) ? (gw - NMOD) + NFREE * q : X + gw + NGW * (q - 6); else it = X + gw + NGW * q;
        if (it >= N_TOT) break;
        int r = it;
        if (r < N_IN) { const int m = r / I_IN; p0_transpose_item<false>(pin(F, I_WIN) + (size_t)m * 1024 * NIN, NIN, NZ, (bf16*)(F.ws + WS_WIN) + (size_t)m * NZ * 1024, scr, r % I_IN, F.lane); continue; } r -= N_IN;
        if (r < N_OUT) { const int m = r / I_OUT; p0_transpose_item<false>(pin(F, I_WOUT) + (size_t)m * 1024 * 1024, 1024, 1024, (bf16*)(F.ws + WS_WOUT) + (size_t)m * 1024 * 1024, scr, r % I_OUT, F.lane); continue; } r -= N_OUT;
        if (r < N_1) { const int m = r / I_1; p0_transpose_item<true>(pin(F, I_W1) + (size_t)m * 1024 * 2048, 2048, 2048, F.ws + WS_W1 + (size_t)m * 2048 * 1024, scr, r % I_1, F.lane); continue; } r -= N_1;
        { const int m = r / I_2; p0_transpose_item<true>(pin(F, I_W2) + (size_t)m * 1024 * 1024, 1024, 1024, F.ws + WS_W2 + (size_t)m * 1024 * 1024, scr, r % I_2, F.lane); }
    }
}

__device__ __forceinline__ void load_w8t(Frame& F, int l, LAS float* w8t) {
    const float* w = pin(F, I_WIN) + (size_t)l * 1024 * NIN + NZ;
    for (int i = F.tid; i < 8192; i += 512) { const int k = i >> 3, q = i & 7; w8t[q * 1024 + k] = w[(size_t)k * NIN + q]; }
}
__device__ __forceinline__ f32x4 unpack4_fp8(unsigned w) { const f32x2 a = __builtin_amdgcn_cvt_pk_f32_fp8((int)w, false), b = __builtin_amdgcn_cvt_pk_f32_fp8((int)w, true); return (f32x4){a[0], a[1], b[0], b[1]}; }
__device__ __forceinline__ f32x4 unpack4(u32x2 w) { return (f32x4){bflo(w.x), bfhi(w.x), bflo(w.y), bfhi(w.y)}; }
template <bool F8 = false>
__device__ __forceinline__ void norm_mod_emit(const f32x4 (&v)[4], const float* g, const float* sh, const float* sc, void* hrowv, int lane, f32x4 (&h)[4]) {
    float ss = 0.f;
#pragma unroll
    for (int j = 0; j < 4; ++j) ss += (v[j].x * v[j].x + v[j].y * v[j].y) + (v[j].z * v[j].z + v[j].w * v[j].w);
    const float r = rsqrtf(wave_sum(ss) * (1.0f / 1024.0f) + NORM_EPS);
#pragma unroll
    for (int j = 0; j < 4; ++j) { const int col = 256 * j + 4 * lane;
        const f32x4 gg = *(const f32x4*)(g + col), s1 = *(const f32x4*)(sc + col), s0 = *(const f32x4*)(sh + col);
        h[j] = (v[j] * r) * gg * (s1 + 1.0f) + s0;
        if constexpr (F8) *(unsigned*)((unsigned char*)hrowv + col) = pk4_fp8(h[j].x, h[j].y, h[j].z, h[j].w);
        else { u32x2 w; w.x = pk2(h[j].x, h[j].y); w.y = pk2(h[j].z, h[j].w); *(u32x2*)((bf16*)hrowv + col) = w; } }
}
__device__ __forceinline__ void emit_gab(const f32x4 (&h)[4], const LAS float* w8t, float* gabrow, int lane) {
    float a[8];
#pragma unroll
    for (int q = 0; q < 8; ++q) { float s = 0.f;
#pragma unroll
        for (int j = 0; j < 4; ++j) { const f32x4 w = *(const LAS f32x4*)(w8t + q * 1024 + 256 * j + 4 * lane); s += (h[j].x * w.x + h[j].y * w.y) + (h[j].z * w.z + h[j].w * w.w); }
        a[q] = wave_sum(s); }
    if (lane == 0) { *(f32x4*)gabrow = (f32x4){a[0], a[1], a[2], a[3]}; *(f32x4*)(gabrow + 4) = (f32x4){a[4], a[5], a[6], a[7]}; }
}

__device__ __forceinline__ void phase_norm1_first(Frame& F) {
    LAS float* w8t = (LAS float*)F.lds;
    LAS float* GS = (LAS float*)(F.lds + 32768); LAS float* SH = GS + 1024;
    const float* mod = (const float*)(F.ws + WS_MOD);
    const int gw = F.bid * 8 + F.wave, NGW = F.G * 8, RPW = NTOK / NGW, row0 = gw * RPW, rend = row0 + RPW;
    f32x4 vn[4];
    { const f32x4* xr = (const f32x4*)(pin(F, I_X) + (size_t)row0 * 1024) + F.lane;
#pragma unroll
      for (int j = 0; j < 4; ++j) vn[j] = __builtin_nontemporal_load(xr + 64 * j); }
    load_w8t(F, 0, w8t);
    if (F.tid < 256) { const int bb = (F.bid * 8 * RPW) >> 13, col = 4 * F.tid; const float* mp = mod + (size_t)bb * 6144;
        *(LAS f32x4*)(GS + col) = *(const f32x4*)(pin(F, I_N1G) + col) * (*(const f32x4*)(mp + 1024 + col) + 1.0f); *(LAS f32x4*)(SH + col) = *(const f32x4*)(mp + col); }
    lds_barrier();
#pragma unroll 1
    for (int row = row0; row < rend; ++row) {
        int ml = 4 * F.lane; asm volatile("" : "+v"(ml));
        f32x4 v[4], h[4];
#pragma unroll
        for (int j = 0; j < 4; ++j) v[j] = vn[j];
        if (row + 1 < rend) { const f32x4* xr = (const f32x4*)(pin(F, I_X) + (size_t)(row + 1) * 1024) + F.lane;
#pragma unroll
            for (int j = 0; j < 4; ++j) vn[j] = __builtin_nontemporal_load(xr + 64 * j); }
        float ss = 0.f;
#pragma unroll
        for (int j = 0; j < 4; ++j) ss += (v[j].x * v[j].x + v[j].y * v[j].y) + (v[j].z * v[j].z + v[j].w * v[j].w);
        const float r = rsqrtf(wave_sum(ss) * (1.0f / 1024.0f) + NORM_EPS);
        bf16* hrow = (bf16*)(F.ws + WS_HN) + (size_t)row * 1024;
#pragma unroll
        for (int j = 0; j < 4; ++j) { h[j] = (v[j] * r) * *(const LAS f32x4*)(GS + 256 * j + ml) + *(const LAS f32x4*)(SH + 256 * j + ml);
            u32x2 w; w.x = pk2(h[j].x, h[j].y); w.y = pk2(h[j].z, h[j].w); *(u32x2*)(hrow + 256 * j + 4 * F.lane) = w; }
        emit_gab(h, w8t, (float*)(F.ws + WS_GAB) + (size_t)row * 8, F.lane);
    }
    __syncthreads();
}

__device__ __forceinline__ void hgrn_naive(Frame& F, int l, int b, int h) {
    LAS float* Fg = (LAS float*)F.lds;
    LAS float* Kk = Fg + 2048, *Qq = Kk + 2048, *Vv = Qq + 2048, *Gt = Vv + 2048, *Pp = Gt + 2048;
    const bf16* z = (const bf16*)(F.ws + WS_R1);
    const float* lb = (const float*)(F.ws + WS_LB) + l * 512 + h * 128;
    const float* gn = pin(F, I_HGG) + l * 512 + h * 128;
    bf16* om = (bf16*)(F.ws + WS_OMIX);
    const int e = F.tid & 127, dq = F.tid >> 7;
    float S[32];
#pragma unroll
    for (int j = 0; j < 32; ++j) S[j] = 0.f;
    for (int t0 = 0; t0 < SEQ; t0 += 16) {
#pragma unroll
        for (int i = 0; i < 4; ++i) { const int idx = F.tid + 512 * i, tt = idx >> 7, d = idx & 127;
            const bf16* zr = z + (size_t)(b * SEQ + t0 + tt) * NZ + h * 128 + d;
            const float q = bf2f(zr[0]), fl = bf2f(zr[512]), vv = bf2f(zr[1024]), gt = bf2f(zr[1536]);
            const float lbd = lb[d], f = lbd + (1.0f - lbd) * sigm(fl);
            Fg[idx] = f; Kk[idx] = 1.0f - f; Qq[idx] = siluf(q); Vv[idx] = vv; Gt[idx] = siluf(gt); }
        __syncthreads();
        for (int tt = 0; tt < 16; ++tt) { const float vv = Vv[tt * 128 + e]; float acc = 0.f;
#pragma unroll
            for (int j4 = 0; j4 < 8; ++j4) { const int d = tt * 128 + 32 * dq + 4 * j4;
                const f32x4 ff = *(const LAS f32x4*)(Fg + d), kk = *(const LAS f32x4*)(Kk + d), qq = *(const LAS f32x4*)(Qq + d);
#pragma unroll
                for (int i = 0; i < 4; ++i) { S[4 * j4 + i] = ff[i] * S[4 * j4 + i] + kk[i] * vv; acc += S[4 * j4 + i] * qq[i]; }
                if ((j4 & 1) == 1) __builtin_amdgcn_sched_barrier(0); }
            Pp[(dq * 16 + tt) * 128 + e] = acc; }
        __syncthreads();
#pragma unroll
        for (int r = 0; r < 2; ++r) { const int tt = 2 * F.wave + r;
            float o0 = 0.f, o1 = 0.f;
#pragma unroll
            for (int q = 0; q < 4; ++q) { o0 += Pp[(q * 16 + tt) * 128 + F.lane]; o1 += Pp[(q * 16 + tt) * 128 + 64 + F.lane]; }
            const float rr = rsqrtf(wave_sum(o0 * o0 + o1 * o1) * (1.0f / 128.0f) + NORM_EPS);
            bf16* orow = om + (size_t)(b * SEQ + t0 + tt) * 1024 + h * 128;
            orow[F.lane] = (bf16)f2bf(o0 * rr * gn[F.lane] * Gt[tt * 128 + F.lane]);
            orow[64 + F.lane] = (bf16)f2bf(o1 * rr * gn[64 + F.lane] * Gt[tt * 128 + 64 + F.lane]); }
        __syncthreads();
    }
}
__device__ __forceinline__ void ret_naive(Frame& F, int l, int b, int h) {
    LAS float* Kk = (LAS float*)F.lds;
    LAS float* Qq = Kk + 1024, *Vv = Qq + 1024, *Gt = Vv + 1024, *Pp = Gt + 1024;
    const bf16* z = (const bf16*)(F.ws + WS_R1);
    const float* gn = pin(F, I_RETG) + l * 256 + h * 64;
    bf16* om = (bf16*)(F.ws + WS_OMIX);
    const int e = F.tid & 63, dq = F.tid >> 6;
    const float gamma = 1.0f - exp2f(-5.0f - (float)h);
    float S[8];
#pragma unroll
    for (int j = 0; j < 8; ++j) S[j] = 0.f;
    const int ri = F.tid & 31, rtt = F.tid >> 5;
    const double inv_rev = ((const double*)(F.ws + WS_ROPE))[ri];
    for (int t0 = 0; t0 < SEQ; t0 += 16) {
        { const bf16* zr = z + (size_t)(b * SEQ + t0 + rtt) * NZ + 2048 + h * 64 + ri;
          const float q1 = bf2f(zr[0]), q2 = bf2f(zr[32]), k1 = bf2f(zr[256]) * 0.125f, k2 = bf2f(zr[256 + 32]) * 0.125f;
          double rev = (double)(t0 + rtt) * inv_rev; rev -= floor(rev);
          const float ang = (float)rev * 6.283185307179586f; float sn, cs; __sincosf(ang, &sn, &cs);
          Qq[rtt * 64 + ri] = q1 * cs - q2 * sn; Qq[rtt * 64 + 32 + ri] = q1 * sn + q2 * cs;
          Kk[rtt * 64 + ri] = k1 * cs - k2 * sn; Kk[rtt * 64 + 32 + ri] = k1 * sn + k2 * cs; }
#pragma unroll
        for (int i = 0; i < 2; ++i) { const int idx = F.tid + 512 * i, tt = idx >> 6, d = idx & 63;
            const bf16* zr = z + (size_t)(b * SEQ + t0 + tt) * NZ + 2048 + h * 64 + d;
            Vv[idx] = bf2f(zr[512]); Gt[idx] = siluf(bf2f(zr[768])); }
        __syncthreads();
        for (int tt = 0; tt < 16; ++tt) { const float vv = Vv[tt * 64 + e]; float acc = 0.f;
#pragma unroll
            for (int j4 = 0; j4 < 2; ++j4) { const int d = tt * 64 + 8 * dq + 4 * j4;
                const f32x4 kk = *(const LAS f32x4*)(Kk + d), qq = *(const LAS f32x4*)(Qq + d);
#pragma unroll
                for (int i = 0; i < 4; ++i) { S[4 * j4 + i] = gamma * S[4 * j4 + i] + kk[i] * vv; acc += S[4 * j4 + i] * qq[i]; } }
            Pp[(dq * 16 + tt) * 64 + e] = acc; }
        __syncthreads();
#pragma unroll
        for (int r = 0; r < 2; ++r) { const int tt = 2 * F.wave + r;
            float o = 0.f;
#pragma unroll
            for (int q = 0; q < 8; ++q) o += Pp[(q * 16 + tt) * 64 + F.lane];
            const float rr = rsqrtf(wave_sum(o * o) * (1.0f / 64.0f) + NORM_EPS);
            om[(size_t)(b * SEQ + t0 + tt) * 1024 + 512 + h * 64 + F.lane] = (bf16)f2bf(o * rr * gn[F.lane] * Gt[tt * 64 + F.lane]); }
        __syncthreads();
    }
}
__device__ __forceinline__ void gdn_naive(Frame& F, int l, int b, int h) {
    LAS float* Kk = (LAS float*)F.lds;
    LAS float* Qq = Kk + 1024, *Vv = Qq + 1024, *Gt = Vv + 1024, *AB = Gt + 1024;
    const bf16* z = (const bf16*)(F.ws + WS_R1);
    const float* gab = (const float*)(F.ws + WS_GAB);
    const float* gn = pin(F, I_GDNG) + l * 256 + h * 64;
    const float* cw = pin(F, I_CONVW) + (size_t)l * 4 * 768;
    const float Aexp = __expf(pin(F, I_ALOG)[l * 4 + h]), dtb = pin(F, I_DTB)[l * 4 + h];
    bf16* om = (bf16*)(F.ws + WS_OMIX);
    float S[32];
#pragma unroll
    for (int j = 0; j < 32; ++j) S[j] = 0.f;
    const int ge = 32 * (F.wave & 1) + (F.lane & 31), gdh = F.lane >> 5;
    for (int t0 = 0; t0 < SEQ; t0 += 16) {
#pragma unroll
        for (int i = 0; i < 6; ++i) { const int idx = F.tid + 512 * i, tt = idx / 192, rem = idx % 192, which = rem >> 6, d = rem & 63;
            const int ch = which * 256 + h * 64 + d, t = t0 + tt; float u = 0.f;
#pragma unroll
            for (int j = 0; j < 4; ++j) { const int ts = t - 3 + j; if (ts >= 0) u += cw[j * 768 + ch] * bf2f(z[(size_t)(b * SEQ + ts) * NZ + 3072 + ch]); }
            const float a = siluf(u);
            if (which == 0) Qq[tt * 64 + d] = a; else if (which == 1) Kk[tt * 64 + d] = a; else Vv[tt * 64 + d] = a; }
#pragma unroll
        for (int i = 0; i < 2; ++i) { const int idx = F.tid + 512 * i, tt = idx >> 6, d = idx & 63;
            Gt[idx] = siluf(bf2f(z[(size_t)(b * SEQ + t0 + tt) * NZ + 3840 + h * 64 + d])); }
        if (F.tid < 16) { const float* gr = gab + (size_t)(b * SEQ + t0 + F.tid) * 8;
            const float xa = gr[h] + dtb, sp = (xa > 20.f) ? xa : log1pf(__expf(xa));
            AB[F.tid * 2] = __expf(-Aexp * sp); AB[F.tid * 2 + 1] = sigm(gr[4 + h]); }
        __syncthreads();
#pragma unroll
        for (int r = 0; r < 4; ++r) { const int vi = F.wave * 4 + r, tt = vi & 15; LAS float* arr = (vi < 16) ? Qq : Kk;
            const float x = arr[tt * 64 + F.lane]; const float rr = rsqrtf(wave_sum(x * x) + 1e-6f);
            arr[tt * 64 + F.lane] = x * rr * ((vi < 16) ? 0.125f : 1.0f); }
        __syncthreads();
        LAS float* Oo = AB + 64;
        if (F.wave < 2) {
            for (int tt = 0; tt < 16; ++tt) { const float vv = Vv[tt * 64 + ge], al = AB[tt * 2], be = AB[tt * 2 + 1];
                float u = 0.f;
#pragma unroll
                for (int j4 = 0; j4 < 8; ++j4) { const f32x4 kk = *(const LAS f32x4*)(Kk + tt * 64 + 32 * gdh + 4 * j4);
#pragma unroll
                    for (int i = 0; i < 4; ++i) u += S[4 * j4 + i] * kk[i]; }
                u += shx(u, 32, F.lane);
                const float w = be * (vv - al * u); float o = 0.f;
#pragma unroll
                for (int j4 = 0; j4 < 8; ++j4) { const f32x4 kk = *(const LAS f32x4*)(Kk + tt * 64 + 32 * gdh + 4 * j4), qq = *(const LAS f32x4*)(Qq + tt * 64 + 32 * gdh + 4 * j4);
#pragma unroll
                    for (int i = 0; i < 4; ++i) { S[4 * j4 + i] = al * S[4 * j4 + i] + kk[i] * w; o += S[4 * j4 + i] * qq[i]; }
                    if ((j4 & 1) == 1) __builtin_amdgcn_sched_barrier(0); }
                o += shx(o, 32, F.lane);
                if (gdh == 0) Oo[tt * 64 + ge] = o; }
        }
        __syncthreads();
#pragma unroll
        for (int r = 0; r < 2; ++r) { const int tt = 2 * F.wave + r; const float o = Oo[tt * 64 + F.lane];
            const float rr = rsqrtf(wave_sum(o * o) * (1.0f / 64.0f) + NORM_EPS);
            om[(size_t)(b * SEQ + t0 + tt) * 1024 + 768 + h * 64 + F.lane] = (bf16)f2bf(o * rr * gn[F.lane] * Gt[tt * 64 + F.lane]); }
        __syncthreads();
    }
}
__device__ __forceinline__ void phase_mix_naive(Frame& F, int l) {
    if (F.bid < 48) {
        const int u = F.bid, kind = u >> 4, b = (u >> 2) & 3, h = u & 3;
#ifdef NAIVE_HG
        if (kind == 0) hgrn_naive(F, l, b, h);
#endif
#ifdef NAIVE_RT
        if (kind == 1) ret_naive(F, l, b, h);
#endif
#ifndef NO_GD
        if (kind == 2) gdn_naive(F, l, b, h);
#endif
    }
}

#define MFMA16(a, b, c) __builtin_amdgcn_mfma_f32_16x16x32_bf16((a), (b), (c), 0, 0, 0)
__device__ __forceinline__ bf16x8 lfrag(const LAS bf16* base, int ld, int row, int k) { return *(const LAS bf16x8*)(base + row * ld + k); }
__device__ __forceinline__ bf16x8 gfrag(const bf16* base, int ld, int row, int k) { return *(const bf16x8*)(base + (size_t)row * ld + k); }
constexpr int GL_QS = 0, GL_KH = 17408, GL_VT = 34816, GL_SC = 53248, GL_KDT = 62464, GL_RAW = 80896, GL_STL = 84992, GL_DECL = 121600, GL_RS = 122112;

struct HgRaw { unsigned q[8], f[8], v[8]; };
template <bool NEED_Q>
__device__ __forceinline__ void hg_issue(Frame& F, int b, int n, int h, HgRaw& r) {
    const bf16* z = (const bf16*)(F.ws + WS_R1) + (size_t)(b * SEQ + n * 64 + 8 * F.wave) * NZ + h * 128;
#pragma unroll
    for (int i = 0; i < 8; ++i) { const unsigned* zr = (const unsigned*)(z + (size_t)i * NZ) + F.lane;
        r.q[i] = NEED_Q ? __builtin_nontemporal_load(zr) : 0u; r.f[i] = __builtin_nontemporal_load(zr + 256); r.v[i] = __builtin_nontemporal_load(zr + 512); }
}
constexpr int GL_RSTL = 71680;
constexpr int GL_GNH = 122624, GL_GNR = 123136, GL_GNG = 123392, GL_LB = 123648;
constexpr int GL_BP = GL_RAW;
template <int MODE>
__device__ __forceinline__ void hg_prep(Frame& F, int l, int h, const HgRaw& r) {
    constexpr bool m3 = (MODE == 2);
    constexpr int LQ = 136, LT = 72;
    LAS bf16* QS = (LAS bf16*)(F.lds + GL_QS); LAS bf16* KH = (LAS bf16*)(F.lds + GL_KH); LAS bf16* VT = (LAS bf16*)(F.lds + GL_VT); LAS bf16* KDT = (LAS bf16*)(F.lds + GL_KDT);
    LAS float* BP = (LAS float*)(F.lds + GL_BP); LAS float* DECL = (LAS float*)(F.lds + GL_DECL);
    const int j = F.lane, w = F.wave;
    const f32x2 lb2 = *(const LAS f32x2*)(F.lds + GL_LB + 8 * j);
    float kx[2][8], pp[2][8], sx[2][8];
#pragma unroll
    for (int hh = 0; hh < 2; ++hh) { const float om = 1.0f - lb2[hh];
#pragma unroll
        for (int i = 0; i < 8; ++i) { const float fl = hh ? bfhi(r.f[i]) : bflo(r.f[i]); const float k = om * sigm(-fl); kx[hh][i] = k;
            const float f = fmaxf(1.0f - k, 4.0e-18f); pp[hh][i] = (i == 0) ? f : pp[hh][i - 1] * f; }
#pragma unroll
        for (int i = 7; i >= 0; --i) { const float fl = hh ? bfhi(r.f[i]) : bflo(r.f[i]); (void)fl; sx[hh][i] = (i == 7) ? 1.0f : sx[hh][i + 1] * fmaxf(1.0f - kx[hh][i + 1], 4.0e-18f); }
        BP[w * 128 + 2 * j + hh] = pp[hh][7]; }
    { u32x4 v0, v1;
      v0.x = (r.v[0] & 0xffffu) | (r.v[1] << 16); v0.y = (r.v[2] & 0xffffu) | (r.v[3] << 16); v0.z = (r.v[4] & 0xffffu) | (r.v[5] << 16); v0.w = (r.v[6] & 0xffffu) | (r.v[7] << 16);
      v1.x = (r.v[0] >> 16) | (r.v[1] & 0xffff0000u); v1.y = (r.v[2] >> 16) | (r.v[3] & 0xffff0000u); v1.z = (r.v[4] >> 16) | (r.v[5] & 0xffff0000u); v1.w = (r.v[6] >> 16) | (r.v[7] & 0xffff0000u);
      *(LAS u32x4*)(VT + (2 * j) * LT + 8 * w) = v0; *(LAS u32x4*)(VT + (2 * j + 1) * LT + 8 * w) = v1; }
    lds_barrier();
    float pre[2], post[2];
#pragma unroll
    for (int hh = 0; hh < 2; ++hh) { float a = 1.0f, c = 1.0f;
#pragma unroll
        for (int ww = 0; ww < 8; ++ww) { const float bp = BP[ww * 128 + 2 * j + hh]; a *= (ww < w) ? bp : 1.0f; c *= (ww > w) ? bp : 1.0f; }
        pre[hh] = a; post[hh] = c;
        if (w == 7) DECL[2 * j + hh] = a * pp[hh][7]; }
    if (m3) {
#pragma unroll
        for (int i = 0; i < 8; ++i) { float qs[2], kh[2];
#pragma unroll
            for (int hh = 0; hh < 2; ++hh) { const float q = hh ? bfhi(r.q[i]) : bflo(r.q[i]); const float P = pre[hh] * pp[hh][i];
                qs[hh] = siluf(q) * P; kh[hh] = kx[hh][i] * fminf(__builtin_amdgcn_rcpf(P), 5.5e34f); }
            *(LAS unsigned*)(QS + (8 * w + i) * LQ + 2 * j) = pk2(qs[0], qs[1]); *(LAS unsigned*)(KH + (8 * w + i) * LQ + 2 * j) = pk2(kh[0], kh[1]); }
    }
    {
#pragma unroll
        for (int hh = 0; hh < 2; ++hh) { float kd[8];
#pragma unroll
            for (int i = 0; i < 8; ++i) kd[i] = kx[hh][i] * sx[hh][i] * post[hh];
            u32x4 wv; wv.x = pk2(kd[0], kd[1]); wv.y = pk2(kd[2], kd[3]); wv.z = pk2(kd[4], kd[5]); wv.w = pk2(kd[6], kd[7]);
            *(LAS u32x4*)(KDT + (2 * j + hh) * LT + 8 * w) = wv; }
    }
    lds_barrier();
}
struct RtRaw { unsigned q[4], k[4], v[4]; };
template <bool NEED_Q>
__device__ __forceinline__ void rt_issue(Frame& F, int b, int n, int h, RtRaw& r) {
    const bf16* z = (const bf16*)(F.ws + WS_R1) + (size_t)(b * SEQ + n * 64) * NZ + 2048 + h * 64;
#pragma unroll
    for (int i = 0; i < 4; ++i) { const int idx = F.tid + 512 * i, t = idx >> 5, j = idx & 31;
        const unsigned* zr = (const unsigned*)(z + (size_t)t * NZ) + j;
        r.q[i] = NEED_Q ? __builtin_nontemporal_load(zr) : 0u; r.k[i] = __builtin_nontemporal_load(zr + 128); r.v[i] = __builtin_nontemporal_load(zr + 256); }
}
template <bool NEED_Q>
__device__ __forceinline__ void rt_stage(Frame& F, const RtRaw& r) {
    LAS unsigned* RQ = (LAS unsigned*)(F.lds + GL_RAW); LAS unsigned* RK = RQ + 64 * 33; LAS unsigned* RV = RK + 64 * 33;
#pragma unroll
    for (int i = 0; i < 4; ++i) { const int idx = F.tid + 512 * i, t = idx >> 5, j = idx & 31;
        if (NEED_Q) RQ[t * 33 + j] = r.q[i]; RK[t * 33 + j] = r.k[i]; RV[t * 33 + j] = r.v[i]; }
}
template <int MODE>
__device__ __forceinline__ void rt_prep(Frame& F, int n, int h) {
    constexpr bool m3 = (MODE == 2);
    constexpr int LQ = 72, LT = 72;
    LAS bf16* QS = (LAS bf16*)(F.lds + GL_QS); LAS bf16* KH = (LAS bf16*)(F.lds + GL_KH); LAS bf16* VT = (LAS bf16*)(F.lds + GL_VT); LAS bf16* KDT = (LAS bf16*)(F.lds + GL_KDT);
    LAS unsigned* RQ = (LAS unsigned*)(F.lds + GL_RAW); LAS unsigned* RK = RQ + 64 * 33; LAS unsigned* RV = RK + 64 * 33;
    const int t = F.lane;
    const float lg = log1pf(-exp2f(-5.0f - (float)h));
    const float bt = (float)(t + 1) * lg, eq = __expf(bt), ekh = __expf(-bt) * 0.125f, ekd = __expf(64.0f * lg - bt) * 0.125f;
    const double* ropet = (const double*)(F.ws + WS_ROPE);
    const LAS bf16* rq = (const LAS bf16*)RQ; const LAS bf16* rk = (const LAS bf16*)RK; const LAS bf16* rv = (const LAS bf16*)RV;
    float qa4[4], qb4[4], ka4[4], kb4[4];
#pragma unroll
    for (int i = 0; i < 4; ++i) { const int ri = F.wave * 4 + i;
        double rev = (double)(n * 64 + t) * ropet[ri]; rev -= floor(rev);
        float sn, cs; __sincosf((float)rev * 6.283185307179586f, &sn, &cs);
        const float q1 = bf2f(rq[t * 66 + ri]), q2 = bf2f(rq[t * 66 + 32 + ri]), k1 = bf2f(rk[t * 66 + ri]), k2 = bf2f(rk[t * 66 + 32 + ri]);
        const float qa = q1 * cs - q2 * sn, qb = q1 * sn + q2 * cs, ka = k1 * cs - k2 * sn, kb = k1 * sn + k2 * cs;
        qa4[i] = qa * eq; qb4[i] = qb * eq; ka4[i] = ka * ekh; kb4[i] = kb * ekh;
        { KDT[ri * LT + t] = (bf16)f2bf(ka * ekd); KDT[(32 + ri) * LT + t] = (bf16)f2bf(kb * ekd); }
    }
    if (m3) { u32x2 w;
        w.x = pk2(qa4[0], qa4[1]); w.y = pk2(qa4[2], qa4[3]); *(LAS u32x2*)(QS + t * LQ + 4 * F.wave) = w;
        w.x = pk2(qb4[0], qb4[1]); w.y = pk2(qb4[2], qb4[3]); *(LAS u32x2*)(QS + t * LQ + 32 + 4 * F.wave) = w;
        w.x = pk2(ka4[0], ka4[1]); w.y = pk2(ka4[2], ka4[3]); *(LAS u32x2*)(KH + t * LQ + 4 * F.wave) = w;
        w.x = pk2(kb4[0], kb4[1]); w.y = pk2(kb4[2], kb4[3]); *(LAS u32x2*)(KH + t * LQ + 32 + 4 * F.wave) = w; }
#pragma unroll
    for (int i = 0; i < 8; ++i) { const int e = F.wave * 8 + i; VT[e * LT + t] = rv[t * 66 + e]; }
    lds_barrier();
}
template <int DK, int DV>
__device__ __forceinline__ void gla_m1_mma(Frame& F, bf16* kvt  ) {
    constexpr int LT = 72, NXT = DK / 16, NYT = DV / 16, PER = NXT * NYT / 8;
    const LAS bf16* KDT = (const LAS bf16*)(F.lds + GL_KDT); const LAS bf16* VT = (const LAS bf16*)(F.lds + GL_VT);
    const int fr = F.lane & 15, fq = F.lane >> 4;
    const int yt = (NYT == 8) ? F.wave : (F.wave & 3), xt0 = (NYT == 8) ? 0 : 2 * (F.wave >> 2);
    f32x4 acc[PER];
#pragma unroll
    for (int i = 0; i < PER; ++i) acc[i] = (f32x4){0.f, 0.f, 0.f, 0.f};
#pragma unroll
    for (int ks = 0; ks < 2; ++ks) { const bf16x8 yf = lfrag(VT, LT, yt * 16 + fr, 32 * ks + 8 * fq);
#pragma unroll
        for (int i = 0; i < PER; ++i) acc[i] = MFMA16(lfrag(KDT, LT, (xt0 + i) * 16 + fr, 32 * ks + 8 * fq), yf, acc[i]); }
#pragma unroll
    for (int i = 0; i < PER; ++i) { u32x2 w; w.x = pk2(acc[i][0], acc[i][1]); w.y = pk2(acc[i][2], acc[i][3]); *(u32x2*)(kvt + (size_t)(yt * 16 + fr) * DK + (xt0 + i) * 16 + 4 * fq) = w; }
}
__device__ __forceinline__ void hg_kv_acc(Frame& F, f32x4 (&kv)[8]) {
    const LAS bf16* KDT = (const LAS bf16*)(F.lds + GL_KDT); const LAS bf16* VT = (const LAS bf16*)(F.lds + GL_VT);
    const int fr = F.lane & 15, fq = F.lane >> 4;
#pragma unroll
    for (int i = 0; i < 8; ++i) kv[i] = (f32x4){0.f, 0.f, 0.f, 0.f};
#pragma unroll
    for (int ks = 0; ks < 2; ++ks) { const bf16x8 yf = lfrag(VT, 72, F.wave * 16 + fr, 32 * ks + 8 * fq);
#pragma unroll
        for (int i = 0; i < 8; ++i) kv[i] = MFMA16(lfrag(KDT, 72, i * 16 + fr, 32 * ks + 8 * fq), yf, kv[i]); }
}
__device__ __forceinline__ void rt_kv_acc(Frame& F, f32x4 (&kv)[2]) {
    const LAS bf16* KDT = (const LAS bf16*)(F.lds + GL_KDT); const LAS bf16* VT = (const LAS bf16*)(F.lds + GL_VT);
    const int fr = F.lane & 15, fq = F.lane >> 4, yt = F.wave & 3, xt0 = 2 * (F.wave >> 2);
    kv[0] = (f32x4){0.f, 0.f, 0.f, 0.f}; kv[1] = (f32x4){0.f, 0.f, 0.f, 0.f};
#pragma unroll
    for (int ks = 0; ks < 2; ++ks) { const bf16x8 yf = lfrag(VT, 72, yt * 16 + fr, 32 * ks + 8 * fq);
#pragma unroll
        for (int i = 0; i < 2; ++i) kv[i] = MFMA16(lfrag(KDT, 72, (xt0 + i) * 16 + fr, 32 * ks + 8 * fq), yf, kv[i]); }
}
template <int PER, int DV>
__device__ __forceinline__ void mix_out_epilogue(Frame& F, const f32x4 (&acc)[PER], const LAS float* gn, const u32x2 (&gwv)[PER], bf16* om) {
    LAS float* RS = (LAS float*)(F.lds + GL_RS);
    const int fr = F.lane & 15, fq = F.lane >> 4, tt = F.wave & 3, hi = F.wave >> 2;
    float ss = 0.f;
#pragma unroll
    for (int i = 0; i < PER; ++i) ss += (acc[i][0] * acc[i][0] + acc[i][1] * acc[i][1]) + (acc[i][2] * acc[i][2] + acc[i][3] * acc[i][3]);
    ss += shx(ss, 16, F.lane); ss += shx(ss, 32, F.lane);
    if (fq == 0) RS[hi * 64 + tt * 16 + fr] = ss;
    lds_barrier();
    const int t = tt * 16 + fr;
    const float rr = rsqrtf((RS[t] + RS[64 + t]) * (1.0f / (float)DV) + NORM_EPS);
#pragma unroll
    for (int i = 0; i < PER; ++i) { const int e = (PER * hi + i) * 16 + 4 * fq;
        const u32x2 gw = gwv[i]; const f32x4 g4 = *(const LAS f32x4*)(gn + e);
        const float o0 = acc[i][0] * rr * g4[0] * siluf(bflo(gw.x)), o1 = acc[i][1] * rr * g4[1] * siluf(bfhi(gw.x)), o2 = acc[i][2] * rr * g4[2] * siluf(bflo(gw.y)), o3 = acc[i][3] * rr * g4[3] * siluf(bfhi(gw.y));
        u32x2 w; w.x = pk2(o0, o1); w.y = pk2(o2, o3); *(u32x2*)(om + (size_t)t * 1024 + e) = w; }
}
template <int DK, int DV>
__device__ __forceinline__ void gla_m3_loads(Frame& F, const bf16* spt, const bf16* zgate, bf16x8 (&sf)[DV / 32][DK / 32], u32x2 (&gw)[DV / 32]) {
    constexpr int KS = DK / 32, PER = DV / 32;
    const int fr = F.lane & 15, fq = F.lane >> 4, tt = F.wave & 3, hi = F.wave >> 2;
#pragma unroll
    for (int i = 0; i < PER; ++i) { gw[i] = *(const u32x2*)(zgate + (size_t)(tt * 16 + fr) * NZ + (PER * hi + i) * 16 + 4 * fq);
#pragma unroll
        for (int ks = 0; ks < KS; ++ks) sf[i][ks] = gfrag(spt, DK, (PER * hi + i) * 16 + fr, 32 * ks + 8 * fq); }
}
template <int DK, int DV, bool ST_LDS, int STO, class Mid>
__device__ __forceinline__ void gla_m3_mma(Frame& F, const bf16x8 (&sf)[DV / 32][DK / 32], const u32x2 (&gw)[DV / 32], const LAS float* gn  , bf16* om  , Mid mid) {
    constexpr int LQ = DK + 8, LT = 72, KS = DK / 32, PER = DV / 32;
    const LAS bf16* QS = (const LAS bf16*)(F.lds + GL_QS); const LAS bf16* KH = (const LAS bf16*)(F.lds + GL_KH); const LAS bf16* VT = (const LAS bf16*)(F.lds + GL_VT);
    LAS bf16* SC = (LAS bf16*)(F.lds + GL_SC); LAS float* RS = (LAS float*)(F.lds + GL_RS);
    const int fr = F.lane & 15, fq = F.lane >> 4, tt = F.wave & 3, hi = F.wave >> 2;
    {
        f32x4 a2[2] = {(f32x4){0.f, 0.f, 0.f, 0.f}, (f32x4){0.f, 0.f, 0.f, 0.f}};
#pragma unroll
        for (int ks = 0; ks < KS; ++ks) { const bf16x8 yf = lfrag(QS, LQ, tt * 16 + fr, 32 * ks + 8 * fq);
#pragma unroll
            for (int i = 0; i < 2; ++i) a2[i] = MFMA16(lfrag(KH, LQ, (2 * hi + i) * 16 + fr, 32 * ks + 8 * fq), yf, a2[i]); }
#pragma unroll
        for (int i = 0; i < 2; ++i) { const int t = tt * 16 + fr, s0 = (2 * hi + i) * 16 + 4 * fq; float v[4];
#pragma unroll
            for (int j = 0; j < 4; ++j) v[j] = (s0 + j <= t) ? a2[i][j] : 0.0f;
            u32x2 w; w.x = pk2(v[0], v[1]); w.y = pk2(v[2], v[3]); *(LAS u32x2*)(SC + t * LT + s0) = w; }
    }
    mid();
    lds_barrier();
    f32x4 acc[PER];
#pragma unroll
    for (int i = 0; i < PER; ++i) acc[i] = (f32x4){0.f, 0.f, 0.f, 0.f};
#pragma unroll
    for (int ks = 0; ks < 2; ++ks) { const bf16x8 yf = lfrag(SC, LT, tt * 16 + fr, 32 * ks + 8 * fq);
#pragma unroll
        for (int i = 0; i < PER; ++i) acc[i] = MFMA16(lfrag(VT, LT, (PER * hi + i) * 16 + fr, 32 * ks + 8 * fq), yf, acc[i]); }
#pragma unroll
    for (int ks = 0; ks < KS; ++ks) { const bf16x8 yf = lfrag(QS, LQ, tt * 16 + fr, 32 * ks + 8 * fq);
#pragma unroll
        for (int i = 0; i < PER; ++i) acc[i] = MFMA16(ST_LDS ? lfrag((const LAS bf16*)(F.lds + STO), DK + 8, (PER * hi + i) * 16 + fr, 32 * ks + 8 * fq) : sf[i][ks], yf, acc[i]); }
    mix_out_epilogue<PER, DV>(F, acc, gn, gw, om);
}
constexpr int GD_CW = 119552;
constexpr int GD_RAW = 0, GD_MM = 0, GD_CQ = 26112, GD_XT = 26112, GD_CK = 44544, GD_CV = 61184, GD_QN = 77824, GD_KN = 87040, GD_KDT = 96256, GD_QDL = 105472, GD_PART = 114688, GD_BV = 118784, GD_BK = 119040, GD_GC = 119296;
struct GdRaw { unsigned w[13]; float ga, gb; };
__device__ __forceinline__ void gdn_issue(Frame& F, int b, int n, int h, GdRaw& r) {
    const bf16* z = (const bf16*)(F.ws + WS_R1);
#pragma unroll
    for (int i = 0; i < 13; ++i) { const int idx = F.tid + 512 * i, rr = idx / 96, j = idx - rr * 96, seg = j >> 5, jj = j & 31, ts = n * 64 - 3 + rr;
        unsigned w = 0u; if (idx < 67 * 96 && ts >= 0) w = __builtin_nontemporal_load((const unsigned*)(z + (size_t)(b * SEQ + ts) * NZ + 3072 + seg * 256 + h * 64 + 2 * jj));
        r.w[i] = w; }
    const float* gr = (const float*)(F.ws + WS_GAB) + (size_t)(b * SEQ + n * 64 + F.lane) * 8;
    r.ga = gr[h]; r.gb = gr[4 + h];
}
__device__ __forceinline__ void gdn_stage(Frame& F, const GdRaw& r) {
    LAS unsigned* RAW = (LAS unsigned*)(F.lds + GD_RAW);
#pragma unroll
    for (int i = 0; i < 13; ++i) { const int idx = F.tid + 512 * i, rr = idx / 96, j = idx - rr * 96; if (idx < 67 * 96) RAW[rr * 97 + j] = r.w[i]; }
}
__device__ __forceinline__ void gdn_load_cw(Frame& F, int l, int h) {
    LAS float* CW = (LAS float*)(F.lds + GD_CW); const float* cw = pin(F, I_CONVW) + (size_t)l * 4 * 768;
    for (int i = F.tid; i < 768; i += 512) { const int j = i / 192, rem = i - j * 192, c = rem >> 1, p = rem & 1, seg = c >> 5, jj = c & 31; CW[i] = cw[j * 768 + seg * 256 + h * 64 + 2 * jj + p]; }
}
__device__ __forceinline__ void gdn_m1(Frame& F, int l, int h, int uid, const GdRaw& raw) {
    LAS unsigned* RAW = (LAS unsigned*)(F.lds + GD_RAW); LAS float* MM = (LAS float*)(F.lds + GD_MM);
    LAS float* CQ = (LAS float*)(F.lds + GD_CQ); LAS float* CK = (LAS float*)(F.lds + GD_CK); LAS float* CV = (LAS float*)(F.lds + GD_CV);
    LAS bf16* XT = (LAS bf16*)(F.lds + GD_XT); LAS bf16* QN = (LAS bf16*)(F.lds + GD_QN); LAS bf16* KN = (LAS bf16*)(F.lds + GD_KN);
    LAS bf16* KDT = (LAS bf16*)(F.lds + GD_KDT); LAS bf16* QDL = (LAS bf16*)(F.lds + GD_QDL);
    LAS float* PART = (LAS float*)(F.lds + GD_PART); LAS float* BV = (LAS float*)(F.lds + GD_BV); LAS float* BK = (LAS float*)(F.lds + GD_BK); LAS float* GCL = (LAS float*)(F.lds + GD_GC);
    const int t = F.lane;
    float gc, beta, gl;
    { const float Aexp = __expf(pin(F, I_ALOG)[l * 4 + h]), xa = raw.ga + pin(F, I_DTB)[l * 4 + h], sp = (xa > 20.f) ? xa : log1pf(__expf(xa));
      gc = wave_scan_incl(-Aexp * sp, F.lane); gl = __shfl(gc, 63); beta = sigm(raw.gb); }
    const LAS float* CW = (const LAS float*)(F.lds + GD_CW);
    float pq = 0.f, pk = 0.f;
#pragma unroll 2
    for (int i = 0; i < 12; ++i) { const int c = F.wave * 12 + i, seg = c >> 5, jj = c & 31;
        float u0 = 0.f, u1 = 0.f;
#pragma unroll
        for (int j = 0; j < 4; ++j) { const unsigned w = RAW[(t + j) * 97 + c]; const f32x2 cwv = *(const LAS f32x2*)(CW + (j * 96 + c) * 2); u0 += cwv[0] * bflo(w); u1 += cwv[1] * bfhi(w); }
        const float a0 = siluf(u0), a1 = siluf(u1);
        LAS float* dst = (seg == 0) ? CQ : ((seg == 1) ? CK : CV);
        dst[t * 65 + 2 * jj] = a0; dst[t * 65 + 2 * jj + 1] = a1;
        const float s2 = a0 * a0 + a1 * a1; pq += (seg == 0) ? s2 : 0.f; pk += (seg == 1) ? s2 : 0.f; }
    PART[(F.wave * 2 + 0) * 64 + t] = pq; PART[(F.wave * 2 + 1) * 64 + t] = pk;
    lds_barrier();
    { float sq = 0.f, sk = 0.f;
#pragma unroll
      for (int w = 0; w < 8; ++w) { sq += PART[(w * 2) * 64 + t]; sk += PART[(w * 2 + 1) * 64 + t]; }
      const float rq = rsqrtf(sq + 1e-6f) * 0.125f, rk = rsqrtf(sk + 1e-6f), eg = __expf(gc), ekd = __expf(gl - gc);
      float qn[8], kn[8];
#pragma unroll
      for (int i = 0; i < 8; ++i) { const int d = F.wave * 8 + i; qn[i] = CQ[t * 65 + d] * rq; kn[i] = CK[t * 65 + d] * rk; KDT[d * 72 + t] = (bf16)f2bf(kn[i] * ekd); CK[t * 65 + d] = kn[i]; }
      { u32x4 wq, wk, wd;
        wq.x = pk2(qn[0], qn[1]); wq.y = pk2(qn[2], qn[3]); wq.z = pk2(qn[4], qn[5]); wq.w = pk2(qn[6], qn[7]);
        wk.x = pk2(kn[0], kn[1]); wk.y = pk2(kn[2], kn[3]); wk.z = pk2(kn[4], kn[5]); wk.w = pk2(kn[6], kn[7]);
        wd.x = pk2(qn[0] * eg, qn[1] * eg); wd.y = pk2(qn[2] * eg, qn[3] * eg); wd.z = pk2(qn[4] * eg, qn[5] * eg); wd.w = pk2(qn[6] * eg, qn[7] * eg);
        *(LAS u32x4*)(QN + t * 72 + 8 * F.wave) = wq; *(LAS u32x4*)(KN + t * 72 + 8 * F.wave) = wk; *(LAS u32x4*)(QDL + t * 72 + 8 * F.wave) = wd; }
      if (F.wave == 0) { BV[t] = beta; BK[t] = beta * eg; GCL[t] = gc; } }
    lds_barrier();
    const int fr = F.lane & 15, fq = F.lane >> 4, tt = F.wave & 3, hi = F.wave >> 2;
    {
        const LAS bf16* Y = hi ? QN : KN;
        f32x4 a4[4];
#pragma unroll
        for (int i = 0; i < 4; ++i) a4[i] = (f32x4){0.f, 0.f, 0.f, 0.f};
#pragma unroll
        for (int ks = 0; ks < 2; ++ks) { const bf16x8 yf = lfrag(Y, 72, tt * 16 + fr, 32 * ks + 8 * fq);
#pragma unroll
            for (int i = 0; i < 4; ++i) a4[i] = MFMA16(lfrag(KN, 72, i * 16 + fr, 32 * ks + 8 * fq), yf, a4[i]); }
        const int tr = tt * 16 + fr; const float gct = GCL[tr], bt = BV[tr];
        bf16* gqk = (bf16*)(F.ws + WS_GQK) + (size_t)uid * 4096;
#pragma unroll
        for (int i = 0; i < 4; ++i) { const int s0 = i * 16 + 4 * fq; const f32x4 gs = *(const LAS f32x4*)(GCL + s0); float v[4];
#pragma unroll
            for (int j = 0; j < 4; ++j) { const bool keep = hi ? (s0 + j <= tr) : (s0 + j < tr); v[j] = keep ? a4[i][j] * __expf(gct - gs[j]) * (hi ? 1.0f : bt) : 0.0f; }
            if (hi) { u32x2 w; w.x = pk2(v[0], v[1]); w.y = pk2(v[2], v[3]); *(u32x2*)(gqk + tr * 64 + s0) = w; }
            else *(LAS f32x4*)(MM + tr * 68 + s0) = (f32x4){v[0], v[1], v[2], v[3]}; }
    }
    lds_barrier();
    {
        typedef short s16x4 __attribute__((ext_vector_type(4)));
        LAS bf16* MMb = (LAS bf16*)(F.lds + GD_QN);
        LAS bf16* LINV = (LAS bf16*)(F.lds + GD_PART);
        for (int i = F.tid; i < 128 * 72 / 8; i += 512) *(LAS u32x4*)(XT + 8 * i) = (u32x4){0u, 0u, 0u, 0u};
        { const int r = F.tid >> 3, c8 = F.tid & 7; const f32x4 a = *(const LAS f32x4*)(MM + r * 68 + 8 * c8), b2 = *(const LAS f32x4*)(MM + r * 68 + 8 * c8 + 4);
          u32x4 w; w.x = pk2(a[0], a[1]); w.y = pk2(a[2], a[3]); w.z = pk2(b2[0], b2[1]); w.w = pk2(b2[2], b2[3]); *(LAS u32x4*)(MMb + r * 72 + 8 * c8) = w; }
        if (F.wave < 4) {
            const int bq = F.wave;
            LAS bf16* Rr = (LAS bf16*)(F.lds + GD_KN) + bq * 960; LAS bf16* Cc = Rr + 320; LAS bf16* Pr = Cc + 320;
            f32x4 n4, p4;
#pragma unroll
            for (int j = 0; j < 4; ++j) { n4[j] = -MM[(16 * bq + 4 * fq + j) * 68 + 16 * bq + fr]; p4[j] = n4[j] + ((4 * fq + j == fr) ? 1.0f : 0.0f); }
            { u32x2 w; w.x = pk2(n4[0], n4[1]); w.y = pk2(n4[2], n4[3]); *(LAS u32x2*)(Cc + fr * 20 + 4 * fq) = w; }
#pragma unroll
            for (int j = 0; j < 4; ++j) { Rr[(4 * fq + j) * 20 + fr] = (bf16)f2bf(n4[j]); Pr[(4 * fq + j) * 20 + fr] = (bf16)f2bf(p4[j]); }
#pragma unroll
            for (int s = 0; s < 3; ++s) {
                asm volatile("s_waitcnt lgkmcnt(0)" ::: "memory");
                const s16x4 xr = *(const LAS s16x4*)(Rr + fr * 20 + 4 * fq), yc = *(const LAS s16x4*)(Cc + fr * 20 + 4 * fq);
                const f32x4 a2 = __builtin_amdgcn_mfma_f32_16x16x16bf16_1k(xr, yc, (f32x4){0.f, 0.f, 0.f, 0.f}, 0, 0, 0);
                const s16x4 xp = *(const LAS s16x4*)(Pr + fr * 20 + 4 * fq);
                asm volatile("s_waitcnt lgkmcnt(0)" ::: "memory");
                { u32x2 w; w.x = pk2(a2[0], a2[1]); w.y = pk2(a2[2], a2[3]); *(LAS u32x2*)(Cc + fr * 20 + 4 * fq) = w; }
#pragma unroll
                for (int j = 0; j < 4; ++j) Rr[(4 * fq + j) * 20 + fr] = (bf16)f2bf(a2[j]);
                asm volatile("s_waitcnt lgkmcnt(0)" ::: "memory");
                const s16x4 yc2 = *(const LAS s16x4*)(Cc + fr * 20 + 4 * fq);
                p4 = __builtin_amdgcn_mfma_f32_16x16x16bf16_1k(xp, yc2, p4, 0, 0, 0);
#pragma unroll
                for (int j = 0; j < 4; ++j) Pr[(4 * fq + j) * 20 + fr] = (bf16)f2bf(p4[j]);
            }
#pragma unroll
            for (int j = 0; j < 4; ++j) LINV[bq * 320 + (4 * fq + j) * 20 + fr] = (bf16)f2bf(p4[j]);
        }
        lds_barrier();
        const int cw = 16 * F.wave + fr;
        const LAS float* SRCw = (cw < 64) ? (CV + cw) : (CK + (cw - 64)); const LAS float* COEFw = (cw < 64) ? BV : BK;
#pragma unroll 1
        for (int bt = 0; bt < 4; ++bt) {
            f32x4 acc = (f32x4){0.f, 0.f, 0.f, 0.f};
            if (bt > 0) acc = MFMA16(lfrag(MMb, 72, 16 * bt + fr, 8 * fq), lfrag(XT, 72, cw, 8 * fq), acc);
            if (bt == 3) acc = MFMA16(lfrag(MMb, 72, 16 * bt + fr, 32 + 8 * fq), lfrag(XT, 72, cw, 32 + 8 * fq), acc);
            float y[4];
#pragma unroll
            for (int j = 0; j < 4; ++j) { const int t2 = 16 * bt + 4 * fq + j; y[j] = SRCw[t2 * 65] * COEFw[t2] - acc[j]; }
            u32x2 yw; yw.x = pk2m(y[0], y[1]); yw.y = pk2m(y[2], y[3]);
            const s16x4 li = *(const LAS s16x4*)(LINV + bt * 320 + fr * 20 + 4 * fq);
            const f32x4 x4 = __builtin_amdgcn_mfma_f32_16x16x16bf16_1k(li, __builtin_bit_cast(s16x4, yw), (f32x4){0.f, 0.f, 0.f, 0.f}, 0, 0, 0);
            { u32x2 w; w.x = pk2(x4[0], x4[1]); w.y = pk2(x4[2], x4[3]); *(LAS u32x2*)(XT + cw * 72 + 16 * bt + 4 * fq) = w; }
            lds_barrier();
        }
    }
    {
        const LAS bf16* X = hi ? KDT : (XT + 64 * 72); const LAS bf16* Y = hi ? XT : KDT;
        f32x4 a4[4];
#pragma unroll
        for (int i = 0; i < 4; ++i) a4[i] = (f32x4){0.f, 0.f, 0.f, 0.f};
#pragma unroll
        for (int ks = 0; ks < 2; ++ks) { const bf16x8 yf = lfrag(Y, 72, tt * 16 + fr, 32 * ks + 8 * fq);
#pragma unroll
            for (int i = 0; i < 4; ++i) a4[i] = MFMA16(lfrag(X, 72, i * 16 + fr, 32 * ks + 8 * fq), yf, a4[i]); }
        const int yr = tt * 16 + fr;
        if (hi) { bf16* ut = (bf16*)(F.ws + WS_GUT) + (size_t)uid * 4096 + yr * 64 + fq * 16;
            u32x4 w0, w1; w0.x = pk2(a4[0][0], a4[0][1]); w0.y = pk2(a4[0][2], a4[0][3]); w0.z = pk2(a4[1][0], a4[1][1]); w0.w = pk2(a4[1][2], a4[1][3]);
            w1.x = pk2(a4[2][0], a4[2][1]); w1.y = pk2(a4[2][2], a4[2][3]); w1.z = pk2(a4[3][0], a4[3][1]); w1.w = pk2(a4[3][2], a4[3][3]);
            *(u32x4*)ut = w0; *(u32x4*)(ut + 8) = w1;
            LAS bf16* ul = (LAS bf16*)(F.lds + GD_KN) + yr * 64; *(LAS u32x4*)(ul + (((2 * fq) ^ (yr & 7)) << 3)) = w0; *(LAS u32x4*)(ul + (((2 * fq + 1) ^ (yr & 7)) << 3)) = w1; }
        else { bf16* gt = (bf16*)(F.ws + WS_GT) + (size_t)uid * 4096 + yr * 64; const float last = __expf(gl);
            unsigned pw[4][2];
#pragma unroll
            for (int i = 0; i < 4; ++i) { const int d0 = i * 16 + 4 * fq; float v[4];
#pragma unroll
                for (int j = 0; j < 4; ++j) v[j] = ((d0 + j == yr) ? last : 0.0f) - a4[i][j];
                pw[i][0] = pk2(v[0], v[1]); pw[i][1] = pk2(v[2], v[3]); }
#pragma unroll
            for (int ks = 0; ks < 2; ++ks) { u32x4 w; w.x = pw[2 * ks][0]; w.y = pw[2 * ks][1]; w.z = pw[2 * ks + 1][0]; w.w = pw[2 * ks + 1][1]; *(u32x4*)(gt + ks * 32 + fq * 8) = w;
                *(LAS u32x4*)((LAS bf16*)(F.lds + GD_QN) + yr * 64 + (((ks * 4 + fq) ^ (yr & 7)) << 3)) = w; } }
        { const int tq = F.tid & 63, dg = F.tid >> 6; u32x4 w; unsigned short e8[8];
#pragma unroll
          for (int i = 0; i < 8; ++i) e8[i] = XT[(64 + 8 * dg + i) * 72 + tq];
          w.x = e8[0] | ((unsigned)e8[1] << 16); w.y = e8[2] | ((unsigned)e8[3] << 16); w.z = e8[4] | ((unsigned)e8[5] << 16); w.w = e8[6] | ((unsigned)e8[7] << 16);
          *(u32x4*)((bf16*)(F.ws + WS_GKC) + (size_t)uid * 4096 + tq * 64 + 8 * dg) = w; }
        { const int r = F.tid >> 3, c8 = F.tid & 7;
          *(u32x4*)((bf16*)(F.ws + WS_GWT) + (size_t)uid * 4096 + r * 64 + 8 * c8) = *(const LAS u32x4*)(XT + r * 72 + 8 * c8);
          *(u32x4*)((bf16*)(F.ws + WS_GQD) + (size_t)uid * 4096 + r * 64 + 8 * c8) = *(const LAS u32x4*)(QDL + r * 72 + 8 * c8); }
    }
    lds_barrier();
}
struct GdnStep { u32x4 T[4][2]; u32x4 U[2]; };
__device__ __forceinline__ void gdn_m2_load(GdnStep& s, const bf16* gt, const bf16* ut, int n, int fr, int fq) {
    s.U[0] = *(const u32x4*)(ut + (size_t)n * 4096); s.U[1] = *(const u32x4*)(ut + (size_t)n * 4096 + 8);
#pragma unroll
    for (int i = 0; i < 4; ++i)
#pragma unroll
        for (int ks = 0; ks < 2; ++ks) s.T[i][ks] = *(const u32x4*)(gt + (size_t)n * 4096 + (i * 16 + fr) * 64 + ks * 32 + fq * 8);
}
__device__ __forceinline__ void gdn_step(f32x4 (&S)[4], const GdnStep& st, float us) {
    bf16x8 sf[2];
#pragma unroll
    for (int ks = 0; ks < 2; ++ks) { u32x4 w; w.x = pk2m(S[2 * ks][0], S[2 * ks][1]); w.y = pk2m(S[2 * ks][2], S[2 * ks][3]); w.z = pk2m(S[2 * ks + 1][0], S[2 * ks + 1][1]); w.w = pk2m(S[2 * ks + 1][2], S[2 * ks + 1][3]);
        sf[ks] = __builtin_bit_cast(bf16x8, w); }
#pragma unroll
    for (int i = 0; i < 4; ++i) { const unsigned u0 = (i & 1) ? st.U[i >> 1].z : st.U[i >> 1].x, u1 = (i & 1) ? st.U[i >> 1].w : st.U[i >> 1].y;
        f32x4 a = (f32x4){bflo(u0), bfhi(u0), bflo(u1), bfhi(u1)} * us;
#pragma unroll
        for (int ks = 0; ks < 2; ++ks) a = MFMA16(__builtin_bit_cast(bf16x8, st.T[i][ks]), sf[ks], a);
        S[i] = a; }
}
__device__ __forceinline__ void gdn_m2a(Frame& F, int bh, int seg) {
    const int fr = F.lane & 15, fq = F.lane >> 4, role = F.wave >> 2, c = (F.wave & 3) * 16 + fr;
    const bf16* gt = (const bf16*)(F.ws + WS_GT) + (size_t)(bh * 128 + seg * 8) * 4096;
    const bf16* ut = (const bf16*)(F.ws + WS_GUT) + (size_t)(bh * 128 + seg * 8) * 4096 + c * 64 + 16 * fq;
    const float us = role ? 0.0f : 1.0f;
    f32x4 S[4];
#pragma unroll
    for (int i = 0; i < 4; ++i)
#pragma unroll
        for (int j = 0; j < 4; ++j) S[i][j] = (role && (16 * i + 4 * fq + j == c)) ? 1.0f : 0.0f;
    GdnStep st[4];
#pragma unroll
    for (int r = 0; r < 4; ++r) gdn_m2_load(st[r], gt, ut, r, fr, fq);
    for (int n0 = 0; n0 < 8; n0 += 4) {
#pragma unroll
        for (int r = 0; r < 4; ++r) { const int n = n0 + r; gdn_step(S, st[r], us); gdn_m2_load(st[r], gt, ut, (n + 4 < 8) ? n + 4 : 7, fr, fq); } }
    if (role == 0) { bf16* qg = (bf16*)(F.ws + WS_GQG) + (size_t)(bh * 16 + seg) * 4096 + c * 64 + fq * 16;
        u32x4 w0, w1; w0.x = pk2(S[0][0], S[0][1]); w0.y = pk2(S[0][2], S[0][3]); w0.z = pk2(S[1][0], S[1][1]); w0.w = pk2(S[1][2], S[1][3]);
        w1.x = pk2(S[2][0], S[2][1]); w1.y = pk2(S[2][2], S[2][3]); w1.z = pk2(S[3][0], S[3][1]); w1.w = pk2(S[3][2], S[3][3]);
        *(u32x4*)qg = w0; *(u32x4*)(qg + 8) = w1; }
    else { bf16* pg = (bf16*)(F.ws + WS_GPG) + (size_t)(bh * 16 + seg) * 4096 + (c >> 5) * 32 + ((c & 15) >> 2) * 8 + ((c >> 4) & 1) * 4 + (c & 3);
#pragma unroll
        for (int i = 0; i < 4; ++i)
#pragma unroll
            for (int j = 0; j < 4; ++j) pg[(16 * i + 4 * fq + j) * 64] = (bf16)f2bf(S[i][j]); }
}
__device__ __forceinline__ void gdn_m2b(Frame& F, int bh) {
    const int fr = F.lane & 15, fq = F.lane >> 4, c = (F.wave & 3) * 16 + fr;
    const bf16* pg = (const bf16*)(F.ws + WS_GPG) + (size_t)bh * 16 * 4096;
    const bf16* qg = (const bf16*)(F.ws + WS_GQG) + (size_t)bh * 16 * 4096 + c * 64 + 16 * fq;
    float* ss = (float*)(F.ws + WS_GSS) + (size_t)bh * 16 * 4096 + c * 64 + 4 * fq;
    { u32x4 pv[16]; const int r = F.tid >> 3, sl = F.tid & 7;
#pragma unroll
      for (int g = 0; g < 16; ++g) pv[g] = *(const u32x4*)(pg + (size_t)g * 4096 + r * 64 + ((sl ^ (r & 7)) << 3));
#pragma unroll
      for (int g = 0; g < 16; ++g) *(LAS u32x4*)(F.lds + g * 8192 + F.tid * 16) = pv[g]; }
    u32x4 qv[16][2];
    if (F.wave < 4) {
#pragma unroll
        for (int g = 0; g < 16; ++g) { qv[g][0] = *(const u32x4*)(qg + (size_t)g * 4096); qv[g][1] = *(const u32x4*)(qg + (size_t)g * 4096 + 8); } }
    lds_barrier();
    if (F.wave < 4) {
        f32x4 S[4];
#pragma unroll
        for (int i = 0; i < 4; ++i) S[i] = (f32x4){0.f, 0.f, 0.f, 0.f};
#pragma unroll
        for (int g = 0; g < 16; ++g) {
#pragma unroll
            for (int i = 0; i < 4; ++i) *(f32x4*)(ss + (size_t)g * 4096 + i * 16) = S[i];
            GdnStep st; st.U[0] = qv[g][0]; st.U[1] = qv[g][1];
#pragma unroll
            for (int i = 0; i < 4; ++i)
#pragma unroll
                for (int ks = 0; ks < 2; ++ks) st.T[i][ks] = *(const LAS u32x4*)(F.lds + g * 8192 + (i * 16 + fr) * 128 + (((ks * 4 + fq) ^ (fr & 7)) << 4));
            gdn_step(S, st, 1.0f); } }
    lds_barrier();
}
__device__ __forceinline__ void gdn_compose(Frame& F, f32x4 (&S)[4]) {
    const int fr = F.lane & 15, fq = F.lane >> 4, c = (F.wave & 3) * 16 + fr;
    const LAS bf16* TL = (const LAS bf16*)(F.lds + GD_QN); const LAS bf16* UL = (const LAS bf16*)(F.lds + GD_KN) + c * 64;
    GdnStep st; st.U[0] = *(const LAS u32x4*)(UL + (((2 * fq) ^ (c & 7)) << 3)); st.U[1] = *(const LAS u32x4*)(UL + (((2 * fq + 1) ^ (c & 7)) << 3));
#pragma unroll
    for (int i = 0; i < 4; ++i)
#pragma unroll
        for (int ks = 0; ks < 2; ++ks) st.T[i][ks] = *(const LAS u32x4*)(TL + (i * 16 + fr) * 64 + (((ks * 4 + fq) ^ (fr & 7)) << 3));
    gdn_step(S, st, (F.wave >> 2) ? 0.0f : 1.0f);
}
struct Gd3Raw { u32x4 kc, qk, qd; u32x2 wwv[2]; GdnStep st; };
struct Gd3Gate { u32x2 gw[2]; };
__device__ __forceinline__ void gdn3_gates(Frame& F, int b, int n, int h, Gd3Gate& g) {
    const int fr = F.lane & 15, fq = F.lane >> 4, tt = F.wave & 3, hi = F.wave >> 2;
    const bf16* zg = (const bf16*)(F.ws + WS_R1) + (size_t)(b * SEQ + n * 64) * NZ + 3840 + h * 64;
#pragma unroll
    for (int i = 0; i < 2; ++i) g.gw[i] = __builtin_nontemporal_load((const u32x2*)(zg + (size_t)(tt * 16 + fr) * NZ + (2 * hi + i) * 16 + 4 * fq));
}
__device__ __forceinline__ void gdn3_issue(Frame& F, int b, int n, int h, int uid, Gd3Raw& r) {
    const size_t row0 = (size_t)(b * SEQ + n * 64);
    const int fr = F.lane & 15, fq = F.lane >> 4, tt = F.wave & 3, hi = F.wave >> 2;
    const bf16* zg = (const bf16*)(F.ws + WS_R1) + row0 * NZ + 3840 + h * 64; const bf16* wt = (const bf16*)(F.ws + WS_GWT) + (size_t)uid * 4096 + (tt * 16 + fr) * 64;
    { const int rr = F.tid >> 3, c8 = F.tid & 7; const size_t go = (size_t)uid * 4096 + rr * 64 + 8 * c8;
      r.kc = __builtin_nontemporal_load((const u32x4*)((const bf16*)(F.ws + WS_GKC) + go)); r.qk = __builtin_nontemporal_load((const u32x4*)((const bf16*)(F.ws + WS_GQK) + go)); r.qd = __builtin_nontemporal_load((const u32x4*)((const bf16*)(F.ws + WS_GQD) + go)); }
#pragma unroll
    for (int i = 0; i < 2; ++i) r.wwv[i] = __builtin_nontemporal_load((const u32x2*)(wt + (2 * hi + i) * 16 + 4 * fq));
    gdn_m2_load(r.st, (const bf16*)(F.ws + WS_GT) + (size_t)uid * 4096, (const bf16*)(F.ws + WS_GUT) + (size_t)uid * 4096 + ((F.wave & 3) * 16 + fr) * 64 + 16 * fq, 0, fr, fq);
}
__device__ __forceinline__ void gdn_m3(Frame& F, int l, int b, int n, int h, const Gd3Raw& r, const Gd3Gate& gt_, f32x4 (&S)[4]) {
    LAS bf16* KCL = (LAS bf16*)(F.lds + GL_QS); LAS bf16* QKL = KCL + 64 * 72; LAS bf16* QDL = QKL + 64 * 72; LAS bf16* VNT = QDL + 64 * 72; LAS bf16* STL = VNT + 64 * 72;
    const size_t row0 = (size_t)(b * SEQ + n * 64);
    const int fr = F.lane & 15, fq = F.lane >> 4, tt = F.wave & 3, hi = F.wave >> 2;
    { const int rr = F.tid >> 3, c8 = F.tid & 7;
      *(LAS u32x4*)(KCL + rr * 72 + 8 * c8) = r.kc; *(LAS u32x4*)(QKL + rr * 72 + 8 * c8) = r.qk; *(LAS u32x4*)(QDL + rr * 72 + 8 * c8) = r.qd; }
    if (F.wave < 4) {
#pragma unroll
        for (int i = 0; i < 4; ++i) { u32x2 w; w.x = pk2(S[i][0], S[i][1]); w.y = pk2(S[i][2], S[i][3]); *(LAS u32x2*)(STL + (F.wave * 16 + fr) * 72 + 16 * i + 4 * fq) = w; } }
    u32x2 gw[2], wwv[2];
#pragma unroll
    for (int i = 0; i < 2; ++i) { gw[i] = gt_.gw[i]; wwv[i] = r.wwv[i]; }
    lds_barrier();
    {
        f32x4 a2[2] = {(f32x4){0.f, 0.f, 0.f, 0.f}, (f32x4){0.f, 0.f, 0.f, 0.f}};
#pragma unroll
        for (int ks = 0; ks < 2; ++ks) { const bf16x8 yf = lfrag(STL, 72, tt * 16 + fr, 32 * ks + 8 * fq);
#pragma unroll
            for (int i = 0; i < 2; ++i) a2[i] = MFMA16(lfrag(KCL, 72, (2 * hi + i) * 16 + fr, 32 * ks + 8 * fq), yf, a2[i]); }
        const int e = tt * 16 + fr;
#pragma unroll
        for (int i = 0; i < 2; ++i) { const int t0 = (2 * hi + i) * 16 + 4 * fq; const u32x2 ww = wwv[i];
            u32x2 w; w.x = pk2(bflo(ww.x) - a2[i][0], bfhi(ww.x) - a2[i][1]); w.y = pk2(bflo(ww.y) - a2[i][2], bfhi(ww.y) - a2[i][3]);
            *(LAS u32x2*)(VNT + e * 72 + t0) = w; }
    }
    lds_barrier();
    f32x4 acc[2] = {(f32x4){0.f, 0.f, 0.f, 0.f}, (f32x4){0.f, 0.f, 0.f, 0.f}};
#pragma unroll
    for (int ks = 0; ks < 2; ++ks) { const bf16x8 yf = lfrag(QKL, 72, tt * 16 + fr, 32 * ks + 8 * fq);
#pragma unroll
        for (int i = 0; i < 2; ++i) acc[i] = MFMA16(lfrag(VNT, 72, (2 * hi + i) * 16 + fr, 32 * ks + 8 * fq), yf, acc[i]); }
#pragma unroll
    for (int ks = 0; ks < 2; ++ks) { const bf16x8 yf = lfrag(QDL, 72, tt * 16 + fr, 32 * ks + 8 * fq);
#pragma unroll
        for (int i = 0; i < 2; ++i) acc[i] = MFMA16(lfrag(STL, 72, (2 * hi + i) * 16 + fr, 32 * ks + 8 * fq), yf, acc[i]); }
    mix_out_epilogue<2, 64>(F, acc, (const LAS float*)(F.lds + GL_GNG), gw, (bf16*)(F.ws + WS_OMIX) + row0 * 1024 + 768 + h * 64);
    gdn_step(S, r.st, 1.0f);
}
#define LAUNDER() do { F.lane = F0.lane; asm volatile("" : "+v"(F.lane)); F.tid = F.wave * 64 + F.lane; } while (0)
#define UNIT_IDX(k) const int idx = F.bid + F.G * (k), b = idx >> 9, n = (idx >> 2) & 127, h = idx & 3, uid = ((b * 4 + h) << 7) | n
__device__ __forceinline__ void phase_mix_m1(Frame& F0, int l) {
    Frame F = F0; const int NU = 2048 / F.G;
    const int bh = F.bid >> 4, seg = F.bid & 15, b = bh >> 2, h = bh & 3;
    RtRaw rraw; GdRaw graw;
    {
      f32x4 S[8];
#pragma unroll
      for (int i = 0; i < 8; ++i) S[i] = (f32x4){0.f, 0.f, 0.f, 0.f};
      float dseg = 1.0f;
      HgRaw raw; hg_issue<false>(F, b, 8 * seg, h, raw);
      if (F.tid < 128) ((LAS float*)(F.lds + GL_LB))[F.tid] = ((const float*)(F.ws + WS_LB))[l * 512 + ((F.bid >> 4) & 3) * 128 + F.tid];
      lds_barrier();
      auto hg_chunk = [&](int k, auto next_issue) __attribute__((always_inline)) { LAUNDER();
        const HgRaw cur = raw;
        next_issue(k);
        hg_prep<0>(F, l, h, cur);
        f32x4 kv[8]; hg_kv_acc(F, kv);
        const LAS float* DECL = (const LAS float*)(F.lds + GL_DECL); const int fq = F.lane >> 4;
#pragma unroll
        for (int i = 0; i < 8; ++i) S[i] = S[i] * *(const LAS f32x4*)(DECL + 16 * i + 4 * fq) + kv[i];
        if (F.tid < 128) dseg *= DECL[F.tid];
        lds_barrier(); };
      for (int k = 0; k < 7; ++k) hg_chunk(k, [&](int kk) __attribute__((always_inline)) { hg_issue<false>(F, b, 8 * seg + kk + 1, h, raw); });
      hg_chunk(7, [&](int) __attribute__((always_inline)) { rt_issue<false>(F, b, 8 * seg, h, rraw); });
      { const int fr = F.lane & 15, fq = F.lane >> 4; float* kvg = (float*)(F.ws + WS_HKV) + (size_t)(bh * 16 + seg) * 16384 + (F.wave * 16 + fr) * 128 + 4 * fq;
#pragma unroll
        for (int i = 0; i < 8; ++i) *(f32x4*)(kvg + 16 * i) = S[i];
        if (F.tid < 128) ((float*)(F.ws + WS_HDEC))[(size_t)(bh * 16 + seg) * 128 + F.tid] = dseg; } }
    {
      const float dec = __expf(64.0f * log1pf(-exp2f(-5.0f - (float)h)));
      f32x4 S[2] = {(f32x4){0.f, 0.f, 0.f, 0.f}, (f32x4){0.f, 0.f, 0.f, 0.f}};
      auto rt_chunk = [&](int k, auto next_issue) __attribute__((always_inline)) { LAUNDER();
        rt_stage<false>(F, rraw); lds_barrier();
        next_issue(k);
        rt_prep<0>(F, 8 * seg + k, h);
        f32x4 kv[2]; rt_kv_acc(F, kv);
        S[0] = S[0] * dec + kv[0]; S[1] = S[1] * dec + kv[1];
        lds_barrier(); };
      for (int k = 0; k < 7; ++k) rt_chunk(k, [&](int kk) __attribute__((always_inline)) { rt_issue<false>(F, b, 8 * seg + kk + 1, h, rraw); });
      rt_chunk(7, [&](int) __attribute__((always_inline)) { gdn_issue(F, b, 8 * seg, h, graw); gdn_load_cw(F, l, h); });
      { const int fr = F.lane & 15, fq = F.lane >> 4; float* kvg = (float*)(F.ws + WS_RKV) + (size_t)(bh * 16 + seg) * 4096 + ((F.wave & 3) * 16 + fr) * 64 + (2 * (F.wave >> 2)) * 16 + 4 * fq;
        *(f32x4*)kvg = S[0]; *(f32x4*)(kvg + 16) = S[1]; } }
    {
      f32x4 S[4];
      { const int fr = F.lane & 15, fq = F.lane >> 4, role = F.wave >> 2, c = (F.wave & 3) * 16 + fr;
#pragma unroll
        for (int i = 0; i < 4; ++i)
#pragma unroll
            for (int j = 0; j < 4; ++j) S[i][j] = (role && (16 * i + 4 * fq + j == c)) ? 1.0f : 0.0f; }
      for (int k = 0; k < 8; ++k) { LAUNDER(); const int n = 8 * seg + k;
        gdn_stage(F, graw); const GdRaw cur = graw; lds_barrier();
        if (k + 1 < 8) gdn_issue(F, b, n + 1, h, graw);
        gdn_m1(F, l, h, bh * 128 + n, cur);
        gdn_compose(F, S); }
      { const int fr = F.lane & 15, fq = F.lane >> 4, role = F.wave >> 2, c = (F.wave & 3) * 16 + fr;
        if (role == 0) { bf16* qg = (bf16*)(F.ws + WS_GQG) + (size_t)(bh * 16 + seg) * 4096 + c * 64 + fq * 16;
            u32x4 w0, w1; w0.x = pk2(S[0][0], S[0][1]); w0.y = pk2(S[0][2], S[0][3]); w0.z = pk2(S[1][0], S[1][1]); w0.w = pk2(S[1][2], S[1][3]);
            w1.x = pk2(S[2][0], S[2][1]); w1.y = pk2(S[2][2], S[2][3]); w1.z = pk2(S[3][0], S[3][1]); w1.w = pk2(S[3][2], S[3][3]);
            *(u32x4*)qg = w0; *(u32x4*)(qg + 8) = w1; }
        else { bf16* pg = (bf16*)(F.ws + WS_GPG) + (size_t)(bh * 16 + seg) * 4096 + (c >> 5) * 32 + ((c & 15) >> 2) * 8 + ((c >> 4) & 1) * 4 + (c & 3);
#pragma unroll
            for (int i = 0; i < 4; ++i)
#pragma unroll
                for (int j = 0; j < 4; ++j) pg[(16 * i + 4 * fq + j) * 64] = (bf16)f2bf(S[i][j]); } } }
}
__device__ __forceinline__ void phase_mix_m2a(Frame& F, int l) { gdn_m2a(F, F.bid >> 4, F.bid & 15); }
__device__ __forceinline__ void phase_mix_m2b(Frame& F, int l) {
    if (F.bid < 16) gdn_m2b(F, F.bid);
    else if (F.bid < 144) { const int item = (F.bid - 16) * 512 + F.tid;
        if (item < 65536) { const int bh = item >> 12, e = (item >> 5) & 127, d4 = item & 31;
            const float* kv = (const float*)(F.ws + WS_HKV) + (size_t)bh * 16 * 16384 + e * 128 + d4 * 4;
            const float* dc = (const float*)(F.ws + WS_HDEC) + (size_t)bh * 16 * 128 + d4 * 4;
            float* sp = (float*)(F.ws + WS_HSP) + (size_t)bh * 16 * 16384 + e * 128 + d4 * 4;
            f32x4 S = (f32x4){0.f, 0.f, 0.f, 0.f};
            { f32x4 kb[16], db[16];
#pragma unroll
                for (int u = 0; u < 16; ++u) { kb[u] = *(const f32x4*)(kv + (size_t)u * 16384); db[u] = *(const f32x4*)(dc + u * 128); }
#pragma unroll
                for (int u = 0; u < 16; ++u) { *(f32x4*)(sp + (size_t)u * 16384) = S; S = db[u] * S + kb[u]; } }
        }
    }
    else if (F.bid < 176) { const int item = (F.bid - 144) * 512 + F.tid;
        if (item < 16384) { const int it = item, bh = it >> 10, e = (it >> 4) & 63, d4 = it & 15;
            const float* kv = (const float*)(F.ws + WS_RKV) + (size_t)bh * 16 * 4096 + e * 64 + d4 * 4;
            float* sp = (float*)(F.ws + WS_RSP) + (size_t)bh * 16 * 4096 + e * 64 + d4 * 4;
            const float dec = __expf(512.0f * log1pf(-exp2f(-5.0f - (float)(bh & 3))));
            f32x4 kb[16];
#pragma unroll
            for (int u = 0; u < 16; ++u) kb[u] = *(const f32x4*)(kv + (size_t)u * 4096);
            f32x4 S = (f32x4){0.f, 0.f, 0.f, 0.f};
#pragma unroll
            for (int u = 0; u < 16; ++u) { *(f32x4*)(sp + (size_t)u * 4096) = S; S = S * dec + kb[u]; }
        }
    }
}
__device__ __forceinline__ void phase_mix_m3(Frame& F0, int l) {
    Frame F = F0; const int NU = 2048 / F.G;
    const int bh = F.bid >> 4, seg = F.bid & 15, b = bh >> 2, h = bh & 3;
    f32x4 rS[2]; RtRaw rraw; u32x2 rgw[2]; f32x4 gS[4]; Gd3Raw gring[2]; Gd3Gate ggate[3];
#define RT_GATES(n_) do { const int fr_ = F.lane & 15, fq_ = F.lane >> 4, tt_ = F.wave & 3, hi_ = F.wave >> 2; const bf16* zg_ = (const bf16*)(F.ws + WS_R1) + (size_t)(b * SEQ + (n_) * 64) * NZ + 2816 + h * 64; \
        _Pragma("unroll") for (int i_ = 0; i_ < 2; ++i_) rgw[i_] = __builtin_nontemporal_load((const u32x2*)(zg_ + (size_t)(tt_ * 16 + fr_) * NZ + (2 * hi_ + i_) * 16 + 4 * fq_)); } while (0)
    auto rt_entry = [&]() __attribute__((always_inline)) {
        const int fr = F.lane & 15, fq = F.lane >> 4; const float* sg = (const float*)(F.ws + WS_RSP) + (size_t)(bh * 16 + seg) * 4096 + ((F.wave & 3) * 16 + fr) * 64 + (2 * (F.wave >> 2)) * 16 + 4 * fq;
        rS[0] = *(const f32x4*)sg; rS[1] = *(const f32x4*)(sg + 16);
        rt_issue<true>(F, b, 8 * seg, h, rraw); RT_GATES(8 * seg); };
    auto gd_entry = [&]() __attribute__((always_inline)) {
        const int fr = F.lane & 15, fq = F.lane >> 4; const float* ss = (const float*)(F.ws + WS_GSS) + (size_t)(bh * 16 + seg) * 4096 + ((F.wave & 3) * 16 + fr) * 64 + 4 * fq;
#pragma unroll
        for (int i = 0; i < 4; ++i) gS[i] = *(const f32x4*)(ss + i * 16);
        gdn3_issue(F, b, 8 * seg, h, bh * 128 + 8 * seg, gring[0]); gdn3_gates(F, b, 8 * seg, h, ggate[0]); gdn3_gates(F, b, 8 * seg + 1, h, ggate[1]); };
    {
      f32x4 S[8]; bf16x8 sfd[4][4]; u32x2 gw[4];
      { const int fr = F.lane & 15, fq = F.lane >> 4; const float* sg = (const float*)(F.ws + WS_HSP) + (size_t)(bh * 16 + seg) * 16384 + (F.wave * 16 + fr) * 128 + 4 * fq;
#pragma unroll
        for (int i = 0; i < 8; ++i) S[i] = *(const f32x4*)(sg + 16 * i); }
#define HG_GATES(n_) do { const int fr_ = F.lane & 15, fq_ = F.lane >> 4, tt_ = F.wave & 3, hi_ = F.wave >> 2; const bf16* zg_ = (const bf16*)(F.ws + WS_R1) + (size_t)(b * SEQ + (n_) * 64) * NZ + 1536 + h * 128; \
        _Pragma("unroll") for (int i_ = 0; i_ < 4; ++i_) gw[i_] = __builtin_nontemporal_load((const u32x2*)(zg_ + (size_t)(tt_ * 16 + fr_) * NZ + (4 * hi_ + i_) * 16 + 4 * fq_)); } while (0)
      HgRaw raw; hg_issue<true>(F, b, 8 * seg, h, raw); HG_GATES(8 * seg);
    {
      if (F.tid < 128) { ((LAS float*)(F.lds + GL_LB))[F.tid] = ((const float*)(F.ws + WS_LB))[l * 512 + h * 128 + F.tid]; ((LAS float*)(F.lds + GL_GNH))[F.tid] = pin(F, I_HGG)[l * 512 + h * 128 + F.tid]; }
      else if (F.tid < 192) ((LAS float*)(F.lds + GL_GNR))[F.tid - 128] = pin(F, I_RETG)[l * 256 + h * 64 + F.tid - 128];
      else if (F.tid < 256) ((LAS float*)(F.lds + GL_GNG))[F.tid - 192] = pin(F, I_GDNG)[l * 256 + h * 64 + F.tid - 192];
      lds_barrier(); }
      auto hg_chunk = [&](int k, auto next_issue, auto next_gates) __attribute__((always_inline)) { LAUNDER(); const int n = 8 * seg + k;
        { LAS bf16* STL = (LAS bf16*)(F.lds + GL_STL); const int fr = F.lane & 15, fq = F.lane >> 4;
#pragma unroll
          for (int i = 0; i < 8; ++i) { u32x2 w; w.x = pk2(S[i][0], S[i][1]); w.y = pk2(S[i][2], S[i][3]); *(LAS u32x2*)(STL + (F.wave * 16 + fr) * 136 + 16 * i + 4 * fq) = w; } }
        const HgRaw cur = raw;
        next_issue(n);
        hg_prep<2>(F, l, h, cur);
        gla_m3_mma<128, 128, true, GL_STL>(F, sfd, gw, (const LAS float*)(F.lds + GL_GNH), (bf16*)(F.ws + WS_OMIX) + (size_t)(b * SEQ + n * 64) * 1024 + h * 128, [&]() {});
        next_gates(n);
        { f32x4 kv[8]; hg_kv_acc(F, kv);
          const LAS float* DECL = (const LAS float*)(F.lds + GL_DECL); const int fq = F.lane >> 4;
#pragma unroll
          for (int i = 0; i < 8; ++i) S[i] = S[i] * *(const LAS f32x4*)(DECL + 16 * i + 4 * fq) + kv[i]; }
        lds_barrier(); };
      for (int k = 0; k < 7; ++k) hg_chunk(k, [&](int n) __attribute__((always_inline)) { hg_issue<true>(F, b, n + 1, h, raw); }, [&](int n) __attribute__((always_inline)) { HG_GATES(n + 1); });
      hg_chunk(7, [&](int) __attribute__((always_inline)) { rt_entry(); }, [&](int) __attribute__((always_inline)) {});
#undef HG_GATES
    }
    {
      const float dec = __expf(64.0f * log1pf(-exp2f(-5.0f - (float)h)));
      bf16x8 sfd[2][2];
      auto rt_chunk = [&](int k, auto next_issue, auto next_gates) __attribute__((always_inline)) { LAUNDER(); const int n = 8 * seg + k;
        { LAS bf16* STL = (LAS bf16*)(F.lds + GL_RSTL); const int fr = F.lane & 15, fq = F.lane >> 4;
#pragma unroll
          for (int i = 0; i < 2; ++i) { u32x2 w; w.x = pk2(rS[i][0], rS[i][1]); w.y = pk2(rS[i][2], rS[i][3]); *(LAS u32x2*)(STL + ((F.wave & 3) * 16 + fr) * 72 + (2 * (F.wave >> 2) + i) * 16 + 4 * fq) = w; } }
        rt_stage<true>(F, rraw); lds_barrier();
        next_issue(n);
        rt_prep<2>(F, n, h);
        gla_m3_mma<64, 64, true, GL_RSTL>(F, sfd, rgw, (const LAS float*)(F.lds + GL_GNR), (bf16*)(F.ws + WS_OMIX) + (size_t)(b * SEQ + n * 64) * 1024 + 512 + h * 64, [&]() {});
        next_gates(n);
        { f32x4 kv[2]; rt_kv_acc(F, kv);
          rS[0] = rS[0] * dec + kv[0]; rS[1] = rS[1] * dec + kv[1]; }
        lds_barrier(); };
      for (int k = 0; k < 7; ++k) rt_chunk(k, [&](int n) __attribute__((always_inline)) { rt_issue<true>(F, b, n + 1, h, rraw); }, [&](int n) __attribute__((always_inline)) { RT_GATES(n + 1); });
      rt_chunk(7, [&](int) __attribute__((always_inline)) { gd_entry(); }, [&](int) __attribute__((always_inline)) {});
    }
#undef RT_GATES
    {
#pragma unroll
      for (int k = 0; k < 8; ++k) { LAUNDER(); const int n = 8 * seg + k;
        if (k + 1 < 8) gdn3_issue(F, b, n + 1, h, bh * 128 + n + 1, gring[(k + 1) & 1]);
        if (k + 2 < 8) gdn3_gates(F, b, n + 2, h, ggate[(k + 2) % 3]);
        gdn_m3(F, l, b, n, h, gring[k & 1], ggate[k % 3], gS); } }
}

constexpr int RT_LDW = 520;
constexpr int RT_WH = 0, RT_WL = 32 * RT_LDW * 2, RT_GV = 2 * 32 * RT_LDW * 2, RT_SH = RT_GV + 4096, RT_CB = RT_SH + 4096, RT_CP = RT_CB + 128;
__device__ __forceinline__ void phase_norm2_route(Frame& F, int l) {
    LAS bf16* WH = (LAS bf16*)(F.lds + RT_WH); LAS bf16* WL = (LAS bf16*)(F.lds + RT_WL);
    LAS float* GV = (LAS float*)(F.lds + RT_GV); LAS float* SHV = (LAS float*)(F.lds + RT_SH); LAS float* CB = (LAS float*)(F.lds + RT_CB); LAS float* CP = (LAS float*)(F.lds + RT_CP);
    LAS int* lcnt = (LAS int*)(F.lds + LDS_SM); LAS int* lbase = lcnt + 32; LAS int* le = lcnt + 64; LAS int* ls = le + 512;
    const float* rw = pin(F, I_RW) + (size_t)l * 1024 * 32;
    const float* mod = (const float*)(F.ws + WS_MOD);
    const bf16* xa = (const bf16*)(F.ws + WS_XA);
    int* re = (int*)(F.ws + WS_RE); int* rs = (int*)(F.ws + WS_RS); float* rg = (float*)(F.ws + WS_RG);
    unsigned* cnt = F.ctl + CW_CNT + l * 64;
    for (int rb0 = F.bid; rb0 < NTOK / 128; rb0 += F.G) {
        int ln_ = F.lane; asm volatile("" : "+v"(ln_));
        const int fr = ln_ & 15, fq = ln_ >> 4;
        const int bb = (rb0 * 128) >> 13;
        const float* mp = mod + (size_t)(l * 4 + bb) * 6144;
        const int row = rb0 * 128 + F.wave * 16 + fr;
        bf16x8 xf[32];
#pragma unroll
        for (int ks = 0; ks < 32; ++ks) xf[ks] = *(const bf16x8*)(xa + (size_t)row * 1024 + 32 * ks + 8 * fq);
        if (F.tid < 32) lcnt[F.tid] = 0;
        for (int k = F.tid; k < 1024; k += 512) { GV[k] = pin(F, I_N2G)[l * 1024 + k] * (1.0f + mp[4096 + k]); SHV[k] = mp[3072 + k]; }
        lds_barrier();
        { const int e = F.tid & 31, part = F.tid >> 5; float s = 0.f;
#pragma unroll 8
          for (int k = part * 64; k < part * 64 + 64; ++k) s += SHV[k] * rw[k * 32 + e];
          CP[part * 32 + e] = s; }
        f32x4 acc[2] = {(f32x4){0.f, 0.f, 0.f, 0.f}, (f32x4){0.f, 0.f, 0.f, 0.f}};
#pragma unroll
        for (int hk = 0; hk < 2; ++hk) {
#pragma unroll 4
            for (int idx = F.tid; idx < 512 * 32; idx += 512) { const int k = idx >> 5, e = idx & 31;
                const float w = rw[(size_t)(512 * hk + k) * 32 + e] * GV[512 * hk + k]; const unsigned hb = f2bf(w); const float lo = w - bflo(hb);
                WH[e * RT_LDW + k] = (bf16)hb; WL[e * RT_LDW + k] = (bf16)f2bf(lo); }
            lds_barrier();
#pragma unroll
            for (int ks = 0; ks < 16; ++ks) {
                const bf16x8 y = xf[16 * hk + ks];
#pragma unroll
                for (int n = 0; n < 2; ++n) { acc[n] = MFMA16(lfrag(WH, RT_LDW, 16 * n + fr, 32 * ks + 8 * fq), y, acc[n]); acc[n] = MFMA16(lfrag(WL, RT_LDW, 16 * n + fr, 32 * ks + 8 * fq), y, acc[n]); } }
            lds_barrier();
        }
        if (F.tid < 32) { float s = pin(F, I_RB)[l * 32 + F.tid];
#pragma unroll
            for (int pz = 0; pz < 16; ++pz) s += CP[pz * 32 + F.tid];
            CB[F.tid] = s; }
        float ss = 0.f;
#pragma unroll
        for (int ks = 0; ks < 32; ++ks) { const u32x4 w = __builtin_bit_cast(u32x4, xf[ks]);
            const float a0 = bflo(w.x), a1 = bfhi(w.x), a2 = bflo(w.y), a3 = bfhi(w.y), a4 = bflo(w.z), a5 = bfhi(w.z), a6 = bflo(w.w), a7 = bfhi(w.w);
            ss += ((a0 * a0 + a1 * a1) + (a2 * a2 + a3 * a3)) + ((a4 * a4 + a5 * a5) + (a6 * a6 + a7 * a7)); }
        ss += shx(ss, 16, ln_); ss += shx(ss, 32, ln_);
        const float rinv = rsqrtf(ss * (1.0f / 1024.0f) + NORM_EPS);
        lds_barrier();
        float lg[8];
#pragma unroll
        for (int n = 0; n < 2; ++n)
#pragma unroll
            for (int j = 0; j < 4; ++j) lg[4 * n + j] = acc[n][j] * rinv + CB[16 * n + 4 * fq + j];
        int te[4]; float tv[4];
#pragma unroll
        for (int k = 0; k < 4; ++k) { float best = -3.0e38f; int bi = 0;
#pragma unroll
            for (int i = 0; i < 8; ++i) { const int e = 16 * (i >> 2) + 4 * fq + (i & 3); if (lg[i] > best) { best = lg[i]; bi = e; } }
#pragma unroll
            for (int o = 16; o <= 32; o <<= 1) { const float ob = shx(best, o, ln_); const int oi = shxi(bi, o, ln_); if (ob > best || (ob == best && oi < bi)) { best = ob; bi = oi; } }
#pragma unroll
            for (int i = 0; i < 8; ++i) { const int e = 16 * (i >> 2) + 4 * fq + (i & 3); lg[i] = (e == bi) ? -3.0e38f : lg[i]; }
            te[k] = bi; tv[k] = best; }
        { const float e1 = __expf(tv[1] - tv[0]), e2 = __expf(tv[2] - tv[0]), e3 = __expf(tv[3] - tv[0]), inv = 1.0f / (1.0f + e1 + e2 + e3);
          if (fq == 0) { const int lr = F.wave * 16 + fr;
              *(f32x4*)(rg + (size_t)row * 4) = (f32x4){inv, e1 * inv, e2 * inv, e3 * inv};
#pragma unroll
              for (int k = 0; k < 4; ++k) { le[lr * 4 + k] = te[k]; ls[lr * 4 + k] = atomicAdd((int*)&lcnt[te[k]], 1); } } }
        { unsigned char* hrow = F.ws + WS_HN + (size_t)row * 1024;
#pragma unroll
          for (int ks = 0; ks < 32; ++ks) { u32x4 w = __builtin_bit_cast(u32x4, xf[ks]); asm volatile("" : "+v"(w)); const int k0 = 32 * ks + 8 * fq;
              const f32x4 g0 = *(const LAS f32x4*)(GV + k0), g1 = *(const LAS f32x4*)(GV + k0 + 4), s0 = *(const LAS f32x4*)(SHV + k0), s1 = *(const LAS f32x4*)(SHV + k0 + 4);
              u32x2 o; o.x = pk4_fp8(bflo(w.x) * rinv * g0[0] + s0[0], bfhi(w.x) * rinv * g0[1] + s0[1], bflo(w.y) * rinv * g0[2] + s0[2], bfhi(w.y) * rinv * g0[3] + s0[3]);
              o.y = pk4_fp8(bflo(w.z) * rinv * g1[0] + s1[0], bfhi(w.z) * rinv * g1[1] + s1[1], bflo(w.w) * rinv * g1[2] + s1[2], bfhi(w.w) * rinv * g1[3] + s1[3]);
              *(u32x2*)(hrow + k0) = o; } }
        lds_barrier();
        if (F.tid < 32) lbase[F.tid] = (int)__hip_atomic_fetch_add(cnt + F.tid, (unsigned)lcnt[F.tid], __ATOMIC_RELAXED, __HIP_MEMORY_SCOPE_AGENT);
        lds_barrier();
        { const int i = F.tid, e = le[i], sl = lbase[e] + ls[i]; re[(size_t)rb0 * 512 + i] = e; rs[(size_t)rb0 * 512 + i] = sl; ((int*)(F.ws + WS_TOKE))[e * NTOK + sl] = rb0 * 128 + (i >> 2); }
        lds_barrier();
    }
}

__device__ __forceinline__ void build_rt(Frame& F, int l) {
    LAS int* rt_e = (LAS int*)(F.lds + LDS_RT); LAS int* off = rt_e + 608; LAS int* cn = off + 32;
    if (F.tid < 64) {
        const int e = F.lane, c = (e < 32) ? (int)F.ctl[CW_CNT + l * 64 + e] : 0, t = (c + 255) >> 8;
        const int incl = (int)wave_scan_incl((float)t, F.lane), n0 = incl - t;
        if (e < 32) { off[e] = n0 * 256; cn[e] = c; for (int i = 0; i < t; ++i) rt_e[n0 + i] = e; }
        if (e == 31) rt_e[600] = incl; }
    __syncthreads();
}
__device__ __forceinline__ void phase_gather(Frame& F, int l) {
    build_rt(F, l);
    const LAS int* rt_e = (const LAS int*)(F.lds + LDS_RT); const LAS int* off = rt_e + 608; const LAS int* cn = off + 32;
    const int* re = (const int*)(F.ws + WS_RE); int* rs = (int*)(F.ws + WS_RS); int* tok = (int*)(F.ws + WS_TOK);
    for (int i = F.bid * 512 + F.tid; i < NTOK * 4; i += F.G * 512) { const int pos = off[re[i]] + rs[i]; rs[i] = pos; tok[pos] = i >> 2; }
    for (int e = F.bid; e < 32; e += F.G) { const int c = cn[e], r0 = off[e] + c, r1 = off[e] + ((c + 255) >> 8) * 256;
        for (int r = r0 + F.tid; r < r1; r += 512) tok[r] = 0; }
}

__device__ __forceinline__ void phase_combine(Frame& F, int l) {
    LAS float* w8t = (LAS float*)F.lds;
    LAS float* G2 = (LAS float*)(F.lds + 32768); LAS float* GS = G2 + 1024; LAS float* SH = GS + 1024;
    const float* mod = (const float*)(F.ws + WS_MOD);
    const int gw = F.bid * 8 + F.wave, NGW = F.G * 8, RPW = NTOK / NGW, row0 = gw * RPW, rend = row0 + RPW;
    bf16* xa = (bf16*)(F.ws + WS_XA);
    const int* rs = (const int*)(F.ws + WS_RS); const int* re = (const int*)(F.ws + WS_RE); const float* rg = (const float*)(F.ws + WS_RG);
    const LAS int* offl = (const LAS int*)(F.lds + LDS_RT) + 608;
    const unsigned char* y = F.ws + WS_R1;
    int4 ren2;
    u32x2 vn[4]; int4 posn, posn2; f32x4 ggn, ggn2; unsigned yn[4][4];
    { const u32x2* xr0 = (const u32x2*)(xa + (size_t)row0 * 1024) + F.lane;
#pragma unroll
      for (int j = 0; j < 4; ++j) vn[j] = xr0[64 * j];
      posn = *(const int4*)(rs + (size_t)row0 * 4); ggn = *(const f32x4*)(rg + (size_t)row0 * 4); const int4 ren = *(const int4*)(re + (size_t)row0 * 4);
      { const size_t r2 = (row0 + 1 < rend) ? (size_t)(row0 + 1) : (size_t)row0; posn2 = *(const int4*)(rs + r2 * 4); ggn2 = *(const f32x4*)(rg + r2 * 4); ren2 = *(const int4*)(re + r2 * 4); }
      const int pk0[4] = {offl[ren.x] + posn.x, offl[ren.y] + posn.y, offl[ren.z] + posn.z, offl[ren.w] + posn.w};
#pragma unroll
      for (int k = 0; k < 4; ++k) { const unsigned* yr = (const unsigned*)(y + (size_t)pk0[k] * 1024) + F.lane;
#pragma unroll
          for (int j = 0; j < 4; ++j) yn[k][j] = __builtin_nontemporal_load(yr + 64 * j); } }
    if (l + 1 < DEPTH) load_w8t(F, l + 1, w8t);
    if (F.tid < 256) { const int bb = (F.bid * 8 * RPW) >> 13, col = 4 * F.tid;
        const float* mp = mod + (size_t)(l * 4 + bb) * 6144; const float* mq = mod + (size_t)(((l + 1 < DEPTH) ? l + 1 : l) * 4 + bb) * 6144;
        *(LAS f32x4*)(G2 + col) = *(const f32x4*)(mp + 5120 + col);
        if (l + 1 < DEPTH) { *(LAS f32x4*)(GS + col) = *(const f32x4*)(pin(F, I_N1G) + (l + 1) * 1024 + col) * (*(const f32x4*)(mq + 1024 + col) + 1.0f); *(LAS f32x4*)(SH + col) = *(const f32x4*)(mq + col); }
        else *(LAS f32x4*)(GS + col) = *(const f32x4*)(pin(F, I_FNG) + col); }
    lds_barrier();
#pragma unroll 1
    for (int row = row0; row < rend; ++row) {
        u32x2* xr = (u32x2*)(xa + (size_t)row * 1024) + F.lane;
        int ml = 4 * F.lane; asm volatile("" : "+v"(ml));
        f32x4 v[4], a[4]; unsigned yc[4][4];
#pragma unroll
        for (int j = 0; j < 4; ++j) { v[j] = unpack4(vn[j]); a[j] = (f32x4){0.f, 0.f, 0.f, 0.f}; }
        const f32x4 gg = ggn;
#pragma unroll
        for (int k = 0; k < 4; ++k)
#pragma unroll
            for (int j = 0; j < 4; ++j) yc[k][j] = yn[k][j];
        const bool more = row + 1 < rend;
        if (more) { const u32x2* xr2 = (const u32x2*)(xa + (size_t)(row + 1) * 1024) + F.lane;
#pragma unroll
            for (int j = 0; j < 4; ++j) vn[j] = xr2[64 * j];
            const int pk2_[4] = {offl[ren2.x] + posn2.x, offl[ren2.y] + posn2.y, offl[ren2.z] + posn2.z, offl[ren2.w] + posn2.w};
#pragma unroll
            for (int k = 0; k < 4; ++k) { const unsigned* yr = (const unsigned*)(y + (size_t)pk2_[k] * 1024) + F.lane;
#pragma unroll
                for (int j = 0; j < 4; ++j) yn[k][j] = __builtin_nontemporal_load(yr + 64 * j); }
            ggn = ggn2;
            { const size_t r3 = (row + 2 < rend) ? (size_t)(row + 2) : (size_t)row; posn2 = *(const int4*)(rs + r3 * 4); ggn2 = *(const f32x4*)(rg + r3 * 4); ren2 = *(const int4*)(re + r3 * 4); } }
        const float gk[4] = {gg.x, gg.y, gg.z, gg.w};
#pragma unroll
        for (int k = 0; k < 4; ++k)
#pragma unroll
            for (int j = 0; j < 4; ++j) a[j] += unpack4_fp8(yc[k][j]) * gk[k];
        float ss = 0.f;
#pragma unroll
        for (int j = 0; j < 4; ++j) { v[j] = v[j] + *(const LAS f32x4*)(G2 + 256 * j + ml) * a[j]; ss += (v[j].x * v[j].x + v[j].y * v[j].y) + (v[j].z * v[j].z + v[j].w * v[j].w); }
        const float r = rsqrtf(wave_sum(ss) * (1.0f / 1024.0f) + NORM_EPS);
        if (l + 1 < DEPTH) {
            f32x4 h[4]; bf16* hrow = (bf16*)(F.ws + WS_HN) + (size_t)row * 1024;
#pragma unroll
            for (int j = 0; j < 4; ++j) { u32x2 w; w.x = pk2(v[j].x, v[j].y); w.y = pk2(v[j].z, v[j].w); xr[64 * j] = w;
                h[j] = (v[j] * r) * *(const LAS f32x4*)(GS + 256 * j + ml) + *(const LAS f32x4*)(SH + 256 * j + ml);
                u32x2 w2; w2.x = pk2(h[j].x, h[j].y); w2.y = pk2(h[j].z, h[j].w); *(u32x2*)(hrow + 256 * j + 4 * F.lane) = w2; }
            emit_gab(h, w8t, (float*)(F.ws + WS_GAB) + (size_t)row * 8, F.lane);
        } else {
            f32x4* orow = (f32x4*)(pout(F) + (size_t)row * 1024) + F.lane;
#pragma unroll
            for (int j = 0; j < 4; ++j) orow[64 * j] = (v[j] * r) * *(const LAS f32x4*)(GS + 256 * j + ml);
        }
    }
    __syncthreads();
}

#define PHASE __device__ __forceinline__ void
PHASE ph_prologue(int w0) { Frame F = make_frame(w0); phase0(F); }
PHASE ph_norm1_first(int w0) { Frame F = make_frame(w0); phase_norm1_first(F); }
PHASE ph_gemm_in(int w0, int l_) { Frame F = make_frame(w0); const int l = __builtin_amdgcn_readfirstlane(l_);
    pg8::DenseOrder S; S.init(F.ws + WS_HN, (bf16*)(F.ws + WS_WIN) + (size_t)l * NZ * 1024, NTOK, NZ, F.G, F.bid);
    pg8::EpiZ E{(bf16*)(F.ws + WS_R1), NZ};
    pg8::gemm_phase<pg8::EpiZ, pg8::DenseOrder>(F.lds, S, E, pg8::HSTEP, F.wave0); }
PHASE ph_mix(int w0, int l_) { Frame F = make_frame(w0); const int l = __builtin_amdgcn_readfirstlane(l_); phase_mix_naive(F, l); }
PHASE ph_mix_m1(int w0, int l_) { Frame F = make_frame(w0); const int l = __builtin_amdgcn_readfirstlane(l_); phase_mix_m1(F, l); }
PHASE ph_mix_m2a(int w0, int l_) { Frame F = make_frame(w0); const int l = __builtin_amdgcn_readfirstlane(l_); phase_mix_m2a(F, l); }
PHASE ph_mix_m2b(int w0, int l_) { Frame F = make_frame(w0); const int l = __builtin_amdgcn_readfirstlane(l_); phase_mix_m2b(F, l); }
PHASE ph_mix_m3(int w0, int l_) { Frame F = make_frame(w0); const int l = __builtin_amdgcn_readfirstlane(l_); phase_mix_m3(F, l); }
PHASE ph_gemm_out(int w0, int l_) { Frame F = make_frame(w0); const int l = __builtin_amdgcn_readfirstlane(l_);
    const float* mod = (const float*)(F.ws + WS_MOD);
    pg8::DenseOrder S; S.init(F.ws + WS_OMIX, (bf16*)(F.ws + WS_WOUT) + (size_t)l * 1024 * 1024, NTOK, 1024, F.G, F.bid);
    if (l == 0) { pg8::EpiXres<false> E{(const void*)pin(F, I_X), (bf16*)(F.ws + WS_XA), mod + 2048};
        pg8::gemm_phase<pg8::EpiXres<false>, pg8::DenseOrder>(F.lds, S, E, pg8::HSTEP, F.wave0); }
    else { pg8::EpiXres<true> E{(const void*)(F.ws + WS_XA), (bf16*)(F.ws + WS_XA), mod + (size_t)l * 4 * 6144 + 2048};
        pg8::gemm_phase<pg8::EpiXres<true>, pg8::DenseOrder>(F.lds, S, E, pg8::HSTEP, F.wave0); } }
PHASE ph_route(int w0, int l_) { Frame F = make_frame(w0); const int l = __builtin_amdgcn_readfirstlane(l_); phase_norm2_route(F, l); }
PHASE ph_gather(int w0, int l_) { Frame F = make_frame(w0); const int l = __builtin_amdgcn_readfirstlane(l_); phase_gather(F, l); }
PHASE ph_moe_up(int w0, int l_) { Frame F = make_frame(w0); const int l = __builtin_amdgcn_readfirstlane(l_);
    build_rt(F, l);
    const LAS int* rt_e = (const LAS int*)(F.lds + LDS_RT); const int nrt = __builtin_amdgcn_readfirstlane(rt_e[600]);
    pg8::MoeOrder S; S.A = (const char*)(F.ws + WS_HN); S.gather = true; S.atstep = 0; S.Bt = (const char*)(F.ws + WS_W1 + (size_t)l * 32 * 2048 * 1024); S.nct = 8; S.nrt = nrt; S.ntot = nrt * 8; S.G = F.G; S.c = F.bid;
    S.estride = (size_t)2048 * 1024; S.ctstep = (size_t)128 * 1024; S.rt_e = rt_e;
    pg8::EpiAct E{F.ws + WS_R2, pin(F, I_B1) + (size_t)l * 32 * 2048};
    pg8::gemm_phase<pg8::EpiAct, pg8::MoeOrder, true, true>(F.lds, S, E, (size_t)1024 * 1024, F.wave0, (const int*)(F.ws + WS_TOKE)); }
PHASE ph_moe_down(int w0, int l_) { Frame F = make_frame(w0); const int l = __builtin_amdgcn_readfirstlane(l_);
    const LAS int* rt_e = (const LAS int*)(F.lds + LDS_RT); const int nrt = __builtin_amdgcn_readfirstlane(rt_e[600]);
    pg8::MoeOrder S; S.A = (const char*)(F.ws + WS_R2); S.gather = false; S.atstep = (size_t)256 * 1024; S.Bt = (const char*)(F.ws + WS_W2 + (size_t)l * 32 * 1024 * 1024); S.nct = 4; S.nrt = nrt; S.ntot = nrt * 4; S.G = F.G; S.c = F.bid;
    S.estride = (size_t)1024 * 1024; S.ctstep = (size_t)256 * 1024; S.rt_e = rt_e;
    pg8::EpiY E{F.ws + WS_R1, pin(F, I_B2) + (size_t)l * 32 * 1024};
    pg8::gemm_phase<pg8::EpiY, pg8::MoeOrder, false, true>(F.lds, S, E, (size_t)128 * 1024, F.wave0); }
PHASE ph_combine(int w0, int l_) { Frame F = make_frame(w0); const int l = __builtin_amdgcn_readfirstlane(l_); phase_combine(F, l); }

__global__ void __launch_bounds__(512, 2) fwd(Params p) {
    LAS unsigned char* lds = (LAS unsigned char*)lds_raw;
    const int tid = threadIdx.x;
    for (int u = tid; u < (LDS_BYTES - LDSCTL_OFF) / 4; u += 512) ((LAS unsigned*)(lds + LDSCTL_OFF))[u] = 0u;
    __syncthreads();
    if (tid == 0) {
        LAS unsigned long long* P = (LAS unsigned long long*)(lds + LDS_PAR);
#pragma unroll
        for (int i = 0; i < 22; ++i) P[i] = (unsigned long long)p.in[i];
        P[22] = (unsigned long long)p.out; P[23] = (unsigned long long)p.ws;
    }
    __syncthreads();
    (void)xcd_barrier_post((unsigned*)(p.ws + WS_CTL) + CW_BAR, (volatile LAS unsigned*)(lds + MISC_OFF) + 8);
#define GRID_BAR() do { XcdBarrier b2_; unsigned long long bp_ = ldpar(lds, 23) + WS_CTL + 4ull * CW_BAR; asm volatile("" : "+s"(bp_)); b2_.bar = (unsigned*)(GAS unsigned*)bp_; b2_.x = xb_xcc_id(); b2_.st = (volatile LAS unsigned*)(lds + MISC_OFF) + 8; xcd_barrier(b2_); } while (0)
    const int w0 = __builtin_amdgcn_readfirstlane(tid >> 6);
#ifndef DBL_P0
#define DBL_P0 1
#endif
    for (int r_ = 0; r_ < DBL_P0; ++r_) { ph_prologue(w0); GRID_BAR(); }
    ph_norm1_first(w0); GRID_BAR();
#ifndef DBL_GIN
#define DBL_GIN 1
#endif
#define DBL_M1 1
#define DBL_M2 1
#define DBL_M3 1
#ifndef DBL_MOE
#define DBL_MOE 1
#endif
#define LAYER(l) do { for (int r_ = 0; r_ < DBL_GIN; ++r_) { ph_gemm_in(w0, l); GRID_BAR(); } \
        for (int r_ = 0; r_ < DBL_M1; ++r_) { ph_mix_m1(w0, l); GRID_BAR(); } for (int r_ = 0; r_ < DBL_M2; ++r_) { ph_mix_m2b(w0, l); GRID_BAR(); } for (int r_ = 0; r_ < DBL_M3; ++r_) { ph_mix_m3(w0, l); GRID_BAR(); } \
        ph_gemm_out(w0, l); GRID_BAR(); ph_route(w0, l); GRID_BAR(); \
        for (int r_ = 0; r_ < DBL_MOE; ++r_) { ph_moe_up(w0, l); GRID_BAR(); } for (int r_ = 0; r_ < DBL_MOE; ++r_) { ph_moe_down(w0, l); GRID_BAR(); } ph_combine(w0, l); } while (0)
    LAYER(0); GRID_BAR();
    LAYER(1);
}

extern "C" void kernel_launch(void* const* d_in, const int* in_sizes, int n_in, void* d_out, int out_size, void* d_ws, size_t ws_size, hipStream_t stream) {
    static int grid = 0;
    if (grid == 0) {
        if (n_in != 22 || out_size != NTOK * D || ws_size < WS_END) { fprintf(stderr, "kernel_launch: unexpected shapes (n_in %d out %d ws %zu need %zu)\n", n_in, out_size, ws_size, (size_t)WS_END); grid = -1; return; }
        int dev = 0, cus = 0, per_cu = 0;
        if (hipGetDevice(&dev) != hipSuccess || hipDeviceGetAttribute(&cus, hipDeviceAttributeMultiprocessorCount, dev) != hipSuccess) { grid = -1; return; }
        if (hipFuncSetAttribute((const void*)fwd, hipFuncAttributeMaxDynamicSharedMemorySize, LDS_BYTES) != hipSuccess) { fprintf(stderr, "kernel_launch: hipFuncSetAttribute failed\n"); grid = -1; return; }
        if (hipOccupancyMaxActiveBlocksPerMultiprocessor(&per_cu, (const void*)fwd, 512, LDS_BYTES) != hipSuccess || per_cu < 1) fprintf(stderr, "kernel_launch: occupancy query reports %d\n", per_cu);
        (void)hipGetLastError();
        grid = cus;
    }
    if (grid < 0) return;
    if (hipMemsetAsync((char*)d_ws + WS_CTL, 0, CTL_ZERO_BYTES, stream) != hipSuccess) return;
    Params p{};
    for (int i = 0; i < 22; ++i) p.in[i] = (const float*)d_in[i];
    p.out = (float*)d_out; p.ws = (unsigned char*)d_ws;
    hipLaunchKernelGGL(fwd, dim3(grid), dim3(512), LDS_BYTES, stream, p);
}
```

```cpp
#include <hip/hip_runtime.h>
#include <cstdio>
#include <cstdint>

#define GAS __attribute__((address_space(1)))
#define LAS __attribute__((address_space(3)))
typedef unsigned short bf16;
typedef short bf16x8 __attribute__((ext_vector_type(8)));
typedef float f32x4 __attribute__((ext_vector_type(4)));
typedef float f32x2 __attribute__((ext_vector_type(2)));
typedef unsigned u32x4 __attribute__((ext_vector_type(4)));
typedef unsigned u32x2 __attribute__((ext_vector_type(2)));

constexpr int D = 1024, BATCH = 4, SEQ = 8192, NTOK = BATCH * SEQ, DEPTH = 2;
constexpr int NIN = 4104, NZ = 4096, NE = 32, TOPK = 4, FF = 1024;
constexpr int NROWS_S = NTOK * TOPK + NE * 256;
constexpr float NORM_EPS = 1e-6f;

constexpr size_t MiB = 1u << 20;
constexpr size_t WS_CTL = 0, CTL_ZERO_BYTES = 1 * MiB;
constexpr size_t WS_MOD = 1 * MiB;
constexpr size_t WS_LB = WS_MOD + 256 * 1024;
constexpr size_t WS_ROPE = WS_LB + 8192;
constexpr size_t WS_WIN = 2 * MiB;
constexpr size_t WS_WOUT = WS_WIN + 16 * MiB;
constexpr size_t WS_W1 = WS_WOUT + 4 * MiB;
constexpr size_t WS_W2 = WS_W1 + 256 * MiB;
constexpr size_t WS_XA = WS_W2 + 128 * MiB;
constexpr size_t WS_HN = WS_XA + 128 * MiB;
constexpr size_t WS_OMIX = WS_HN + 64 * MiB;
constexpr size_t WS_GAB = WS_OMIX + 64 * MiB;
constexpr size_t WS_RE = WS_GAB + 1 * MiB;
constexpr size_t WS_RS = WS_RE + 512 * 1024;
constexpr size_t WS_RG = WS_RS + 512 * 1024;
constexpr size_t WS_TOK = WS_RG + 512 * 1024;
constexpr size_t WS_R1 = WS_TOK + 1 * MiB;
constexpr size_t WS_R2 = WS_R1 + 272 * MiB;
constexpr size_t WS_HKV = WS_R2 + 272 * MiB;
constexpr size_t WS_HDEC = WS_HKV + 128 * MiB;
constexpr size_t WS_HSP = WS_HDEC + 1 * MiB;
constexpr size_t WS_RKV = WS_HSP + 64 * MiB;
constexpr size_t WS_RSP = WS_RKV + 32 * MiB;
constexpr size_t WS_GT = WS_RSP + 16 * MiB;
constexpr size_t WS_GUT = WS_GT + 16 * MiB;
constexpr size_t WS_GKC = WS_GUT + 32 * MiB;
constexpr size_t WS_GWT = WS_GKC + 16 * MiB;
constexpr size_t WS_GQK = WS_GWT + 16 * MiB;
constexpr size_t WS_GQD = WS_GQK + 16 * MiB;
constexpr size_t WS_GSP = WS_GQD + 16 * MiB;
constexpr size_t WS_TOKE = WS_GSP;
constexpr size_t WS_GPG = WS_GSP + 16 * MiB;
constexpr size_t WS_GQG = WS_GPG + 2 * MiB;
constexpr size_t WS_GSS = WS_GQG + 2 * MiB;
constexpr size_t WS_END = WS_GSS + 4 * MiB;
constexpr int CW_BAR = 4096;
constexpr int CW_CNT = 16384;

constexpr int RING_BYTES = 131072;
constexpr int LDSCTL_OFF = RING_BYTES, MISC_OFF = LDSCTL_OFF + 320;
constexpr int LDS_RT = LDSCTL_OFF + 1024;
constexpr int LDS_SM = LDSCTL_OFF + 4096;
constexpr int LDS_BYTES = 147456;

#define LDS_WAIT() asm volatile("s_waitcnt lgkmcnt(0)" ::: "memory")
__device__ __forceinline__ void lds_barrier() { asm volatile("s_waitcnt lgkmcnt(0)" ::: "memory"); __builtin_amdgcn_s_barrier(); asm volatile("" ::: "memory"); }
#define VM_WAIT() asm volatile("s_waitcnt vmcnt(0)" ::: "memory")
__device__ __forceinline__ unsigned f2bf(float f) { unsigned u = __builtin_bit_cast(unsigned, f); return (u + 0x7fffu + ((u >> 16) & 1u)) >> 16; }
typedef __bf16 bf16x2_t __attribute__((ext_vector_type(2)));
__device__ __forceinline__ unsigned pk2(float lo, float hi) { return __builtin_bit_cast(unsigned, __builtin_convertvector((f32x2){lo, hi}, bf16x2_t)); }
__device__ __forceinline__ unsigned pk2m(float lo, float hi) { return pk2(lo, hi); }
typedef int i32x8 __attribute__((ext_vector_type(8)));
__device__ __forceinline__ unsigned pk4_fp8(float a, float b, float c, float d) {
    int w = __builtin_amdgcn_cvt_pk_fp8_f32(a, b, 0, false); w = __builtin_amdgcn_cvt_pk_fp8_f32(c, d, w, true); return (unsigned)w; }
constexpr float W8_SCALE = 64.0f, W8_INV = 1.0f / 64.0f;
__device__ __forceinline__ float bf2f(bf16 v) { return __builtin_bit_cast(float, ((unsigned)v) << 16); }
__device__ __forceinline__ float bflo(unsigned w) { return __builtin_bit_cast(float, w << 16); }
__device__ __forceinline__ float bfhi(unsigned w) { return __builtin_bit_cast(float, w & 0xffff0000u); }
#define DPP_ADD(x, ctrl, rmask) x += __builtin_bit_cast(float, __builtin_amdgcn_update_dpp(0, __builtin_bit_cast(int, x), ctrl, rmask, 0xf, false))
__device__ __forceinline__ float wave_scan_incl(float x, int lane) {
    (void)lane;
    DPP_ADD(x, 0x111, 0xf); DPP_ADD(x, 0x112, 0xf); DPP_ADD(x, 0x114, 0xf); DPP_ADD(x, 0x118, 0xf);
    DPP_ADD(x, 0x142, 0xa); DPP_ADD(x, 0x143, 0xc);
    return x;
}
__device__ __forceinline__ float wave_sum(float v) {
    return __builtin_bit_cast(float, __builtin_amdgcn_readlane(__builtin_bit_cast(int, wave_scan_incl(v, 0)), 63));
}
__device__ __forceinline__ float shx(float v, int o, int lane) { return __builtin_bit_cast(float, __builtin_amdgcn_ds_bpermute((lane ^ o) << 2, __builtin_bit_cast(int, v))); }
__device__ __forceinline__ int shxi(int v, int o, int lane) { return __builtin_amdgcn_ds_bpermute((lane ^ o) << 2, v); }
__device__ __forceinline__ float sigm(float x) { return __builtin_amdgcn_rcpf(1.0f + __expf(-x)); }
__device__ __forceinline__ float siluf(float x) { return x * sigm(x); }

#define XB_TMO      128
#define XB_XCNT(j)  (256  + 64 * (j))
#define XB_XSUB(j)  (1280 + 64 * (j))
#define XB_XGEN(j)  (2304 + 64 * (j))
#define XB_TOP      3328
#define XB_TOPGEN   3392
#define XCD_BAR_WORDS 3456
#define XB_SPIN_CAP (1u << 20)

__device__ __forceinline__ unsigned xb_ld(unsigned* p)              { return __hip_atomic_load(p, __ATOMIC_RELAXED, __HIP_MEMORY_SCOPE_AGENT); }
__device__ __forceinline__ unsigned xb_add(unsigned* p, unsigned v) { return __hip_atomic_fetch_add(p, v, __ATOMIC_RELAXED, __HIP_MEMORY_SCOPE_AGENT); }
__device__ __forceinline__ unsigned xb_xcc_id() { return (unsigned)__builtin_amdgcn_s_getreg((3 << 11) | 20) & 0xFu; }
#define XB_SPIN(cond, bar) do { unsigned _sp = 0; while (cond) { __builtin_amdgcn_s_sleep(1); \
    if ((++_sp & 255u) == 0u) { if (xb_ld(&(bar)[XB_TMO])) break; if (_sp > XB_SPIN_CAP) { atomicAdd(&(bar)[XB_TMO], 1u); break; } } } } while (0)

struct XcdBarrier { unsigned* bar; unsigned x; volatile LAS unsigned* st; };

__device__ __forceinline__ XcdBarrier xcd_barrier_post(unsigned* bar, volatile LAS unsigned* st) {
    XcdBarrier b; b.bar = bar; b.x = xb_xcc_id(); b.st = st;
    if (threadIdx.x == 0) (void)xb_add(&bar[XB_XCNT(b.x)], 1u);
    return b;
}
__device__ __forceinline__ void xcd_barrier_complete(unsigned* bar, unsigned x, unsigned& nloc, unsigned& nx) {
    const unsigned G = gridDim.x * gridDim.y * gridDim.z;
    unsigned sum, cnt, mine, sp = 0u;
    for (;;) {
        sum = 0u; cnt = 0u; mine = 0u;
#pragma unroll
        for (unsigned j = 0; j < 16; ++j) { const unsigned c = xb_ld(&bar[XB_XCNT(j)]); sum += c; cnt += (c > 0u) ? 1u : 0u; mine = (j == x) ? c : mine; }
        if (sum == G) break;
        __builtin_amdgcn_s_sleep(1);
        if ((++sp & 255u) == 0u) { if (xb_ld(&bar[XB_TMO])) break; if (sp > XB_SPIN_CAP) { atomicAdd(&bar[XB_TMO], 1u); break; } }
    }
    nloc = mine > 0u ? mine : 1u; nx = cnt > 0u ? cnt : 1u;
}
__device__ __forceinline__ void xcd_barrier(const XcdBarrier& b) {
    asm volatile("s_waitcnt vmcnt(0)" ::: "memory");
    __syncthreads();
    if (threadIdx.x == 0) {
        unsigned* bar = b.bar;
        __builtin_amdgcn_s_waitcnt(0);
        unsigned nloc = b.st[0], nx = b.st[1];
        if (nloc == 0u) { xcd_barrier_complete(bar, b.x, nloc, nx); b.st[0] = nloc; b.st[1] = nx; }
        const unsigned old = xb_add(&bar[XB_XSUB(b.x)], 1u);
        const unsigned gen = old / nloc;
        if (old + 1u == (gen + 1u) * nloc) {
            __builtin_amdgcn_fence(__ATOMIC_RELEASE, "agent");
            asm volatile("s_waitcnt vmcnt(0)" ::: "memory");
            const unsigned og = xb_add(&bar[XB_TOP], 1u);
            const unsigned tg = og / nx;
            if (og + 1u == (tg + 1u) * nx) xb_add(&bar[XB_TOPGEN], 1u);
            else XB_SPIN(xb_ld(&bar[XB_TOPGEN]) == tg, bar);
            __builtin_amdgcn_fence(__ATOMIC_ACQUIRE, "agent");
            xb_add(&bar[XB_XGEN(b.x)], 1u);
            asm volatile("s_waitcnt vmcnt(0)" ::: "memory");
        } else {
            XB_SPIN(xb_ld(&bar[XB_XGEN(b.x)]) == gen, bar);
            __builtin_amdgcn_fence(__ATOMIC_ACQUIRE, "agent");
            asm volatile("s_waitcnt vmcnt(0)" ::: "memory");
        }
    }
    __syncthreads();
}

namespace pg8 {
typedef int i32x4_ __attribute__((ext_vector_type(4)));
constexpr int BM = 256, BK = 64, HALF = 128, HTB = HALF * BK * 2, STAGE_BYTES = 8 * HTB, NXCD = 8, WGM = 8, KD = 1024;
constexpr size_t HSTEP = (size_t)HALF * KD * 2, TSTEP = 2 * HSTEP;
__host__ __device__ __forceinline__ int lds_byte(int r, int c) { const int st = (r >> 4) * 2 + (c >> 5), rr = r & 15, cc = c & 31, ob = rr * 64 + cc * 2; return st * 1024 + (ob ^ (((ob >> 9) & 1) << 5)); }
__host__ __device__ __forceinline__ void stage_rc(int b, int& R, int& C) { const int st = b / 1024, sb = b % 1024, swz = sb ^ (((sb >> 9) & 1) << 5); R = (st >> 1) * 16 + swz / 64; C = (st & 1) * 32 + (swz % 64) / 2; }
__host__ __device__ __forceinline__ int perm32(int rho) { const int n = rho >> 4, i = rho & 15; return 8 * (i >> 2) + 4 * n + (i & 3); }

struct Unit { int pm, pn, e, tb; const char* a; const char* b; };

struct DenseOrder {
    const char* A; const char* Bt; int nM, nN, nwg, G, c;
    __device__ void init(const void* A_, const void* Bt_, int M, int N, int G_, int c_) { A = (const char*)A_; Bt = (const char*)Bt_; nM = M / BM; nN = N / BM; nwg = nM * nN; G = G_; c = c_; }
    __device__ __forceinline__ bool next(int i, Unit& u) const {
        const long L = (long)i * G + c; if (L >= nwg) return false;
        int wgid = (int)L; { const int q = nwg / NXCD, r = nwg % NXCD, xcd = wgid % NXCD, off = wgid / NXCD; wgid = (xcd < r ? xcd * (q + 1) : r * (q + 1) + (xcd - r) * q) + off; }
        const int nig = WGM * nN, gid = wgid / nig, fm = gid * WGM, gsz = (nM - fm) < WGM ? (nM - fm) : WGM;
        u.pm = fm + ((wgid % nig) % gsz); u.pn = (wgid % nig) / gsz; u.e = 0; u.tb = 0;
        u.a = A + (size_t)u.pm * TSTEP; u.b = Bt + (size_t)u.pn * TSTEP; return true;
    }
};
struct MoeOrder {
    const char* A; const char* Bt; int nct, nrt, ntot, G, c; size_t estride, ctstep, atstep; const LAS int* rt_e; bool gather;
    __device__ __forceinline__ bool next(int i, Unit& u) const {
        const int L = i * G + c; if (L >= ntot) return false;
        const int per = 8 * nct, grp = L / per, rem = L % per, fm = grp * 8, gsz = (nrt - fm) < 8 ? (nrt - fm) : 8;
        const int rt = fm + rem % gsz, ct = rem / gsz;
        const int e = __builtin_amdgcn_readfirstlane(rt_e[rt]);
        u.pm = rt; u.pn = ct; u.e = e; u.tb = e * 32768 + rt * 256 - __builtin_amdgcn_readfirstlane(rt_e[608 + e]);
        u.a = gather ? A : A + (size_t)rt * atstep; u.b = Bt + (size_t)e * estride + (size_t)ct * ctstep; return true;
    }
};

template <class Epi, class Sched, bool GATHER = false, bool FP8 = false>
__device__ __forceinline__ void gemm_phase(LAS unsigned char* lds, const Sched& S, const Epi& E, const size_t hstepB, const int wave0, const int* tok = nullptr) {
    int ln_; asm volatile("v_mbcnt_lo_u32_b32 %0, -1, 0\n\tv_mbcnt_hi_u32_b32 %0, -1, %0" : "=v"(ln_));
    int wid_ = wave0; asm volatile("" : "+s"(wid_));
    const int wid = wid_, lane = ln_, tid = wid * 64 + lane, wr = wid >> 2, wc = wid & 3, fr = lane & 15, fq = lane >> 4;
    constexpr int K = KD, ROWB = FP8 ? K : 2 * K, nt = FP8 ? K / 128 : K / BK;
    unsigned voffA[2], voffB[2]; int RA[2];
#pragma unroll
    for (int i = 0; i < 2; ++i) { int R, C; stage_rc(tid * 16 + i * 8192, R, C); const int Rb = Epi::PERM ? ((R & ~31) + perm32(R & 31)) : R;
        voffA[i] = GATHER ? 0u : (unsigned)(R * ROWB + C * 2); voffB[i] = (unsigned)(Rb * ROWB + C * 2); RA[i] = R; }
    unsigned va[2] = {0u, 0u}, vn[2] = {0u, 0u};
#define PG8_GOFF(dst, tb_) do { int t2_; asm volatile("v_mbcnt_lo_u32_b32 %0, -1, 0\n\tv_mbcnt_hi_u32_b32 %0, -1, %0" : "=v"(t2_)); t2_ += wid * 64; int R0_, C0_, R1_, C1_; stage_rc(t2_ * 16, R0_, C0_); stage_rc(t2_ * 16 + 8192, R1_, C1_); \
        _Pragma("unroll") for (int _h = 0; _h < 2; ++_h) dst[_h] = ((unsigned)tok[(tb_) + 128 * _h + R0_] & 32767u) | (((unsigned)tok[(tb_) + 128 * _h + R1_] & 32767u) << 16); } while (0)
#define PG8_GVOFF(p, _i) ({ int t3_; asm volatile("v_mbcnt_lo_u32_b32 %0, -1, 0\n\tv_mbcnt_hi_u32_b32 %0, -1, %0" : "=v"(t3_)); t3_ += wid * 64; int R3_, C3_; stage_rc(t3_ * 16 + (_i) * 8192, R3_, C3_); \
        (int)((((p) >> (16 * (_i))) & 0xffffu) * (unsigned)ROWB + (unsigned)C3_ * 2u); })
    const size_t kstep = (size_t)(BK * 2);
    const size_t hstep = (size_t)HALF * ROWB;
    const unsigned ldsw = (unsigned)wid * 1024u;
    const int aoff = lds_byte(wr * 64 + fr, fq * 8), boff = lds_byte(wc * 32 + fr, fq * 8);
#define PG8_SA(b, h) (((b) * 2 + (h)) * HTB)
#define PG8_SB(b, h) ((4 + (b) * 2 + (h)) * HTB)
    __amdgpu_buffer_rsrc_t rsA = __builtin_amdgcn_make_buffer_rsrc((void*)S.A, 0, 0x7fffffff, 0x00020000), rsB = __builtin_amdgcn_make_buffer_rsrc((void*)S.Bt, 0, 0x7fffffff, 0x00020000);
#define PG8_STAGE_X(bufoff, gbase, voff, RS, BASE) do { if constexpr (FP8) { _Pragma("unroll") for (int _i = 0; _i < 2; ++_i) \
        __builtin_amdgcn_raw_ptr_buffer_load_lds(RS, (LAS void*)(lds + (bufoff) + ldsw + _i * 8192), 16, (int)(voff)[_i], (int)(unsigned)((const char*)(gbase) - (BASE)), 0, 0); } \
        else { _Pragma("unroll") for (int _i = 0; _i < 2; ++_i) \
        __builtin_amdgcn_global_load_lds((const unsigned*)((const char*)(gbase) + (voff)[_i]), (LAS unsigned*)(lds + (bufoff) + ldsw + _i * 8192), 16, 0, 0); } } while (0)
#define PG8_STAGE(bufoff, gbase, voff) PG8_STAGE_X(bufoff, gbase, voff, rsB, S.Bt)
#define PG8_STAGE_A(bufoff, gbase, hh, nx) do { if constexpr (GATHER && FP8) { _Pragma("unroll") for (int _i = 0; _i < 2; ++_i) \
        __builtin_amdgcn_raw_ptr_buffer_load_lds(rsA, (LAS void*)(lds + (bufoff) + ldsw + _i * 8192), 16, PG8_GVOFF((nx) ? vn[hh] : va[hh], _i), (int)(unsigned)((const char*)(gbase) - S.A), 0, 0); } \
        else if constexpr (GATHER) { _Pragma("unroll") for (int _i = 0; _i < 2; ++_i) \
        __builtin_amdgcn_global_load_lds((const unsigned*)((const char*)(gbase) + (unsigned)PG8_GVOFF((nx) ? vn[hh] : va[hh], _i)), (LAS unsigned*)(lds + (bufoff) + ldsw + _i * 8192), 16, 0, 0); } \
        else { PG8_STAGE_X(bufoff, (gbase) + (hh) * hstep, voffA, rsA, S.A); } } while (0)
#define PG8_LDA(dst, b, h) do { if constexpr (FP8) { _Pragma("unroll") for (int m = 0; m < 4; ++m) dst##8[m] = __builtin_shufflevector(*(const LAS i32x4_*)(lds + PG8_SA(b, h) + aoff + m * 2048), *(const LAS i32x4_*)(lds + PG8_SA(b, h) + aoff + m * 2048 + 1024), 0, 1, 2, 3, 4, 5, 6, 7); } \
        else { _Pragma("unroll") for (int m = 0; m < 4; ++m) _Pragma("unroll") for (int k = 0; k < 2; ++k) dst[m][k] = *(const LAS bf16x8*)(lds + PG8_SA(b, h) + aoff + m * 2048 + k * 1024); } } while (0)
#define PG8_LDB(dst, b, h) do { if constexpr (FP8) { _Pragma("unroll") for (int n = 0; n < 2; ++n) dst##8[n] = __builtin_shufflevector(*(const LAS i32x4_*)(lds + PG8_SB(b, h) + boff + n * 2048), *(const LAS i32x4_*)(lds + PG8_SB(b, h) + boff + n * 2048 + 1024), 0, 1, 2, 3, 4, 5, 6, 7); } \
        else { _Pragma("unroll") for (int n = 0; n < 2; ++n) _Pragma("unroll") for (int k = 0; k < 2; ++k) dst[n][k] = *(const LAS bf16x8*)(lds + PG8_SB(b, h) + boff + n * 2048 + k * 1024); } } while (0)
#define PG8_MMA(ai, bj, At, Bt) do { __builtin_amdgcn_s_setprio(1); if constexpr (FP8) { _Pragma("unroll") for (int m = 0; m < 4; ++m) _Pragma("unroll") for (int n = 0; n < 2; ++n) \
        acc[ai][bj][m][n] = __builtin_amdgcn_mfma_scale_f32_16x16x128_f8f6f4(Bt##8[n], At##8[m], acc[ai][bj][m][n], 0, 0, 0, 0, 0, 0); } \
        else { _Pragma("unroll") for (int m = 0; m < 4; ++m) _Pragma("unroll") for (int n = 0; n < 2; ++n) _Pragma("unroll") for (int k = 0; k < 2; ++k) \
        acc[ai][bj][m][n] = __builtin_amdgcn_mfma_f32_16x16x32_bf16(Bt[n][k], At[m][k], acc[ai][bj][m][n], 0, 0, 0); } __builtin_amdgcn_s_setprio(0); } while (0)
#define PG8_WAIT_V(n) asm volatile("s_waitcnt vmcnt(" #n ")" ::: "memory")
#define PG8_WAIT_L(n) asm volatile("s_waitcnt lgkmcnt(" #n ")" ::: "memory")
#define PG8_BAR __builtin_amdgcn_s_barrier()
#define PG8_SCHED __builtin_amdgcn_sched_barrier(0)
    Unit cur, nxt; int ui = 0;
    if (!S.next(0, cur)) return;
    f32x4 acc[2][2][4][2];
    { f32x4 ib[2][2]; E.init(ib, cur, wc, fq);
#pragma unroll
      for (int a = 0; a < 2; ++a)
#pragma unroll
        for (int b = 0; b < 2; ++b)
#pragma unroll
            for (int m = 0; m < 4; ++m)
#pragma unroll
                for (int n = 0; n < 2; ++n) acc[a][b][m][n] = ib[b][n]; }
    bf16x8 At[4][2], B0[2][2], B1[2][2]; i32x8 At8[4], B08[2], B18[2];
    const char* cA = cur.a; const char* cB = cur.b;
    if constexpr (GATHER) { PG8_GOFF(va, cur.tb); }
    PG8_STAGE(PG8_SB(0, 0), cB, voffB); PG8_STAGE(PG8_SB(0, 1), cB + hstepB, voffB); PG8_STAGE_A(PG8_SA(0, 0), cA, 0, false); PG8_STAGE_A(PG8_SA(0, 1), cA, 1, false);
    if (wr == 1) PG8_BAR;
    PG8_WAIT_V(2); PG8_BAR;
    PG8_STAGE(PG8_SB(1, 0), cB + kstep, voffB); PG8_STAGE_A(PG8_SA(1, 0), cA + kstep, 0, false); PG8_STAGE(PG8_SB(1, 1), cB + hstepB + kstep, voffB);
    PG8_WAIT_V(6); PG8_BAR;
    for (;;) {
        const bool has_next = S.next(ui + 1, nxt);
        const char* nA = has_next ? nxt.a : cA; const char* nB = has_next ? nxt.b : cB;
        if constexpr (GATHER) { if (has_next) { PG8_GOFF(vn, nxt.tb); } else { vn[0] = va[0]; vn[1] = va[1]; } }
#pragma unroll 1
        for (int t = 0; t < nt; t += 2) {
            const bool last = (t == nt - 2);
            const char* a1 = cA + (size_t)(t + 1) * kstep;
            const char* a2 = last ? nA : cA + (size_t)(t + 2) * kstep; const char* b2 = last ? nB : cB + (size_t)(t + 2) * kstep;
            const char* a3 = a2 + kstep; const char* b3 = b2 + kstep;
            PG8_LDB(B0, 0, 0); PG8_LDB(B1, 0, 1); PG8_SCHED; PG8_LDA(At, 0, 0); PG8_STAGE_A(PG8_SA(1, 1), a1, 1, false);
            PG8_WAIT_V(8); PG8_WAIT_L(0); PG8_BAR; PG8_MMA(0, 0, At, B0); PG8_MMA(0, 1, At, B1); PG8_BAR; PG8_SCHED;
            PG8_LDA(At, 0, 1); PG8_STAGE(PG8_SB(0, 0), b2, voffB); PG8_STAGE(PG8_SB(0, 1), b2 + hstepB, voffB); PG8_STAGE_A(PG8_SA(0, 0), a2, 0, last);
            PG8_WAIT_V(8); PG8_WAIT_L(0); PG8_BAR; PG8_MMA(1, 0, At, B0); PG8_MMA(1, 1, At, B1); PG8_BAR; PG8_SCHED;
            PG8_LDB(B0, 1, 0); PG8_LDB(B1, 1, 1); PG8_SCHED; PG8_LDA(At, 1, 0); PG8_STAGE_A(PG8_SA(0, 1), a2, 1, last);
            PG8_WAIT_V(8); PG8_WAIT_L(0); PG8_BAR; PG8_MMA(0, 0, At, B0); PG8_MMA(0, 1, At, B1); PG8_BAR; PG8_SCHED;
            PG8_LDA(At, 1, 1); PG8_STAGE(PG8_SB(1, 0), b3, voffB); PG8_STAGE(PG8_SB(1, 1), b3 + hstepB, voffB); PG8_STAGE_A(PG8_SA(1, 0), a3, 0, last);
            PG8_WAIT_V(8); PG8_WAIT_L(0); PG8_BAR; PG8_MMA(1, 0, At, B0); PG8_MMA(1, 1, At, B1); PG8_BAR; PG8_SCHED;
        }
        if (wr == 0) PG8_BAR;
        f32x4 nb[2][2];
        { int l2_; asm volatile("v_mbcnt_lo_u32_b32 %0, -1, 0\n\tv_mbcnt_hi_u32_b32 %0, -1, %0" : "=v"(l2_)); E.init(nb, has_next ? nxt : cur, wc, l2_ >> 4); E(acc, cur, wr, wc, l2_ & 15, l2_ >> 4); }
        if (!has_next) break;
#pragma unroll
        for (int a = 0; a < 2; ++a)
#pragma unroll
            for (int b = 0; b < 2; ++b)
#pragma unroll
                for (int m = 0; m < 4; ++m)
#pragma unroll
                    for (int n = 0; n < 2; ++n) acc[a][b][m][n] = nb[b][n];
        cur = nxt; cA = nA; cB = nB; ++ui;
        if constexpr (GATHER) { va[0] = vn[0]; va[1] = vn[1]; }
        if (wr == 1) PG8_BAR;
    }
    PG8_WAIT_V(0);
    PG8_BAR;
#undef PG8_SA
#undef PG8_SB
#undef PG8_STAGE
#undef PG8_STAGE_X
#undef PG8_STAGE_A
#undef PG8_GOFF
#undef PG8_GVOFF
#undef PG8_LDA
#undef PG8_LDB
#undef PG8_MMA
#undef PG8_WAIT_V
#undef PG8_WAIT_L
#undef PG8_BAR
#undef PG8_SCHED
}

struct EpiZ {
    static constexpr bool PERM = true;
    bf16* O; int ldc;
    __device__ __forceinline__ void init(f32x4 (&ib)[2][2], const Unit&, int, int) const { ib[0][0] = ib[0][1] = ib[1][0] = ib[1][1] = (f32x4){0.f, 0.f, 0.f, 0.f}; }
    __device__ __forceinline__ void operator()(const f32x4 (&acc)[2][2][4][2], const Unit& u, int wr, int wc, int fr, int fq) const {
        const int row0 = u.pm * BM + wr * 64 + fr, col0 = u.pn * BM + wc * 32 + 8 * fq;
#pragma unroll
        for (int ai = 0; ai < 2; ++ai)
#pragma unroll
            for (int m = 0; m < 4; ++m) { bf16* rowp = O + (size_t)(row0 + ai * HALF + m * 16) * ldc + col0;
#pragma unroll
                for (int bj = 0; bj < 2; ++bj) { const f32x4 v0 = acc[ai][bj][m][0], v1 = acc[ai][bj][m][1];
                    u32x4 w; w.x = pk2(v0[0], v0[1]); w.y = pk2(v0[2], v0[3]); w.z = pk2(v1[0], v1[1]); w.w = pk2(v1[2], v1[3]);
                    *(u32x4*)(rowp + bj * HALF) = w; } }
    }
};
template <bool BASE_BF16>
struct EpiXres {
    static constexpr bool PERM = true;
    const void* base; bf16* out; const float* gate;
    __device__ __forceinline__ void init(f32x4 (&ib)[2][2], const Unit&, int, int) const { ib[0][0] = ib[0][1] = ib[1][0] = ib[1][1] = (f32x4){0.f, 0.f, 0.f, 0.f}; }
    __device__ __forceinline__ void operator()(const f32x4 (&acc)[2][2][4][2], const Unit& u, int wr, int wc, int fr, int fq) const {
        const int row0 = u.pm * BM + wr * 64 + fr, col0 = u.pn * BM + wc * 32 + 8 * fq;
        const float* gp = gate + (size_t)((u.pm * BM) >> 13) * 6144 + col0;
        f32x4 gv[2][2];
#pragma unroll
        for (int bj = 0; bj < 2; ++bj)
#pragma unroll
            for (int n = 0; n < 2; ++n) gv[bj][n] = *(const f32x4*)(gp + bj * HALF + 4 * n);
#pragma unroll
        for (int ai = 0; ai < 2; ++ai)
#pragma unroll
            for (int m = 0; m < 4; ++m) { const size_t off = (size_t)(row0 + ai * HALF + m * 16) * 1024 + col0;
#pragma unroll
                for (int bj = 0; bj < 2; ++bj) { f32x4 b0, b1;
                    if constexpr (BASE_BF16) { const u32x4 w = *(const u32x4*)((const bf16*)base + off + bj * HALF); b0 = (f32x4){bflo(w.x), bfhi(w.x), bflo(w.y), bfhi(w.y)}; b1 = (f32x4){bflo(w.z), bfhi(w.z), bflo(w.w), bfhi(w.w)}; }
                    else { b0 = *(const f32x4*)((const float*)base + off + bj * HALF); b1 = *(const f32x4*)((const float*)base + off + bj * HALF + 4); }
                    const f32x4 v0 = b0 + gv[bj][0] * acc[ai][bj][m][0], v1 = b1 + gv[bj][1] * acc[ai][bj][m][1];
                    u32x4 w; w.x = pk2(v0[0], v0[1]); w.y = pk2(v0[2], v0[3]); w.z = pk2(v1[0], v1[1]); w.w = pk2(v1[2], v1[3]);
                    *(u32x4*)(out + off + bj * HALF) = w; } }
    }
};
struct EpiAct {
    static constexpr bool PERM = true;
    unsigned char* O; const float* b1;
    __device__ __forceinline__ void init(f32x4 (&ib)[2][2], const Unit& u, int wc, int fq) const {
        const float* bp = b1 + (size_t)u.e * 2048 + u.pn * HALF + wc * 32 + 8 * fq;
#pragma unroll
        for (int n = 0; n < 2; ++n) { ib[0][n] = *(const f32x4*)(bp + 4 * n) * W8_SCALE; ib[1][n] = *(const f32x4*)(bp + 1024 + 4 * n) * W8_SCALE; } }
    __device__ __forceinline__ void operator()(const f32x4 (&acc)[2][2][4][2], const Unit& u, int wr, int wc, int fr, int fq) const {
        const int row0 = u.pm * BM + wr * 64 + fr, cc0 = u.pn * HALF + wc * 32 + 8 * fq;
#pragma unroll
        for (int ai = 0; ai < 2; ++ai)
#pragma unroll
            for (int m = 0; m < 4; ++m) { unsigned char* rowp = O + (size_t)(row0 + ai * HALF + m * 16) * 1024 + cc0;
                float r[8];
#pragma unroll
                for (int n = 0; n < 2; ++n)
#pragma unroll
                    for (int p = 0; p < 2; ++p) {
                        const f32x2 a2 = (f32x2){acc[ai][0][m][n][2 * p], acc[ai][0][m][n][2 * p + 1]}, c2 = (f32x2){acc[ai][1][m][n][2 * p], acc[ai][1][m][n][2 * p + 1]};
                        f32x2 m2, lc;
                        m2[0] = fminf(a2[0], 448.0f); m2[1] = fminf(a2[1], 448.0f);
                        lc[0] = __builtin_amdgcn_fmed3f(c2[0], -448.0f, 448.0f); lc[1] = __builtin_amdgcn_fmed3f(c2[1], -448.0f, 448.0f);
                        const f32x2 ea = m2 * (-1.702f * 1.4426950408889634f * W8_INV); f32x2 d;
                        d[0] = __builtin_amdgcn_exp2f(ea[0]); d[1] = __builtin_amdgcn_exp2f(ea[1]);
                        d = d + 1.0f; f32x2 rc; rc[0] = __builtin_amdgcn_rcpf(d[0]); rc[1] = __builtin_amdgcn_rcpf(d[1]);
                        const f32x2 o2 = (m2 * rc) * (lc * (W8_INV * W8_INV) + W8_INV);
                        r[4 * n + 2 * p] = o2[0]; r[4 * n + 2 * p + 1] = o2[1]; }
                u32x2 w; w.x = pk4_fp8(r[0], r[1], r[2], r[3]); w.y = pk4_fp8(r[4], r[5], r[6], r[7]);
                __builtin_nontemporal_store(w, (u32x2*)rowp); }
    }
};
struct EpiY {
    static constexpr bool PERM = true;
    unsigned char* O; const float* b2;
    __device__ __forceinline__ void init(f32x4 (&ib)[2][2], const Unit& u, int wc, int fq) const {
        const float* bp = b2 + (size_t)u.e * 1024 + u.pn * BM + wc * 32 + 8 * fq;
#pragma unroll
        for (int bj = 0; bj < 2; ++bj)
#pragma unroll
            for (int n = 0; n < 2; ++n) ib[bj][n] = *(const f32x4*)(bp + bj * HALF + 4 * n) * W8_SCALE; }
    __device__ __forceinline__ void operator()(const f32x4 (&acc)[2][2][4][2], const Unit& u, int wr, int wc, int fr, int fq) const {
        const int row0 = u.pm * BM + wr * 64 + fr, col0 = u.pn * BM + wc * 32 + 8 * fq;
#pragma unroll
        for (int ai = 0; ai < 2; ++ai)
#pragma unroll
            for (int m = 0; m < 4; ++m) { unsigned char* rowp = O + (size_t)(row0 + ai * HALF + m * 16) * 1024 + col0;
#pragma unroll
                for (int bj = 0; bj < 2; ++bj) { const f32x4 v0 = acc[ai][bj][m][0] * W8_INV, v1 = acc[ai][bj][m][1] * W8_INV;
                    u32x2 w; w.x = pk4_fp8(v0[0], v0[1], v0[2], v0[3]); w.y = pk4_fp8(v1[0], v1[1], v1[2], v1[3]);
                    *(u32x2*)(rowp + bj * HALF) = w; } }
    }
};
}

struct Params { const float* in[22]; float* out; unsigned char* ws; };
enum { I_X = 0, I_C, I_ADAW, I_ADAB, I_N1G, I_N2G, I_WIN, I_WOUT, I_LBL, I_HGG, I_RETG, I_CONVW, I_ALOG, I_DTB, I_GDNG, I_RW, I_RB, I_W1, I_B1, I_W2, I_B2, I_FNG };

struct Frame {
    LAS unsigned char* lds;
    int tid, lane, wave, wave0, G, bid;
    unsigned char* ws;
    unsigned* ctl;
};
extern __shared__ __attribute__((aligned(16))) unsigned char lds_raw[];
constexpr int LDS_PAR = LDSCTL_OFF + 512;
__device__ __forceinline__ unsigned long long ldpar(LAS unsigned char* lds, int i) {
    const u32x2 v = *(const LAS u32x2*)(lds + LDS_PAR + 8 * i);
    return ((unsigned long long)(unsigned)__builtin_amdgcn_readfirstlane((int)v.y) << 32) | (unsigned)__builtin_amdgcn_readfirstlane((int)v.x);
}
__device__ __forceinline__ const float* pin(const Frame& F, int i) { return (const float*)(const GAS float*)ldpar(F.lds, i); }
__device__ __forceinline__ float* pout(const Frame& F) { return (float*)(GAS float*)ldpar(F.lds, 22); }
__device__ __forceinline__ int lane_id_opaque() { int ln; asm volatile("v_mbcnt_lo_u32_b32 %0, -1, 0\n\tv_mbcnt_hi_u32_b32 %0, -1, %0" : "=v"(ln)); return ln; }
__device__ __forceinline__ Frame make_frame(int wave0) {
    Frame F; F.lds = (LAS unsigned char*)lds_raw;
    const int ln = lane_id_opaque();
    int w = wave0; asm volatile("" : "+s"(w));
    F.tid = w * 64 + ln; F.lane = ln; F.wave = w; F.wave0 = w;
    int g = gridDim.x, bi = blockIdx.x; asm volatile("" : "+s"(g), "+s"(bi));
    unsigned long long wsp = ldpar(F.lds, 23); asm volatile("" : "+s"(wsp));
    F.G = g; F.bid = bi; F.ws = (unsigned char*)(GAS unsigned char*)wsp; F.ctl = (unsigned*)(F.ws + WS_CTL);
    return F;
}

template <bool F8>
__device__ __forceinline__ void p0_transpose_item(const float* W, int ld, int ncol, void* WTv, LAS float* scr, int item, int lane) {
    const int nblk = ncol / 32, kb = item / nblk, nb = item % nblk, k0 = 64 * kb, n0 = 32 * nb;
    f32x4 v[8];
#pragma unroll
    for (int i = 0; i < 8; ++i) v[i] = __builtin_nontemporal_load((const f32x4*)(W + (size_t)(k0 + 8 * i + (lane >> 3)) * ld + n0 + 4 * (lane & 7)));
#pragma unroll
    for (int i = 0; i < 8; ++i) { LAS float* d = scr + (8 * i + (lane >> 3)) * 33 + 4 * (lane & 7); d[0] = v[i][0]; d[1] = v[i][1]; d[2] = v[i][2]; d[3] = v[i][3]; }
    LDS_WAIT(); asm volatile("" ::: "memory");
    const int c = lane & 7;
#pragma unroll
    for (int j = 0; j < 4; ++j) { const int n = (lane >> 3) + 8 * j; const LAS float* s = scr + (8 * c) * 33 + n;
        if constexpr (F8) { u32x2 o; o.x = pk4_fp8(s[0 * 33] * W8_SCALE, s[1 * 33] * W8_SCALE, s[2 * 33] * W8_SCALE, s[3 * 33] * W8_SCALE); o.y = pk4_fp8(s[4 * 33] * W8_SCALE, s[5 * 33] * W8_SCALE, s[6 * 33] * W8_SCALE, s[7 * 33] * W8_SCALE);
            *(u32x2*)((unsigned char*)WTv + (size_t)(n0 + n) * 1024 + k0 + 8 * c) = o; }
        else { u32x4 o; o.x = pk2(s[0 * 33], s[1 * 33]); o.y = pk2(s[2 * 33], s[3 * 33]); o.z = pk2(s[4 * 33], s[5 * 33]); o.w = pk2(s[6 * 33], s[7 * 33]);
            *(u32x4*)((bf16*)WTv + (size_t)(n0 + n) * 1024 + k0 + 8 * c) = o; } }
    LDS_WAIT(); asm volatile("" ::: "memory");
}
__device__ __forceinline__ void phase0(Frame& F) {
    if (F.bid < 96) {
        LAS float* cs = (LAS float*)(F.lds);
        LAS float* part = (LAS float*)(F.lds + 16384);
        const float* c = pin(F, I_C);
        for (int i = F.tid; i < 4096; i += 512) cs[i] = siluf(c[i]);
        __syncthreads();
        const int cb = F.bid * 128, l = cb / 6144, j0 = cb % 6144;
        const int cg = F.wave & 1, kq = F.wave >> 1, j = j0 + cg * 64 + F.lane;
        const float* aw = pin(F, I_ADAW) + (size_t)l * 1024 * 6144 + j;
        float a0 = 0.f, a1 = 0.f, a2 = 0.f, a3 = 0.f;
#pragma unroll 8
        for (int k = kq * 256; k < kq * 256 + 256; ++k) { const float w = aw[(size_t)k * 6144]; a0 += cs[k] * w; a1 += cs[1024 + k] * w; a2 += cs[2048 + k] * w; a3 += cs[3072 + k] * w; }
        part[(kq * 4 + 0) * 128 + cg * 64 + F.lane] = a0; part[(kq * 4 + 1) * 128 + cg * 64 + F.lane] = a1;
        part[(kq * 4 + 2) * 128 + cg * 64 + F.lane] = a2; part[(kq * 4 + 3) * 128 + cg * 64 + F.lane] = a3;
        __syncthreads();
        { const int b = F.tid >> 7, jj = F.tid & 127;
          const float s = part[(0 * 4 + b) * 128 + jj] + part[(1 * 4 + b) * 128 + jj] + part[(2 * 4 + b) * 128 + jj] + part[(3 * 4 + b) * 128 + jj] + pin(F, I_ADAB)[l * 6144 + j0 + jj];
          ((float*)(F.ws + WS_MOD))[(size_t)(l * 4 + b) * 6144 + j0 + jj] = s; }
        __syncthreads();
    }
    if (F.bid == 96) {
        const float* lg = pin(F, I_LBL); float* lb = (float*)(F.ws + WS_LB);
        { const int i = F.tid; const float l0 = lg[i], l1 = lg[512 + i]; lb[i] = 0.f; lb[512 + i] = fmaxf(1.0f / (1.0f + __expf(l0 - l1)), 0.f); }
    }
    if (F.bid == 97 && F.tid < 32) ((double*)(F.ws + WS_ROPE))[F.tid] = exp(-(double)F.tid / 31.0 * 9.210340371976184) * 0.15915494309189535;
    LAS float* scr = (LAS float*)(F.lds + 32768 + F.wave * 12288);
    const int gw = F.bid * 8 + F.wave, NGW = F.G * 8;
    constexpr int I_IN = 16 * 128, I_OUT = 16 * 32, I_1 = 16 * 64, I_2 = 16 * 32;
    constexpr int N_IN = 2 * I_IN, N_OUT = 2 * I_OUT, N_1 = 64 * I_1, N_2 = 64 * I_2;
    const int NMOD = 96 * 8, NFREE = NGW - NMOD, X = (NGW > NMOD) ? 9 * NFREE : 0, N_TOT = N_IN + N_OUT + N_1 + N_2;
    const int nrounds = (F.bid >= 96 ? 9 : 0) + (N_TOT - X + NGW - 1) / NGW;
    for (int q = 0; q < nrounds; ++q) {
        int it;
        if (F.bid >= 96) it = (q < 9) ? (gw - NMOD) + NFREE * q : X + gw + NGW * (q - 9); else it = X + gw + NGW * q;
        if (it >= N_TOT) break;
        int r = it;
        if (r < N_IN) { const int m = r / I_IN; p0_transpose_item<false>(pin(F, I_WIN) + (size_t)m * 1024 * NIN, NIN, NZ, (bf16*)(F.ws + WS_WIN) + (size_t)m * NZ * 1024, scr, r % I_IN, F.lane); continue; } r -= N_IN;
        if (r < N_OUT) { const int m = r / I_OUT; p0_transpose_item<false>(pin(F, I_WOUT) + (size_t)m * 1024 * 1024, 1024, 1024, (bf16*)(F.ws + WS_WOUT) + (size_t)m * 1024 * 1024, scr, r % I_OUT, F.lane); continue; } r -= N_OUT;
        if (r < N_1) { const int m = r / I_1; p0_transpose_item<true>(pin(F, I_W1) + (size_t)m * 1024 * 2048, 2048, 2048, F.ws + WS_W1 + (size_t)m * 2048 * 1024, scr, r % I_1, F.lane); continue; } r -= N_1;
        { const int m = r / I_2; p0_transpose_item<true>(pin(F, I_W2) + (size_t)m * 1024 * 1024, 1024, 1024, F.ws + WS_W2 + (size_t)m * 1024 * 1024, scr, r % I_2, F.lane); }
    }
}

__device__ __forceinline__ void load_w8t(Frame& F, int l, LAS float* w8t) {
    const float* w = pin(F, I_WIN) + (size_t)l * 1024 * NIN + NZ;
    for (int i = F.tid; i < 8192; i += 512) { const int k = i >> 3, q = i & 7; w8t[q * 1024 + k] = w[(size_t)k * NIN + q]; }
}
__device__ __forceinline__ f32x4 unpack4_fp8(unsigned w) { const f32x2 a = __builtin_amdgcn_cvt_pk_f32_fp8((int)w, false), b = __builtin_amdgcn_cvt_pk_f32_fp8((int)w, true); return (f32x4){a[0], a[1], b[0], b[1]}; }
__device__ __forceinline__ f32x4 unpack4(u32x2 w) { return (f32x4){bflo(w.x), bfhi(w.x), bflo(w.y), bfhi(w.y)}; }
template <bool F8 = false>
__device__ __forceinline__ void norm_mod_emit(const f32x4 (&v)[4], const float* g, const float* sh, const float* sc, void* hrowv, int lane, f32x4 (&h)[4]) {
    float ss = 0.f;
#pragma unroll
    for (int j = 0; j < 4; ++j) ss += (v[j].x * v[j].x + v[j].y * v[j].y) + (v[j].z * v[j].z + v[j].w * v[j].w);
    const float r = rsqrtf(wave_sum(ss) * (1.0f / 1024.0f) + NORM_EPS);
#pragma unroll
    for (int j = 0; j < 4; ++j) { const int col = 256 * j + 4 * lane;
        const f32x4 gg = *(const f32x4*)(g + col), s1 = *(const f32x4*)(sc + col), s0 = *(const f32x4*)(sh + col);
        h[j] = (v[j] * r) * gg * (s1 + 1.0f) + s0;
        if constexpr (F8) *(unsigned*)((unsigned char*)hrowv + col) = pk4_fp8(h[j].x, h[j].y, h[j].z, h[j].w);
        else { u32x2 w; w.x = pk2(h[j].x, h[j].y); w.y = pk2(h[j].z, h[j].w); *(u32x2*)((bf16*)hrowv + col) = w; } }
}
__device__ __forceinline__ void emit_gab(const f32x4 (&h)[4], const LAS float* w8t, float* gabrow, int lane) {
    float a[8];
#pragma unroll
    for (int q = 0; q < 8; ++q) { float s = 0.f;
#pragma unroll
        for (int j = 0; j < 4; ++j) { const f32x4 w = *(const LAS f32x4*)(w8t + q * 1024 + 256 * j + 4 * lane); s += (h[j].x * w.x + h[j].y * w.y) + (h[j].z * w.z + h[j].w * w.w); }
        a[q] = wave_sum(s); }
    if (lane == 0) { *(f32x4*)gabrow = (f32x4){a[0], a[1], a[2], a[3]}; *(f32x4*)(gabrow + 4) = (f32x4){a[4], a[5], a[6], a[7]}; }
}

__device__ __forceinline__ void phase_norm1_first(Frame& F) {
    LAS float* w8t = (LAS float*)F.lds;
    LAS float* GS = (LAS float*)(F.lds + 32768); LAS float* SH = GS + 1024;
    const float* mod = (const float*)(F.ws + WS_MOD);
    const int gw = F.bid * 8 + F.wave, NGW = F.G * 8, RPW = NTOK / NGW, row0 = gw * RPW, rend = row0 + RPW;
    f32x4 vn[4];
    { const f32x4* xr = (const f32x4*)(pin(F, I_X) + (size_t)row0 * 1024) + F.lane;
#pragma unroll
      for (int j = 0; j < 4; ++j) vn[j] = __builtin_nontemporal_load(xr + 64 * j); }
    load_w8t(F, 0, w8t);
    if (F.tid < 256) { const int bb = (F.bid * 8 * RPW) >> 13, col = 4 * F.tid; const float* mp = mod + (size_t)bb * 6144;
        *(LAS f32x4*)(GS + col) = *(const f32x4*)(pin(F, I_N1G) + col) * (*(const f32x4*)(mp + 1024 + col) + 1.0f); *(LAS f32x4*)(SH + col) = *(const f32x4*)(mp + col); }
    lds_barrier();
#pragma unroll 1
    for (int row = row0; row < rend; ++row) {
        int ml = 4 * F.lane; asm volatile("" : "+v"(ml));
        f32x4 v[4], h[4];
#pragma unroll
        for (int j = 0; j < 4; ++j) v[j] = vn[j];
        if (row + 1 < rend) { const f32x4* xr = (const f32x4*)(pin(F, I_X) + (size_t)(row + 1) * 1024) + F.lane;
#pragma unroll
            for (int j = 0; j < 4; ++j) vn[j] = __builtin_nontemporal_load(xr + 64 * j); }
        float ss = 0.f;
#pragma unroll
        for (int j = 0; j < 4; ++j) ss += (v[j].x * v[j].x + v[j].y * v[j].y) + (v[j].z * v[j].z + v[j].w * v[j].w);
        const float r = rsqrtf(wave_sum(ss) * (1.0f / 1024.0f) + NORM_EPS);
        bf16* hrow = (bf16*)(F.ws + WS_HN) + (size_t)row * 1024;
#pragma unroll
        for (int j = 0; j < 4; ++j) { h[j] = (v[j] * r) * *(const LAS f32x4*)(GS + 256 * j + ml) + *(const LAS f32x4*)(SH + 256 * j + ml);
            u32x2 w; w.x = pk2(h[j].x, h[j].y); w.y = pk2(h[j].z, h[j].w); *(u32x2*)(hrow + 256 * j + 4 * F.lane) = w; }
        emit_gab(h, w8t, (float*)(F.ws + WS_GAB) + (size_t)row * 8, F.lane);
    }
    __syncthreads();
}

__device__ __forceinline__ void hgrn_naive(Frame& F, int l, int b, int h) {
    LAS float* Fg = (LAS float*)F.lds;
    LAS float* Kk = Fg + 2048, *Qq = Kk + 2048, *Vv = Qq + 2048, *Gt = Vv + 2048, *Pp = Gt + 2048;
    const bf16* z = (const bf16*)(F.ws + WS_R1);
    const float* lb = (const float*)(F.ws + WS_LB) + l * 512 + h * 128;
    const float* gn = pin(F, I_HGG) + l * 512 + h * 128;
    bf16* om = (bf16*)(F.ws + WS_OMIX);
    const int e = F.tid & 127, dq = F.tid >> 7;
    float S[32];
#pragma unroll
    for (int j = 0; j < 32; ++j) S[j] = 0.f;
    for (int t0 = 0; t0 < SEQ; t0 += 16) {
#pragma unroll
        for (int i = 0; i < 4; ++i) { const int idx = F.tid + 512 * i, tt = idx >> 7, d = idx & 127;
            const bf16* zr = z + (size_t)(b * SEQ + t0 + tt) * NZ + h * 128 + d;
            const float q = bf2f(zr[0]), fl = bf2f(zr[512]), vv = bf2f(zr[1024]), gt = bf2f(zr[1536]);
            const float lbd = lb[d], f = lbd + (1.0f - lbd) * sigm(fl);
            Fg[idx] = f; Kk[idx] = 1.0f - f; Qq[idx] = siluf(q); Vv[idx] = vv; Gt[idx] = siluf(gt); }
        __syncthreads();
        for (int tt = 0; tt < 16; ++tt) { const float vv = Vv[tt * 128 + e]; float acc = 0.f;
#pragma unroll
            for (int j4 = 0; j4 < 8; ++j4) { const int d = tt * 128 + 32 * dq + 4 * j4;
                const f32x4 ff = *(const LAS f32x4*)(Fg + d), kk = *(const LAS f32x4*)(Kk + d), qq = *(const LAS f32x4*)(Qq + d);
#pragma unroll
                for (int i = 0; i < 4; ++i) { S[4 * j4 + i] = ff[i] * S[4 * j4 + i] + kk[i] * vv; acc += S[4 * j4 + i] * qq[i]; }
                if ((j4 & 1) == 1) __builtin_amdgcn_sched_barrier(0); }
            Pp[(dq * 16 + tt) * 128 + e] = acc; }
        __syncthreads();
#pragma unroll
        for (int r = 0; r < 2; ++r) { const int tt = 2 * F.wave + r;
            float o0 = 0.f, o1 = 0.f;
#pragma unroll
            for (int q = 0; q < 4; ++q) { o0 += Pp[(q * 16 + tt) * 128 + F.lane]; o1 += Pp[(q * 16 + tt) * 128 + 64 + F.lane]; }
            const float rr = rsqrtf(wave_sum(o0 * o0 + o1 * o1) * (1.0f / 128.0f) + NORM_EPS);
            bf16* orow = om + (size_t)(b * SEQ + t0 + tt) * 1024 + h * 128;
            orow[F.lane] = (bf16)f2bf(o0 * rr * gn[F.lane] * Gt[tt * 128 + F.lane]);
            orow[64 + F.lane] = (bf16)f2bf(o1 * rr * gn[64 + F.lane] * Gt[tt * 128 + 64 + F.lane]); }
        __syncthreads();
    }
}
__device__ __forceinline__ void ret_naive(Frame& F, int l, int b, int h) {
    LAS float* Kk = (LAS float*)F.lds;
    LAS float* Qq = Kk + 1024, *Vv = Qq + 1024, *Gt = Vv + 1024, *Pp = Gt + 1024;
    const bf16* z = (const bf16*)(F.ws + WS_R1);
    const float* gn = pin(F, I_RETG) + l * 256 + h * 64;
    bf16* om = (bf16*)(F.ws + WS_OMIX);
    const int e = F.tid & 63, dq = F.tid >> 6;
    const float gamma = 1.0f - exp2f(-5.0f - (float)h);
    float S[8];
#pragma unroll
    for (int j = 0; j < 8; ++j) S[j] = 0.f;
    const int ri = F.tid & 31, rtt = F.tid >> 5;
    const double inv_rev = ((const double*)(F.ws + WS_ROPE))[ri];
    for (int t0 = 0; t0 < SEQ; t0 += 16) {
        { const bf16* zr = z + (size_t)(b * SEQ + t0 + rtt) * NZ + 2048 + h * 64 + ri;
          const float q1 = bf2f(zr[0]), q2 = bf2f(zr[32]), k1 = bf2f(zr[256]) * 0.125f, k2 = bf2f(zr[256 + 32]) * 0.125f;
          double rev = (double)(t0 + rtt) * inv_rev; rev -= floor(rev);
          const float ang = (float)rev * 6.283185307179586f; float sn, cs; __sincosf(ang, &sn, &cs);
          Qq[rtt * 64 + ri] = q1 * cs - q2 * sn; Qq[rtt * 64 + 32 + ri] = q1 * sn + q2 * cs;
          Kk[rtt * 64 + ri] = k1 * cs - k2 * sn; Kk[rtt * 64 + 32 + ri] = k1 * sn + k2 * cs; }
#pragma unroll
        for (int i = 0; i < 2; ++i) { const int idx = F.tid + 512 * i, tt = idx >> 6, d = idx & 63;
            const bf16* zr = z + (size_t)(b * SEQ + t0 + tt) * NZ + 2048 + h * 64 + d;
            Vv[idx] = bf2f(zr[512]); Gt[idx] = siluf(bf2f(zr[768])); }
        __syncthreads();
        for (int tt = 0; tt < 16; ++tt) { const float vv = Vv[tt * 64 + e]; float acc = 0.f;
#pragma unroll
            for (int j4 = 0; j4 < 2; ++j4) { const int d = tt * 64 + 8 * dq + 4 * j4;
                const f32x4 kk = *(const LAS f32x4*)(Kk + d), qq = *(const LAS f32x4*)(Qq + d);
#pragma unroll
                for (int i = 0; i < 4; ++i) { S[4 * j4 + i] = gamma * S[4 * j4 + i] + kk[i] * vv; acc += S[4 * j4 + i] * qq[i]; } }
            Pp[(dq * 16 + tt) * 64 + e] = acc; }
        __syncthreads();
#pragma unroll
        for (int r = 0; r < 2; ++r) { const int tt = 2 * F.wave + r;
            float o = 0.f;
#pragma unroll
            for (int q = 0; q < 8; ++q) o += Pp[(q * 16 + tt) * 64 + F.lane];
            const float rr = rsqrtf(wave_sum(o * o) * (1.0f / 64.0f) + NORM_EPS);
            om[(size_t)(b * SEQ + t0 + tt) * 1024 + 512 + h * 64 + F.lane] = (bf16)f2bf(o * rr * gn[F.lane] * Gt[tt * 64 + F.lane]); }
        __syncthreads();
    }
}
__device__ __forceinline__ void gdn_naive(Frame& F, int l, int b, int h) {
    LAS float* Kk = (LAS float*)F.lds;
    LAS float* Qq = Kk + 1024, *Vv = Qq + 1024, *Gt = Vv + 1024, *AB = Gt + 1024;
    const bf16* z = (const bf16*)(F.ws + WS_R1);
    const float* gab = (const float*)(F.ws + WS_GAB);
    const float* gn = pin(F, I_GDNG) + l * 256 + h * 64;
    const float* cw = pin(F, I_CONVW) + (size_t)l * 4 * 768;
    const float Aexp = __expf(pin(F, I_ALOG)[l * 4 + h]), dtb = pin(F, I_DTB)[l * 4 + h];
    bf16* om = (bf16*)(F.ws + WS_OMIX);
    float S[32];
#pragma unroll
    for (int j = 0; j < 32; ++j) S[j] = 0.f;
    const int ge = 32 * (F.wave & 1) + (F.lane & 31), gdh = F.lane >> 5;
    for (int t0 = 0; t0 < SEQ; t0 += 16) {
#pragma unroll
        for (int i = 0; i < 6; ++i) { const int idx = F.tid + 512 * i, tt = idx / 192, rem = idx % 192, which = rem >> 6, d = rem & 63;
            const int ch = which * 256 + h * 64 + d, t = t0 + tt; float u = 0.f;
#pragma unroll
            for (int j = 0; j < 4; ++j) { const int ts = t - 3 + j; if (ts >= 0) u += cw[j * 768 + ch] * bf2f(z[(size_t)(b * SEQ + ts) * NZ + 3072 + ch]); }
            const float a = siluf(u);
            if (which == 0) Qq[tt * 64 + d] = a; else if (which == 1) Kk[tt * 64 + d] = a; else Vv[tt * 64 + d] = a; }
#pragma unroll
        for (int i = 0; i < 2; ++i) { const int idx = F.tid + 512 * i, tt = idx >> 6, d = idx & 63;
            Gt[idx] = siluf(bf2f(z[(size_t)(b * SEQ + t0 + tt) * NZ + 3840 + h * 64 + d])); }
        if (F.tid < 16) { const float* gr = gab + (size_t)(b * SEQ + t0 + F.tid) * 8;
            const float xa = gr[h] + dtb, sp = (xa > 20.f) ? xa : log1pf(__expf(xa));
            AB[F.tid * 2] = __expf(-Aexp * sp); AB[F.tid * 2 + 1] = sigm(gr[4 + h]); }
        __syncthreads();
#pragma unroll
        for (int r = 0; r < 4; ++r) { const int vi = F.wave * 4 + r, tt = vi & 15; LAS float* arr = (vi < 16) ? Qq : Kk;
            const float x = arr[tt * 64 + F.lane]; const float rr = rsqrtf(wave_sum(x * x) + 1e-6f);
            arr[tt * 64 + F.lane] = x * rr * ((vi < 16) ? 0.125f : 1.0f); }
        __syncthreads();
        LAS float* Oo = AB + 64;
        if (F.wave < 2) {
            for (int tt = 0; tt < 16; ++tt) { const float vv = Vv[tt * 64 + ge], al = AB[tt * 2], be = AB[tt * 2 + 1];
                float u = 0.f;
#pragma unroll
                for (int j4 = 0; j4 < 8; ++j4) { const f32x4 kk = *(const LAS f32x4*)(Kk + tt * 64 + 32 * gdh + 4 * j4);
#pragma unroll
                    for (int i = 0; i < 4; ++i) u += S[4 * j4 + i] * kk[i]; }
                u += shx(u, 32, F.lane);
                const float w = be * (vv - al * u); float o = 0.f;
#pragma unroll
                for (int j4 = 0; j4 < 8; ++j4) { const f32x4 kk = *(const LAS f32x4*)(Kk + tt * 64 + 32 * gdh + 4 * j4), qq = *(const LAS f32x4*)(Qq + tt * 64 + 32 * gdh + 4 * j4);
#pragma unroll
                    for (int i = 0; i < 4; ++i) { S[4 * j4 + i] = al * S[4 * j4 + i] + kk[i] * w; o += S[4 * j4 + i] * qq[i]; }
                    if ((j4 & 1) == 1) __builtin_amdgcn_sched_barrier(0); }
                o += shx(o, 32, F.lane);
                if (gdh == 0) Oo[tt * 64 + ge] = o; }
        }
        __syncthreads();
#pragma unroll
        for (int r = 0; r < 2; ++r) { const int tt = 2 * F.wave + r; const float o = Oo[tt * 64 + F.lane];
            const float rr = rsqrtf(wave_sum(o * o) * (1.0f / 64.0f) + NORM_EPS);
            om[(size_t)(b * SEQ + t0 + tt) * 1024 + 768 + h * 64 + F.lane] = (bf16)f2bf(o * rr * gn[F.lane] * Gt[tt * 64 + F.lane]); }
        __syncthreads();
    }
}
__device__ __forceinline__ void phase_mix_naive(Frame& F, int l) {
    if (F.bid < 48) {
        const int u = F.bid, kind = u >> 4, b = (u >> 2) & 3, h = u & 3;
#ifdef NAIVE_HG
        if (kind == 0) hgrn_naive(F, l, b, h);
#endif
#ifdef NAIVE_RT
        if (kind == 1) ret_naive(F, l, b, h);
#endif
#ifndef NO_GD
        if (kind == 2) gdn_naive(F, l, b, h);
#endif
    }
}

#define MFMA16(a, b, c) __builtin_amdgcn_mfma_f32_16x16x32_bf16((a), (b), (c), 0, 0, 0)
__device__ __forceinline__ bf16x8 lfrag(const LAS bf16* base, int ld, int row, int k) { return *(const LAS bf16x8*)(base + row * ld + k); }
__device__ __forceinline__ bf16x8 gfrag(const bf16* base, int ld, int row, int k) { return *(const bf16x8*)(base + (size_t)row * ld + k); }
constexpr int GL_QS = 0, GL_KH = 17408, GL_VT = 34816, GL_SC = 53248, GL_KDT = 62464, GL_RAW = 80896, GL_STL = 84992, GL_DECL = 121600, GL_RS = 122112;

struct HgRaw { unsigned q[8], f[8], v[8]; };
template <bool NEED_Q>
__device__ __forceinline__ void hg_issue(Frame& F, int b, int n, int h, HgRaw& r) {
    const bf16* z = (const bf16*)(F.ws + WS_R1) + (size_t)(b * SEQ + n * 64 + 8 * F.wave) * NZ + h * 128;
#pragma unroll
    for (int i = 0; i < 8; ++i) { const unsigned* zr = (const unsigned*)(z + (size_t)i * NZ) + F.lane;
        r.q[i] = NEED_Q ? __builtin_nontemporal_load(zr) : 0u; r.f[i] = __builtin_nontemporal_load(zr + 256); r.v[i] = __builtin_nontemporal_load(zr + 512); }
}
constexpr int GL_RSTL = 71680;
constexpr int GL_GNH = 122624, GL_GNR = 123136, GL_GNG = 123392, GL_LB = 123648;
constexpr int GL_BP = GL_RAW;
template <int MODE>
__device__ __forceinline__ void hg_prep(Frame& F, int l, int h, const HgRaw& r) {
    constexpr bool m3 = (MODE == 2);
    constexpr int LQ = 136, LT = 72;
    LAS bf16* QS = (LAS bf16*)(F.lds + GL_QS); LAS bf16* KH = (LAS bf16*)(F.lds + GL_KH); LAS bf16* VT = (LAS bf16*)(F.lds + GL_VT); LAS bf16* KDT = (LAS bf16*)(F.lds + GL_KDT);
    LAS float* BP = (LAS float*)(F.lds + GL_BP); LAS float* DECL = (LAS float*)(F.lds + GL_DECL);
    const int j = F.lane, w = F.wave;
    const f32x2 lb2 = *(const LAS f32x2*)(F.lds + GL_LB + 8 * j);
    float kx[2][8], pp[2][8], sx[2][8];
#pragma unroll
    for (int hh = 0; hh < 2; ++hh) { const float om = 1.0f - lb2[hh];
#pragma unroll
        for (int i = 0; i < 8; ++i) { const float fl = hh ? bfhi(r.f[i]) : bflo(r.f[i]); const float k = om * sigm(-fl); kx[hh][i] = k;
            const float f = fmaxf(1.0f - k, 4.0e-18f); pp[hh][i] = (i == 0) ? f : pp[hh][i - 1] * f; }
#pragma unroll
        for (int i = 7; i >= 0; --i) { const float fl = hh ? bfhi(r.f[i]) : bflo(r.f[i]); (void)fl; sx[hh][i] = (i == 7) ? 1.0f : sx[hh][i + 1] * fmaxf(1.0f - kx[hh][i + 1], 4.0e-18f); }
        BP[w * 128 + 2 * j + hh] = pp[hh][7]; }
    { u32x4 v0, v1;
      v0.x = (r.v[0] & 0xffffu) | (r.v[1] << 16); v0.y = (r.v[2] & 0xffffu) | (r.v[3] << 16); v0.z = (r.v[4] & 0xffffu) | (r.v[5] << 16); v0.w = (r.v[6] & 0xffffu) | (r.v[7] << 16);
      v1.x = (r.v[0] >> 16) | (r.v[1] & 0xffff0000u); v1.y = (r.v[2] >> 16) | (r.v[3] & 0xffff0000u); v1.z = (r.v[4] >> 16) | (r.v[5] & 0xffff0000u); v1.w = (r.v[6] >> 16) | (r.v[7] & 0xffff0000u);
      *(LAS u32x4*)(VT + (2 * j) * LT + 8 * w) = v0; *(LAS u32x4*)(VT + (2 * j + 1) * LT + 8 * w) = v1; }
    lds_barrier();
    float pre[2], post[2];
#pragma unroll
    for (int hh = 0; hh < 2; ++hh) { float a = 1.0f, c = 1.0f;
#pragma unroll
        for (int ww = 0; ww < 8; ++ww) { const float bp = BP[ww * 128 + 2 * j + hh]; a *= (ww < w) ? bp : 1.0f; c *= (ww > w) ? bp : 1.0f; }
        pre[hh] = a; post[hh] = c;
        if (w == 7) DECL[2 * j + hh] = a * pp[hh][7]; }
    if (m3) {
#pragma unroll
        for (int i = 0; i < 8; ++i) { float qs[2], kh[2];
#pragma unroll
            for (int hh = 0; hh < 2; ++hh) { const float q = hh ? bfhi(r.q[i]) : bflo(r.q[i]); const float P = pre[hh] * pp[hh][i];
                qs[hh] = siluf(q) * P; kh[hh] = kx[hh][i] * fminf(__builtin_amdgcn_rcpf(P), 5.5e34f); }
            *(LAS unsigned*)(QS + (8 * w + i) * LQ + 2 * j) = pk2(qs[0], qs[1]); *(LAS unsigned*)(KH + (8 * w + i) * LQ + 2 * j) = pk2(kh[0], kh[1]); }
    }
    {
#pragma unroll
        for (int hh = 0; hh < 2; ++hh) { float kd[8];
#pragma unroll
            for (int i = 0; i < 8; ++i) kd[i] = kx[hh][i] * sx[hh][i] * post[hh];
            u32x4 wv; wv.x = pk2(kd[0], kd[1]); wv.y = pk2(kd[2], kd[3]); wv.z = pk2(kd[4], kd[5]); wv.w = pk2(kd[6], kd[7]);
            *(LAS u32x4*)(KDT + (2 * j + hh) * LT + 8 * w) = wv; }
    }
    lds_barrier();
}
struct RtRaw { unsigned q[4], k[4], v[4]; };
template <bool NEED_Q>
__device__ __forceinline__ void rt_issue(Frame& F, int b, int n, int h, RtRaw& r) {
    const bf16* z = (const bf16*)(F.ws + WS_R1) + (size_t)(b * SEQ + n * 64) * NZ + 2048 + h * 64;
#pragma unroll
    for (int i = 0; i < 4; ++i) { const int idx = F.tid + 512 * i, t = idx >> 5, j = idx & 31;
        const unsigned* zr = (const unsigned*)(z + (size_t)t * NZ) + j;
        r.q[i] = NEED_Q ? __builtin_nontemporal_load(zr) : 0u; r.k[i] = __builtin_nontemporal_load(zr + 128); r.v[i] = __builtin_nontemporal_load(zr + 256); }
}
template <bool NEED_Q>
__device__ __forceinline__ void rt_stage(Frame& F, const RtRaw& r) {
    LAS unsigned* RQ = (LAS unsigned*)(F.lds + GL_RAW); LAS unsigned* RK = RQ + 64 * 33; LAS unsigned* RV = RK + 64 * 33;
#pragma unroll
    for (int i = 0; i < 4; ++i) { const int idx = F.tid + 512 * i, t = idx >> 5, j = idx & 31;
        if (NEED_Q) RQ[t * 33 + j] = r.q[i]; RK[t * 33 + j] = r.k[i]; RV[t * 33 + j] = r.v[i]; }
}
template <int MODE>
__device__ __forceinline__ void rt_prep(Frame& F, int n, int h) {
    constexpr bool m3 = (MODE == 2);
    constexpr int LQ = 72, LT = 72;
    LAS bf16* QS = (LAS bf16*)(F.lds + GL_QS); LAS bf16* KH = (LAS bf16*)(F.lds + GL_KH); LAS bf16* VT = (LAS bf16*)(F.lds + GL_VT); LAS bf16* KDT = (LAS bf16*)(F.lds + GL_KDT);
    LAS unsigned* RQ = (LAS unsigned*)(F.lds + GL_RAW); LAS unsigned* RK = RQ + 64 * 33; LAS unsigned* RV = RK + 64 * 33;
    const int t = F.lane;
    const float lg = log1pf(-exp2f(-5.0f - (float)h));
    const float bt = (float)(t + 1) * lg, eq = __expf(bt), ekh = __expf(-bt) * 0.125f, ekd = __expf(64.0f * lg - bt) * 0.125f;
    const double* ropet = (const double*)(F.ws + WS_ROPE);
    const LAS bf16* rq = (const LAS bf16*)RQ; const LAS bf16* rk = (const LAS bf16*)RK; const LAS bf16* rv = (const LAS bf16*)RV;
    float qa4[4], qb4[4], ka4[4], kb4[4];
#pragma unroll
    for (int i = 0; i < 4; ++i) { const int ri = F.wave * 4 + i;
        double rev = (double)(n * 64 + t) * ropet[ri]; rev -= floor(rev);
        float sn, cs; __sincosf((float)rev * 6.283185307179586f, &sn, &cs);
        const float q1 = bf2f(rq[t * 66 + ri]), q2 = bf2f(rq[t * 66 + 32 + ri]), k1 = bf2f(rk[t * 66 + ri]), k2 = bf2f(rk[t * 66 + 32 + ri]);
        const float qa = q1 * cs - q2 * sn, qb = q1 * sn + q2 * cs, ka = k1 * cs - k2 * sn, kb = k1 * sn + k2 * cs;
        qa4[i] = qa * eq; qb4[i] = qb * eq; ka4[i] = ka * ekh; kb4[i] = kb * ekh;
        { KDT[ri * LT + t] = (bf16)f2bf(ka * ekd); KDT[(32 + ri) * LT + t] = (bf16)f2bf(kb * ekd); }
    }
    if (m3) { u32x2 w;
        w.x = pk2(qa4[0], qa4[1]); w.y = pk2(qa4[2], qa4[3]); *(LAS u32x2*)(QS + t * LQ + 4 * F.wave) = w;
        w.x = pk2(qb4[0], qb4[1]); w.y = pk2(qb4[2], qb4[3]); *(LAS u32x2*)(QS + t * LQ + 32 + 4 * F.wave) = w;
        w.x = pk2(ka4[0], ka4[1]); w.y = pk2(ka4[2], ka4[3]); *(LAS u32x2*)(KH + t * LQ + 4 * F.wave) = w;
        w.x = pk2(kb4[0], kb4[1]); w.y = pk2(kb4[2], kb4[3]); *(LAS u32x2*)(KH + t * LQ + 32 + 4 * F.wave) = w; }
#pragma unroll
    for (int i = 0; i < 8; ++i) { const int e = F.wave * 8 + i; VT[e * LT + t] = rv[t * 66 + e]; }
    lds_barrier();
}
template <int DK, int DV>
__device__ __forceinline__ void gla_m1_mma(Frame& F, bf16* kvt  ) {
    constexpr int LT = 72, NXT = DK / 16, NYT = DV / 16, PER = NXT * NYT / 8;
    const LAS bf16* KDT = (const LAS bf16*)(F.lds + GL_KDT); const LAS bf16* VT = (const LAS bf16*)(F.lds + GL_VT);
    const int fr = F.lane & 15, fq = F.lane >> 4;
    const int yt = (NYT == 8) ? F.wave : (F.wave & 3), xt0 = (NYT == 8) ? 0 : 2 * (F.wave >> 2);
    f32x4 acc[PER];
#pragma unroll
    for (int i = 0; i < PER; ++i) acc[i] = (f32x4){0.f, 0.f, 0.f, 0.f};
#pragma unroll
    for (int ks = 0; ks < 2; ++ks) { const bf16x8 yf = lfrag(VT, LT, yt * 16 + fr, 32 * ks + 8 * fq);
#pragma unroll
        for (int i = 0; i < PER; ++i) acc[i] = MFMA16(lfrag(KDT, LT, (xt0 + i) * 16 + fr, 32 * ks + 8 * fq), yf, acc[i]); }
#pragma unroll
    for (int i = 0; i < PER; ++i) { u32x2 w; w.x = pk2(acc[i][0], acc[i][1]); w.y = pk2(acc[i][2], acc[i][3]); *(u32x2*)(kvt + (size_t)(yt * 16 + fr) * DK + (xt0 + i) * 16 + 4 * fq) = w; }
}
__device__ __forceinline__ void hg_kv_acc(Frame& F, f32x4 (&kv)[8]) {
    const LAS bf16* KDT = (const LAS bf16*)(F.lds + GL_KDT); const LAS bf16* VT = (const LAS bf16*)(F.lds + GL_VT);
    const int fr = F.lane & 15, fq = F.lane >> 4;
#pragma unroll
    for (int i = 0; i < 8; ++i) kv[i] = (f32x4){0.f, 0.f, 0.f, 0.f};
#pragma unroll
    for (int ks = 0; ks < 2; ++ks) { const bf16x8 yf = lfrag(VT, 72, F.wave * 16 + fr, 32 * ks + 8 * fq);
#pragma unroll
        for (int i = 0; i < 8; ++i) kv[i] = MFMA16(lfrag(KDT, 72, i * 16 + fr, 32 * ks + 8 * fq), yf, kv[i]); }
}
__device__ __forceinline__ void rt_kv_acc(Frame& F, f32x4 (&kv)[2]) {
    const LAS bf16* KDT = (const LAS bf16*)(F.lds + GL_KDT); const LAS bf16* VT = (const LAS bf16*)(F.lds + GL_VT);
    const int fr = F.lane & 15, fq = F.lane >> 4, yt = F.wave & 3, xt0 = 2 * (F.wave >> 2);
    kv[0] = (f32x4){0.f, 0.f, 0.f, 0.f}; kv[1] = (f32x4){0.f, 0.f, 0.f, 0.f};
#pragma unroll
    for (int ks = 0; ks < 2; ++ks) { const bf16x8 yf = lfrag(VT, 72, yt * 16 + fr, 32 * ks + 8 * fq);
#pragma unroll
        for (int i = 0; i < 2; ++i) kv[i] = MFMA16(lfrag(KDT, 72, (xt0 + i) * 16 + fr, 32 * ks + 8 * fq), yf, kv[i]); }
}
template <int PER, int DV>
__device__ __forceinline__ void mix_out_epilogue(Frame& F, const f32x4 (&acc)[PER], const LAS float* gn, const u32x2 (&gwv)[PER], bf16* om) {
    LAS float* RS = (LAS float*)(F.lds + GL_RS);
    const int fr = F.lane & 15, fq = F.lane >> 4, tt = F.wave & 3, hi = F.wave >> 2;
    float ss = 0.f;
#pragma unroll
    for (int i = 0; i < PER; ++i) ss += (acc[i][0] * acc[i][0] + acc[i][1] * acc[i][1]) + (acc[i][2] * acc[i][2] + acc[i][3] * acc[i][3]);
    ss += shx(ss, 16, F.lane); ss += shx(ss, 32, F.lane);
    if (fq == 0) RS[hi * 64 + tt * 16 + fr] = ss;
    lds_barrier();
    const int t = tt * 16 + fr;
    const float rr = rsqrtf((RS[t] + RS[64 + t]) * (1.0f / (float)DV) + NORM_EPS);
#pragma unroll
    for (int i = 0; i < PER; ++i) { const int e = (PER * hi + i) * 16 + 4 * fq;
        const u32x2 gw = gwv[i]; const f32x4 g4 = *(const LAS f32x4*)(gn + e);
        const float o0 = acc[i][0] * rr * g4[0] * siluf(bflo(gw.x)), o1 = acc[i][1] * rr * g4[1] * siluf(bfhi(gw.x)), o2 = acc[i][2] * rr * g4[2] * siluf(bflo(gw.y)), o3 = acc[i][3] * rr * g4[3] * siluf(bfhi(gw.y));
        u32x2 w; w.x = pk2(o0, o1); w.y = pk2(o2, o3); *(u32x2*)(om + (size_t)t * 1024 + e) = w; }
}
template <int DK, int DV>
__device__ __forceinline__ void gla_m3_loads(Frame& F, const bf16* spt, const bf16* zgate, bf16x8 (&sf)[DV / 32][DK / 32], u32x2 (&gw)[DV / 32]) {
    constexpr int KS = DK / 32, PER = DV / 32;
    const int fr = F.lane & 15, fq = F.lane >> 4, tt = F.wave & 3, hi = F.wave >> 2;
#pragma unroll
    for (int i = 0; i < PER; ++i) { gw[i] = *(const u32x2*)(zgate + (size_t)(tt * 16 + fr) * NZ + (PER * hi + i) * 16 + 4 * fq);
#pragma unroll
        for (int ks = 0; ks < KS; ++ks) sf[i][ks] = gfrag(spt, DK, (PER * hi + i) * 16 + fr, 32 * ks + 8 * fq); }
}
template <int DK, int DV, bool ST_LDS, int STO, class Mid>
__device__ __forceinline__ void gla_m3_mma(Frame& F, const bf16x8 (&sf)[DV / 32][DK / 32], const u32x2 (&gw)[DV / 32], const LAS float* gn  , bf16* om  , Mid mid) {
    constexpr int LQ = DK + 8, LT = 72, KS = DK / 32, PER = DV / 32;
    const LAS bf16* QS = (const LAS bf16*)(F.lds + GL_QS); const LAS bf16* KH = (const LAS bf16*)(F.lds + GL_KH); const LAS bf16* VT = (const LAS bf16*)(F.lds + GL_VT);
    LAS bf16* SC = (LAS bf16*)(F.lds + GL_SC); LAS float* RS = (LAS float*)(F.lds + GL_RS);
    const int fr = F.lane & 15, fq = F.lane >> 4, tt = F.wave & 3, hi = F.wave >> 2;
    {
        f32x4 a2[2] = {(f32x4){0.f, 0.f, 0.f, 0.f}, (f32x4){0.f, 0.f, 0.f, 0.f}};
#pragma unroll
        for (int ks = 0; ks < KS; ++ks) { const bf16x8 yf = lfrag(QS, LQ, tt * 16 + fr, 32 * ks + 8 * fq);
#pragma unroll
            for (int i = 0; i < 2; ++i) a2[i] = MFMA16(lfrag(KH, LQ, (2 * hi + i) * 16 + fr, 32 * ks + 8 * fq), yf, a2[i]); }
#pragma unroll
        for (int i = 0; i < 2; ++i) { const int t = tt * 16 + fr, s0 = (2 * hi + i) * 16 + 4 * fq; float v[4];
#pragma unroll
            for (int j = 0; j < 4; ++j) v[j] = (s0 + j <= t) ? a2[i][j] : 0.0f;
            u32x2 w; w.x = pk2(v[0], v[1]); w.y = pk2(v[2], v[3]); *(LAS u32x2*)(SC + t * LT + s0) = w; }
    }
    mid();
    lds_barrier();
    f32x4 acc[PER];
#pragma unroll
    for (int i = 0; i < PER; ++i) acc[i] = (f32x4){0.f, 0.f, 0.f, 0.f};
#pragma unroll
    for (int ks = 0; ks < 2; ++ks) { const bf16x8 yf = lfrag(SC, LT, tt * 16 + fr, 32 * ks + 8 * fq);
#pragma unroll
        for (int i = 0; i < PER; ++i) acc[i] = MFMA16(lfrag(VT, LT, (PER * hi + i) * 16 + fr, 32 * ks + 8 * fq), yf, acc[i]); }
#pragma unroll
    for (int ks = 0; ks < KS; ++ks) { const bf16x8 yf = lfrag(QS, LQ, tt * 16 + fr, 32 * ks + 8 * fq);
#pragma unroll
        for (int i = 0; i < PER; ++i) acc[i] = MFMA16(ST_LDS ? lfrag((const LAS bf16*)(F.lds + STO), DK + 8, (PER * hi + i) * 16 + fr, 32 * ks + 8 * fq) : sf[i][ks], yf, acc[i]); }
    mix_out_epilogue<PER, DV>(F, acc, gn, gw, om);
}
constexpr int GD_CW = 119552;
constexpr int GD_RAW = 0, GD_MM = 0, GD_CQ = 26112, GD_XT = 26112, GD_CK = 44544, GD_CV = 61184, GD_QN = 77824, GD_KN = 87040, GD_KDT = 96256, GD_QDL = 105472, GD_PART = 114688, GD_BV = 118784, GD_BK = 119040, GD_GC = 119296;
struct GdRaw { unsigned w[13]; float ga, gb; };
__device__ __forceinline__ void gdn_issue(Frame& F, int b, int n, int h, GdRaw& r) {
    const bf16* z = (const bf16*)(F.ws + WS_R1);
#pragma unroll
    for (int i = 0; i < 13; ++i) { const int idx = F.tid + 512 * i, rr = idx / 96, j = idx - rr * 96, seg = j >> 5, jj = j & 31, ts = n * 64 - 3 + rr;
        unsigned w = 0u; if (idx < 67 * 96 && ts >= 0) w = __builtin_nontemporal_load((const unsigned*)(z + (size_t)(b * SEQ + ts) * NZ + 3072 + seg * 256 + h * 64 + 2 * jj));
        r.w[i] = w; }
    const float* gr = (const float*)(F.ws + WS_GAB) + (size_t)(b * SEQ + n * 64 + F.lane) * 8;
    r.ga = gr[h]; r.gb = gr[4 + h];
}
__device__ __forceinline__ void gdn_stage(Frame& F, const GdRaw& r) {
    LAS unsigned* RAW = (LAS unsigned*)(F.lds + GD_RAW);
#pragma unroll
    for (int i = 0; i < 13; ++i) { const int idx = F.tid + 512 * i, rr = idx / 96, j = idx - rr * 96; if (idx < 67 * 96) RAW[rr * 97 + j] = r.w[i]; }
}
__device__ __forceinline__ void gdn_load_cw(Frame& F, int l, int h) {
    LAS float* CW = (LAS float*)(F.lds + GD_CW); const float* cw = pin(F, I_CONVW) + (size_t)l * 4 * 768;
    for (int i = F.tid; i < 768; i += 512) { const int j = i / 192, rem = i - j * 192, c = rem >> 1, p = rem & 1, seg = c >> 5, jj = c & 31; CW[i] = cw[j * 768 + seg * 256 + h * 64 + 2 * jj + p]; }
}
__device__ __forceinline__ void gdn_m1(Frame& F, int l, int h, int uid, const GdRaw& raw) {
    LAS unsigned* RAW = (LAS unsigned*)(F.lds + GD_RAW); LAS float* MM = (LAS float*)(F.lds + GD_MM);
    LAS float* CQ = (LAS float*)(F.lds + GD_CQ); LAS float* CK = (LAS float*)(F.lds + GD_CK); LAS float* CV = (LAS float*)(F.lds + GD_CV);
    LAS bf16* XT = (LAS bf16*)(F.lds + GD_XT); LAS bf16* QN = (LAS bf16*)(F.lds + GD_QN); LAS bf16* KN = (LAS bf16*)(F.lds + GD_KN);
    LAS bf16* KDT = (LAS bf16*)(F.lds + GD_KDT); LAS bf16* QDL = (LAS bf16*)(F.lds + GD_QDL);
    LAS float* PART = (LAS float*)(F.lds + GD_PART); LAS float* BV = (LAS float*)(F.lds + GD_BV); LAS float* BK = (LAS float*)(F.lds + GD_BK); LAS float* GCL = (LAS float*)(F.lds + GD_GC);
    const int t = F.lane;
    float gc, beta, gl;
    { const float Aexp = __expf(pin(F, I_ALOG)[l * 4 + h]), xa = raw.ga + pin(F, I_DTB)[l * 4 + h], sp = (xa > 20.f) ? xa : log1pf(__expf(xa));
      gc = wave_scan_incl(-Aexp * sp, F.lane); gl = __shfl(gc, 63); beta = sigm(raw.gb); }
    const LAS float* CW = (const LAS float*)(F.lds + GD_CW);
    float pq = 0.f, pk = 0.f;
#pragma unroll 2
    for (int i = 0; i < 12; ++i) { const int c = F.wave * 12 + i, seg = c >> 5, jj = c & 31;
        float u0 = 0.f, u1 = 0.f;
#pragma unroll
        for (int j = 0; j < 4; ++j) { const unsigned w = RAW[(t + j) * 97 + c]; const f32x2 cwv = *(const LAS f32x2*)(CW + (j * 96 + c) * 2); u0 += cwv[0] * bflo(w); u1 += cwv[1] * bfhi(w); }
        const float a0 = siluf(u0), a1 = siluf(u1);
        LAS float* dst = (seg == 0) ? CQ : ((seg == 1) ? CK : CV);
        dst[t * 65 + 2 * jj] = a0; dst[t * 65 + 2 * jj + 1] = a1;
        const float s2 = a0 * a0 + a1 * a1; pq += (seg == 0) ? s2 : 0.f; pk += (seg == 1) ? s2 : 0.f; }
    PART[(F.wave * 2 + 0) * 64 + t] = pq; PART[(F.wave * 2 + 1) * 64 + t] = pk;
    lds_barrier();
    { float sq = 0.f, sk = 0.f;
#pragma unroll
      for (int w = 0; w < 8; ++w) { sq += PART[(w * 2) * 64 + t]; sk += PART[(w * 2 + 1) * 64 + t]; }
      const float rq = rsqrtf(sq + 1e-6f) * 0.125f, rk = rsqrtf(sk + 1e-6f), eg = __expf(gc), ekd = __expf(gl - gc);
      float qn[8], kn[8];
#pragma unroll
      for (int i = 0; i < 8; ++i) { const int d = F.wave * 8 + i; qn[i] = CQ[t * 65 + d] * rq; kn[i] = CK[t * 65 + d] * rk; KDT[d * 72 + t] = (bf16)f2bf(kn[i] * ekd); CK[t * 65 + d] = kn[i]; }
      { u32x4 wq, wk, wd;
        wq.x = pk2(qn[0], qn[1]); wq.y = pk2(qn[2], qn[3]); wq.z = pk2(qn[4], qn[5]); wq.w = pk2(qn[6], qn[7]);
        wk.x = pk2(kn[0], kn[1]); wk.y = pk2(kn[2], kn[3]); wk.z = pk2(kn[4], kn[5]); wk.w = pk2(kn[6], kn[7]);
        wd.x = pk2(qn[0] * eg, qn[1] * eg); wd.y = pk2(qn[2] * eg, qn[3] * eg); wd.z = pk2(qn[4] * eg, qn[5] * eg); wd.w = pk2(qn[6] * eg, qn[7] * eg);
        *(LAS u32x4*)(QN + t * 72 + 8 * F.wave) = wq; *(LAS u32x4*)(KN + t * 72 + 8 * F.wave) = wk; *(LAS u32x4*)(QDL + t * 72 + 8 * F.wave) = wd; }
      if (F.wave == 0) { BV[t] = beta; BK[t] = beta * eg; GCL[t] = gc; } }
    lds_barrier();
    const int fr = F.lane & 15, fq = F.lane >> 4, tt = F.wave & 3, hi = F.wave >> 2;
    {
        const LAS bf16* Y = hi ? QN : KN;
        f32x4 a4[4];
#pragma unroll
        for (int i = 0; i < 4; ++i) a4[i] = (f32x4){0.f, 0.f, 0.f, 0.f};
#pragma unroll
        for (int ks = 0; ks < 2; ++ks) { const bf16x8 yf = lfrag(Y, 72, tt * 16 + fr, 32 * ks + 8 * fq);
#pragma unroll
            for (int i = 0; i < 4; ++i) a4[i] = MFMA16(lfrag(KN, 72, i * 16 + fr, 32 * ks + 8 * fq), yf, a4[i]); }
        const int tr = tt * 16 + fr; const float gct = GCL[tr], bt = BV[tr];
        bf16* gqk = (bf16*)(F.ws + WS_GQK) + (size_t)uid * 4096;
#pragma unroll
        for (int i = 0; i < 4; ++i) { const int s0 = i * 16 + 4 * fq; const f32x4 gs = *(const LAS f32x4*)(GCL + s0); float v[4];
#pragma unroll
            for (int j = 0; j < 4; ++j) { const bool keep = hi ? (s0 + j <= tr) : (s0 + j < tr); v[j] = keep ? a4[i][j] * __expf(gct - gs[j]) * (hi ? 1.0f : bt) : 0.0f; }
            if (hi) { u32x2 w; w.x = pk2(v[0], v[1]); w.y = pk2(v[2], v[3]); *(u32x2*)(gqk + tr * 64 + s0) = w; }
            else *(LAS f32x4*)(MM + tr * 68 + s0) = (f32x4){v[0], v[1], v[2], v[3]}; }
    }
    lds_barrier();
    {
        typedef short s16x4 __attribute__((ext_vector_type(4)));
        LAS bf16* MMb = (LAS bf16*)(F.lds + GD_QN);
        LAS bf16* LINV = (LAS bf16*)(F.lds + GD_PART);
        for (int i = F.tid; i < 128 * 72 / 8; i += 512) *(LAS u32x4*)(XT + 8 * i) = (u32x4){0u, 0u, 0u, 0u};
        { const int r = F.tid >> 3, c8 = F.tid & 7; const f32x4 a = *(const LAS f32x4*)(MM + r * 68 + 8 * c8), b2 = *(const LAS f32x4*)(MM + r * 68 + 8 * c8 + 4);
          u32x4 w; w.x = pk2(a[0], a[1]); w.y = pk2(a[2], a[3]); w.z = pk2(b2[0], b2[1]); w.w = pk2(b2[2], b2[3]); *(LAS u32x4*)(MMb + r * 72 + 8 * c8) = w; }
        if (F.wave < 4) {
            const int bq = F.wave;
            LAS bf16* Rr = (LAS bf16*)(F.lds + GD_KN) + bq * 960; LAS bf16* Cc = Rr + 320; LAS bf16* Pr = Cc + 320;
            f32x4 n4, p4;
#pragma unroll
            for (int j = 0; j < 4; ++j) { n4[j] = -MM[(16 * bq + 4 * fq + j) * 68 + 16 * bq + fr]; p4[j] = n4[j] + ((4 * fq + j == fr) ? 1.0f : 0.0f); }
            { u32x2 w; w.x = pk2(n4[0], n4[1]); w.y = pk2(n4[2], n4[3]); *(LAS u32x2*)(Cc + fr * 20 + 4 * fq) = w; }
#pragma unroll
            for (int j = 0; j < 4; ++j) { Rr[(4 * fq + j) * 20 + fr] = (bf16)f2bf(n4[j]); Pr[(4 * fq + j) * 20 + fr] = (bf16)f2bf(p4[j]); }
#pragma unroll
            for (int s = 0; s < 3; ++s) {
                asm volatile("s_waitcnt lgkmcnt(0)" ::: "memory");
                const s16x4 xr = *(const LAS s16x4*)(Rr + fr * 20 + 4 * fq), yc = *(const LAS s16x4*)(Cc + fr * 20 + 4 * fq);
                const f32x4 a2 = __builtin_amdgcn_mfma_f32_16x16x16bf16_1k(xr, yc, (f32x4){0.f, 0.f, 0.f, 0.f}, 0, 0, 0);
                const s16x4 xp = *(const LAS s16x4*)(Pr + fr * 20 + 4 * fq);
                asm volatile("s_waitcnt lgkmcnt(0)" ::: "memory");
                { u32x2 w; w.x = pk2(a2[0], a2[1]); w.y = pk2(a2[2], a2[3]); *(LAS u32x2*)(Cc + fr * 20 + 4 * fq) = w; }
#pragma unroll
                for (int j = 0; j < 4; ++j) Rr[(4 * fq + j) * 20 + fr] = (bf16)f2bf(a2[j]);
                asm volatile("s_waitcnt lgkmcnt(0)" ::: "memory");
                const s16x4 yc2 = *(const LAS s16x4*)(Cc + fr * 20 + 4 * fq);
                p4 = __builtin_amdgcn_mfma_f32_16x16x16bf16_1k(xp, yc2, p4, 0, 0, 0);
#pragma unroll
                for (int j = 0; j < 4; ++j) Pr[(4 * fq + j) * 20 + fr] = (bf16)f2bf(p4[j]);
            }
#pragma unroll
            for (int j = 0; j < 4; ++j) LINV[bq * 320 + (4 * fq + j) * 20 + fr] = (bf16)f2bf(p4[j]);
        }
        lds_barrier();
        const int cw = 16 * F.wave + fr;
        const LAS float* SRCw = (cw < 64) ? (CV + cw) : (CK + (cw - 64)); const LAS float* COEFw = (cw < 64) ? BV : BK;
#pragma unroll 1
        for (int bt = 0; bt < 4; ++bt) {
            f32x4 acc = (f32x4){0.f, 0.f, 0.f, 0.f};
            if (bt > 0) acc = MFMA16(lfrag(MMb, 72, 16 * bt + fr, 8 * fq), lfrag(XT, 72, cw, 8 * fq), acc);
            if (bt == 3) acc = MFMA16(lfrag(MMb, 72, 16 * bt + fr, 32 + 8 * fq), lfrag(XT, 72, cw, 32 + 8 * fq), acc);
            float y[4];
#pragma unroll
            for (int j = 0; j < 4; ++j) { const int t2 = 16 * bt + 4 * fq + j; y[j] = SRCw[t2 * 65] * COEFw[t2] - acc[j]; }
            u32x2 yw; yw.x = pk2m(y[0], y[1]); yw.y = pk2m(y[2], y[3]);
            const s16x4 li = *(const LAS s16x4*)(LINV + bt * 320 + fr * 20 + 4 * fq);
            const f32x4 x4 = __builtin_amdgcn_mfma_f32_16x16x16bf16_1k(li, __builtin_bit_cast(s16x4, yw), (f32x4){0.f, 0.f, 0.f, 0.f}, 0, 0, 0);
            { u32x2 w; w.x = pk2(x4[0], x4[1]); w.y = pk2(x4[2], x4[3]); *(LAS u32x2*)(XT + cw * 72 + 16 * bt + 4 * fq) = w; }
            lds_barrier();
        }
    }
    {
        const LAS bf16* X = hi ? KDT : (XT + 64 * 72); const LAS bf16* Y = hi ? XT : KDT;
        f32x4 a4[4];
#pragma unroll
        for (int i = 0; i < 4; ++i) a4[i] = (f32x4){0.f, 0.f, 0.f, 0.f};
#pragma unroll
        for (int ks = 0; ks < 2; ++ks) { const bf16x8 yf = lfrag(Y, 72, tt * 16 + fr, 32 * ks + 8 * fq);
#pragma unroll
            for (int i = 0; i < 4; ++i) a4[i] = MFMA16(lfrag(X, 72, i * 16 + fr, 32 * ks + 8 * fq), yf, a4[i]); }
        const int yr = tt * 16 + fr;
        if (hi) { bf16* ut = (bf16*)(F.ws + WS_GUT) + (size_t)uid * 4096 + yr * 64 + fq * 16;
            u32x4 w0, w1; w0.x = pk2(a4[0][0], a4[0][1]); w0.y = pk2(a4[0][2], a4[0][3]); w0.z = pk2(a4[1][0], a4[1][1]); w0.w = pk2(a4[1][2], a4[1][3]);
            w1.x = pk2(a4[2][0], a4[2][1]); w1.y = pk2(a4[2][2], a4[2][3]); w1.z = pk2(a4[3][0], a4[3][1]); w1.w = pk2(a4[3][2], a4[3][3]);
            *(u32x4*)ut = w0; *(u32x4*)(ut + 8) = w1;
            LAS bf16* ul = (LAS bf16*)(F.lds + GD_KN) + yr * 64; *(LAS u32x4*)(ul + (((2 * fq) ^ (yr & 7)) << 3)) = w0; *(LAS u32x4*)(ul + (((2 * fq + 1) ^ (yr & 7)) << 3)) = w1; }
        else { bf16* gt = (bf16*)(F.ws + WS_GT) + (size_t)uid * 4096 + yr * 64; const float last = __expf(gl);
            unsigned pw[4][2];
#pragma unroll
            for (int i = 0; i < 4; ++i) { const int d0 = i * 16 + 4 * fq; float v[4];
#pragma unroll
                for (int j = 0; j < 4; ++j) v[j] = ((d0 + j == yr) ? last : 0.0f) - a4[i][j];
                pw[i][0] = pk2(v[0], v[1]); pw[i][1] = pk2(v[2], v[3]); }
#pragma unroll
            for (int ks = 0; ks < 2; ++ks) { u32x4 w; w.x = pw[2 * ks][0]; w.y = pw[2 * ks][1]; w.z = pw[2 * ks + 1][0]; w.w = pw[2 * ks + 1][1]; *(u32x4*)(gt + ks * 32 + fq * 8) = w;
                *(LAS u32x4*)((LAS bf16*)(F.lds + GD_QN) + yr * 64 + (((ks * 4 + fq) ^ (yr & 7)) << 3)) = w; } }
        { const int tq = F.tid & 63, dg = F.tid >> 6; u32x4 w; unsigned short e8[8];
#pragma unroll
          for (int i = 0; i < 8; ++i) e8[i] = XT[(64 + 8 * dg + i) * 72 + tq];
          w.x = e8[0] | ((unsigned)e8[1] << 16); w.y = e8[2] | ((unsigned)e8[3] << 16); w.z = e8[4] | ((unsigned)e8[5] << 16); w.w = e8[6] | ((unsigned)e8[7] << 16);
          *(u32x4*)((bf16*)(F.ws + WS_GKC) + (size_t)uid * 4096 + tq * 64 + 8 * dg) = w; }
        { const int r = F.tid >> 3, c8 = F.tid & 7;
          *(u32x4*)((bf16*)(F.ws + WS_GWT) + (size_t)uid * 4096 + r * 64 + 8 * c8) = *(const LAS u32x4*)(XT + r * 72 + 8 * c8);
          *(u32x4*)((bf16*)(F.ws + WS_GQD) + (size_t)uid * 4096 + r * 64 + 8 * c8) = *(const LAS u32x4*)(QDL + r * 72 + 8 * c8); }
    }
    lds_barrier();
}
struct GdnStep { u32x4 T[4][2]; u32x4 U[2]; };
__device__ __forceinline__ void gdn_m2_load(GdnStep& s, const bf16* gt, const bf16* ut, int n, int fr, int fq) {
    s.U[0] = *(const u32x4*)(ut + (size_t)n * 4096); s.U[1] = *(const u32x4*)(ut + (size_t)n * 4096 + 8);
#pragma unroll
    for (int i = 0; i < 4; ++i)
#pragma unroll
        for (int ks = 0; ks < 2; ++ks) s.T[i][ks] = *(const u32x4*)(gt + (size_t)n * 4096 + (i * 16 + fr) * 64 + ks * 32 + fq * 8);
}
__device__ __forceinline__ void gdn_step(f32x4 (&S)[4], const GdnStep& st, float us) {
    bf16x8 sf[2];
#pragma unroll
    for (int ks = 0; ks < 2; ++ks) { u32x4 w; w.x = pk2m(S[2 * ks][0], S[2 * ks][1]); w.y = pk2m(S[2 * ks][2], S[2 * ks][3]); w.z = pk2m(S[2 * ks + 1][0], S[2 * ks + 1][1]); w.w = pk2m(S[2 * ks + 1][2], S[2 * ks + 1][3]);
        sf[ks] = __builtin_bit_cast(bf16x8, w); }
#pragma unroll
    for (int i = 0; i < 4; ++i) { const unsigned u0 = (i & 1) ? st.U[i >> 1].z : st.U[i >> 1].x, u1 = (i & 1) ? st.U[i >> 1].w : st.U[i >> 1].y;
        f32x4 a = (f32x4){bflo(u0), bfhi(u0), bflo(u1), bfhi(u1)} * us;
#pragma unroll
        for (int ks = 0; ks < 2; ++ks) a = MFMA16(__builtin_bit_cast(bf16x8, st.T[i][ks]), sf[ks], a);
        S[i] = a; }
}
__device__ __forceinline__ void gdn_m2a(Frame& F, int bh, int seg) {
    const int fr = F.lane & 15, fq = F.lane >> 4, role = F.wave >> 2, c = (F.wave & 3) * 16 + fr;
    const bf16* gt = (const bf16*)(F.ws + WS_GT) + (size_t)(bh * 128 + seg * 8) * 4096;
    const bf16* ut = (const bf16*)(F.ws + WS_GUT) + (size_t)(bh * 128 + seg * 8) * 4096 + c * 64 + 16 * fq;
    const float us = role ? 0.0f : 1.0f;
    f32x4 S[4];
#pragma unroll
    for (int i = 0; i < 4; ++i)
#pragma unroll
        for (int j = 0; j < 4; ++j) S[i][j] = (role && (16 * i + 4 * fq + j == c)) ? 1.0f : 0.0f;
    GdnStep st[4];
#pragma unroll
    for (int r = 0; r < 4; ++r) gdn_m2_load(st[r], gt, ut, r, fr, fq);
    for (int n0 = 0; n0 < 8; n0 += 4) {
#pragma unroll
        for (int r = 0; r < 4; ++r) { const int n = n0 + r; gdn_step(S, st[r], us); gdn_m2_load(st[r], gt, ut, (n + 4 < 8) ? n + 4 : 7, fr, fq); } }
    if (role == 0) { bf16* qg = (bf16*)(F.ws + WS_GQG) + (size_t)(bh * 16 + seg) * 4096 + c * 64 + fq * 16;
        u32x4 w0, w1; w0.x = pk2(S[0][0], S[0][1]); w0.y = pk2(S[0][2], S[0][3]); w0.z = pk2(S[1][0], S[1][1]); w0.w = pk2(S[1][2], S[1][3]);
        w1.x = pk2(S[2][0], S[2][1]); w1.y = pk2(S[2][2], S[2][3]); w1.z = pk2(S[3][0], S[3][1]); w1.w = pk2(S[3][2], S[3][3]);
        *(u32x4*)qg = w0; *(u32x4*)(qg + 8) = w1; }
    else { bf16* pg = (bf16*)(F.ws + WS_GPG) + (size_t)(bh * 16 + seg) * 4096 + (c >> 5) * 32 + ((c & 15) >> 2) * 8 + ((c >> 4) & 1) * 4 + (c & 3);
#pragma unroll
        for (int i = 0; i < 4; ++i)
#pragma unroll
            for (int j = 0; j < 4; ++j) pg[(16 * i + 4 * fq + j) * 64] = (bf16)f2bf(S[i][j]); }
}
__device__ __forceinline__ void gdn_m2b(Frame& F, int bh) {
    const int fr = F.lane & 15, fq = F.lane >> 4, c = (F.wave & 3) * 16 + fr;
    const bf16* pg = (const bf16*)(F.ws + WS_GPG) + (size_t)bh * 16 * 4096;
    const bf16* qg = (const bf16*)(F.ws + WS_GQG) + (size_t)bh * 16 * 4096 + c * 64 + 16 * fq;
    float* ss = (float*)(F.ws + WS_GSS) + (size_t)bh * 16 * 4096 + c * 64 + 4 * fq;
    { u32x4 pv[16]; const int r = F.tid >> 3, sl = F.tid & 7;
#pragma unroll
      for (int g = 0; g < 16; ++g) pv[g] = *(const u32x4*)(pg + (size_t)g * 4096 + r * 64 + ((sl ^ (r & 7)) << 3));
#pragma unroll
      for (int g = 0; g < 16; ++g) *(LAS u32x4*)(F.lds + g * 8192 + F.tid * 16) = pv[g]; }
    u32x4 qv[16][2];
    if (F.wave < 4) {
#pragma unroll
        for (int g = 0; g < 16; ++g) { qv[g][0] = *(const u32x4*)(qg + (size_t)g * 4096); qv[g][1] = *(const u32x4*)(qg + (size_t)g * 4096 + 8); } }
    lds_barrier();
    if (F.wave < 4) {
        f32x4 S[4];
#pragma unroll
        for (int i = 0; i < 4; ++i) S[i] = (f32x4){0.f, 0.f, 0.f, 0.f};
#pragma unroll
        for (int g = 0; g < 16; ++g) {
#pragma unroll
            for (int i = 0; i < 4; ++i) *(f32x4*)(ss + (size_t)g * 4096 + i * 16) = S[i];
            GdnStep st; st.U[0] = qv[g][0]; st.U[1] = qv[g][1];
#pragma unroll
            for (int i = 0; i < 4; ++i)
#pragma unroll
                for (int ks = 0; ks < 2; ++ks) st.T[i][ks] = *(const LAS u32x4*)(F.lds + g * 8192 + (i * 16 + fr) * 128 + (((ks * 4 + fq) ^ (fr & 7)) << 4));
            gdn_step(S, st, 1.0f); } }
    lds_barrier();
}
__device__ __forceinline__ void gdn_compose(Frame& F, f32x4 (&S)[4]) {
    const int fr = F.lane & 15, fq = F.lane >> 4, c = (F.wave & 3) * 16 + fr;
    const LAS bf16* TL = (const LAS bf16*)(F.lds + GD_QN); const LAS bf16* UL = (const LAS bf16*)(F.lds + GD_KN) + c * 64;
    GdnStep st; st.U[0] = *(const LAS u32x4*)(UL + (((2 * fq) ^ (c & 7)) << 3)); st.U[1] = *(const LAS u32x4*)(UL + (((2 * fq + 1) ^ (c & 7)) << 3));
#pragma unroll
    for (int i = 0; i < 4; ++i)
#pragma unroll
        for (int ks = 0; ks < 2; ++ks) st.T[i][ks] = *(const LAS u32x4*)(TL + (i * 16 + fr) * 64 + (((ks * 4 + fq) ^ (fr & 7)) << 3));
    gdn_step(S, st, (F.wave >> 2) ? 0.0f : 1.0f);
}
struct Gd3Raw { u32x4 kc, qk, qd; u32x2 wwv[2]; GdnStep st; };
struct Gd3Gate { u32x2 gw[2]; };
__device__ __forceinline__ void gdn3_gates(Frame& F, int b, int n, int h, Gd3Gate& g) {
    const int fr = F.lane & 15, fq = F.lane >> 4, tt = F.wave & 3, hi = F.wave >> 2;
    const bf16* zg = (const bf16*)(F.ws + WS_R1) + (size_t)(b * SEQ + n * 64) * NZ + 3840 + h * 64;
#pragma unroll
    for (int i = 0; i < 2; ++i) g.gw[i] = __builtin_nontemporal_load((const u32x2*)(zg + (size_t)(tt * 16 + fr) * NZ + (2 * hi + i) * 16 + 4 * fq));
}
__device__ __forceinline__ void gdn3_issue(Frame& F, int b, int n, int h, int uid, Gd3Raw& r) {
    const size_t row0 = (size_t)(b * SEQ + n * 64);
    const int fr = F.lane & 15, fq = F.lane >> 4, tt = F.wave & 3, hi = F.wave >> 2;
    const bf16* zg = (const bf16*)(F.ws + WS_R1) + row0 * NZ + 3840 + h * 64; const bf16* wt = (const bf16*)(F.ws + WS_GWT) + (size_t)uid * 4096 + (tt * 16 + fr) * 64;
    { const int rr = F.tid >> 3, c8 = F.tid & 7; const size_t go = (size_t)uid * 4096 + rr * 64 + 8 * c8;
      r.kc = __builtin_nontemporal_load((const u32x4*)((const bf16*)(F.ws + WS_GKC) + go)); r.qk = __builtin_nontemporal_load((const u32x4*)((const bf16*)(F.ws + WS_GQK) + go)); r.qd = __builtin_nontemporal_load((const u32x4*)((const bf16*)(F.ws + WS_GQD) + go)); }
#pragma unroll
    for (int i = 0; i < 2; ++i) r.wwv[i] = __builtin_nontemporal_load((const u32x2*)(wt + (2 * hi + i) * 16 + 4 * fq));
    gdn_m2_load(r.st, (const bf16*)(F.ws + WS_GT) + (size_t)uid * 4096, (const bf16*)(F.ws + WS_GUT) + (size_t)uid * 4096 + ((F.wave & 3) * 16 + fr) * 64 + 16 * fq, 0, fr, fq);
}
__device__ __forceinline__ void gdn_m3(Frame& F, int l, int b, int n, int h, const Gd3Raw& r, const Gd3Gate& gt_, f32x4 (&S)[4]) {
    LAS bf16* KCL = (LAS bf16*)(F.lds + GL_QS); LAS bf16* QKL = KCL + 64 * 72; LAS bf16* QDL = QKL + 64 * 72; LAS bf16* VNT = QDL + 64 * 72; LAS bf16* STL = VNT + 64 * 72;
    const size_t row0 = (size_t)(b * SEQ + n * 64);
    const int fr = F.lane & 15, fq = F.lane >> 4, tt = F.wave & 3, hi = F.wave >> 2;
    { const int rr = F.tid >> 3, c8 = F.tid & 7;
      *(LAS u32x4*)(KCL + rr * 72 + 8 * c8) = r.kc; *(LAS u32x4*)(QKL + rr * 72 + 8 * c8) = r.qk; *(LAS u32x4*)(QDL + rr * 72 + 8 * c8) = r.qd; }
    if (F.wave < 4) {
#pragma unroll
        for (int i = 0; i < 4; ++i) { u32x2 w; w.x = pk2(S[i][0], S[i][1]); w.y = pk2(S[i][2], S[i][3]); *(LAS u32x2*)(STL + (F.wave * 16 + fr) * 72 + 16 * i + 4 * fq) = w; } }
    u32x2 gw[2], wwv[2];
#pragma unroll
    for (int i = 0; i < 2; ++i) { gw[i] = gt_.gw[i]; wwv[i] = r.wwv[i]; }
    lds_barrier();
    {
        f32x4 a2[2] = {(f32x4){0.f, 0.f, 0.f, 0.f}, (f32x4){0.f, 0.f, 0.f, 0.f}};
#pragma unroll
        for (int ks = 0; ks < 2; ++ks) { const bf16x8 yf = lfrag(STL, 72, tt * 16 + fr, 32 * ks + 8 * fq);
#pragma unroll
            for (int i = 0; i < 2; ++i) a2[i] = MFMA16(lfrag(KCL, 72, (2 * hi + i) * 16 + fr, 32 * ks + 8 * fq), yf, a2[i]); }
        const int e = tt * 16 + fr;
#pragma unroll
        for (int i = 0; i < 2; ++i) { const int t0 = (2 * hi + i) * 16 + 4 * fq; const u32x2 ww = wwv[i];
            u32x2 w; w.x = pk2(bflo(ww.x) - a2[i][0], bfhi(ww.x) - a2[i][1]); w.y = pk2(bflo(ww.y) - a2[i][2], bfhi(ww.y) - a2[i][3]);
            *(LAS u32x2*)(VNT + e * 72 + t0) = w; }
    }
    lds_barrier();
    f32x4 acc[2] = {(f32x4){0.f, 0.f, 0.f, 0.f}, (f32x4){0.f, 0.f, 0.f, 0.f}};
#pragma unroll
    for (int ks = 0; ks < 2; ++ks) { const bf16x8 yf = lfrag(QKL, 72, tt * 16 + fr, 32 * ks + 8 * fq);
#pragma unroll
        for (int i = 0; i < 2; ++i) acc[i] = MFMA16(lfrag(VNT, 72, (2 * hi + i) * 16 + fr, 32 * ks + 8 * fq), yf, acc[i]); }
#pragma unroll
    for (int ks = 0; ks < 2; ++ks) { const bf16x8 yf = lfrag(QDL, 72, tt * 16 + fr, 32 * ks + 8 * fq);
#pragma unroll
        for (int i = 0; i < 2; ++i) acc[i] = MFMA16(lfrag(STL, 72, (2 * hi + i) * 16 + fr, 32 * ks + 8 * fq), yf, acc[i]); }
    mix_out_epilogue<2, 64>(F, acc, (const LAS float*)(F.lds + GL_GNG), gw, (bf16*)(F.ws + WS_OMIX) + row0 * 1024 + 768 + h * 64);
    gdn_step(S, r.st, 1.0f);
}
#define LAUNDER() do { F.lane = F0.lane; asm volatile("" : "+v"(F.lane)); F.tid = F.wave * 64 + F.lane; } while (0)
#define UNIT_IDX(k) const int idx = F.bid + F.G * (k), b = idx >> 9, n = (idx >> 2) & 127, h = idx & 3, uid = ((b * 4 + h) << 7) | n
__device__ __forceinline__ void phase_mix_m1(Frame& F0, int l) {
    Frame F = F0; const int NU = 2048 / F.G;
    if (F.tid < 128) ((LAS float*)(F.lds + GL_LB))[F.tid] = ((const float*)(F.ws + WS_LB))[l * 512 + ((F.bid >> 4) & 3) * 128 + F.tid];
    lds_barrier();
    const int bh = F.bid >> 4, seg = F.bid & 15, b = bh >> 2, h = bh & 3;
    RtRaw rraw; GdRaw graw;
    {
      f32x4 S[8];
#pragma unroll
      for (int i = 0; i < 8; ++i) S[i] = (f32x4){0.f, 0.f, 0.f, 0.f};
      float dseg = 1.0f;
      HgRaw raw; hg_issue<false>(F, b, 8 * seg, h, raw);
      auto hg_chunk = [&](int k, auto next_issue) __attribute__((always_inline)) { LAUNDER();
        const HgRaw cur = raw;
        next_issue(k);
        hg_prep<0>(F, l, h, cur);
        f32x4 kv[8]; hg_kv_acc(F, kv);
        const LAS float* DECL = (const LAS float*)(F.lds + GL_DECL); const int fq = F.lane >> 4;
#pragma unroll
        for (int i = 0; i < 8; ++i) S[i] = S[i] * *(const LAS f32x4*)(DECL + 16 * i + 4 * fq) + kv[i];
        if (F.tid < 128) dseg *= DECL[F.tid];
        lds_barrier(); };
      for (int k = 0; k < 7; ++k) hg_chunk(k, [&](int kk) __attribute__((always_inline)) { hg_issue<false>(F, b, 8 * seg + kk + 1, h, raw); });
      hg_chunk(7, [&](int) __attribute__((always_inline)) { rt_issue<false>(F, b, 8 * seg, h, rraw); });
      { const int fr = F.lane & 15, fq = F.lane >> 4; float* kvg = (float*)(F.ws + WS_HKV) + (size_t)(bh * 16 + seg) * 16384 + (F.wave * 16 + fr) * 128 + 4 * fq;
#pragma unroll
        for (int i = 0; i < 8; ++i) *(f32x4*)(kvg + 16 * i) = S[i];
        if (F.tid < 128) ((float*)(F.ws + WS_HDEC))[(size_t)(bh * 16 + seg) * 128 + F.tid] = dseg; } }
    {
      const float dec = __expf(64.0f * log1pf(-exp2f(-5.0f - (float)h)));
      f32x4 S[2] = {(f32x4){0.f, 0.f, 0.f, 0.f}, (f32x4){0.f, 0.f, 0.f, 0.f}};
      auto rt_chunk = [&](int k, auto next_issue) __attribute__((always_inline)) { LAUNDER();
        rt_stage<false>(F, rraw); lds_barrier();
        next_issue(k);
        rt_prep<0>(F, 8 * seg + k, h);
        f32x4 kv[2]; rt_kv_acc(F, kv);
        S[0] = S[0] * dec + kv[0]; S[1] = S[1] * dec + kv[1];
        lds_barrier(); };
      for (int k = 0; k < 7; ++k) rt_chunk(k, [&](int kk) __attribute__((always_inline)) { rt_issue<false>(F, b, 8 * seg + kk + 1, h, rraw); });
      rt_chunk(7, [&](int) __attribute__((always_inline)) { gdn_issue(F, b, 8 * seg, h, graw); gdn_load_cw(F, l, h); });
      { const int fr = F.lane & 15, fq = F.lane >> 4; float* kvg = (float*)(F.ws + WS_RKV) + (size_t)(bh * 16 + seg) * 4096 + ((F.wave & 3) * 16 + fr) * 64 + (2 * (F.wave >> 2)) * 16 + 4 * fq;
        *(f32x4*)kvg = S[0]; *(f32x4*)(kvg + 16) = S[1]; } }
    {
      f32x4 S[4];
      { const int fr = F.lane & 15, fq = F.lane >> 4, role = F.wave >> 2, c = (F.wave & 3) * 16 + fr;
#pragma unroll
        for (int i = 0; i < 4; ++i)
#pragma unroll
            for (int j = 0; j < 4; ++j) S[i][j] = (role && (16 * i + 4 * fq + j == c)) ? 1.0f : 0.0f; }
      for (int k = 0; k < 8; ++k) { LAUNDER(); const int n = 8 * seg + k;
        gdn_stage(F, graw); const GdRaw cur = graw; lds_barrier();
        if (k + 1 < 8) gdn_issue(F, b, n + 1, h, graw);
        gdn_m1(F, l, h, bh * 128 + n, cur);
        gdn_compose(F, S); }
      { const int fr = F.lane & 15, fq = F.lane >> 4, role = F.wave >> 2, c = (F.wave & 3) * 16 + fr;
        if (role == 0) { bf16* qg = (bf16*)(F.ws + WS_GQG) + (size_t)(bh * 16 + seg) * 4096 + c * 64 + fq * 16;
            u32x4 w0, w1; w0.x = pk2(S[0][0], S[0][1]); w0.y = pk2(S[0][2], S[0][3]); w0.z = pk2(S[1][0], S[1][1]); w0.w = pk2(S[1][2], S[1][3]);
            w1.x = pk2(S[2][0], S[2][1]); w1.y = pk2(S[2][2], S[2][3]); w1.z = pk2(S[3][0], S[3][1]); w1.w = pk2(S[3][2], S[3][3]);
            *(u32x4*)qg = w0; *(u32x4*)(qg + 8) = w1; }
        else { bf16* pg = (bf16*)(F.ws + WS_GPG) + (size_t)(bh * 16 + seg) * 4096 + (c >> 5) * 32 + ((c & 15) >> 2) * 8 + ((c >> 4) & 1) * 4 + (c & 3);
#pragma unroll
            for (int i = 0; i < 4; ++i)
#pragma unroll
                for (int j = 0; j < 4; ++j) pg[(16 * i + 4 * fq + j) * 64] = (bf16)f2bf(S[i][j]); } } }
}
__device__ __forceinline__ void phase_mix_m2a(Frame& F, int l) { gdn_m2a(F, F.bid >> 4, F.bid & 15); }
__device__ __forceinline__ void phase_mix_m2b(Frame& F, int l) {
    if (F.bid < 16) gdn_m2b(F, F.bid);
    else if (F.bid < 144) { const int item = (F.bid - 16) * 512 + F.tid;
        if (item < 65536) { const int bh = item >> 12, e = (item >> 5) & 127, d4 = item & 31;
            const float* kv = (const float*)(F.ws + WS_HKV) + (size_t)bh * 16 * 16384 + e * 128 + d4 * 4;
            const float* dc = (const float*)(F.ws + WS_HDEC) + (size_t)bh * 16 * 128 + d4 * 4;
            float* sp = (float*)(F.ws + WS_HSP) + (size_t)bh * 16 * 16384 + e * 128 + d4 * 4;
            f32x4 S = (f32x4){0.f, 0.f, 0.f, 0.f};
            { f32x4 kb[16], db[16];
#pragma unroll
                for (int u = 0; u < 16; ++u) { kb[u] = *(const f32x4*)(kv + (size_t)u * 16384); db[u] = *(const f32x4*)(dc + u * 128); }
#pragma unroll
                for (int u = 0; u < 16; ++u) { *(f32x4*)(sp + (size_t)u * 16384) = S; S = db[u] * S + kb[u]; } }
        }
    }
    else if (F.bid < 176) { const int item = (F.bid - 144) * 512 + F.tid;
        if (item < 16384) { const int it = item, bh = it >> 10, e = (it >> 4) & 63, d4 = it & 15;
            const float* kv = (const float*)(F.ws + WS_RKV) + (size_t)bh * 16 * 4096 + e * 64 + d4 * 4;
            float* sp = (float*)(F.ws + WS_RSP) + (size_t)bh * 16 * 4096 + e * 64 + d4 * 4;
            const float dec = __expf(512.0f * log1pf(-exp2f(-5.0f - (float)(bh & 3))));
            f32x4 kb[16];
#pragma unroll
            for (int u = 0; u < 16; ++u) kb[u] = *(const f32x4*)(kv + (size_t)u * 4096);
            f32x4 S = (f32x4){0.f, 0.f, 0.f, 0.f};
#pragma unroll
            for (int u = 0; u < 16; ++u) { *(f32x4*)(sp + (size_t)u * 4096) = S; S = S * dec + kb[u]; }
        }
    }
}
__device__ __forceinline__ void phase_mix_m3(Frame& F0, int l) {
    Frame F = F0; const int NU = 2048 / F.G;
    { const int h = (F.bid >> 4) & 3;
      if (F.tid < 128) { ((LAS float*)(F.lds + GL_LB))[F.tid] = ((const float*)(F.ws + WS_LB))[l * 512 + h * 128 + F.tid]; ((LAS float*)(F.lds + GL_GNH))[F.tid] = pin(F, I_HGG)[l * 512 + h * 128 + F.tid]; }
      else if (F.tid < 192) ((LAS float*)(F.lds + GL_GNR))[F.tid - 128] = pin(F, I_RETG)[l * 256 + h * 64 + F.tid - 128];
      else if (F.tid < 256) ((LAS float*)(F.lds + GL_GNG))[F.tid - 192] = pin(F, I_GDNG)[l * 256 + h * 64 + F.tid - 192];
      lds_barrier(); }
    const int bh = F.bid >> 4, seg = F.bid & 15, b = bh >> 2, h = bh & 3;
    f32x4 rS[2]; RtRaw rraw; u32x2 rgw[2]; f32x4 gS[4]; Gd3Raw gring[2]; Gd3Gate ggate[3];
#define RT_GATES(n_) do { const int fr_ = F.lane & 15, fq_ = F.lane >> 4, tt_ = F.wave & 3, hi_ = F.wave >> 2; const bf16* zg_ = (const bf16*)(F.ws + WS_R1) + (size_t)(b * SEQ + (n_) * 64) * NZ + 2816 + h * 64; \
        _Pragma("unroll") for (int i_ = 0; i_ < 2; ++i_) rgw[i_] = __builtin_nontemporal_load((const u32x2*)(zg_ + (size_t)(tt_ * 16 + fr_) * NZ + (2 * hi_ + i_) * 16 + 4 * fq_)); } while (0)
    auto rt_entry = [&]() __attribute__((always_inline)) {
        const int fr = F.lane & 15, fq = F.lane >> 4; const float* sg = (const float*)(F.ws + WS_RSP) + (size_t)(bh * 16 + seg) * 4096 + ((F.wave & 3) * 16 + fr) * 64 + (2 * (F.wave >> 2)) * 16 + 4 * fq;
        rS[0] = *(const f32x4*)sg; rS[1] = *(const f32x4*)(sg + 16);
        rt_issue<true>(F, b, 8 * seg, h, rraw); RT_GATES(8 * seg); };
    auto gd_entry = [&]() __attribute__((always_inline)) {
        const int fr = F.lane & 15, fq = F.lane >> 4; const float* ss = (const float*)(F.ws + WS_GSS) + (size_t)(bh * 16 + seg) * 4096 + ((F.wave & 3) * 16 + fr) * 64 + 4 * fq;
#pragma unroll
        for (int i = 0; i < 4; ++i) gS[i] = *(const f32x4*)(ss + i * 16);
        gdn3_issue(F, b, 8 * seg, h, bh * 128 + 8 * seg, gring[0]); gdn3_gates(F, b, 8 * seg, h, ggate[0]); gdn3_gates(F, b, 8 * seg + 1, h, ggate[1]); };
    {
      f32x4 S[8]; bf16x8 sfd[4][4]; u32x2 gw[4];
      { const int fr = F.lane & 15, fq = F.lane >> 4; const float* sg = (const float*)(F.ws + WS_HSP) + (size_t)(bh * 16 + seg) * 16384 + (F.wave * 16 + fr) * 128 + 4 * fq;
#pragma unroll
        for (int i = 0; i < 8; ++i) S[i] = *(const f32x4*)(sg + 16 * i); }
#define HG_GATES(n_) do { const int fr_ = F.lane & 15, fq_ = F.lane >> 4, tt_ = F.wave & 3, hi_ = F.wave >> 2; const bf16* zg_ = (const bf16*)(F.ws + WS_R1) + (size_t)(b * SEQ + (n_) * 64) * NZ + 1536 + h * 128; \
        _Pragma("unroll") for (int i_ = 0; i_ < 4; ++i_) gw[i_] = __builtin_nontemporal_load((const u32x2*)(zg_ + (size_t)(tt_ * 16 + fr_) * NZ + (4 * hi_ + i_) * 16 + 4 * fq_)); } while (0)
      HgRaw raw; hg_issue<true>(F, b, 8 * seg, h, raw); HG_GATES(8 * seg);
      auto hg_chunk = [&](int k, auto next_issue, auto next_gates) __attribute__((always_inline)) { LAUNDER(); const int n = 8 * seg + k;
        { LAS bf16* STL = (LAS bf16*)(F.lds + GL_STL); const int fr = F.lane & 15, fq = F.lane >> 4;
#pragma unroll
          for (int i = 0; i < 8; ++i) { u32x2 w; w.x = pk2(S[i][0], S[i][1]); w.y = pk2(S[i][2], S[i][3]); *(LAS u32x2*)(STL + (F.wave * 16 + fr) * 136 + 16 * i + 4 * fq) = w; } }
        const HgRaw cur = raw;
        next_issue(n);
        hg_prep<2>(F, l, h, cur);
        gla_m3_mma<128, 128, true, GL_STL>(F, sfd, gw, (const LAS float*)(F.lds + GL_GNH), (bf16*)(F.ws + WS_OMIX) + (size_t)(b * SEQ + n * 64) * 1024 + h * 128, [&]() {});
        next_gates(n);
        { f32x4 kv[8]; hg_kv_acc(F, kv);
          const LAS float* DECL = (const LAS float*)(F.lds + GL_DECL); const int fq = F.lane >> 4;
#pragma unroll
          for (int i = 0; i < 8; ++i) S[i] = S[i] * *(const LAS f32x4*)(DECL + 16 * i + 4 * fq) + kv[i]; }
        lds_barrier(); };
      for (int k = 0; k < 7; ++k) hg_chunk(k, [&](int n) __attribute__((always_inline)) { hg_issue<true>(F, b, n + 1, h, raw); }, [&](int n) __attribute__((always_inline)) { HG_GATES(n + 1); });
      hg_chunk(7, [&](int) __attribute__((always_inline)) { rt_entry(); }, [&](int) __attribute__((always_inline)) {});
#undef HG_GATES
    }
    {
      const float dec = __expf(64.0f * log1pf(-exp2f(-5.0f - (float)h)));
      bf16x8 sfd[2][2];
      auto rt_chunk = [&](int k, auto next_issue, auto next_gates) __attribute__((always_inline)) { LAUNDER(); const int n = 8 * seg + k;
        { LAS bf16* STL = (LAS bf16*)(F.lds + GL_RSTL); const int fr = F.lane & 15, fq = F.lane >> 4;
#pragma unroll
          for (int i = 0; i < 2; ++i) { u32x2 w; w.x = pk2(rS[i][0], rS[i][1]); w.y = pk2(rS[i][2], rS[i][3]); *(LAS u32x2*)(STL + ((F.wave & 3) * 16 + fr) * 72 + (2 * (F.wave >> 2) + i) * 16 + 4 * fq) = w; } }
        rt_stage<true>(F, rraw); lds_barrier();
        next_issue(n);
        rt_prep<2>(F, n, h);
        gla_m3_mma<64, 64, true, GL_RSTL>(F, sfd, rgw, (const LAS float*)(F.lds + GL_GNR), (bf16*)(F.ws + WS_OMIX) + (size_t)(b * SEQ + n * 64) * 1024 + 512 + h * 64, [&]() {});
        next_gates(n);
        { f32x4 kv[2]; rt_kv_acc(F, kv);
          rS[0] = rS[0] * dec + kv[0]; rS[1] = rS[1] * dec + kv[1]; }
        lds_barrier(); };
      for (int k = 0; k < 7; ++k) rt_chunk(k, [&](int n) __attribute__((always_inline)) { rt_issue<true>(F, b, n + 1, h, rraw); }, [&](int n) __attribute__((always_inline)) { RT_GATES(n + 1); });
      rt_chunk(7, [&](int) __attribute__((always_inline)) { gd_entry(); }, [&](int) __attribute__((always_inline)) {});
    }
#undef RT_GATES
    {
#pragma unroll
      for (int k = 0; k < 8; ++k) { LAUNDER(); const int n = 8 * seg + k;
        if (k + 1 < 8) gdn3_issue(F, b, n + 1, h, bh * 128 + n + 1, gring[(k + 1) & 1]);
        if (k + 2 < 8) gdn3_gates(F, b, n + 2, h, ggate[(k + 2) % 3]);
        gdn_m3(F, l, b, n, h, gring[k & 1], ggate[k % 3], gS); } }
}

constexpr int RT_LDW = 520;
constexpr int RT_WH = 0, RT_WL = 32 * RT_LDW * 2, RT_GV = 2 * 32 * RT_LDW * 2, RT_SH = RT_GV + 4096, RT_CB = RT_SH + 4096, RT_CP = RT_CB + 128;
__device__ __forceinline__ void phase_norm2_route(Frame& F, int l) {
    LAS bf16* WH = (LAS bf16*)(F.lds + RT_WH); LAS bf16* WL = (LAS bf16*)(F.lds + RT_WL);
    LAS float* GV = (LAS float*)(F.lds + RT_GV); LAS float* SHV = (LAS float*)(F.lds + RT_SH); LAS float* CB = (LAS float*)(F.lds + RT_CB); LAS float* CP = (LAS float*)(F.lds + RT_CP);
    LAS int* lcnt = (LAS int*)(F.lds + LDS_SM); LAS int* lbase = lcnt + 32; LAS int* le = lcnt + 64; LAS int* ls = le + 512;
    const float* rw = pin(F, I_RW) + (size_t)l * 1024 * 32;
    const float* mod = (const float*)(F.ws + WS_MOD);
    const bf16* xa = (const bf16*)(F.ws + WS_XA);
    int* re = (int*)(F.ws + WS_RE); int* rs = (int*)(F.ws + WS_RS); float* rg = (float*)(F.ws + WS_RG);
    unsigned* cnt = F.ctl + CW_CNT + l * 64;
    for (int rb0 = F.bid; rb0 < NTOK / 128; rb0 += F.G) {
        int ln_ = F.lane; asm volatile("" : "+v"(ln_));
        const int fr = ln_ & 15, fq = ln_ >> 4;
        const int bb = (rb0 * 128) >> 13;
        const float* mp = mod + (size_t)(l * 4 + bb) * 6144;
        const int row = rb0 * 128 + F.wave * 16 + fr;
        bf16x8 xf[32];
#pragma unroll
        for (int ks = 0; ks < 32; ++ks) xf[ks] = *(const bf16x8*)(xa + (size_t)row * 1024 + 32 * ks + 8 * fq);
        if (F.tid < 32) lcnt[F.tid] = 0;
        for (int k = F.tid; k < 1024; k += 512) { GV[k] = pin(F, I_N2G)[l * 1024 + k] * (1.0f + mp[4096 + k]); SHV[k] = mp[3072 + k]; }
        lds_barrier();
        { const int e = F.tid & 31, part = F.tid >> 5; float s = 0.f;
#pragma unroll 8
          for (int k = part * 64; k < part * 64 + 64; ++k) s += SHV[k] * rw[k * 32 + e];
          CP[part * 32 + e] = s; }
        f32x4 acc[2] = {(f32x4){0.f, 0.f, 0.f, 0.f}, (f32x4){0.f, 0.f, 0.f, 0.f}};
#pragma unroll
        for (int hk = 0; hk < 2; ++hk) {
#pragma unroll 4
            for (int idx = F.tid; idx < 512 * 32; idx += 512) { const int k = idx >> 5, e = idx & 31;
                const float w = rw[(size_t)(512 * hk + k) * 32 + e] * GV[512 * hk + k]; const unsigned hb = f2bf(w); const float lo = w - bflo(hb);
                WH[e * RT_LDW + k] = (bf16)hb; WL[e * RT_LDW + k] = (bf16)f2bf(lo); }
            lds_barrier();
#pragma unroll
            for (int ks = 0; ks < 16; ++ks) {
                const bf16x8 y = xf[16 * hk + ks];
#pragma unroll
                for (int n = 0; n < 2; ++n) { acc[n] = MFMA16(lfrag(WH, RT_LDW, 16 * n + fr, 32 * ks + 8 * fq), y, acc[n]); acc[n] = MFMA16(lfrag(WL, RT_LDW, 16 * n + fr, 32 * ks + 8 * fq), y, acc[n]); } }
            lds_barrier();
        }
        if (F.tid < 32) { float s = pin(F, I_RB)[l * 32 + F.tid];
#pragma unroll
            for (int pz = 0; pz < 16; ++pz) s += CP[pz * 32 + F.tid];
            CB[F.tid] = s; }
        float ss = 0.f;
#pragma unroll
        for (int ks = 0; ks < 32; ++ks) { const u32x4 w = __builtin_bit_cast(u32x4, xf[ks]);
            const float a0 = bflo(w.x), a1 = bfhi(w.x), a2 = bflo(w.y), a3 = bfhi(w.y), a4 = bflo(w.z), a5 = bfhi(w.z), a6 = bflo(w.w), a7 = bfhi(w.w);
            ss += ((a0 * a0 + a1 * a1) + (a2 * a2 + a3 * a3)) + ((a4 * a4 + a5 * a5) + (a6 * a6 + a7 * a7)); }
        ss += shx(ss, 16, ln_); ss += shx(ss, 32, ln_);
        const float rinv = rsqrtf(ss * (1.0f / 1024.0f) + NORM_EPS);
        lds_barrier();
        float lg[8];
#pragma unroll
        for (int n = 0; n < 2; ++n)
#pragma unroll
            for (int j = 0; j < 4; ++j) lg[4 * n + j] = acc[n][j] * rinv + CB[16 * n + 4 * fq + j];
        int te[4]; float tv[4];
#pragma unroll
        for (int k = 0; k < 4; ++k) { float best = -3.0e38f; int bi = 0;
#pragma unroll
            for (int i = 0; i < 8; ++i) { const int e = 16 * (i >> 2) + 4 * fq + (i & 3); if (lg[i] > best) { best = lg[i]; bi = e; } }
#pragma unroll
            for (int o = 16; o <= 32; o <<= 1) { const float ob = shx(best, o, ln_); const int oi = shxi(bi, o, ln_); if (ob > best || (ob == best && oi < bi)) { best = ob; bi = oi; } }
#pragma unroll
            for (int i = 0; i < 8; ++i) { const int e = 16 * (i >> 2) + 4 * fq + (i & 3); lg[i] = (e == bi) ? -3.0e38f : lg[i]; }
            te[k] = bi; tv[k] = best; }
        { const float e1 = __expf(tv[1] - tv[0]), e2 = __expf(tv[2] - tv[0]), e3 = __expf(tv[3] - tv[0]), inv = 1.0f / (1.0f + e1 + e2 + e3);
          if (fq == 0) { const int lr = F.wave * 16 + fr;
              *(f32x4*)(rg + (size_t)row * 4) = (f32x4){inv, e1 * inv, e2 * inv, e3 * inv};
#pragma unroll
              for (int k = 0; k < 4; ++k) { le[lr * 4 + k] = te[k]; ls[lr * 4 + k] = atomicAdd((int*)&lcnt[te[k]], 1); } } }
        { unsigned char* hrow = F.ws + WS_HN + (size_t)row * 1024;
#pragma unroll
          for (int ks = 0; ks < 32; ++ks) { u32x4 w = __builtin_bit_cast(u32x4, xf[ks]); asm volatile("" : "+v"(w)); const int k0 = 32 * ks + 8 * fq;
              const f32x4 g0 = *(const LAS f32x4*)(GV + k0), g1 = *(const LAS f32x4*)(GV + k0 + 4), s0 = *(const LAS f32x4*)(SHV + k0), s1 = *(const LAS f32x4*)(SHV + k0 + 4);
              u32x2 o; o.x = pk4_fp8(bflo(w.x) * rinv * g0[0] + s0[0], bfhi(w.x) * rinv * g0[1] + s0[1], bflo(w.y) * rinv * g0[2] + s0[2], bfhi(w.y) * rinv * g0[3] + s0[3]);
              o.y = pk4_fp8(bflo(w.z) * rinv * g1[0] + s1[0], bfhi(w.z) * rinv * g1[1] + s1[1], bflo(w.w) * rinv * g1[2] + s1[2], bfhi(w.w) * rinv * g1[3] + s1[3]);
              *(u32x2*)(hrow + k0) = o; } }
        lds_barrier();
        if (F.tid < 32) lbase[F.tid] = (int)__hip_atomic_fetch_add(cnt + F.tid, (unsigned)lcnt[F.tid], __ATOMIC_RELAXED, __HIP_MEMORY_SCOPE_AGENT);
        lds_barrier();
        { const int i = F.tid, e = le[i], sl = lbase[e] + ls[i]; re[(size_t)rb0 * 512 + i] = e; rs[(size_t)rb0 * 512 + i] = sl; ((int*)(F.ws + WS_TOKE))[e * NTOK + sl] = rb0 * 128 + (i >> 2); }
        lds_barrier();
    }
}

__device__ __forceinline__ void build_rt(Frame& F, int l) {
    LAS int* rt_e = (LAS int*)(F.lds + LDS_RT); LAS int* off = rt_e + 608; LAS int* cn = off + 32;
    if (F.tid < 64) {
        const int e = F.lane, c = (e < 32) ? (int)F.ctl[CW_CNT + l * 64 + e] : 0, t = (c + 255) >> 8;
        const int incl = (int)wave_scan_incl((float)t, F.lane), n0 = incl - t;
        if (e < 32) { off[e] = n0 * 256; cn[e] = c; for (int i = 0; i < t; ++i) rt_e[n0 + i] = e; }
        if (e == 31) rt_e[600] = incl; }
    __syncthreads();
}
__device__ __forceinline__ void phase_gather(Frame& F, int l) {
    build_rt(F, l);
    const LAS int* rt_e = (const LAS int*)(F.lds + LDS_RT); const LAS int* off = rt_e + 608; const LAS int* cn = off + 32;
    const int* re = (const int*)(F.ws + WS_RE); int* rs = (int*)(F.ws + WS_RS); int* tok = (int*)(F.ws + WS_TOK);
    for (int i = F.bid * 512 + F.tid; i < NTOK * 4; i += F.G * 512) { const int pos = off[re[i]] + rs[i]; rs[i] = pos; tok[pos] = i >> 2; }
    for (int e = F.bid; e < 32; e += F.G) { const int c = cn[e], r0 = off[e] + c, r1 = off[e] + ((c + 255) >> 8) * 256;
        for (int r = r0 + F.tid; r < r1; r += 512) tok[r] = 0; }
}

__device__ __forceinline__ void phase_combine(Frame& F, int l) {
    LAS float* w8t = (LAS float*)F.lds;
    LAS float* G2 = (LAS float*)(F.lds + 32768); LAS float* GS = G2 + 1024; LAS float* SH = GS + 1024;
    const float* mod = (const float*)(F.ws + WS_MOD);
    const int gw = F.bid * 8 + F.wave, NGW = F.G * 8, RPW = NTOK / NGW, row0 = gw * RPW, rend = row0 + RPW;
    bf16* xa = (bf16*)(F.ws + WS_XA);
    const int* rs = (const int*)(F.ws + WS_RS); const int* re = (const int*)(F.ws + WS_RE); const float* rg = (const float*)(F.ws + WS_RG);
    const LAS int* offl = (const LAS int*)(F.lds + LDS_RT) + 608;
    const unsigned char* y = F.ws + WS_R1;
    int4 ren2;
    u32x2 vn[4]; int4 posn, posn2; f32x4 ggn, ggn2; unsigned yn[4][4];
    { const u32x2* xr0 = (const u32x2*)(xa + (size_t)row0 * 1024) + F.lane;
#pragma unroll
      for (int j = 0; j < 4; ++j) vn[j] = xr0[64 * j];
      posn = *(const int4*)(rs + (size_t)row0 * 4); ggn = *(const f32x4*)(rg + (size_t)row0 * 4); const int4 ren = *(const int4*)(re + (size_t)row0 * 4);
      { const size_t r2 = (row0 + 1 < rend) ? (size_t)(row0 + 1) : (size_t)row0; posn2 = *(const int4*)(rs + r2 * 4); ggn2 = *(const f32x4*)(rg + r2 * 4); ren2 = *(const int4*)(re + r2 * 4); }
      const int pk0[4] = {offl[ren.x] + posn.x, offl[ren.y] + posn.y, offl[ren.z] + posn.z, offl[ren.w] + posn.w};
#pragma unroll
      for (int k = 0; k < 4; ++k) { const unsigned* yr = (const unsigned*)(y + (size_t)pk0[k] * 1024) + F.lane;
#pragma unroll
          for (int j = 0; j < 4; ++j) yn[k][j] = __builtin_nontemporal_load(yr + 64 * j); } }
    if (l + 1 < DEPTH) load_w8t(F, l + 1, w8t);
    if (F.tid < 256) { const int bb = (F.bid * 8 * RPW) >> 13, col = 4 * F.tid;
        const float* mp = mod + (size_t)(l * 4 + bb) * 6144; const float* mq = mod + (size_t)(((l + 1 < DEPTH) ? l + 1 : l) * 4 + bb) * 6144;
        *(LAS f32x4*)(G2 + col) = *(const f32x4*)(mp + 5120 + col);
        if (l + 1 < DEPTH) { *(LAS f32x4*)(GS + col) = *(const f32x4*)(pin(F, I_N1G) + (l + 1) * 1024 + col) * (*(const f32x4*)(mq + 1024 + col) + 1.0f); *(LAS f32x4*)(SH + col) = *(const f32x4*)(mq + col); }
        else *(LAS f32x4*)(GS + col) = *(const f32x4*)(pin(F, I_FNG) + col); }
    lds_barrier();
#pragma unroll 1
    for (int row = row0; row < rend; ++row) {
        u32x2* xr = (u32x2*)(xa + (size_t)row * 1024) + F.lane;
        int ml = 4 * F.lane; asm volatile("" : "+v"(ml));
        f32x4 v[4], a[4]; unsigned yc[4][4];
#pragma unroll
        for (int j = 0; j < 4; ++j) { v[j] = unpack4(vn[j]); a[j] = (f32x4){0.f, 0.f, 0.f, 0.f}; }
        const f32x4 gg = ggn;
#pragma unroll
        for (int k = 0; k < 4; ++k)
#pragma unroll
            for (int j = 0; j < 4; ++j) yc[k][j] = yn[k][j];
        const bool more = row + 1 < rend;
        if (more) { const u32x2* xr2 = (const u32x2*)(xa + (size_t)(row + 1) * 1024) + F.lane;
#pragma unroll
            for (int j = 0; j < 4; ++j) vn[j] = xr2[64 * j];
            const int pk2_[4] = {offl[ren2.x] + posn2.x, offl[ren2.y] + posn2.y, offl[ren2.z] + posn2.z, offl[ren2.w] + posn2.w};
#pragma unroll
            for (int k = 0; k < 4; ++k) { const unsigned* yr = (const unsigned*)(y + (size_t)pk2_[k] * 1024) + F.lane;
#pragma unroll
                for (int j = 0; j < 4; ++j) yn[k][j] = __builtin_nontemporal_load(yr + 64 * j); }
            ggn = ggn2;
            { const size_t r3 = (row + 2 < rend) ? (size_t)(row + 2) : (size_t)row; posn2 = *(const int4*)(rs + r3 * 4); ggn2 = *(const f32x4*)(rg + r3 * 4); ren2 = *(const int4*)(re + r3 * 4); } }
        const float gk[4] = {gg.x, gg.y, gg.z, gg.w};
#pragma unroll
        for (int k = 0; k < 4; ++k)
#pragma unroll
            for (int j = 0; j < 4; ++j) a[j] += unpack4_fp8(yc[k][j]) * gk[k];
        float ss = 0.f;
#pragma unroll
        for (int j = 0; j < 4; ++j) { v[j] = v[j] + *(const LAS f32x4*)(G2 + 256 * j + ml) * a[j]; ss += (v[j].x * v[j].x + v[j].y * v[j].y) + (v[j].z * v[j].z + v[j].w * v[j].w); }
        const float r = rsqrtf(wave_sum(ss) * (1.0f / 1024.0f) + NORM_EPS);
        if (l + 1 < DEPTH) {
            f32x4 h[4]; bf16* hrow = (bf16*)(F.ws + WS_HN) + (size_t)row * 1024;
#pragma unroll
            for (int j = 0; j < 4; ++j) { u32x2 w; w.x = pk2(v[j].x, v[j].y); w.y = pk2(v[j].z, v[j].w); xr[64 * j] = w;
                h[j] = (v[j] * r) * *(const LAS f32x4*)(GS + 256 * j + ml) + *(const LAS f32x4*)(SH + 256 * j + ml);
                u32x2 w2; w2.x = pk2(h[j].x, h[j].y); w2.y = pk2(h[j].z, h[j].w); *(u32x2*)(hrow + 256 * j + 4 * F.lane) = w2; }
            emit_gab(h, w8t, (float*)(F.ws + WS_GAB) + (size_t)row * 8, F.lane);
        } else {
            f32x4* orow = (f32x4*)(pout(F) + (size_t)row * 1024) + F.lane;
#pragma unroll
            for (int j = 0; j < 4; ++j) orow[64 * j] = (v[j] * r) * *(const LAS f32x4*)(GS + 256 * j + ml);
        }
    }
    __syncthreads();
}

#define PHASE __device__ __forceinline__ void
PHASE ph_prologue(int w0) { Frame F = make_frame(w0); phase0(F); }
PHASE ph_norm1_first(int w0) { Frame F = make_frame(w0); phase_norm1_first(F); }
PHASE ph_gemm_in(int w0, int l_) { Frame F = make_frame(w0); const int l = __builtin_amdgcn_readfirstlane(l_);
    pg8::DenseOrder S; S.init(F.ws + WS_HN, (bf16*)(F.ws + WS_WIN) + (size_t)l * NZ * 1024, NTOK, NZ, F.G, F.bid);
    pg8::EpiZ E{(bf16*)(F.ws + WS_R1), NZ};
    pg8::gemm_phase<pg8::EpiZ, pg8::DenseOrder>(F.lds, S, E, pg8::HSTEP, F.wave0); }
PHASE ph_mix(int w0, int l_) { Frame F = make_frame(w0); const int l = __builtin_amdgcn_readfirstlane(l_); phase_mix_naive(F, l); }
PHASE ph_mix_m1(int w0, int l_) { Frame F = make_frame(w0); const int l = __builtin_amdgcn_readfirstlane(l_); phase_mix_m1(F, l); }
PHASE ph_mix_m2a(int w0, int l_) { Frame F = make_frame(w0); const int l = __builtin_amdgcn_readfirstlane(l_); phase_mix_m2a(F, l); }
PHASE ph_mix_m2b(int w0, int l_) { Frame F = make_frame(w0); const int l = __builtin_amdgcn_readfirstlane(l_); phase_mix_m2b(F, l); }
PHASE ph_mix_m3(int w0, int l_) { Frame F = make_frame(w0); const int l = __builtin_amdgcn_readfirstlane(l_); phase_mix_m3(F, l); }
PHASE ph_gemm_out(int w0, int l_) { Frame F = make_frame(w0); const int l = __builtin_amdgcn_readfirstlane(l_);
    const float* mod = (const float*)(F.ws + WS_MOD);
    pg8::DenseOrder S; S.init(F.ws + WS_OMIX, (bf16*)(F.ws + WS_WOUT) + (size_t)l * 1024 * 1024, NTOK, 1024, F.G, F.bid);
    if (l == 0) { pg8::EpiXres<false> E{(const void*)pin(F, I_X), (bf16*)(F.ws + WS_XA), mod + 2048};
        pg8::gemm_phase<pg8::EpiXres<false>, pg8::DenseOrder>(F.lds, S, E, pg8::HSTEP, F.wave0); }
    else { pg8::EpiXres<true> E{(const void*)(F.ws + WS_XA), (bf16*)(F.ws + WS_XA), mod + (size_t)l * 4 * 6144 + 2048};
        pg8::gemm_phase<pg8::EpiXres<true>, pg8::DenseOrder>(F.lds, S, E, pg8::HSTEP, F.wave0); } }
PHASE ph_route(int w0, int l_) { Frame F = make_frame(w0); const int l = __builtin_amdgcn_readfirstlane(l_); phase_norm2_route(F, l); }
PHASE ph_gather(int w0, int l_) { Frame F = make_frame(w0); const int l = __builtin_amdgcn_readfirstlane(l_); phase_gather(F, l); }
PHASE ph_moe_up(int w0, int l_) { Frame F = make_frame(w0); const int l = __builtin_amdgcn_readfirstlane(l_);
    build_rt(F, l);
    const LAS int* rt_e = (const LAS int*)(F.lds + LDS_RT); const int nrt = __builtin_amdgcn_readfirstlane(rt_e[600]);
    pg8::MoeOrder S; S.A = (const char*)(F.ws + WS_HN); S.gather = true; S.atstep = 0; S.Bt = (const char*)(F.ws + WS_W1 + (size_t)l * 32 * 2048 * 1024); S.nct = 8; S.nrt = nrt; S.ntot = nrt * 8; S.G = F.G; S.c = F.bid;
    S.estride = (size_t)2048 * 1024; S.ctstep = (size_t)128 * 1024; S.rt_e = rt_e;
    pg8::EpiAct E{F.ws + WS_R2, pin(F, I_B1) + (size_t)l * 32 * 2048};
    pg8::gemm_phase<pg8::EpiAct, pg8::MoeOrder, true, true>(F.lds, S, E, (size_t)1024 * 1024, F.wave0, (const int*)(F.ws + WS_TOKE)); }
PHASE ph_moe_down(int w0, int l_) { Frame F = make_frame(w0); const int l = __builtin_amdgcn_readfirstlane(l_);
    const LAS int* rt_e = (const LAS int*)(F.lds + LDS_RT); const int nrt = __builtin_amdgcn_readfirstlane(rt_e[600]);
    pg8::MoeOrder S; S.A = (const char*)(F.ws + WS_R2); S.gather = false; S.atstep = (size_t)256 * 1024; S.Bt = (const char*)(F.ws + WS_W2 + (size_t)l * 32 * 1024 * 1024); S.nct = 4; S.nrt = nrt; S.ntot = nrt * 4; S.G = F.G; S.c = F.bid;
    S.estride = (size_t)1024 * 1024; S.ctstep = (size_t)256 * 1024; S.rt_e = rt_e;
    pg8::EpiY E{F.ws + WS_R1, pin(F, I_B2) + (size_t)l * 32 * 1024};
    pg8::gemm_phase<pg8::EpiY, pg8::MoeOrder, false, true>(F.lds, S, E, (size_t)128 * 1024, F.wave0); }
PHASE ph_combine(int w0, int l_) { Frame F = make_frame(w0); const int l = __builtin_amdgcn_readfirstlane(l_); phase_combine(F, l); }

__global__ void __launch_bounds__(512, 2) fwd(Params p) {
    LAS unsigned char* lds = (LAS unsigned char*)lds_raw;
    const int tid = threadIdx.x;
    for (int u = tid; u < (LDS_BYTES - LDSCTL_OFF) / 4; u += 512) ((LAS unsigned*)(lds + LDSCTL_OFF))[u] = 0u;
    __syncthreads();
    if (tid == 0) {
        LAS unsigned long long* P = (LAS unsigned long long*)(lds + LDS_PAR);
#pragma unroll
        for (int i = 0; i < 22; ++i) P[i] = (unsigned long long)p.in[i];
        P[22] = (unsigned long long)p.out; P[23] = (unsigned long long)p.ws;
    }
    __syncthreads();
    (void)xcd_barrier_post((unsigned*)(p.ws + WS_CTL) + CW_BAR, (volatile LAS unsigned*)(lds + MISC_OFF) + 8);
#define GRID_BAR() do { XcdBarrier b2_; unsigned long long bp_ = ldpar(lds, 23) + WS_CTL + 4ull * CW_BAR; asm volatile("" : "+s"(bp_)); b2_.bar = (unsigned*)(GAS unsigned*)bp_; b2_.x = xb_xcc_id(); b2_.st = (volatile LAS unsigned*)(lds + MISC_OFF) + 8; xcd_barrier(b2_); } while (0)
    const int w0 = __builtin_amdgcn_readfirstlane(tid >> 6);
#ifndef DBL_P0
#define DBL_P0 1
#endif
    for (int r_ = 0; r_ < DBL_P0; ++r_) { ph_prologue(w0); GRID_BAR(); }
    ph_norm1_first(w0); GRID_BAR();
#ifndef DBL_GIN
#define DBL_GIN 1
#endif
#define DBL_M1 1
#define DBL_M2 1
#define DBL_M3 1
#ifndef DBL_MOE
#define DBL_MOE 1
#endif
#define LAYER(l) do { for (int r_ = 0; r_ < DBL_GIN; ++r_) { ph_gemm_in(w0, l); GRID_BAR(); } \
        for (int r_ = 0; r_ < DBL_M1; ++r_) { ph_mix_m1(w0, l); GRID_BAR(); } for (int r_ = 0; r_ < DBL_M2; ++r_) { ph_mix_m2b(w0, l); GRID_BAR(); } for (int r_ = 0; r_ < DBL_M3; ++r_) { ph_mix_m3(w0, l); GRID_BAR(); } \
        ph_gemm_out(w0, l); GRID_BAR(); ph_route(w0, l); GRID_BAR(); \
        for (int r_ = 0; r_ < DBL_MOE; ++r_) { ph_moe_up(w0, l); GRID_BAR(); } for (int r_ = 0; r_ < DBL_MOE; ++r_) { ph_moe_down(w0, l); GRID_BAR(); } ph_combine(w0, l); } while (0)
    LAYER(0); GRID_BAR();
    LAYER(1);
}

extern "C" void kernel_launch(void* const* d_in, const int* in_sizes, int n_in, void* d_out, int out_size, void* d_ws, size_t ws_size, hipStream_t stream) {
    static int grid = 0;
    if (grid == 0) {
        if (n_in != 22 || out_size != NTOK * D || ws_size < WS_END) { fprintf(stderr, "kernel_launch: unexpected shapes (n_in %d out %d ws %zu need %zu)\n", n_in, out_size, ws_size, (size_t)WS_END); grid = -1; return; }
        int dev = 0, cus = 0, per_cu = 0;
        if (hipGetDevice(&dev) != hipSuccess || hipDeviceGetAttribute(&cus, hipDeviceAttributeMultiprocessorCount, dev) != hipSuccess) { grid = -1; return; }
        if (hipFuncSetAttribute((const void*)fwd, hipFuncAttributeMaxDynamicSharedMemorySize, LDS_BYTES) != hipSuccess) { fprintf(stderr, "kernel_launch: hipFuncSetAttribute failed\n"); grid = -1; return; }
        if (hipOccupancyMaxActiveBlocksPerMultiprocessor(&per_cu, (const void*)fwd, 512, LDS_BYTES) != hipSuccess || per_cu < 1) fprintf(stderr, "kernel_launch: occupancy query reports %d\n", per_cu);
        (void)hipGetLastError();
        grid = cus;
    }
    if (grid < 0) return;
    if (hipMemsetAsync((char*)d_ws + WS_CTL, 0, CTL_ZERO_BYTES, stream) != hipSuccess) return;
    Params p{};
    for (int i = 0; i < 22; ++i) p.in[i] = (const float*)d_in[i];
    p.out = (float*)d_out; p.ws = (unsigned char*)d_ws;
    hipLaunchKernelGGL(fwd, dim3(grid), dim3(512), LDS_BYTES, stream, p);
}
```

```cpp
#include <hip/hip_runtime.h>
#include <cstdio>
#include <cstdint>

#define GAS __attribute__((address_space(1)))
#define LAS __attribute__((address_space(3)))
typedef unsigned short bf16;
typedef short bf16x8 __attribute__((ext_vector_type(8)));
typedef float f32x4 __attribute__((ext_vector_type(4)));
typedef float f32x2 __attribute__((ext_vector_type(2)));
typedef unsigned u32x4 __attribute__((ext_vector_type(4)));
typedef unsigned u32x2 __attribute__((ext_vector_type(2)));

constexpr int D = 1024, BATCH = 4, SEQ = 8192, NTOK = BATCH * SEQ, DEPTH = 2;
constexpr int NIN = 4104, NZ = 4096, NE = 32, TOPK = 4, FF = 1024;
constexpr int NROWS_S = NTOK * TOPK + NE * 256;
constexpr float NORM_EPS = 1e-6f;

constexpr size_t MiB = 1u << 20;
constexpr size_t WS_CTL = 0, CTL_ZERO_BYTES = 1 * MiB;
constexpr size_t WS_MOD = 1 * MiB;
constexpr size_t WS_LB = WS_MOD + 256 * 1024;
constexpr size_t WS_ROPE = WS_LB + 8192;
constexpr size_t WS_WIN = 2 * MiB;
constexpr size_t WS_WOUT = WS_WIN + 16 * MiB;
constexpr size_t WS_W1 = WS_WOUT + 4 * MiB;
constexpr size_t WS_W2 = WS_W1 + 256 * MiB;
constexpr size_t WS_XA = WS_W2 + 128 * MiB;
constexpr size_t WS_HN = WS_XA + 128 * MiB;
constexpr size_t WS_OMIX = WS_HN + 64 * MiB;
constexpr size_t WS_GAB = WS_OMIX + 64 * MiB;
constexpr size_t WS_RE = WS_GAB + 1 * MiB;
constexpr size_t WS_RS = WS_RE + 512 * 1024;
constexpr size_t WS_RG = WS_RS + 512 * 1024;
constexpr size_t WS_TOK = WS_RG + 512 * 1024;
constexpr size_t WS_R1 = WS_TOK + 1 * MiB;
constexpr size_t WS_R2 = WS_R1 + 272 * MiB;
constexpr size_t WS_HKV = WS_R2 + 272 * MiB;
constexpr size_t WS_HDEC = WS_HKV + 128 * MiB;
constexpr size_t WS_HSP = WS_HDEC + 1 * MiB;
constexpr size_t WS_RKV = WS_HSP + 64 * MiB;
constexpr size_t WS_RSP = WS_RKV + 32 * MiB;
constexpr size_t WS_GT = WS_RSP + 16 * MiB;
constexpr size_t WS_GUT = WS_GT + 16 * MiB;
constexpr size_t WS_GKC = WS_GUT + 32 * MiB;
constexpr size_t WS_GWT = WS_GKC + 16 * MiB;
constexpr size_t WS_GQK = WS_GWT + 16 * MiB;
constexpr size_t WS_GQD = WS_GQK + 16 * MiB;
constexpr size_t WS_GSP = WS_GQD + 16 * MiB;
constexpr size_t WS_TOKE = WS_GSP;
constexpr size_t WS_GPG = WS_GSP + 16 * MiB;
constexpr size_t WS_GQG = WS_GPG + 2 * MiB;
constexpr size_t WS_GSS = WS_GQG + 2 * MiB;
constexpr size_t WS_END = WS_GSS + 4 * MiB;
constexpr int CW_BAR = 4096;
constexpr int CW_CNT = 16384;

constexpr int RING_BYTES = 131072;
constexpr int LDSCTL_OFF = RING_BYTES, MISC_OFF = LDSCTL_OFF + 320;
constexpr int LDS_RT = LDSCTL_OFF + 1024;
constexpr int LDS_SM = LDSCTL_OFF + 4096;
constexpr int LDS_BYTES = 147456;

#define LDS_WAIT() asm volatile("s_waitcnt lgkmcnt(0)" ::: "memory")
__device__ __forceinline__ void lds_barrier() { asm volatile("s_waitcnt lgkmcnt(0)" ::: "memory"); __builtin_amdgcn_s_barrier(); asm volatile("" ::: "memory"); }
#define VM_WAIT() asm volatile("s_waitcnt vmcnt(0)" ::: "memory")
__device__ __forceinline__ unsigned f2bf(float f) { unsigned u = __builtin_bit_cast(unsigned, f); return (u + 0x7fffu + ((u >> 16) & 1u)) >> 16; }
typedef __bf16 bf16x2_t __attribute__((ext_vector_type(2)));
__device__ __forceinline__ unsigned pk2(float lo, float hi) { return __builtin_bit_cast(unsigned, __builtin_convertvector((f32x2){lo, hi}, bf16x2_t)); }
__device__ __forceinline__ unsigned pk2m(float lo, float hi) { return pk2(lo, hi); }
typedef int i32x8 __attribute__((ext_vector_type(8)));
__device__ __forceinline__ unsigned pk4_fp8(float a, float b, float c, float d) {
    int w = __builtin_amdgcn_cvt_pk_fp8_f32(a, b, 0, false); w = __builtin_amdgcn_cvt_pk_fp8_f32(c, d, w, true); return (unsigned)w; }
constexpr float W8_SCALE = 64.0f, W8_INV = 1.0f / 64.0f;
__device__ __forceinline__ float bf2f(bf16 v) { return __builtin_bit_cast(float, ((unsigned)v) << 16); }
__device__ __forceinline__ float bflo(unsigned w) { return __builtin_bit_cast(float, w << 16); }
__device__ __forceinline__ float bfhi(unsigned w) { return __builtin_bit_cast(float, w & 0xffff0000u); }
#define DPP_ADD(x, ctrl, rmask) x += __builtin_bit_cast(float, __builtin_amdgcn_update_dpp(0, __builtin_bit_cast(int, x), ctrl, rmask, 0xf, false))
__device__ __forceinline__ float wave_scan_incl(float x, int lane) {
    (void)lane;
    DPP_ADD(x, 0x111, 0xf); DPP_ADD(x, 0x112, 0xf); DPP_ADD(x, 0x114, 0xf); DPP_ADD(x, 0x118, 0xf);
    DPP_ADD(x, 0x142, 0xa); DPP_ADD(x, 0x143, 0xc);
    return x;
}
__device__ __forceinline__ float wave_sum(float v) {
    return __builtin_bit_cast(float, __builtin_amdgcn_readlane(__builtin_bit_cast(int, wave_scan_incl(v, 0)), 63));
}
__device__ __forceinline__ float shx(float v, int o, int lane) { return __builtin_bit_cast(float, __builtin_amdgcn_ds_bpermute((lane ^ o) << 2, __builtin_bit_cast(int, v))); }
__device__ __forceinline__ int shxi(int v, int o, int lane) { return __builtin_amdgcn_ds_bpermute((lane ^ o) << 2, v); }
__device__ __forceinline__ float sigm(float x) { return __builtin_amdgcn_rcpf(1.0f + __expf(-x)); }
__device__ __forceinline__ float siluf(float x) { return x * sigm(x); }

#define XB_TMO      128
#define XB_XCNT(j)  (256  + 64 * (j))
#define XB_XSUB(j)  (1280 + 64 * (j))
#define XB_XGEN(j)  (2304 + 64 * (j))
#define XB_TOP      3328
#define XB_TOPGEN   3392
#define XCD_BAR_WORDS 3456
#define XB_SPIN_CAP (1u << 20)

__device__ __forceinline__ unsigned xb_ld(unsigned* p)              { return __hip_atomic_load(p, __ATOMIC_RELAXED, __HIP_MEMORY_SCOPE_AGENT); }
__device__ __forceinline__ unsigned xb_add(unsigned* p, unsigned v) { return __hip_atomic_fetch_add(p, v, __ATOMIC_RELAXED, __HIP_MEMORY_SCOPE_AGENT); }
__device__ __forceinline__ unsigned xb_xcc_id() { return (unsigned)__builtin_amdgcn_s_getreg((3 << 11) | 20) & 0xFu; }
#define XB_SPIN(cond, bar) do { unsigned _sp = 0; while (cond) { __builtin_amdgcn_s_sleep(1); \
    if ((++_sp & 255u) == 0u) { if (xb_ld(&(bar)[XB_TMO])) break; if (_sp > XB_SPIN_CAP) { atomicAdd(&(bar)[XB_TMO], 1u); break; } } } } while (0)

struct XcdBarrier { unsigned* bar; unsigned x; volatile LAS unsigned* st; };

__device__ __forceinline__ XcdBarrier xcd_barrier_post(unsigned* bar, volatile LAS unsigned* st) {
    XcdBarrier b; b.bar = bar; b.x = xb_xcc_id(); b.st = st;
    if (threadIdx.x == 0) (void)xb_add(&bar[XB_XCNT(b.x)], 1u);
    return b;
}
__device__ __forceinline__ void xcd_barrier_complete(unsigned* bar, unsigned x, unsigned& nloc, unsigned& nx) {
    const unsigned G = gridDim.x * gridDim.y * gridDim.z;
    unsigned sum, cnt, mine, sp = 0u;
    for (;;) {
        sum = 0u; cnt = 0u; mine = 0u;
#pragma unroll
        for (unsigned j = 0; j < 16; ++j) { const unsigned c = xb_ld(&bar[XB_XCNT(j)]); sum += c; cnt += (c > 0u) ? 1u : 0u; mine = (j == x) ? c : mine; }
        if (sum == G) break;
        __builtin_amdgcn_s_sleep(1);
        if ((++sp & 255u) == 0u) { if (xb_ld(&bar[XB_TMO])) break; if (sp > XB_SPIN_CAP) { atomicAdd(&bar[XB_TMO], 1u); break; } }
    }
    nloc = mine > 0u ? mine : 1u; nx = cnt > 0u ? cnt : 1u;
}
__device__ __forceinline__ void xcd_barrier(const XcdBarrier& b) {
    asm volatile("s_waitcnt vmcnt(0)" ::: "memory");
    __syncthreads();
    if (threadIdx.x == 0) {
        unsigned* bar = b.bar;
        __builtin_amdgcn_s_waitcnt(0);
        unsigned nloc = b.st[0], nx = b.st[1];
        if (nloc == 0u) { xcd_barrier_complete(bar, b.x, nloc, nx); b.st[0] = nloc; b.st[1] = nx; }
        const unsigned old = xb_add(&bar[XB_XSUB(b.x)], 1u);
        const unsigned gen = old / nloc;
        if (old + 1u == (gen + 1u) * nloc) {
            __builtin_amdgcn_fence(__ATOMIC_RELEASE, "agent");
            asm volatile("s_waitcnt vmcnt(0)" ::: "memory");
            const unsigned og = xb_add(&bar[XB_TOP], 1u);
            const unsigned tg = og / nx;
            if (og + 1u == (tg + 1u) * nx) xb_add(&bar[XB_TOPGEN], 1u);
            else XB_SPIN(xb_ld(&bar[XB_TOPGEN]) == tg, bar);
            __builtin_amdgcn_fence(__ATOMIC_ACQUIRE, "agent");
            xb_add(&bar[XB_XGEN(b.x)], 1u);
            asm volatile("s_waitcnt vmcnt(0)" ::: "memory");
        } else {
            XB_SPIN(xb_ld(&bar[XB_XGEN(b.x)]) == gen, bar);
            __builtin_amdgcn_fence(__ATOMIC_ACQUIRE, "agent");
            asm volatile("s_waitcnt vmcnt(0)" ::: "memory");
        }
    }
    __syncthreads();
}

namespace pg8 {
typedef int i32x4_ __attribute__((ext_vector_type(4)));
constexpr int BM = 256, BK = 64, HALF = 128, HTB = HALF * BK * 2, STAGE_BYTES = 8 * HTB, NXCD = 8, WGM = 8, KD = 1024;
constexpr size_t HSTEP = (size_t)HALF * KD * 2, TSTEP = 2 * HSTEP;
__host__ __device__ __forceinline__ int lds_byte(int r, int c) { const int st = (r >> 4) * 2 + (c >> 5), rr = r & 15, cc = c & 31, ob = rr * 64 + cc * 2; return st * 1024 + (ob ^ (((ob >> 9) & 1) << 5)); }
__host__ __device__ __forceinline__ void stage_rc(int b, int& R, int& C) { const int st = b / 1024, sb = b % 1024, swz = sb ^ (((sb >> 9) & 1) << 5); R = (st >> 1) * 16 + swz / 64; C = (st & 1) * 32 + (swz % 64) / 2; }
__host__ __device__ __forceinline__ int perm32(int rho) { const int n = rho >> 4, i = rho & 15; return 8 * (i >> 2) + 4 * n + (i & 3); }

struct Unit { int pm, pn, e, tb; const char* a; const char* b; };

struct DenseOrder {
    const char* A; const char* Bt; int nM, nN, nwg, G, c;
    __device__ void init(const void* A_, const void* Bt_, int M, int N, int G_, int c_) { A = (const char*)A_; Bt = (const char*)Bt_; nM = M / BM; nN = N / BM; nwg = nM * nN; G = G_; c = c_; }
    __device__ __forceinline__ bool next(int i, Unit& u) const {
        const long L = (long)i * G + c; if (L >= nwg) return false;
        int wgid = (int)L; { const int q = nwg / NXCD, r = nwg % NXCD, xcd = wgid % NXCD, off = wgid / NXCD; wgid = (xcd < r ? xcd * (q + 1) : r * (q + 1) + (xcd - r) * q) + off; }
        const int nig = WGM * nN, gid = wgid / nig, fm = gid * WGM, gsz = (nM - fm) < WGM ? (nM - fm) : WGM;
        u.pm = fm + ((wgid % nig) % gsz); u.pn = (wgid % nig) / gsz; u.e = 0; u.tb = 0;
        u.a = A + (size_t)u.pm * TSTEP; u.b = Bt + (size_t)u.pn * TSTEP; return true;
    }
};
struct MoeOrder {
    const char* A; const char* Bt; int nct, nrt, ntot, G, c; size_t estride, ctstep, atstep; const LAS int* rt_e; bool gather;
    __device__ __forceinline__ bool next(int i, Unit& u) const {
        const int L = i * G + c; if (L >= ntot) return false;
        const int per = 8 * nct, grp = L / per, rem = L % per, fm = grp * 8, gsz = (nrt - fm) < 8 ? (nrt - fm) : 8;
        const int rt = fm + rem % gsz, ct = rem / gsz;
        const int e = __builtin_amdgcn_readfirstlane(rt_e[rt]);
        u.pm = rt; u.pn = ct; u.e = e; u.tb = e * 32768 + rt * 256 - __builtin_amdgcn_readfirstlane(rt_e[608 + e]);
        u.a = gather ? A : A + (size_t)rt * atstep; u.b = Bt + (size_t)e * estride + (size_t)ct * ctstep; return true;
    }
};

template <class Epi, class Sched, bool GATHER = false, bool FP8 = false>
__device__ __forceinline__ void gemm_phase(LAS unsigned char* lds, const Sched& S, const Epi& E, const size_t hstepB, const int wave0, const int* tok = nullptr) {
    int ln_; asm volatile("v_mbcnt_lo_u32_b32 %0, -1, 0\n\tv_mbcnt_hi_u32_b32 %0, -1, %0" : "=v"(ln_));
    int wid_ = wave0; asm volatile("" : "+s"(wid_));
    const int wid = wid_, lane = ln_, tid = wid * 64 + lane, wr = wid >> 2, wc = wid & 3, fr = lane & 15, fq = lane >> 4;
    constexpr int K = KD, ROWB = FP8 ? K : 2 * K, nt = FP8 ? K / 128 : K / BK;
    unsigned voffA[2], voffB[2]; int RA[2];
#pragma unroll
    for (int i = 0; i < 2; ++i) { int R, C; stage_rc(tid * 16 + i * 8192, R, C); const int Rb = Epi::PERM ? ((R & ~31) + perm32(R & 31)) : R;
        voffA[i] = GATHER ? 0u : (unsigned)(R * ROWB + C * 2); voffB[i] = (unsigned)(Rb * ROWB + C * 2); RA[i] = R; }
    unsigned va[2] = {0u, 0u}, vn[2] = {0u, 0u};
#define PG8_GOFF(dst, tb_) do { int t2_; asm volatile("v_mbcnt_lo_u32_b32 %0, -1, 0\n\tv_mbcnt_hi_u32_b32 %0, -1, %0" : "=v"(t2_)); t2_ += wid * 64; int R0_, C0_, R1_, C1_; stage_rc(t2_ * 16, R0_, C0_); stage_rc(t2_ * 16 + 8192, R1_, C1_); \
        _Pragma("unroll") for (int _h = 0; _h < 2; ++_h) dst[_h] = ((unsigned)tok[(tb_) + 128 * _h + R0_] & 32767u) | (((unsigned)tok[(tb_) + 128 * _h + R1_] & 32767u) << 16); } while (0)
#define PG8_GVOFF(p, _i) ({ int t3_; asm volatile("v_mbcnt_lo_u32_b32 %0, -1, 0\n\tv_mbcnt_hi_u32_b32 %0, -1, %0" : "=v"(t3_)); t3_ += wid * 64; int R3_, C3_; stage_rc(t3_ * 16 + (_i) * 8192, R3_, C3_); \
        (int)((((p) >> (16 * (_i))) & 0xffffu) * (unsigned)ROWB + (unsigned)C3_ * 2u); })
    const size_t kstep = (size_t)(BK * 2);
    const size_t hstep = (size_t)HALF * ROWB;
    const unsigned ldsw = (unsigned)wid * 1024u;
    const int aoff = lds_byte(wr * 64 + fr, fq * 8), boff = lds_byte(wc * 32 + fr, fq * 8);
#define PG8_SA(b, h) (((b) * 2 + (h)) * HTB)
#define PG8_SB(b, h) ((4 + (b) * 2 + (h)) * HTB)
    __amdgpu_buffer_rsrc_t rsA = __builtin_amdgcn_make_buffer_rsrc((void*)S.A, 0, 0x7fffffff, 0x00020000), rsB = __builtin_amdgcn_make_buffer_rsrc((void*)S.Bt, 0, 0x7fffffff, 0x00020000);
#define PG8_STAGE_X(bufoff, gbase, voff, RS, BASE) do { if constexpr (FP8) { _Pragma("unroll") for (int _i = 0; _i < 2; ++_i) \
        __builtin_amdgcn_raw_ptr_buffer_load_lds(RS, (LAS void*)(lds + (bufoff) + ldsw + _i * 8192), 16, (int)(voff)[_i], (int)(unsigned)((const char*)(gbase) - (BASE)), 0, 0); } \
        else { _Pragma("unroll") for (int _i = 0; _i < 2; ++_i) \
        __builtin_amdgcn_global_load_lds((const unsigned*)((const char*)(gbase) + (voff)[_i]), (LAS unsigned*)(lds + (bufoff) + ldsw + _i * 8192), 16, 0, 0); } } while (0)
#define PG8_STAGE(bufoff, gbase, voff) PG8_STAGE_X(bufoff, gbase, voff, rsB, S.Bt)
#define PG8_STAGE_A(bufoff, gbase, hh, nx) do { if constexpr (GATHER && FP8) { _Pragma("unroll") for (int _i = 0; _i < 2; ++_i) \
        __builtin_amdgcn_raw_ptr_buffer_load_lds(rsA, (LAS void*)(lds + (bufoff) + ldsw + _i * 8192), 16, PG8_GVOFF((nx) ? vn[hh] : va[hh], _i), (int)(unsigned)((const char*)(gbase) - S.A), 0, 0); } \
        else if constexpr (GATHER) { _Pragma("unroll") for (int _i = 0; _i < 2; ++_i) \
        __builtin_amdgcn_global_load_lds((const unsigned*)((const char*)(gbase) + (unsigned)PG8_GVOFF((nx) ? vn[hh] : va[hh], _i)), (LAS unsigned*)(lds + (bufoff) + ldsw + _i * 8192), 16, 0, 0); } \
        else { PG8_STAGE_X(bufoff, (gbase) + (hh) * hstep, voffA, rsA, S.A); } } while (0)
#define PG8_LDA(dst, b, h) do { if constexpr (FP8) { _Pragma("unroll") for (int m = 0; m < 4; ++m) dst##8[m] = __builtin_shufflevector(*(const LAS i32x4_*)(lds + PG8_SA(b, h) + aoff + m * 2048), *(const LAS i32x4_*)(lds + PG8_SA(b, h) + aoff + m * 2048 + 1024), 0, 1, 2, 3, 4, 5, 6, 7); } \
        else { _Pragma("unroll") for (int m = 0; m < 4; ++m) _Pragma("unroll") for (int k = 0; k < 2; ++k) dst[m][k] = *(const LAS bf16x8*)(lds + PG8_SA(b, h) + aoff + m * 2048 + k * 1024); } } while (0)
#define PG8_LDB(dst, b, h) do { if constexpr (FP8) { _Pragma("unroll") for (int n = 0; n < 2; ++n) dst##8[n] = __builtin_shufflevector(*(const LAS i32x4_*)(lds + PG8_SB(b, h) + boff + n * 2048), *(const LAS i32x4_*)(lds + PG8_SB(b, h) + boff + n * 2048 + 1024), 0, 1, 2, 3, 4, 5, 6, 7); } \
        else { _Pragma("unroll") for (int n = 0; n < 2; ++n) _Pragma("unroll") for (int k = 0; k < 2; ++k) dst[n][k] = *(const LAS bf16x8*)(lds + PG8_SB(b, h) + boff + n * 2048 + k * 1024); } } while (0)
#define PG8_MMA(ai, bj, At, Bt) do { __builtin_amdgcn_s_setprio(1); if constexpr (FP8) { _Pragma("unroll") for (int m = 0; m < 4; ++m) _Pragma("unroll") for (int n = 0; n < 2; ++n) \
        acc[ai][bj][m][n] = __builtin_amdgcn_mfma_scale_f32_16x16x128_f8f6f4(Bt##8[n], At##8[m], acc[ai][bj][m][n], 0, 0, 0, 0, 0, 0); } \
        else { _Pragma("unroll") for (int m = 0; m < 4; ++m) _Pragma("unroll") for (int n = 0; n < 2; ++n) _Pragma("unroll") for (int k = 0; k < 2; ++k) \
        acc[ai][bj][m][n] = __builtin_amdgcn_mfma_f32_16x16x32_bf16(Bt[n][k], At[m][k], acc[ai][bj][m][n], 0, 0, 0); } __builtin_amdgcn_s_setprio(0); } while (0)
#define PG8_WAIT_V(n) asm volatile("s_waitcnt vmcnt(" #n ")" ::: "memory")
#define PG8_WAIT_L(n) asm volatile("s_waitcnt lgkmcnt(" #n ")" ::: "memory")
#define PG8_BAR __builtin_amdgcn_s_barrier()
#define PG8_SCHED __builtin_amdgcn_sched_barrier(0)
    Unit cur, nxt; int ui = 0;
    if (!S.next(0, cur)) return;
    f32x4 acc[2][2][4][2];
    { f32x4 ib[2][2]; E.init(ib, cur, wc, fq);
#pragma unroll
      for (int a = 0; a < 2; ++a)
#pragma unroll
        for (int b = 0; b < 2; ++b)
#pragma unroll
            for (int m = 0; m < 4; ++m)
#pragma unroll
                for (int n = 0; n < 2; ++n) acc[a][b][m][n] = ib[b][n]; }
    bf16x8 At[4][2], B0[2][2], B1[2][2]; i32x8 At8[4], B08[2], B18[2];
    const char* cA = cur.a; const char* cB = cur.b;
    if constexpr (GATHER) { PG8_GOFF(va, cur.tb); }
    PG8_STAGE(PG8_SB(0, 0), cB, voffB); PG8_STAGE(PG8_SB(0, 1), cB + hstepB, voffB); PG8_STAGE_A(PG8_SA(0, 0), cA, 0, false); PG8_STAGE_A(PG8_SA(0, 1), cA, 1, false);
    if (wr == 1) PG8_BAR;
    PG8_WAIT_V(2); PG8_BAR;
    PG8_STAGE(PG8_SB(1, 0), cB + kstep, voffB); PG8_STAGE_A(PG8_SA(1, 0), cA + kstep, 0, false); PG8_STAGE(PG8_SB(1, 1), cB + hstepB + kstep, voffB);
    PG8_WAIT_V(6); PG8_BAR;
    for (;;) {
        const bool has_next = S.next(ui + 1, nxt);
        const char* nA = has_next ? nxt.a : cA; const char* nB = has_next ? nxt.b : cB;
        if constexpr (GATHER) { if (has_next) { PG8_GOFF(vn, nxt.tb); } else { vn[0] = va[0]; vn[1] = va[1]; } }
#pragma unroll 1
        for (int t = 0; t < nt; t += 2) {
            const bool last = (t == nt - 2);
            const char* a1 = cA + (size_t)(t + 1) * kstep;
            const char* a2 = last ? nA : cA + (size_t)(t + 2) * kstep; const char* b2 = last ? nB : cB + (size_t)(t + 2) * kstep;
            const char* a3 = a2 + kstep; const char* b3 = b2 + kstep;
            PG8_LDB(B0, 0, 0); PG8_LDB(B1, 0, 1); PG8_SCHED; PG8_LDA(At, 0, 0); PG8_STAGE_A(PG8_SA(1, 1), a1, 1, false);
            PG8_WAIT_V(8); PG8_WAIT_L(0); PG8_BAR; PG8_MMA(0, 0, At, B0); PG8_MMA(0, 1, At, B1); PG8_BAR; PG8_SCHED;
            PG8_LDA(At, 0, 1); PG8_STAGE(PG8_SB(0, 0), b2, voffB); PG8_STAGE(PG8_SB(0, 1), b2 + hstepB, voffB); PG8_STAGE_A(PG8_SA(0, 0), a2, 0, last);
            PG8_WAIT_V(8); PG8_WAIT_L(0); PG8_BAR; PG8_MMA(1, 0, At, B0); PG8_MMA(1, 1, At, B1); PG8_BAR; PG8_SCHED;
            PG8_LDB(B0, 1, 0); PG8_LDB(B1, 1, 1); PG8_SCHED; PG8_LDA(At, 1, 0); PG8_STAGE_A(PG8_SA(0, 1), a2, 1, last);
            PG8_WAIT_V(8); PG8_WAIT_L(0); PG8_BAR; PG8_MMA(0, 0, At, B0); PG8_MMA(0, 1, At, B1); PG8_BAR; PG8_SCHED;
            PG8_LDA(At, 1, 1); PG8_STAGE(PG8_SB(1, 0), b3, voffB); PG8_STAGE(PG8_SB(1, 1), b3 + hstepB, voffB); PG8_STAGE_A(PG8_SA(1, 0), a3, 0, last);
            PG8_WAIT_V(8); PG8_WAIT_L(0); PG8_BAR; PG8_MMA(1, 0, At, B0); PG8_MMA(1, 1, At, B1); PG8_BAR; PG8_SCHED;
        }
        if (wr == 0) PG8_BAR;
        f32x4 nb[2][2];
        { int l2_; asm volatile("v_mbcnt_lo_u32_b32 %0, -1, 0\n\tv_mbcnt_hi_u32_b32 %0, -1, %0" : "=v"(l2_)); E.init(nb, has_next ? nxt : cur, wc, l2_ >> 4); E(acc, cur, wr, wc, l2_ & 15, l2_ >> 4); }
        if (!has_next) break;
#pragma unroll
        for (int a = 0; a < 2; ++a)
#pragma unroll
            for (int b = 0; b < 2; ++b)
#pragma unroll
                for (int m = 0; m < 4; ++m)
#pragma unroll
                    for (int n = 0; n < 2; ++n) acc[a][b][m][n] = nb[b][n];
        cur = nxt; cA = nA; cB = nB; ++ui;
        if constexpr (GATHER) { va[0] = vn[0]; va[1] = vn[1]; }
        if (wr == 1) PG8_BAR;
    }
    PG8_WAIT_V(0);
    PG8_BAR;
#undef PG8_SA
#undef PG8_SB
#undef PG8_STAGE
#undef PG8_STAGE_X
#undef PG8_STAGE_A
#undef PG8_GOFF
#undef PG8_GVOFF
#undef PG8_LDA
#undef PG8_LDB
#undef PG8_MMA
#undef PG8_WAIT_V
#undef PG8_WAIT_L
#undef PG8_BAR
#undef PG8_SCHED
}

struct EpiZ {
    static constexpr bool PERM = true;
    bf16* O; int ldc;
    __device__ __forceinline__ void init(f32x4 (&ib)[2][2], const Unit&, int, int) const { ib[0][0] = ib[0][1] = ib[1][0] = ib[1][1] = (f32x4){0.f, 0.f, 0.f, 0.f}; }
    __device__ __forceinline__ void operator()(const f32x4 (&acc)[2][2][4][2], const Unit& u, int wr, int wc, int fr, int fq) const {
        const int row0 = u.pm * BM + wr * 64 + fr, col0 = u.pn * BM + wc * 32 + 8 * fq;
#pragma unroll
        for (int ai = 0; ai < 2; ++ai)
#pragma unroll
            for (int m = 0; m < 4; ++m) { bf16* rowp = O + (size_t)(row0 + ai * HALF + m * 16) * ldc + col0;
#pragma unroll
                for (int bj = 0; bj < 2; ++bj) { const f32x4 v0 = acc[ai][bj][m][0], v1 = acc[ai][bj][m][1];
                    u32x4 w; w.x = pk2(v0[0], v0[1]); w.y = pk2(v0[2], v0[3]); w.z = pk2(v1[0], v1[1]); w.w = pk2(v1[2], v1[3]);
                    *(u32x4*)(rowp + bj * HALF) = w; } }
    }
};
template <bool BASE_BF16>
struct EpiXres {
    static constexpr bool PERM = true;
    const void* base; bf16* out; const float* gate;
    __device__ __forceinline__ void init(f32x4 (&ib)[2][2], const Unit&, int, int) const { ib[0][0] = ib[0][1] = ib[1][0] = ib[1][1] = (f32x4){0.f, 0.f, 0.f, 0.f}; }
    __device__ __forceinline__ void operator()(const f32x4 (&acc)[2][2][4][2], const Unit& u, int wr, int wc, int fr, int fq) const {
        const int row0 = u.pm * BM + wr * 64 + fr, col0 = u.pn * BM + wc * 32 + 8 * fq;
        const float* gp = gate + (size_t)((u.pm * BM) >> 13) * 6144 + col0;
        f32x4 gv[2][2];
#pragma unroll
        for (int bj = 0; bj < 2; ++bj)
#pragma unroll
            for (int n = 0; n < 2; ++n) gv[bj][n] = *(const f32x4*)(gp + bj * HALF + 4 * n);
#pragma unroll
        for (int ai = 0; ai < 2; ++ai)
#pragma unroll
            for (int m = 0; m < 4; ++m) { const size_t off = (size_t)(row0 + ai * HALF + m * 16) * 1024 + col0;
#pragma unroll
                for (int bj = 0; bj < 2; ++bj) { f32x4 b0, b1;
                    if constexpr (BASE_BF16) { const u32x4 w = *(const u32x4*)((const bf16*)base + off + bj * HALF); b0 = (f32x4){bflo(w.x), bfhi(w.x), bflo(w.y), bfhi(w.y)}; b1 = (f32x4){bflo(w.z), bfhi(w.z), bflo(w.w), bfhi(w.w)}; }
                    else { b0 = *(const f32x4*)((const float*)base + off + bj * HALF); b1 = *(const f32x4*)((const float*)base + off + bj * HALF + 4); }
                    const f32x4 v0 = b0 + gv[bj][0] * acc[ai][bj][m][0], v1 = b1 + gv[bj][1] * acc[ai][bj][m][1];
                    u32x4 w; w.x = pk2(v0[0], v0[1]); w.y = pk2(v0[2], v0[3]); w.z = pk2(v1[0], v1[1]); w.w = pk2(v1[2], v1[3]);
                    *(u32x4*)(out + off + bj * HALF) = w; } }
    }
};
struct EpiAct {
    static constexpr bool PERM = true;
    unsigned char* O; const float* b1;
    __device__ __forceinline__ void init(f32x4 (&ib)[2][2], const Unit& u, int wc, int fq) const {
        const float* bp = b1 + (size_t)u.e * 2048 + u.pn * HALF + wc * 32 + 8 * fq;
#pragma unroll
        for (int n = 0; n < 2; ++n) { ib[0][n] = *(const f32x4*)(bp + 4 * n) * W8_SCALE; ib[1][n] = *(const f32x4*)(bp + 1024 + 4 * n) * W8_SCALE; } }
    __device__ __forceinline__ void operator()(const f32x4 (&acc)[2][2][4][2], const Unit& u, int wr, int wc, int fr, int fq) const {
        const int row0 = u.pm * BM + wr * 64 + fr, cc0 = u.pn * HALF + wc * 32 + 8 * fq;
#pragma unroll
        for (int ai = 0; ai < 2; ++ai)
#pragma unroll
            for (int m = 0; m < 4; ++m) { unsigned char* rowp = O + (size_t)(row0 + ai * HALF + m * 16) * 1024 + cc0;
                float r[8];
#pragma unroll
                for (int n = 0; n < 2; ++n)
#pragma unroll
                    for (int p = 0; p < 2; ++p) {
                        const f32x2 a2 = (f32x2){acc[ai][0][m][n][2 * p], acc[ai][0][m][n][2 * p + 1]}, c2 = (f32x2){acc[ai][1][m][n][2 * p], acc[ai][1][m][n][2 * p + 1]};
                        f32x2 m2, lc;
                        m2[0] = fminf(a2[0], 448.0f); m2[1] = fminf(a2[1], 448.0f);
                        lc[0] = __builtin_amdgcn_fmed3f(c2[0], -448.0f, 448.0f); lc[1] = __builtin_amdgcn_fmed3f(c2[1], -448.0f, 448.0f);
                        const f32x2 ea = m2 * (-1.702f * 1.4426950408889634f * W8_INV); f32x2 d;
                        d[0] = __builtin_amdgcn_exp2f(ea[0]); d[1] = __builtin_amdgcn_exp2f(ea[1]);
                        d = d + 1.0f; f32x2 rc; rc[0] = __builtin_amdgcn_rcpf(d[0]); rc[1] = __builtin_amdgcn_rcpf(d[1]);
                        const f32x2 o2 = (m2 * rc) * (lc * (W8_INV * W8_INV) + W8_INV);
                        r[4 * n + 2 * p] = o2[0]; r[4 * n + 2 * p + 1] = o2[1]; }
                u32x2 w; w.x = pk4_fp8(r[0], r[1], r[2], r[3]); w.y = pk4_fp8(r[4], r[5], r[6], r[7]);
                *(u32x2*)rowp = w; }
    }
};
struct EpiY {
    static constexpr bool PERM = true;
    unsigned char* O; const float* b2;
    __device__ __forceinline__ void init(f32x4 (&ib)[2][2], const Unit& u, int wc, int fq) const {
        const float* bp = b2 + (size_t)u.e * 1024 + u.pn * BM + wc * 32 + 8 * fq;
#pragma unroll
        for (int bj = 0; bj < 2; ++bj)
#pragma unroll
            for (int n = 0; n < 2; ++n) ib[bj][n] = *(const f32x4*)(bp + bj * HALF + 4 * n) * W8_SCALE; }
    __device__ __forceinline__ void operator()(const f32x4 (&acc)[2][2][4][2], const Unit& u, int wr, int wc, int fr, int fq) const {
        const int row0 = u.pm * BM + wr * 64 + fr, col0 = u.pn * BM + wc * 32 + 8 * fq;
#pragma unroll
        for (int ai = 0; ai < 2; ++ai)
#pragma unroll
            for (int m = 0; m < 4; ++m) { unsigned char* rowp = O + (size_t)(row0 + ai * HALF + m * 16) * 1024 + col0;
#pragma unroll
                for (int bj = 0; bj < 2; ++bj) { const f32x4 v0 = acc[ai][bj][m][0] * W8_INV, v1 = acc[ai][bj][m][1] * W8_INV;
                    u32x2 w; w.x = pk4_fp8(v0[0], v0[1], v0[2], v0[3]); w.y = pk4_fp8(v1[0], v1[1], v1[2], v1[3]);
                    *(u32x2*)(rowp + bj * HALF) = w; } }
    }
};
}

struct Params { const float* in[22]; float* out; unsigned char* ws; };
enum { I_X = 0, I_C, I_ADAW, I_ADAB, I_N1G, I_N2G, I_WIN, I_WOUT, I_LBL, I_HGG, I_RETG, I_CONVW, I_ALOG, I_DTB, I_GDNG, I_RW, I_RB, I_W1, I_B1, I_W2, I_B2, I_FNG };

struct Frame {
    LAS unsigned char* lds;
    int tid, lane, wave, wave0, G, bid;
    unsigned char* ws;
    unsigned* ctl;
};
extern __shared__ __attribute__((aligned(16))) unsigned char lds_raw[];
constexpr int LDS_PAR = LDSCTL_OFF + 512;
__device__ __forceinline__ unsigned long long ldpar(LAS unsigned char* lds, int i) {
    const u32x2 v = *(const LAS u32x2*)(lds + LDS_PAR + 8 * i);
    return ((unsigned long long)(unsigned)__builtin_amdgcn_readfirstlane((int)v.y) << 32) | (unsigned)__builtin_amdgcn_readfirstlane((int)v.x);
}
__device__ __forceinline__ const float* pin(const Frame& F, int i) { return (const float*)(const GAS float*)ldpar(F.lds, i); }
__device__ __forceinline__ float* pout(const Frame& F) { return (float*)(GAS float*)ldpar(F.lds, 22); }
__device__ __forceinline__ int lane_id_opaque() { int ln; asm volatile("v_mbcnt_lo_u32_b32 %0, -1, 0\n\tv_mbcnt_hi_u32_b32 %0, -1, %0" : "=v"(ln)); return ln; }
__device__ __forceinline__ Frame make_frame(int wave0) {
    Frame F; F.lds = (LAS unsigned char*)lds_raw;
    const int ln = lane_id_opaque();
    int w = wave0; asm volatile("" : "+s"(w));
    F.tid = w * 64 + ln; F.lane = ln; F.wave = w; F.wave0 = w;
    int g = gridDim.x, bi = blockIdx.x; asm volatile("" : "+s"(g), "+s"(bi));
    unsigned long long wsp = ldpar(F.lds, 23); asm volatile("" : "+s"(wsp));
    F.G = g; F.bid = bi; F.ws = (unsigned char*)(GAS unsigned char*)wsp; F.ctl = (unsigned*)(F.ws + WS_CTL);
    return F;
}

template <bool F8>
__device__ __forceinline__ void p0_transpose_item(const float* W, int ld, int ncol, void* WTv, LAS float* scr, int item, int lane) {
    const int nblk = ncol / 32, kb = item / nblk, nb = item % nblk, k0 = 64 * kb, n0 = 32 * nb;
    f32x4 v[8];
#pragma unroll
    for (int i = 0; i < 8; ++i) v[i] = __builtin_nontemporal_load((const f32x4*)(W + (size_t)(k0 + 8 * i + (lane >> 3)) * ld + n0 + 4 * (lane & 7)));
#pragma unroll
    for (int i = 0; i < 8; ++i) { LAS float* d = scr + (8 * i + (lane >> 3)) * 33 + 4 * (lane & 7); d[0] = v[i][0]; d[1] = v[i][1]; d[2] = v[i][2]; d[3] = v[i][3]; }
    LDS_WAIT(); asm volatile("" ::: "memory");
    const int c = lane & 7;
#pragma unroll
    for (int j = 0; j < 4; ++j) { const int n = (lane >> 3) + 8 * j; const LAS float* s = scr + (8 * c) * 33 + n;
        if constexpr (F8) { u32x2 o; o.x = pk4_fp8(s[0 * 33] * W8_SCALE, s[1 * 33] * W8_SCALE, s[2 * 33] * W8_SCALE, s[3 * 33] * W8_SCALE); o.y = pk4_fp8(s[4 * 33] * W8_SCALE, s[5 * 33] * W8_SCALE, s[6 * 33] * W8_SCALE, s[7 * 33] * W8_SCALE);
            *(u32x2*)((unsigned char*)WTv + (size_t)(n0 + n) * 1024 + k0 + 8 * c) = o; }
        else { u32x4 o; o.x = pk2(s[0 * 33], s[1 * 33]); o.y = pk2(s[2 * 33], s[3 * 33]); o.z = pk2(s[4 * 33], s[5 * 33]); o.w = pk2(s[6 * 33], s[7 * 33]);
            *(u32x4*)((bf16*)WTv + (size_t)(n0 + n) * 1024 + k0 + 8 * c) = o; } }
    LDS_WAIT(); asm volatile("" ::: "memory");
}
__device__ __forceinline__ void phase0(Frame& F) {
    if (F.bid < 96) {
        LAS float* cs = (LAS float*)(F.lds);
        LAS float* part = (LAS float*)(F.lds + 16384);
        const float* c = pin(F, I_C);
        for (int i = F.tid; i < 4096; i += 512) cs[i] = siluf(c[i]);
        __syncthreads();
        const int cb = F.bid * 128, l = cb / 6144, j0 = cb % 6144;
        const int cg = F.wave & 1, kq = F.wave >> 1, j = j0 + cg * 64 + F.lane;
        const float* aw = pin(F, I_ADAW) + (size_t)l * 1024 * 6144 + j;
        float a0 = 0.f, a1 = 0.f, a2 = 0.f, a3 = 0.f;
#pragma unroll 8
        for (int k = kq * 256; k < kq * 256 + 256; ++k) { const float w = aw[(size_t)k * 6144]; a0 += cs[k] * w; a1 += cs[1024 + k] * w; a2 += cs[2048 + k] * w; a3 += cs[3072 + k] * w; }
        part[(kq * 4 + 0) * 128 + cg * 64 + F.lane] = a0; part[(kq * 4 + 1) * 128 + cg * 64 + F.lane] = a1;
        part[(kq * 4 + 2) * 128 + cg * 64 + F.lane] = a2; part[(kq * 4 + 3) * 128 + cg * 64 + F.lane] = a3;
        __syncthreads();
        { const int b = F.tid >> 7, jj = F.tid & 127;
          const float s = part[(0 * 4 + b) * 128 + jj] + part[(1 * 4 + b) * 128 + jj] + part[(2 * 4 + b) * 128 + jj] + part[(3 * 4 + b) * 128 + jj] + pin(F, I_ADAB)[l * 6144 + j0 + jj];
          ((float*)(F.ws + WS_MOD))[(size_t)(l * 4 + b) * 6144 + j0 + jj] = s; }
        __syncthreads();
    }
    if (F.bid == 96) {
        const float* lg = pin(F, I_LBL); float* lb = (float*)(F.ws + WS_LB);
        { const int i = F.tid; const float l0 = lg[i], l1 = lg[512 + i]; lb[i] = 0.f; lb[512 + i] = fmaxf(1.0f / (1.0f + __expf(l0 - l1)), 0.f); }
    }
    if (F.bid == 97 && F.tid < 32) ((double*)(F.ws + WS_ROPE))[F.tid] = exp(-(double)F.tid / 31.0 * 9.210340371976184) * 0.15915494309189535;
    LAS float* scr = (LAS float*)(F.lds + 32768 + F.wave * 12288);
    const int gw = F.bid * 8 + F.wave, NGW = F.G * 8;
    constexpr int I_IN = 16 * 128, I_OUT = 16 * 32, I_1 = 16 * 64, I_2 = 16 * 32;
    constexpr int N_IN = 2 * I_IN, N_OUT = 2 * I_OUT, N_1 = 64 * I_1, N_2 = 64 * I_2;
    const int NMOD = 96 * 8, NFREE = NGW - NMOD, X = (NGW > NMOD) ? 6 * NFREE : 0, N_TOT = N_IN + N_OUT + N_1 + N_2;
    const int nrounds = (F.bid >= 96 ? 6 : 0) + (N_TOT - X + NGW - 1) / NGW;
    for (int q = 0; q < nrounds; ++q) {
        int it;
        if (F.bid >= 96) it = (q < 6) ? (gw - NMOD) + NFREE * q : X + gw + NGW * (q - 6); else it = X + gw + NGW * q;
        if (it >= N_TOT) break;
        int r = it;
        if (r < N_IN) { const int m = r / I_IN; p0_transpose_item<false>(pin(F, I_WIN) + (size_t)m * 1024 * NIN, NIN, NZ, (bf16*)(F.ws + WS_WIN) + (size_t)m * NZ * 1024, scr, r % I_IN, F.lane); continue; } r -= N_IN;
        if (r < N_OUT) { const int m = r / I_OUT; p0_transpose_item<false>(pin(F, I_WOUT) + (size_t)m * 1024 * 1024, 1024, 1024, (bf16*)(F.ws + WS_WOUT) + (size_t)m * 1024 * 1024, scr, r % I_OUT, F.lane); continue; } r -= N_OUT;
        if (r < N_1) { const int m = r / I_1; p0_transpose_item<true>(pin(F, I_W1) + (size_t)m * 1024 * 2048, 2048, 2048, F.ws + WS_W1 + (size_t)m * 2048 * 1024, scr, r % I_1, F.lane); continue; } r -= N_1;
        { const int m = r / I_2; p0_transpose_item<true>(pin(F, I_W2) + (size_t)m * 1024 * 1024, 1024, 1024, F.ws + WS_W2 + (size_t)m * 1024 * 1024, scr, r % I_2, F.lane); }
    }
}

__device__ __forceinline__ void load_w8t(Frame& F, int l, LAS float* w8t) {
    const float* w = pin(F, I_WIN) + (size_t)l * 1024 * NIN + NZ;
    for (int i = F.tid; i < 8192; i += 512) { const int k = i >> 3, q = i & 7; w8t[q * 1024 + k] = w[(size_t)k * NIN + q]; }
}
__device__ __forceinline__ f32x4 unpack4_fp8(unsigned w) { const f32x2 a = __builtin_amdgcn_cvt_pk_f32_fp8((int)w, false), b = __builtin_amdgcn_cvt_pk_f32_fp8((int)w, true); return (f32x4){a[0], a[1], b[0], b[1]}; }
__device__ __forceinline__ f32x4 unpack4(u32x2 w) { return (f32x4){bflo(w.x), bfhi(w.x), bflo(w.y), bfhi(w.y)}; }
template <bool F8 = false>
__device__ __forceinline__ void norm_mod_emit(const f32x4 (&v)[4], const float* g, const float* sh, const float* sc, void* hrowv, int lane, f32x4 (&h)[4]) {
    float ss = 0.f;
#pragma unroll
    for (int j = 0; j < 4; ++j) ss += (v[j].x * v[j].x + v[j].y * v[j].y) + (v[j].z * v[j].z + v[j].w * v[j].w);
    const float r = rsqrtf(wave_sum(ss) * (1.0f / 1024.0f) + NORM_EPS);
#pragma unroll
    for (int j = 0; j < 4; ++j) { const int col = 256 * j + 4 * lane;
        const f32x4 gg = *(const f32x4*)(g + col), s1 = *(const f32x4*)(sc + col), s0 = *(const f32x4*)(sh + col);
        h[j] = (v[j] * r) * gg * (s1 + 1.0f) + s0;
        if constexpr (F8) *(unsigned*)((unsigned char*)hrowv + col) = pk4_fp8(h[j].x, h[j].y, h[j].z, h[j].w);
        else { u32x2 w; w.x = pk2(h[j].x, h[j].y); w.y = pk2(h[j].z, h[j].w); *(u32x2*)((bf16*)hrowv + col) = w; } }
}
__device__ __forceinline__ void emit_gab(const f32x4 (&h)[4], const LAS float* w8t, float* gabrow, int lane) {
    float a[8];
#pragma unroll
    for (int q = 0; q < 8; ++q) { float s = 0.f;
#pragma unroll
        for (int j = 0; j < 4; ++j) { const f32x4 w = *(const LAS f32x4*)(w8t + q * 1024 + 256 * j + 4 * lane); s += (h[j].x * w.x + h[j].y * w.y) + (h[j].z * w.z + h[j].w * w.w); }
        a[q] = wave_sum(s); }
    if (lane == 0) { *(f32x4*)gabrow = (f32x4){a[0], a[1], a[2], a[3]}; *(f32x4*)(gabrow + 4) = (f32x4){a[4], a[5], a[6], a[7]}; }
}

__device__ __forceinline__ void phase_norm1_first(Frame& F) {
    LAS float* w8t = (LAS float*)F.lds;
    LAS float* GS = (LAS float*)(F.lds + 32768); LAS float* SH = GS + 1024;
    const float* mod = (const float*)(F.ws + WS_MOD);
    const int gw = F.bid * 8 + F.wave, NGW = F.G * 8, RPW = NTOK / NGW, row0 = gw * RPW, rend = row0 + RPW;
    f32x4 vn[4];
    { const f32x4* xr = (const f32x4*)(pin(F, I_X) + (size_t)row0 * 1024) + F.lane;
#pragma unroll
      for (int j = 0; j < 4; ++j) vn[j] = __builtin_nontemporal_load(xr + 64 * j); }
    load_w8t(F, 0, w8t);
    if (F.tid < 256) { const int bb = (F.bid * 8 * RPW) >> 13, col = 4 * F.tid; const float* mp = mod + (size_t)bb * 6144;
        *(LAS f32x4*)(GS + col) = *(const f32x4*)(pin(F, I_N1G) + col) * (*(const f32x4*)(mp + 1024 + col) + 1.0f); *(LAS f32x4*)(SH + col) = *(const f32x4*)(mp + col); }
    lds_barrier();
#pragma unroll 1
    for (int row = row0; row < rend; ++row) {
        int ml = 4 * F.lane; asm volatile("" : "+v"(ml));
        f32x4 v[4], h[4];
#pragma unroll
        for (int j = 0; j < 4; ++j) v[j] = vn[j];
        if (row + 1 < rend) { const f32x4* xr = (const f32x4*)(pin(F, I_X) + (size_t)(row + 1) * 1024) + F.lane;
#pragma unroll
            for (int j = 0; j < 4; ++j) vn[j] = __builtin_nontemporal_load(xr + 64 * j); }
        float ss = 0.f;
#pragma unroll
        for (int j = 0; j < 4; ++j) ss += (v[j].x * v[j].x + v[j].y * v[j].y) + (v[j].z * v[j].z + v[j].w * v[j].w);
        const float r = rsqrtf(wave_sum(ss) * (1.0f / 1024.0f) + NORM_EPS);
        bf16* hrow = (bf16*)(F.ws + WS_HN) + (size_t)row * 1024;
#pragma unroll
        for (int j = 0; j < 4; ++j) { h[j] = (v[j] * r) * *(const LAS f32x4*)(GS + 256 * j + ml) + *(const LAS f32x4*)(SH + 256 * j + ml);
            u32x2 w; w.x = pk2(h[j].x, h[j].y); w.y = pk2(h[j].z, h[j].w); *(u32x2*)(hrow + 256 * j + 4 * F.lane) = w; }
        emit_gab(h, w8t, (float*)(F.ws + WS_GAB) + (size_t)row * 8, F.lane);
    }
    __syncthreads();
}

__device__ __forceinline__ void hgrn_naive(Frame& F, int l, int b, int h) {
    LAS float* Fg = (LAS float*)F.lds;
    LAS float* Kk = Fg + 2048, *Qq = Kk + 2048, *Vv = Qq + 2048, *Gt = Vv + 2048, *Pp = Gt + 2048;
    const bf16* z = (const bf16*)(F.ws + WS_R1);
    const float* lb = (const float*)(F.ws + WS_LB) + l * 512 + h * 128;
    const float* gn = pin(F, I_HGG) + l * 512 + h * 128;
    bf16* om = (bf16*)(F.ws + WS_OMIX);
    const int e = F.tid & 127, dq = F.tid >> 7;
    float S[32];
#pragma unroll
    for (int j = 0; j < 32; ++j) S[j] = 0.f;
    for (int t0 = 0; t0 < SEQ; t0 += 16) {
#pragma unroll
        for (int i = 0; i < 4; ++i) { const int idx = F.tid + 512 * i, tt = idx >> 7, d = idx & 127;
            const bf16* zr = z + (size_t)(b * SEQ + t0 + tt) * NZ + h * 128 + d;
            const float q = bf2f(zr[0]), fl = bf2f(zr[512]), vv = bf2f(zr[1024]), gt = bf2f(zr[1536]);
            const float lbd = lb[d], f = lbd + (1.0f - lbd) * sigm(fl);
            Fg[idx] = f; Kk[idx] = 1.0f - f; Qq[idx] = siluf(q); Vv[idx] = vv; Gt[idx] = siluf(gt); }
        __syncthreads();
        for (int tt = 0; tt < 16; ++tt) { const float vv = Vv[tt * 128 + e]; float acc = 0.f;
#pragma unroll
            for (int j4 = 0; j4 < 8; ++j4) { const int d = tt * 128 + 32 * dq + 4 * j4;
                const f32x4 ff = *(const LAS f32x4*)(Fg + d), kk = *(const LAS f32x4*)(Kk + d), qq = *(const LAS f32x4*)(Qq + d);
#pragma unroll
                for (int i = 0; i < 4; ++i) { S[4 * j4 + i] = ff[i] * S[4 * j4 + i] + kk[i] * vv; acc += S[4 * j4 + i] * qq[i]; }
                if ((j4 & 1) == 1) __builtin_amdgcn_sched_barrier(0); }
            Pp[(dq * 16 + tt) * 128 + e] = acc; }
        __syncthreads();
#pragma unroll
        for (int r = 0; r < 2; ++r) { const int tt = 2 * F.wave + r;
            float o0 = 0.f, o1 = 0.f;
#pragma unroll
            for (int q = 0; q < 4; ++q) { o0 += Pp[(q * 16 + tt) * 128 + F.lane]; o1 += Pp[(q * 16 + tt) * 128 + 64 + F.lane]; }
            const float rr = rsqrtf(wave_sum(o0 * o0 + o1 * o1) * (1.0f / 128.0f) + NORM_EPS);
            bf16* orow = om + (size_t)(b * SEQ + t0 + tt) * 1024 + h * 128;
            orow[F.lane] = (bf16)f2bf(o0 * rr * gn[F.lane] * Gt[tt * 128 + F.lane]);
            orow[64 + F.lane] = (bf16)f2bf(o1 * rr * gn[64 + F.lane] * Gt[tt * 128 + 64 + F.lane]); }
        __syncthreads();
    }
}
__device__ __forceinline__ void ret_naive(Frame& F, int l, int b, int h) {
    LAS float* Kk = (LAS float*)F.lds;
    LAS float* Qq = Kk + 1024, *Vv = Qq + 1024, *Gt = Vv + 1024, *Pp = Gt + 1024;
    const bf16* z = (const bf16*)(F.ws + WS_R1);
    const float* gn = pin(F, I_RETG) + l * 256 + h * 64;
    bf16* om = (bf16*)(F.ws + WS_OMIX);
    const int e = F.tid & 63, dq = F.tid >> 6;
    const float gamma = 1.0f - exp2f(-5.0f - (float)h);
    float S[8];
#pragma unroll
    for (int j = 0; j < 8; ++j) S[j] = 0.f;
    const int ri = F.tid & 31, rtt = F.tid >> 5;
    const double inv_rev = ((const double*)(F.ws + WS_ROPE))[ri];
    for (int t0 = 0; t0 < SEQ; t0 += 16) {
        { const bf16* zr = z + (size_t)(b * SEQ + t0 + rtt) * NZ + 2048 + h * 64 + ri;
          const float q1 = bf2f(zr[0]), q2 = bf2f(zr[32]), k1 = bf2f(zr[256]) * 0.125f, k2 = bf2f(zr[256 + 32]) * 0.125f;
          double rev = (double)(t0 + rtt) * inv_rev; rev -= floor(rev);
          const float ang = (float)rev * 6.283185307179586f; float sn, cs; __sincosf(ang, &sn, &cs);
          Qq[rtt * 64 + ri] = q1 * cs - q2 * sn; Qq[rtt * 64 + 32 + ri] = q1 * sn + q2 * cs;
          Kk[rtt * 64 + ri] = k1 * cs - k2 * sn; Kk[rtt * 64 + 32 + ri] = k1 * sn + k2 * cs; }
#pragma unroll
        for (int i = 0; i < 2; ++i) { const int idx = F.tid + 512 * i, tt = idx >> 6, d = idx & 63;
            const bf16* zr = z + (size_t)(b * SEQ + t0 + tt) * NZ + 2048 + h * 64 + d;
            Vv[idx] = bf2f(zr[512]); Gt[idx] = siluf(bf2f(zr[768])); }
        __syncthreads();
        for (int tt = 0; tt < 16; ++tt) { const float vv = Vv[tt * 64 + e]; float acc = 0.f;
#pragma unroll
            for (int j4 = 0; j4 < 2; ++j4) { const int d = tt * 64 + 8 * dq + 4 * j4;
                const f32x4 kk = *(const LAS f32x4*)(Kk + d), qq = *(const LAS f32x4*)(Qq + d);
#pragma unroll
                for (int i = 0; i < 4; ++i) { S[4 * j4 + i] = gamma * S[4 * j4 + i] + kk[i] * vv; acc += S[4 * j4 + i] * qq[i]; } }
            Pp[(dq * 16 + tt) * 64 + e] = acc; }
        __syncthreads();
#pragma unroll
        for (int r = 0; r < 2; ++r) { const int tt = 2 * F.wave + r;
            float o = 0.f;
#pragma unroll
            for (int q = 0; q < 8; ++q) o += Pp[(q * 16 + tt) * 64 + F.lane];
            const float rr = rsqrtf(wave_sum(o * o) * (1.0f / 64.0f) + NORM_EPS);
            om[(size_t)(b * SEQ + t0 + tt) * 1024 + 512 + h * 64 + F.lane] = (bf16)f2bf(o * rr * gn[F.lane] * Gt[tt * 64 + F.lane]); }
        __syncthreads();
    }
}
__device__ __forceinline__ void gdn_naive(Frame& F, int l, int b, int h) {
    LAS float* Kk = (LAS float*)F.lds;
    LAS float* Qq = Kk + 1024, *Vv = Qq + 1024, *Gt = Vv + 1024, *AB = Gt + 1024;
    const bf16* z = (const bf16*)(F.ws + WS_R1);
    const float* gab = (const float*)(F.ws + WS_GAB);
    const float* gn = pin(F, I_GDNG) + l * 256 + h * 64;
    const float* cw = pin(F, I_CONVW) + (size_t)l * 4 * 768;
    const float Aexp = __expf(pin(F, I_ALOG)[l * 4 + h]), dtb = pin(F, I_DTB)[l * 4 + h];
    bf16* om = (bf16*)(F.ws + WS_OMIX);
    float S[32];
#pragma unroll
    for (int j = 0; j < 32; ++j) S[j] = 0.f;
    const int ge = 32 * (F.wave & 1) + (F.lane & 31), gdh = F.lane >> 5;
    for (int t0 = 0; t0 < SEQ; t0 += 16) {
#pragma unroll
        for (int i = 0; i < 6; ++i) { const int idx = F.tid + 512 * i, tt = idx / 192, rem = idx % 192, which = rem >> 6, d = rem & 63;
            const int ch = which * 256 + h * 64 + d, t = t0 + tt; float u = 0.f;
#pragma unroll
            for (int j = 0; j < 4; ++j) { const int ts = t - 3 + j; if (ts >= 0) u += cw[j * 768 + ch] * bf2f(z[(size_t)(b * SEQ + ts) * NZ + 3072 + ch]); }
            const float a = siluf(u);
            if (which == 0) Qq[tt * 64 + d] = a; else if (which == 1) Kk[tt * 64 + d] = a; else Vv[tt * 64 + d] = a; }
#pragma unroll
        for (int i = 0; i < 2; ++i) { const int idx = F.tid + 512 * i, tt = idx >> 6, d = idx & 63;
            Gt[idx] = siluf(bf2f(z[(size_t)(b * SEQ + t0 + tt) * NZ + 3840 + h * 64 + d])); }
        if (F.tid < 16) { const float* gr = gab + (size_t)(b * SEQ + t0 + F.tid) * 8;
            const float xa = gr[h] + dtb, sp = (xa > 20.f) ? xa : log1pf(__expf(xa));
            AB[F.tid * 2] = __expf(-Aexp * sp); AB[F.tid * 2 + 1] = sigm(gr[4 + h]); }
        __syncthreads();
#pragma unroll
        for (int r = 0; r < 4; ++r) { const int vi = F.wave * 4 + r, tt = vi & 15; LAS float* arr = (vi < 16) ? Qq : Kk;
            const float x = arr[tt * 64 + F.lane]; const float rr = rsqrtf(wave_sum(x * x) + 1e-6f);
            arr[tt * 64 + F.lane] = x * rr * ((vi < 16) ? 0.125f : 1.0f); }
        __syncthreads();
        LAS float* Oo = AB + 64;
        if (F.wave < 2) {
            for (int tt = 0; tt < 16; ++tt) { const float vv = Vv[tt * 64 + ge], al = AB[tt * 2], be = AB[tt * 2 + 1];
                float u = 0.f;
#pragma unroll
                for (int j4 = 0; j4 < 8; ++j4) { const f32x4 kk = *(const LAS f32x4*)(Kk + tt * 64 + 32 * gdh + 4 * j4);
#pragma unroll
                    for (int i = 0; i < 4; ++i) u += S[4 * j4 + i] * kk[i]; }
                u += shx(u, 32, F.lane);
                const float w = be * (vv - al * u); float o = 0.f;
#pragma unroll
                for (int j4 = 0; j4 < 8; ++j4) { const f32x4 kk = *(const LAS f32x4*)(Kk + tt * 64 + 32 * gdh + 4 * j4), qq = *(const LAS f32x4*)(Qq + tt * 64 + 32 * gdh + 4 * j4);
#pragma unroll
                    for (int i = 0; i < 4; ++i) { S[4 * j4 + i] = al * S[4 * j4 + i] + kk[i] * w; o += S[4 * j4 + i] * qq[i]; }
                    if ((j4 & 1) == 1) __builtin_amdgcn_sched_barrier(0); }
                o += shx(o, 32, F.lane);
                if (gdh == 0) Oo[tt * 64 + ge] = o; }
        }
        __syncthreads();
#pragma unroll
        for (int r = 0; r < 2; ++r) { const int tt = 2 * F.wave + r; const float o = Oo[tt * 64 + F.lane];
            const float rr = rsqrtf(wave_sum(o * o) * (1.0f / 64.0f) + NORM_EPS);
            om[(size_t)(b * SEQ + t0 + tt) * 1024 + 768 + h * 64 + F.lane] = (bf16)f2bf(o * rr * gn[F.lane] * Gt[tt * 64 + F.lane]); }
        __syncthreads();
    }
}
__device__ __forceinline__ void phase_mix_naive(Frame& F, int l) {
    if (F.bid < 48) {
        const int u = F.bid, kind = u >> 4, b = (u >> 2) & 3, h = u & 3;
#ifdef NAIVE_HG
        if (kind == 0) hgrn_naive(F, l, b, h);
#endif
#ifdef NAIVE_RT
        if (kind == 1) ret_naive(F, l, b, h);
#endif
#ifndef NO_GD
        if (kind == 2) gdn_naive(F, l, b, h);
#endif
    }
}

#define MFMA16(a, b, c) __builtin_amdgcn_mfma_f32_16x16x32_bf16((a), (b), (c), 0, 0, 0)
__device__ __forceinline__ bf16x8 lfrag(const LAS bf16* base, int ld, int row, int k) { return *(const LAS bf16x8*)(base + row * ld + k); }
__device__ __forceinline__ bf16x8 gfrag(const bf16* base, int ld, int row, int k) { return *(const bf16x8*)(base + (size_t)row * ld + k); }
constexpr int GL_QS = 0, GL_KH = 17408, GL_VT = 34816, GL_SC = 53248, GL_KDT = 62464, GL_RAW = 80896, GL_STL = 84992, GL_DECL = 121600, GL_RS = 122112;

struct HgRaw { unsigned q[8], f[8], v[8]; };
template <bool NEED_Q>
__device__ __forceinline__ void hg_issue(Frame& F, int b, int n, int h, HgRaw& r) {
    const bf16* z = (const bf16*)(F.ws + WS_R1) + (size_t)(b * SEQ + n * 64 + 8 * F.wave) * NZ + h * 128;
#pragma unroll
    for (int i = 0; i < 8; ++i) { const unsigned* zr = (const unsigned*)(z + (size_t)i * NZ) + F.lane;
        r.q[i] = NEED_Q ? __builtin_nontemporal_load(zr) : 0u; r.f[i] = __builtin_nontemporal_load(zr + 256); r.v[i] = __builtin_nontemporal_load(zr + 512); }
}
constexpr int GL_RSTL = 71680;
constexpr int GL_GNH = 122624, GL_GNR = 123136, GL_GNG = 123392, GL_LB = 123648;
constexpr int GL_BP = GL_RAW;
template <int MODE>
__device__ __forceinline__ void hg_prep(Frame& F, int l, int h, const HgRaw& r) {
    constexpr bool m3 = (MODE == 2);
    constexpr int LQ = 136, LT = 72;
    LAS bf16* QS = (LAS bf16*)(F.lds + GL_QS); LAS bf16* KH = (LAS bf16*)(F.lds + GL_KH); LAS bf16* VT = (LAS bf16*)(F.lds + GL_VT); LAS bf16* KDT = (LAS bf16*)(F.lds + GL_KDT);
    LAS float* BP = (LAS float*)(F.lds + GL_BP); LAS float* DECL = (LAS float*)(F.lds + GL_DECL);
    const int j = F.lane, w = F.wave;
    const f32x2 lb2 = *(const LAS f32x2*)(F.lds + GL_LB + 8 * j);
    float kx[2][8], pp[2][8], sx[2][8];
#pragma unroll
    for (int hh = 0; hh < 2; ++hh) { const float om = 1.0f - lb2[hh];
#pragma unroll
        for (int i = 0; i < 8; ++i) { const float fl = hh ? bfhi(r.f[i]) : bflo(r.f[i]); const float k = om * sigm(-fl); kx[hh][i] = k;
            const float f = fmaxf(1.0f - k, 4.0e-18f); pp[hh][i] = (i == 0) ? f : pp[hh][i - 1] * f; }
#pragma unroll
        for (int i = 7; i >= 0; --i) { const float fl = hh ? bfhi(r.f[i]) : bflo(r.f[i]); (void)fl; sx[hh][i] = (i == 7) ? 1.0f : sx[hh][i + 1] * fmaxf(1.0f - kx[hh][i + 1], 4.0e-18f); }
        BP[w * 128 + 2 * j + hh] = pp[hh][7]; }
    { u32x4 v0, v1;
      v0.x = (r.v[0] & 0xffffu) | (r.v[1] << 16); v0.y = (r.v[2] & 0xffffu) | (r.v[3] << 16); v0.z = (r.v[4] & 0xffffu) | (r.v[5] << 16); v0.w = (r.v[6] & 0xffffu) | (r.v[7] << 16);
      v1.x = (r.v[0] >> 16) | (r.v[1] & 0xffff0000u); v1.y = (r.v[2] >> 16) | (r.v[3] & 0xffff0000u); v1.z = (r.v[4] >> 16) | (r.v[5] & 0xffff0000u); v1.w = (r.v[6] >> 16) | (r.v[7] & 0xffff0000u);
      *(LAS u32x4*)(VT + (2 * j) * LT + 8 * w) = v0; *(LAS u32x4*)(VT + (2 * j + 1) * LT + 8 * w) = v1; }
    lds_barrier();
    float pre[2], post[2];
#pragma unroll
    for (int hh = 0; hh < 2; ++hh) { float a = 1.0f, c = 1.0f;
#pragma unroll
        for (int ww = 0; ww < 8; ++ww) { const float bp = BP[ww * 128 + 2 * j + hh]; a *= (ww < w) ? bp : 1.0f; c *= (ww > w) ? bp : 1.0f; }
        pre[hh] = a; post[hh] = c;
        if (w == 7) DECL[2 * j + hh] = a * pp[hh][7]; }
    if (m3) {
#pragma unroll
        for (int i = 0; i < 8; ++i) { float qs[2], kh[2];
#pragma unroll
            for (int hh = 0; hh < 2; ++hh) { const float q = hh ? bfhi(r.q[i]) : bflo(r.q[i]); const float P = pre[hh] * pp[hh][i];
                qs[hh] = siluf(q) * P; kh[hh] = kx[hh][i] * fminf(__builtin_amdgcn_rcpf(P), 5.5e34f); }
            *(LAS unsigned*)(QS + (8 * w + i) * LQ + 2 * j) = pk2(qs[0], qs[1]); *(LAS unsigned*)(KH + (8 * w + i) * LQ + 2 * j) = pk2(kh[0], kh[1]); }
    }
    {
#pragma unroll
        for (int hh = 0; hh < 2; ++hh) { float kd[8];
#pragma unroll
            for (int i = 0; i < 8; ++i) kd[i] = kx[hh][i] * sx[hh][i] * post[hh];
            u32x4 wv; wv.x = pk2(kd[0], kd[1]); wv.y = pk2(kd[2], kd[3]); wv.z = pk2(kd[4], kd[5]); wv.w = pk2(kd[6], kd[7]);
            *(LAS u32x4*)(KDT + (2 * j + hh) * LT + 8 * w) = wv; }
    }
    lds_barrier();
}
struct RtRaw { unsigned q[4], k[4], v[4]; };
template <bool NEED_Q>
__device__ __forceinline__ void rt_issue(Frame& F, int b, int n, int h, RtRaw& r) {
    const bf16* z = (const bf16*)(F.ws + WS_R1) + (size_t)(b * SEQ + n * 64) * NZ + 2048 + h * 64;
#pragma unroll
    for (int i = 0; i < 4; ++i) { const int idx = F.tid + 512 * i, t = idx >> 5, j = idx & 31;
        const unsigned* zr = (const unsigned*)(z + (size_t)t * NZ) + j;
        r.q[i] = NEED_Q ? __builtin_nontemporal_load(zr) : 0u; r.k[i] = __builtin_nontemporal_load(zr + 128); r.v[i] = __builtin_nontemporal_load(zr + 256); }
}
template <bool NEED_Q>
__device__ __forceinline__ void rt_stage(Frame& F, const RtRaw& r) {
    LAS unsigned* RQ = (LAS unsigned*)(F.lds + GL_RAW); LAS unsigned* RK = RQ + 64 * 33; LAS unsigned* RV = RK + 64 * 33;
#pragma unroll
    for (int i = 0; i < 4; ++i) { const int idx = F.tid + 512 * i, t = idx >> 5, j = idx & 31;
        if (NEED_Q) RQ[t * 33 + j] = r.q[i]; RK[t * 33 + j] = r.k[i]; RV[t * 33 + j] = r.v[i]; }
}
template <int MODE>
__device__ __forceinline__ void rt_prep(Frame& F, int n, int h) {
    constexpr bool m3 = (MODE == 2);
    constexpr int LQ = 72, LT = 72;
    LAS bf16* QS = (LAS bf16*)(F.lds + GL_QS); LAS bf16* KH = (LAS bf16*)(F.lds + GL_KH); LAS bf16* VT = (LAS bf16*)(F.lds + GL_VT); LAS bf16* KDT = (LAS bf16*)(F.lds + GL_KDT);
    LAS unsigned* RQ = (LAS unsigned*)(F.lds + GL_RAW); LAS unsigned* RK = RQ + 64 * 33; LAS unsigned* RV = RK + 64 * 33;
    const int t = F.lane;
    const float lg = log1pf(-exp2f(-5.0f - (float)h));
    const float bt = (float)(t + 1) * lg, eq = __expf(bt), ekh = __expf(-bt) * 0.125f, ekd = __expf(64.0f * lg - bt) * 0.125f;
    const double* ropet = (const double*)(F.ws + WS_ROPE);
    const LAS bf16* rq = (const LAS bf16*)RQ; const LAS bf16* rk = (const LAS bf16*)RK; const LAS bf16* rv = (const LAS bf16*)RV;
    float qa4[4], qb4[4], ka4[4], kb4[4];
#pragma unroll
    for (int i = 0; i < 4; ++i) { const int ri = F.wave * 4 + i;
        double rev = (double)(n * 64 + t) * ropet[ri]; rev -= floor(rev);
        float sn, cs; __sincosf((float)rev * 6.283185307179586f, &sn, &cs);
        const float q1 = bf2f(rq[t * 66 + ri]), q2 = bf2f(rq[t * 66 + 32 + ri]), k1 = bf2f(rk[t * 66 + ri]), k2 = bf2f(rk[t * 66 + 32 + ri]);
        const float qa = q1 * cs - q2 * sn, qb = q1 * sn + q2 * cs, ka = k1 * cs - k2 * sn, kb = k1 * sn + k2 * cs;
        qa4[i] = qa * eq; qb4[i] = qb * eq; ka4[i] = ka * ekh; kb4[i] = kb * ekh;
        { KDT[ri * LT + t] = (bf16)f2bf(ka * ekd); KDT[(32 + ri) * LT + t] = (bf16)f2bf(kb * ekd); }
    }
    if (m3) { u32x2 w;
        w.x = pk2(qa4[0], qa4[1]); w.y = pk2(qa4[2], qa4[3]); *(LAS u32x2*)(QS + t * LQ + 4 * F.wave) = w;
        w.x = pk2(qb4[0], qb4[1]); w.y = pk2(qb4[2], qb4[3]); *(LAS u32x2*)(QS + t * LQ + 32 + 4 * F.wave) = w;
        w.x = pk2(ka4[0], ka4[1]); w.y = pk2(ka4[2], ka4[3]); *(LAS u32x2*)(KH + t * LQ + 4 * F.wave) = w;
        w.x = pk2(kb4[0], kb4[1]); w.y = pk2(kb4[2], kb4[3]); *(LAS u32x2*)(KH + t * LQ + 32 + 4 * F.wave) = w; }
#pragma unroll
    for (int i = 0; i < 8; ++i) { const int e = F.wave * 8 + i; VT[e * LT + t] = rv[t * 66 + e]; }
    lds_barrier();
}
template <int DK, int DV>
__device__ __forceinline__ void gla_m1_mma(Frame& F, bf16* kvt  ) {
    constexpr int LT = 72, NXT = DK / 16, NYT = DV / 16, PER = NXT * NYT / 8;
    const LAS bf16* KDT = (const LAS bf16*)(F.lds + GL_KDT); const LAS bf16* VT = (const LAS bf16*)(F.lds + GL_VT);
    const int fr = F.lane & 15, fq = F.lane >> 4;
    const int yt = (NYT == 8) ? F.wave : (F.wave & 3), xt0 = (NYT == 8) ? 0 : 2 * (F.wave >> 2);
    f32x4 acc[PER];
#pragma unroll
    for (int i = 0; i < PER; ++i) acc[i] = (f32x4){0.f, 0.f, 0.f, 0.f};
#pragma unroll
    for (int ks = 0; ks < 2; ++ks) { const bf16x8 yf = lfrag(VT, LT, yt * 16 + fr, 32 * ks + 8 * fq);
#pragma unroll
        for (int i = 0; i < PER; ++i) acc[i] = MFMA16(lfrag(KDT, LT, (xt0 + i) * 16 + fr, 32 * ks + 8 * fq), yf, acc[i]); }
#pragma unroll
    for (int i = 0; i < PER; ++i) { u32x2 w; w.x = pk2(acc[i][0], acc[i][1]); w.y = pk2(acc[i][2], acc[i][3]); *(u32x2*)(kvt + (size_t)(yt * 16 + fr) * DK + (xt0 + i) * 16 + 4 * fq) = w; }
}
__device__ __forceinline__ void hg_kv_acc(Frame& F, f32x4 (&kv)[8]) {
    const LAS bf16* KDT = (const LAS bf16*)(F.lds + GL_KDT); const LAS bf16* VT = (const LAS bf16*)(F.lds + GL_VT);
    const int fr = F.lane & 15, fq = F.lane >> 4;
#pragma unroll
    for (int i = 0; i < 8; ++i) kv[i] = (f32x4){0.f, 0.f, 0.f, 0.f};
#pragma unroll
    for (int ks = 0; ks < 2; ++ks) { const bf16x8 yf = lfrag(VT, 72, F.wave * 16 + fr, 32 * ks + 8 * fq);
#pragma unroll
        for (int i = 0; i < 8; ++i) kv[i] = MFMA16(lfrag(KDT, 72, i * 16 + fr, 32 * ks + 8 * fq), yf, kv[i]); }
}
__device__ __forceinline__ void rt_kv_acc(Frame& F, f32x4 (&kv)[2]) {
    const LAS bf16* KDT = (const LAS bf16*)(F.lds + GL_KDT); const LAS bf16* VT = (const LAS bf16*)(F.lds + GL_VT);
    const int fr = F.lane & 15, fq = F.lane >> 4, yt = F.wave & 3, xt0 = 2 * (F.wave >> 2);
    kv[0] = (f32x4){0.f, 0.f, 0.f, 0.f}; kv[1] = (f32x4){0.f, 0.f, 0.f, 0.f};
#pragma unroll
    for (int ks = 0; ks < 2; ++ks) { const bf16x8 yf = lfrag(VT, 72, yt * 16 + fr, 32 * ks + 8 * fq);
#pragma unroll
        for (int i = 0; i < 2; ++i) kv[i] = MFMA16(lfrag(KDT, 72, (xt0 + i) * 16 + fr, 32 * ks + 8 * fq), yf, kv[i]); }
}
template <int PER, int DV>
__device__ __forceinline__ void mix_out_epilogue(Frame& F, const f32x4 (&acc)[PER], const LAS float* gn, const u32x2 (&gwv)[PER], bf16* om) {
    LAS float* RS = (LAS float*)(F.lds + GL_RS);
    const int fr = F.lane & 15, fq = F.lane >> 4, tt = F.wave & 3, hi = F.wave >> 2;
    float ss = 0.f;
#pragma unroll
    for (int i = 0; i < PER; ++i) ss += (acc[i][0] * acc[i][0] + acc[i][1] * acc[i][1]) + (acc[i][2] * acc[i][2] + acc[i][3] * acc[i][3]);
    ss += shx(ss, 16, F.lane); ss += shx(ss, 32, F.lane);
    if (fq == 0) RS[hi * 64 + tt * 16 + fr] = ss;
    lds_barrier();
    const int t = tt * 16 + fr;
    const float rr = rsqrtf((RS[t] + RS[64 + t]) * (1.0f / (float)DV) + NORM_EPS);
#pragma unroll
    for (int i = 0; i < PER; ++i) { const int e = (PER * hi + i) * 16 + 4 * fq;
        const u32x2 gw = gwv[i]; const f32x4 g4 = *(const LAS f32x4*)(gn + e);
        const float o0 = acc[i][0] * rr * g4[0] * siluf(bflo(gw.x)), o1 = acc[i][1] * rr * g4[1] * siluf(bfhi(gw.x)), o2 = acc[i][2] * rr * g4[2] * siluf(bflo(gw.y)), o3 = acc[i][3] * rr * g4[3] * siluf(bfhi(gw.y));
        u32x2 w; w.x = pk2(o0, o1); w.y = pk2(o2, o3); *(u32x2*)(om + (size_t)t * 1024 + e) = w; }
}
template <int DK, int DV>
__device__ __forceinline__ void gla_m3_loads(Frame& F, const bf16* spt, const bf16* zgate, bf16x8 (&sf)[DV / 32][DK / 32], u32x2 (&gw)[DV / 32]) {
    constexpr int KS = DK / 32, PER = DV / 32;
    const int fr = F.lane & 15, fq = F.lane >> 4, tt = F.wave & 3, hi = F.wave >> 2;
#pragma unroll
    for (int i = 0; i < PER; ++i) { gw[i] = *(const u32x2*)(zgate + (size_t)(tt * 16 + fr) * NZ + (PER * hi + i) * 16 + 4 * fq);
#pragma unroll
        for (int ks = 0; ks < KS; ++ks) sf[i][ks] = gfrag(spt, DK, (PER * hi + i) * 16 + fr, 32 * ks + 8 * fq); }
}
template <int DK, int DV, bool ST_LDS, int STO, class Mid>
__device__ __forceinline__ void gla_m3_mma(Frame& F, const bf16x8 (&sf)[DV / 32][DK / 32], const u32x2 (&gw)[DV / 32], const LAS float* gn  , bf16* om  , Mid mid) {
    constexpr int LQ = DK + 8, LT = 72, KS = DK / 32, PER = DV / 32;
    const LAS bf16* QS = (const LAS bf16*)(F.lds + GL_QS); const LAS bf16* KH = (const LAS bf16*)(F.lds + GL_KH); const LAS bf16* VT = (const LAS bf16*)(F.lds + GL_VT);
    LAS bf16* SC = (LAS bf16*)(F.lds + GL_SC); LAS float* RS = (LAS float*)(F.lds + GL_RS);
    const int fr = F.lane & 15, fq = F.lane >> 4, tt = F.wave & 3, hi = F.wave >> 2;
    {
        f32x4 a2[2] = {(f32x4){0.f, 0.f, 0.f, 0.f}, (f32x4){0.f, 0.f, 0.f, 0.f}};
#pragma unroll
        for (int ks = 0; ks < KS; ++ks) { const bf16x8 yf = lfrag(QS, LQ, tt * 16 + fr, 32 * ks + 8 * fq);
#pragma unroll
            for (int i = 0; i < 2; ++i) a2[i] = MFMA16(lfrag(KH, LQ, (2 * hi + i) * 16 + fr, 32 * ks + 8 * fq), yf, a2[i]); }
#pragma unroll
        for (int i = 0; i < 2; ++i) { const int t = tt * 16 + fr, s0 = (2 * hi + i) * 16 + 4 * fq; float v[4];
#pragma unroll
            for (int j = 0; j < 4; ++j) v[j] = (s0 + j <= t) ? a2[i][j] : 0.0f;
            u32x2 w; w.x = pk2(v[0], v[1]); w.y = pk2(v[2], v[3]); *(LAS u32x2*)(SC + t * LT + s0) = w; }
    }
    mid();
    lds_barrier();
    f32x4 acc[PER];
#pragma unroll
    for (int i = 0; i < PER; ++i) acc[i] = (f32x4){0.f, 0.f, 0.f, 0.f};
#pragma unroll
    for (int ks = 0; ks < 2; ++ks) { const bf16x8 yf = lfrag(SC, LT, tt * 16 + fr, 32 * ks + 8 * fq);
#pragma unroll
        for (int i = 0; i < PER; ++i) acc[i] = MFMA16(lfrag(VT, LT, (PER * hi + i) * 16 + fr, 32 * ks + 8 * fq), yf, acc[i]); }
#pragma unroll
    for (int ks = 0; ks < KS; ++ks) { const bf16x8 yf = lfrag(QS, LQ, tt * 16 + fr, 32 * ks + 8 * fq);
#pragma unroll
        for (int i = 0; i < PER; ++i) acc[i] = MFMA16(ST_LDS ? lfrag((const LAS bf16*)(F.lds + STO), DK + 8, (PER * hi + i) * 16 + fr, 32 * ks + 8 * fq) : sf[i][ks], yf, acc[i]); }
    mix_out_epilogue<PER, DV>(F, acc, gn, gw, om);
}
constexpr int GD_CW = 119552;
constexpr int GD_RAW = 0, GD_MM = 0, GD_CQ = 26112, GD_XT = 26112, GD_CK = 44544, GD_CV = 61184, GD_QN = 77824, GD_KN = 87040, GD_KDT = 96256, GD_QDL = 105472, GD_PART = 114688, GD_BV = 118784, GD_BK = 119040, GD_GC = 119296;
struct GdRaw { unsigned w[13]; float ga, gb; };
__device__ __forceinline__ void gdn_issue(Frame& F, int b, int n, int h, GdRaw& r) {
    const bf16* z = (const bf16*)(F.ws + WS_R1);
#pragma unroll
    for (int i = 0; i < 13; ++i) { const int idx = F.tid + 512 * i, rr = idx / 96, j = idx - rr * 96, seg = j >> 5, jj = j & 31, ts = n * 64 - 3 + rr;
        unsigned w = 0u; if (idx < 67 * 96 && ts >= 0) w = __builtin_nontemporal_load((const unsigned*)(z + (size_t)(b * SEQ + ts) * NZ + 3072 + seg * 256 + h * 64 + 2 * jj));
        r.w[i] = w; }
    const float* gr = (const float*)(F.ws + WS_GAB) + (size_t)(b * SEQ + n * 64 + F.lane) * 8;
    r.ga = gr[h]; r.gb = gr[4 + h];
}
__device__ __forceinline__ void gdn_stage(Frame& F, const GdRaw& r) {
    LAS unsigned* RAW = (LAS unsigned*)(F.lds + GD_RAW);
#pragma unroll
    for (int i = 0; i < 13; ++i) { const int idx = F.tid + 512 * i, rr = idx / 96, j = idx - rr * 96; if (idx < 67 * 96) RAW[rr * 97 + j] = r.w[i]; }
}
__device__ __forceinline__ void gdn_load_cw(Frame& F, int l, int h) {
    LAS float* CW = (LAS float*)(F.lds + GD_CW); const float* cw = pin(F, I_CONVW) + (size_t)l * 4 * 768;
    for (int i = F.tid; i < 768; i += 512) { const int j = i / 192, rem = i - j * 192, c = rem >> 1, p = rem & 1, seg = c >> 5, jj = c & 31; CW[i] = cw[j * 768 + seg * 256 + h * 64 + 2 * jj + p]; }
}
__device__ __forceinline__ void gdn_m1(Frame& F, int l, int h, int uid, const GdRaw& raw) {
    LAS unsigned* RAW = (LAS unsigned*)(F.lds + GD_RAW); LAS float* MM = (LAS float*)(F.lds + GD_MM);
    LAS float* CQ = (LAS float*)(F.lds + GD_CQ); LAS float* CK = (LAS float*)(F.lds + GD_CK); LAS float* CV = (LAS float*)(F.lds + GD_CV);
    LAS bf16* XT = (LAS bf16*)(F.lds + GD_XT); LAS bf16* QN = (LAS bf16*)(F.lds + GD_QN); LAS bf16* KN = (LAS bf16*)(F.lds + GD_KN);
    LAS bf16* KDT = (LAS bf16*)(F.lds + GD_KDT); LAS bf16* QDL = (LAS bf16*)(F.lds + GD_QDL);
    LAS float* PART = (LAS float*)(F.lds + GD_PART); LAS float* BV = (LAS float*)(F.lds + GD_BV); LAS float* BK = (LAS float*)(F.lds + GD_BK); LAS float* GCL = (LAS float*)(F.lds + GD_GC);
    const int t = F.lane;
    float gc, beta, gl;
    { const float Aexp = __expf(pin(F, I_ALOG)[l * 4 + h]), xa = raw.ga + pin(F, I_DTB)[l * 4 + h], sp = (xa > 20.f) ? xa : log1pf(__expf(xa));
      gc = wave_scan_incl(-Aexp * sp, F.lane); gl = __shfl(gc, 63); beta = sigm(raw.gb); }
    const LAS float* CW = (const LAS float*)(F.lds + GD_CW);
    float pq = 0.f, pk = 0.f;
#pragma unroll 2
    for (int i = 0; i < 12; ++i) { const int c = F.wave * 12 + i, seg = c >> 5, jj = c & 31;
        float u0 = 0.f, u1 = 0.f;
#pragma unroll
        for (int j = 0; j < 4; ++j) { const unsigned w = RAW[(t + j) * 97 + c]; const f32x2 cwv = *(const LAS f32x2*)(CW + (j * 96 + c) * 2); u0 += cwv[0] * bflo(w); u1 += cwv[1] * bfhi(w); }
        const float a0 = siluf(u0), a1 = siluf(u1);
        LAS float* dst = (seg == 0) ? CQ : ((seg == 1) ? CK : CV);
        dst[t * 65 + 2 * jj] = a0; dst[t * 65 + 2 * jj + 1] = a1;
        const float s2 = a0 * a0 + a1 * a1; pq += (seg == 0) ? s2 : 0.f; pk += (seg == 1) ? s2 : 0.f; }
    PART[(F.wave * 2 + 0) * 64 + t] = pq; PART[(F.wave * 2 + 1) * 64 + t] = pk;
    lds_barrier();
    { float sq = 0.f, sk = 0.f;
#pragma unroll
      for (int w = 0; w < 8; ++w) { sq += PART[(w * 2) * 64 + t]; sk += PART[(w * 2 + 1) * 64 + t]; }
      const float rq = rsqrtf(sq + 1e-6f) * 0.125f, rk = rsqrtf(sk + 1e-6f), eg = __expf(gc), ekd = __expf(gl - gc);
      float qn[8], kn[8];
#pragma unroll
      for (int i = 0; i < 8; ++i) { const int d = F.wave * 8 + i; qn[i] = CQ[t * 65 + d] * rq; kn[i] = CK[t * 65 + d] * rk; KDT[d * 72 + t] = (bf16)f2bf(kn[i] * ekd); CK[t * 65 + d] = kn[i]; }
      { u32x4 wq, wk, wd;
        wq.x = pk2(qn[0], qn[1]); wq.y = pk2(qn[2], qn[3]); wq.z = pk2(qn[4], qn[5]); wq.w = pk2(qn[6], qn[7]);
        wk.x = pk2(kn[0], kn[1]); wk.y = pk2(kn[2], kn[3]); wk.z = pk2(kn[4], kn[5]); wk.w = pk2(kn[6], kn[7]);
        wd.x = pk2(qn[0] * eg, qn[1] * eg); wd.y = pk2(qn[2] * eg, qn[3] * eg); wd.z = pk2(qn[4] * eg, qn[5] * eg); wd.w = pk2(qn[6] * eg, qn[7] * eg);
        *(LAS u32x4*)(QN + t * 72 + 8 * F.wave) = wq; *(LAS u32x4*)(KN + t * 72 + 8 * F.wave) = wk; *(LAS u32x4*)(QDL + t * 72 + 8 * F.wave) = wd; }
      if (F.wave == 0) { BV[t] = beta; BK[t] = beta * eg; GCL[t] = gc; } }
    lds_barrier();
    const int fr = F.lane & 15, fq = F.lane >> 4, tt = F.wave & 3, hi = F.wave >> 2;
    {
        const LAS bf16* Y = hi ? QN : KN;
        f32x4 a4[4];
#pragma unroll
        for (int i = 0; i < 4; ++i) a4[i] = (f32x4){0.f, 0.f, 0.f, 0.f};
#pragma unroll
        for (int ks = 0; ks < 2; ++ks) { const bf16x8 yf = lfrag(Y, 72, tt * 16 + fr, 32 * ks + 8 * fq);
#pragma unroll
            for (int i = 0; i < 4; ++i) a4[i] = MFMA16(lfrag(KN, 72, i * 16 + fr, 32 * ks + 8 * fq), yf, a4[i]); }
        const int tr = tt * 16 + fr; const float gct = GCL[tr], bt = BV[tr];
        bf16* gqk = (bf16*)(F.ws + WS_GQK) + (size_t)uid * 4096;
#pragma unroll
        for (int i = 0; i < 4; ++i) { const int s0 = i * 16 + 4 * fq; const f32x4 gs = *(const LAS f32x4*)(GCL + s0); float v[4];
#pragma unroll
            for (int j = 0; j < 4; ++j) { const bool keep = hi ? (s0 + j <= tr) : (s0 + j < tr); v[j] = keep ? a4[i][j] * __expf(gct - gs[j]) * (hi ? 1.0f : bt) : 0.0f; }
            if (hi) { u32x2 w; w.x = pk2(v[0], v[1]); w.y = pk2(v[2], v[3]); *(u32x2*)(gqk + tr * 64 + s0) = w; }
            else *(LAS f32x4*)(MM + tr * 68 + s0) = (f32x4){v[0], v[1], v[2], v[3]}; }
    }
    lds_barrier();
    {
        typedef short s16x4 __attribute__((ext_vector_type(4)));
        LAS bf16* MMb = (LAS bf16*)(F.lds + GD_QN);
        LAS bf16* LINV = (LAS bf16*)(F.lds + GD_PART);
        for (int i = F.tid; i < 128 * 72 / 8; i += 512) *(LAS u32x4*)(XT + 8 * i) = (u32x4){0u, 0u, 0u, 0u};
        { const int r = F.tid >> 3, c8 = F.tid & 7; const f32x4 a = *(const LAS f32x4*)(MM + r * 68 + 8 * c8), b2 = *(const LAS f32x4*)(MM + r * 68 + 8 * c8 + 4);
          u32x4 w; w.x = pk2(a[0], a[1]); w.y = pk2(a[2], a[3]); w.z = pk2(b2[0], b2[1]); w.w = pk2(b2[2], b2[3]); *(LAS u32x4*)(MMb + r * 72 + 8 * c8) = w; }
        if (F.wave < 4) {
            const int bq = F.wave;
            LAS bf16* Rr = (LAS bf16*)(F.lds + GD_KN) + bq * 960; LAS bf16* Cc = Rr + 320; LAS bf16* Pr = Cc + 320;
            f32x4 n4, p4;
#pragma unroll
            for (int j = 0; j < 4; ++j) { n4[j] = -MM[(16 * bq + 4 * fq + j) * 68 + 16 * bq + fr]; p4[j] = n4[j] + ((4 * fq + j == fr) ? 1.0f : 0.0f); }
            { u32x2 w; w.x = pk2(n4[0], n4[1]); w.y = pk2(n4[2], n4[3]); *(LAS u32x2*)(Cc + fr * 20 + 4 * fq) = w; }
#pragma unroll
            for (int j = 0; j < 4; ++j) { Rr[(4 * fq + j) * 20 + fr] = (bf16)f2bf(n4[j]); Pr[(4 * fq + j) * 20 + fr] = (bf16)f2bf(p4[j]); }
#pragma unroll
            for (int s = 0; s < 3; ++s) {
                asm volatile("s_waitcnt lgkmcnt(0)" ::: "memory");
                const s16x4 xr = *(const LAS s16x4*)(Rr + fr * 20 + 4 * fq), yc = *(const LAS s16x4*)(Cc + fr * 20 + 4 * fq);
                const f32x4 a2 = __builtin_amdgcn_mfma_f32_16x16x16bf16_1k(xr, yc, (f32x4){0.f, 0.f, 0.f, 0.f}, 0, 0, 0);
                const s16x4 xp = *(const LAS s16x4*)(Pr + fr * 20 + 4 * fq);
                asm volatile("s_waitcnt lgkmcnt(0)" ::: "memory");
                { u32x2 w; w.x = pk2(a2[0], a2[1]); w.y = pk2(a2[2], a2[3]); *(LAS u32x2*)(Cc + fr * 20 + 4 * fq) = w; }
#pragma unroll
                for (int j = 0; j < 4; ++j) Rr[(4 * fq + j) * 20 + fr] = (bf16)f2bf(a2[j]);
                asm volatile("s_waitcnt lgkmcnt(0)" ::: "memory");
                const s16x4 yc2 = *(const LAS s16x4*)(Cc + fr * 20 + 4 * fq);
                p4 = __builtin_amdgcn_mfma_f32_16x16x16bf16_1k(xp, yc2, p4, 0, 0, 0);
#pragma unroll
                for (int j = 0; j < 4; ++j) Pr[(4 * fq + j) * 20 + fr] = (bf16)f2bf(p4[j]);
            }
#pragma unroll
            for (int j = 0; j < 4; ++j) LINV[bq * 320 + (4 * fq + j) * 20 + fr] = (bf16)f2bf(p4[j]);
        }
        lds_barrier();
        const int cw = 16 * F.wave + fr;
        const LAS float* SRCw = (cw < 64) ? (CV + cw) : (CK + (cw - 64)); const LAS float* COEFw = (cw < 64) ? BV : BK;
#pragma unroll 1
        for (int bt = 0; bt < 4; ++bt) {
            f32x4 acc = (f32x4){0.f, 0.f, 0.f, 0.f};
            if (bt > 0) acc = MFMA16(lfrag(MMb, 72, 16 * bt + fr, 8 * fq), lfrag(XT, 72, cw, 8 * fq), acc);
            if (bt == 3) acc = MFMA16(lfrag(MMb, 72, 16 * bt + fr, 32 + 8 * fq), lfrag(XT, 72, cw, 32 + 8 * fq), acc);
            float y[4];
#pragma unroll
            for (int j = 0; j < 4; ++j) { const int t2 = 16 * bt + 4 * fq + j; y[j] = SRCw[t2 * 65] * COEFw[t2] - acc[j]; }
            u32x2 yw; yw.x = pk2m(y[0], y[1]); yw.y = pk2m(y[2], y[3]);
            const s16x4 li = *(const LAS s16x4*)(LINV + bt * 320 + fr * 20 + 4 * fq);
            const f32x4 x4 = __builtin_amdgcn_mfma_f32_16x16x16bf16_1k(li, __builtin_bit_cast(s16x4, yw), (f32x4){0.f, 0.f, 0.f, 0.f}, 0, 0, 0);
            { u32x2 w; w.x = pk2(x4[0], x4[1]); w.y = pk2(x4[2], x4[3]); *(LAS u32x2*)(XT + cw * 72 + 16 * bt + 4 * fq) = w; }
            lds_barrier();
        }
    }
    {
        const LAS bf16* X = hi ? KDT : (XT + 64 * 72); const LAS bf16* Y = hi ? XT : KDT;
        f32x4 a4[4];
#pragma unroll
        for (int i = 0; i < 4; ++i) a4[i] = (f32x4){0.f, 0.f, 0.f, 0.f};
#pragma unroll
        for (int ks = 0; ks < 2; ++ks) { const bf16x8 yf = lfrag(Y, 72, tt * 16 + fr, 32 * ks + 8 * fq);
#pragma unroll
            for (int i = 0; i < 4; ++i) a4[i] = MFMA16(lfrag(X, 72, i * 16 + fr, 32 * ks + 8 * fq), yf, a4[i]); }
        const int yr = tt * 16 + fr;
        if (hi) { bf16* ut = (bf16*)(F.ws + WS_GUT) + (size_t)uid * 4096 + yr * 64 + fq * 16;
            u32x4 w0, w1; w0.x = pk2(a4[0][0], a4[0][1]); w0.y = pk2(a4[0][2], a4[0][3]); w0.z = pk2(a4[1][0], a4[1][1]); w0.w = pk2(a4[1][2], a4[1][3]);
            w1.x = pk2(a4[2][0], a4[2][1]); w1.y = pk2(a4[2][2], a4[2][3]); w1.z = pk2(a4[3][0], a4[3][1]); w1.w = pk2(a4[3][2], a4[3][3]);
            *(u32x4*)ut = w0; *(u32x4*)(ut + 8) = w1;
            LAS bf16* ul = (LAS bf16*)(F.lds + GD_KN) + yr * 64; *(LAS u32x4*)(ul + (((2 * fq) ^ (yr & 7)) << 3)) = w0; *(LAS u32x4*)(ul + (((2 * fq + 1) ^ (yr & 7)) << 3)) = w1; }
        else { bf16* gt = (bf16*)(F.ws + WS_GT) + (size_t)uid * 4096 + yr * 64; const float last = __expf(gl);
            unsigned pw[4][2];
#pragma unroll
            for (int i = 0; i < 4; ++i) { const int d0 = i * 16 + 4 * fq; float v[4];
#pragma unroll
                for (int j = 0; j < 4; ++j) v[j] = ((d0 + j == yr) ? last : 0.0f) - a4[i][j];
                pw[i][0] = pk2(v[0], v[1]); pw[i][1] = pk2(v[2], v[3]); }
#pragma unroll
            for (int ks = 0; ks < 2; ++ks) { u32x4 w; w.x = pw[2 * ks][0]; w.y = pw[2 * ks][1]; w.z = pw[2 * ks + 1][0]; w.w = pw[2 * ks + 1][1]; *(u32x4*)(gt + ks * 32 + fq * 8) = w;
                *(LAS u32x4*)((LAS bf16*)(F.lds + GD_QN) + yr * 64 + (((ks * 4 + fq) ^ (yr & 7)) << 3)) = w; } }
        { const int tq = F.tid & 63, dg = F.tid >> 6; u32x4 w; unsigned short e8[8];
#pragma unroll
          for (int i = 0; i < 8; ++i) e8[i] = XT[(64 + 8 * dg + i) * 72 + tq];
          w.x = e8[0] | ((unsigned)e8[1] << 16); w.y = e8[2] | ((unsigned)e8[3] << 16); w.z = e8[4] | ((unsigned)e8[5] << 16); w.w = e8[6] | ((unsigned)e8[7] << 16);
          *(u32x4*)((bf16*)(F.ws + WS_GKC) + (size_t)uid * 4096 + tq * 64 + 8 * dg) = w; }
        { const int r = F.tid >> 3, c8 = F.tid & 7;
          *(u32x4*)((bf16*)(F.ws + WS_GWT) + (size_t)uid * 4096 + r * 64 + 8 * c8) = *(const LAS u32x4*)(XT + r * 72 + 8 * c8);
          *(u32x4*)((bf16*)(F.ws + WS_GQD) + (size_t)uid * 4096 + r * 64 + 8 * c8) = *(const LAS u32x4*)(QDL + r * 72 + 8 * c8); }
    }
    lds_barrier();
}
struct GdnStep { u32x4 T[4][2]; u32x4 U[2]; };
__device__ __forceinline__ void gdn_m2_load(GdnStep& s, const bf16* gt, const bf16* ut, int n, int fr, int fq) {
    s.U[0] = *(const u32x4*)(ut + (size_t)n * 4096); s.U[1] = *(const u32x4*)(ut + (size_t)n * 4096 + 8);
#pragma unroll
    for (int i = 0; i < 4; ++i)
#pragma unroll
        for (int ks = 0; ks < 2; ++ks) s.T[i][ks] = *(const u32x4*)(gt + (size_t)n * 4096 + (i * 16 + fr) * 64 + ks * 32 + fq * 8);
}
__device__ __forceinline__ void gdn_step(f32x4 (&S)[4], const GdnStep& st, float us) {
    bf16x8 sf[2];
#pragma unroll
    for (int ks = 0; ks < 2; ++ks) { u32x4 w; w.x = pk2m(S[2 * ks][0], S[2 * ks][1]); w.y = pk2m(S[2 * ks][2], S[2 * ks][3]); w.z = pk2m(S[2 * ks + 1][0], S[2 * ks + 1][1]); w.w = pk2m(S[2 * ks + 1][2], S[2 * ks + 1][3]);
        sf[ks] = __builtin_bit_cast(bf16x8, w); }
#pragma unroll
    for (int i = 0; i < 4; ++i) { const unsigned u0 = (i & 1) ? st.U[i >> 1].z : st.U[i >> 1].x, u1 = (i & 1) ? st.U[i >> 1].w : st.U[i >> 1].y;
        f32x4 a = (f32x4){bflo(u0), bfhi(u0), bflo(u1), bfhi(u1)} * us;
#pragma unroll
        for (int ks = 0; ks < 2; ++ks) a = MFMA16(__builtin_bit_cast(bf16x8, st.T[i][ks]), sf[ks], a);
        S[i] = a; }
}
__device__ __forceinline__ void gdn_m2a(Frame& F, int bh, int seg) {
    const int fr = F.lane & 15, fq = F.lane >> 4, role = F.wave >> 2, c = (F.wave & 3) * 16 + fr;
    const bf16* gt = (const bf16*)(F.ws + WS_GT) + (size_t)(bh * 128 + seg * 8) * 4096;
    const bf16* ut = (const bf16*)(F.ws + WS_GUT) + (size_t)(bh * 128 + seg * 8) * 4096 + c * 64 + 16 * fq;
    const float us = role ? 0.0f : 1.0f;
    f32x4 S[4];
#pragma unroll
    for (int i = 0; i < 4; ++i)
#pragma unroll
        for (int j = 0; j < 4; ++j) S[i][j] = (role && (16 * i + 4 * fq + j == c)) ? 1.0f : 0.0f;
    GdnStep st[4];
#pragma unroll
    for (int r = 0; r < 4; ++r) gdn_m2_load(st[r], gt, ut, r, fr, fq);
    for (int n0 = 0; n0 < 8; n0 += 4) {
#pragma unroll
        for (int r = 0; r < 4; ++r) { const int n = n0 + r; gdn_step(S, st[r], us); gdn_m2_load(st[r], gt, ut, (n + 4 < 8) ? n + 4 : 7, fr, fq); } }
    if (role == 0) { bf16* qg = (bf16*)(F.ws + WS_GQG) + (size_t)(bh * 16 + seg) * 4096 + c * 64 + fq * 16;
        u32x4 w0, w1; w0.x = pk2(S[0][0], S[0][1]); w0.y = pk2(S[0][2], S[0][3]); w0.z = pk2(S[1][0], S[1][1]); w0.w = pk2(S[1][2], S[1][3]);
        w1.x = pk2(S[2][0], S[2][1]); w1.y = pk2(S[2][2], S[2][3]); w1.z = pk2(S[3][0], S[3][1]); w1.w = pk2(S[3][2], S[3][3]);
        *(u32x4*)qg = w0; *(u32x4*)(qg + 8) = w1; }
    else { bf16* pg = (bf16*)(F.ws + WS_GPG) + (size_t)(bh * 16 + seg) * 4096 + (c >> 5) * 32 + ((c & 15) >> 2) * 8 + ((c >> 4) & 1) * 4 + (c & 3);
#pragma unroll
        for (int i = 0; i < 4; ++i)
#pragma unroll
            for (int j = 0; j < 4; ++j) pg[(16 * i + 4 * fq + j) * 64] = (bf16)f2bf(S[i][j]); }
}
__device__ __forceinline__ void gdn_m2b(Frame& F, int bh) {
    const int fr = F.lane & 15, fq = F.lane >> 4, c = (F.wave & 3) * 16 + fr;
    const bf16* pg = (const bf16*)(F.ws + WS_GPG) + (size_t)bh * 16 * 4096;
    const bf16* qg = (const bf16*)(F.ws + WS_GQG) + (size_t)bh * 16 * 4096 + c * 64 + 16 * fq;
    float* ss = (float*)(F.ws + WS_GSS) + (size_t)bh * 16 * 4096 + c * 64 + 4 * fq;
    { u32x4 pv[16]; const int r = F.tid >> 3, sl = F.tid & 7;
#pragma unroll
      for (int g = 0; g < 16; ++g) pv[g] = *(const u32x4*)(pg + (size_t)g * 4096 + r * 64 + ((sl ^ (r & 7)) << 3));
#pragma unroll
      for (int g = 0; g < 16; ++g) *(LAS u32x4*)(F.lds + g * 8192 + F.tid * 16) = pv[g]; }
    u32x4 qv[16][2];
    if (F.wave < 4) {
#pragma unroll
        for (int g = 0; g < 16; ++g) { qv[g][0] = *(const u32x4*)(qg + (size_t)g * 4096); qv[g][1] = *(const u32x4*)(qg + (size_t)g * 4096 + 8); } }
    lds_barrier();
    if (F.wave < 4) {
        f32x4 S[4];
#pragma unroll
        for (int i = 0; i < 4; ++i) S[i] = (f32x4){0.f, 0.f, 0.f, 0.f};
#pragma unroll
        for (int g = 0; g < 16; ++g) {
#pragma unroll
            for (int i = 0; i < 4; ++i) *(f32x4*)(ss + (size_t)g * 4096 + i * 16) = S[i];
            GdnStep st; st.U[0] = qv[g][0]; st.U[1] = qv[g][1];
#pragma unroll
            for (int i = 0; i < 4; ++i)
#pragma unroll
                for (int ks = 0; ks < 2; ++ks) st.T[i][ks] = *(const LAS u32x4*)(F.lds + g * 8192 + (i * 16 + fr) * 128 + (((ks * 4 + fq) ^ (fr & 7)) << 4));
            gdn_step(S, st, 1.0f); } }
    lds_barrier();
}
__device__ __forceinline__ void gdn_compose(Frame& F, f32x4 (&S)[4]) {
    const int fr = F.lane & 15, fq = F.lane >> 4, c = (F.wave & 3) * 16 + fr;
    const LAS bf16* TL = (const LAS bf16*)(F.lds + GD_QN); const LAS bf16* UL = (const LAS bf16*)(F.lds + GD_KN) + c * 64;
    GdnStep st; st.U[0] = *(const LAS u32x4*)(UL + (((2 * fq) ^ (c & 7)) << 3)); st.U[1] = *(const LAS u32x4*)(UL + (((2 * fq + 1) ^ (c & 7)) << 3));
#pragma unroll
    for (int i = 0; i < 4; ++i)
#pragma unroll
        for (int ks = 0; ks < 2; ++ks) st.T[i][ks] = *(const LAS u32x4*)(TL + (i * 16 + fr) * 64 + (((ks * 4 + fq) ^ (fr & 7)) << 3));
    gdn_step(S, st, (F.wave >> 2) ? 0.0f : 1.0f);
}
struct Gd3Raw { u32x4 kc, qk, qd; u32x2 wwv[2]; GdnStep st; };
struct Gd3Gate { u32x2 gw[2]; };
__device__ __forceinline__ void gdn3_gates(Frame& F, int b, int n, int h, Gd3Gate& g) {
    const int fr = F.lane & 15, fq = F.lane >> 4, tt = F.wave & 3, hi = F.wave >> 2;
    const bf16* zg = (const bf16*)(F.ws + WS_R1) + (size_t)(b * SEQ + n * 64) * NZ + 3840 + h * 64;
#pragma unroll
    for (int i = 0; i < 2; ++i) g.gw[i] = __builtin_nontemporal_load((const u32x2*)(zg + (size_t)(tt * 16 + fr) * NZ + (2 * hi + i) * 16 + 4 * fq));
}
__device__ __forceinline__ void gdn3_issue(Frame& F, int b, int n, int h, int uid, Gd3Raw& r) {
    const size_t row0 = (size_t)(b * SEQ + n * 64);
    const int fr = F.lane & 15, fq = F.lane >> 4, tt = F.wave & 3, hi = F.wave >> 2;
    const bf16* zg = (const bf16*)(F.ws + WS_R1) + row0 * NZ + 3840 + h * 64; const bf16* wt = (const bf16*)(F.ws + WS_GWT) + (size_t)uid * 4096 + (tt * 16 + fr) * 64;
    { const int rr = F.tid >> 3, c8 = F.tid & 7; const size_t go = (size_t)uid * 4096 + rr * 64 + 8 * c8;
      r.kc = __builtin_nontemporal_load((const u32x4*)((const bf16*)(F.ws + WS_GKC) + go)); r.qk = __builtin_nontemporal_load((const u32x4*)((const bf16*)(F.ws + WS_GQK) + go)); r.qd = __builtin_nontemporal_load((const u32x4*)((const bf16*)(F.ws + WS_GQD) + go)); }
#pragma unroll
    for (int i = 0; i < 2; ++i) r.wwv[i] = __builtin_nontemporal_load((const u32x2*)(wt + (2 * hi + i) * 16 + 4 * fq));
    gdn_m2_load(r.st, (const bf16*)(F.ws + WS_GT) + (size_t)uid * 4096, (const bf16*)(F.ws + WS_GUT) + (size_t)uid * 4096 + ((F.wave & 3) * 16 + fr) * 64 + 16 * fq, 0, fr, fq);
}
__device__ __forceinline__ void gdn_m3(Frame& F, int l, int b, int n, int h, const Gd3Raw& r, const Gd3Gate& gt_, f32x4 (&S)[4]) {
    LAS bf16* KCL = (LAS bf16*)(F.lds + GL_QS); LAS bf16* QKL = KCL + 64 * 72; LAS bf16* QDL = QKL + 64 * 72; LAS bf16* VNT = QDL + 64 * 72; LAS bf16* STL = VNT + 64 * 72;
    const size_t row0 = (size_t)(b * SEQ + n * 64);
    const int fr = F.lane & 15, fq = F.lane >> 4, tt = F.wave & 3, hi = F.wave >> 2;
    { const int rr = F.tid >> 3, c8 = F.tid & 7;
      *(LAS u32x4*)(KCL + rr * 72 + 8 * c8) = r.kc; *(LAS u32x4*)(QKL + rr * 72 + 8 * c8) = r.qk; *(LAS u32x4*)(QDL + rr * 72 + 8 * c8) = r.qd; }
    if (F.wave < 4) {
#pragma unroll
        for (int i = 0; i < 4; ++i) { u32x2 w; w.x = pk2(S[i][0], S[i][1]); w.y = pk2(S[i][2], S[i][3]); *(LAS u32x2*)(STL + (F.wave * 16 + fr) * 72 + 16 * i + 4 * fq) = w; } }
    u32x2 gw[2], wwv[2];
#pragma unroll
    for (int i = 0; i < 2; ++i) { gw[i] = gt_.gw[i]; wwv[i] = r.wwv[i]; }
    lds_barrier();
    {
        f32x4 a2[2] = {(f32x4){0.f, 0.f, 0.f, 0.f}, (f32x4){0.f, 0.f, 0.f, 0.f}};
#pragma unroll
        for (int ks = 0; ks < 2; ++ks) { const bf16x8 yf = lfrag(STL, 72, tt * 16 + fr, 32 * ks + 8 * fq);
#pragma unroll
            for (int i = 0; i < 2; ++i) a2[i] = MFMA16(lfrag(KCL, 72, (2 * hi + i) * 16 + fr, 32 * ks + 8 * fq), yf, a2[i]); }
        const int e = tt * 16 + fr;
#pragma unroll
        for (int i = 0; i < 2; ++i) { const int t0 = (2 * hi + i) * 16 + 4 * fq; const u32x2 ww = wwv[i];
            u32x2 w; w.x = pk2(bflo(ww.x) - a2[i][0], bfhi(ww.x) - a2[i][1]); w.y = pk2(bflo(ww.y) - a2[i][2], bfhi(ww.y) - a2[i][3]);
            *(LAS u32x2*)(VNT + e * 72 + t0) = w; }
    }
    lds_barrier();
    f32x4 acc[2] = {(f32x4){0.f, 0.f, 0.f, 0.f}, (f32x4){0.f, 0.f, 0.f, 0.f}};
#pragma unroll
    for (int ks = 0; ks < 2; ++ks) { const bf16x8 yf = lfrag(QKL, 72, tt * 16 + fr, 32 * ks + 8 * fq);
#pragma unroll
        for (int i = 0; i < 2; ++i) acc[i] = MFMA16(lfrag(VNT, 72, (2 * hi + i) * 16 + fr, 32 * ks + 8 * fq), yf, acc[i]); }
#pragma unroll
    for (int ks = 0; ks < 2; ++ks) { const bf16x8 yf = lfrag(QDL, 72, tt * 16 + fr, 32 * ks + 8 * fq);
#pragma unroll
        for (int i = 0; i < 2; ++i) acc[i] = MFMA16(lfrag(STL, 72, (2 * hi + i) * 16 + fr, 32 * ks + 8 * fq), yf, acc[i]); }
    mix_out_epilogue<2, 64>(F, acc, (const LAS float*)(F.lds + GL_GNG), gw, (bf16*)(F.ws + WS_OMIX) + row0 * 1024 + 768 + h * 64);
    gdn_step(S, r.st, 1.0f);
}
#define LAUNDER() do { F.lane = F0.lane; asm volatile("" : "+v"(F.lane)); F.tid = F.wave * 64 + F.lane; } while (0)
#define UNIT_IDX(k) const int idx = F.bid + F.G * (k), b = idx >> 9, n = (idx >> 2) & 127, h = idx & 3, uid = ((b * 4 + h) << 7) | n
__device__ __forceinline__ void phase_mix_m1(Frame& F0, int l) {
    Frame F = F0; const int NU = 2048 / F.G;
    if (F.tid < 128) ((LAS float*)(F.lds + GL_LB))[F.tid] = ((const float*)(F.ws + WS_LB))[l * 512 + ((F.bid >> 4) & 3) * 128 + F.tid];
    lds_barrier();
    const int bh = F.bid >> 4, seg = F.bid & 15, b = bh >> 2, h = bh & 3;
    RtRaw rraw; GdRaw graw;
    {
      f32x4 S[8];
#pragma unroll
      for (int i = 0; i < 8; ++i) S[i] = (f32x4){0.f, 0.f, 0.f, 0.f};
      float dseg = 1.0f;
      HgRaw raw; hg_issue<false>(F, b, 8 * seg, h, raw);
      auto hg_chunk = [&](int k, auto next_issue) __attribute__((always_inline)) { LAUNDER();
        const HgRaw cur = raw;
        next_issue(k);
        hg_prep<0>(F, l, h, cur);
        f32x4 kv[8]; hg_kv_acc(F, kv);
        const LAS float* DECL = (const LAS float*)(F.lds + GL_DECL); const int fq = F.lane >> 4;
#pragma unroll
        for (int i = 0; i < 8; ++i) S[i] = S[i] * *(const LAS f32x4*)(DECL + 16 * i + 4 * fq) + kv[i];
        if (F.tid < 128) dseg *= DECL[F.tid];
        lds_barrier(); };
      for (int k = 0; k < 7; ++k) hg_chunk(k, [&](int kk) __attribute__((always_inline)) { hg_issue<false>(F, b, 8 * seg + kk + 1, h, raw); });
      hg_chunk(7, [&](int) __attribute__((always_inline)) { rt_issue<false>(F, b, 8 * seg, h, rraw); });
      { const int fr = F.lane & 15, fq = F.lane >> 4; float* kvg = (float*)(F.ws + WS_HKV) + (size_t)(bh * 16 + seg) * 16384 + (F.wave * 16 + fr) * 128 + 4 * fq;
#pragma unroll
        for (int i = 0; i < 8; ++i) *(f32x4*)(kvg + 16 * i) = S[i];
        if (F.tid < 128) ((float*)(F.ws + WS_HDEC))[(size_t)(bh * 16 + seg) * 128 + F.tid] = dseg; } }
    {
      const float dec = __expf(64.0f * log1pf(-exp2f(-5.0f - (float)h)));
      f32x4 S[2] = {(f32x4){0.f, 0.f, 0.f, 0.f}, (f32x4){0.f, 0.f, 0.f, 0.f}};
      auto rt_chunk = [&](int k, auto next_issue) __attribute__((always_inline)) { LAUNDER();
        rt_stage<false>(F, rraw); lds_barrier();
        next_issue(k);
        rt_prep<0>(F, 8 * seg + k, h);
        f32x4 kv[2]; rt_kv_acc(F, kv);
        S[0] = S[0] * dec + kv[0]; S[1] = S[1] * dec + kv[1];
        lds_barrier(); };
      for (int k = 0; k < 7; ++k) rt_chunk(k, [&](int kk) __attribute__((always_inline)) { rt_issue<false>(F, b, 8 * seg + kk + 1, h, rraw); });
      rt_chunk(7, [&](int) __attribute__((always_inline)) { gdn_issue(F, b, 8 * seg, h, graw); gdn_load_cw(F, l, h); });
      { const int fr = F.lane & 15, fq = F.lane >> 4; float* kvg = (float*)(F.ws + WS_RKV) + (size_t)(bh * 16 + seg) * 4096 + ((F.wave & 3) * 16 + fr) * 64 + (2 * (F.wave >> 2)) * 16 + 4 * fq;
        *(f32x4*)kvg = S[0]; *(f32x4*)(kvg + 16) = S[1]; } }
    {
      f32x4 S[4];
      { const int fr = F.lane & 15, fq = F.lane >> 4, role = F.wave >> 2, c = (F.wave & 3) * 16 + fr;
#pragma unroll
        for (int i = 0; i < 4; ++i)
#pragma unroll
            for (int j = 0; j < 4; ++j) S[i][j] = (role && (16 * i + 4 * fq + j == c)) ? 1.0f : 0.0f; }
      for (int k = 0; k < 8; ++k) { LAUNDER(); const int n = 8 * seg + k;
        gdn_stage(F, graw); const GdRaw cur = graw; lds_barrier();
        if (k + 1 < 8) gdn_issue(F, b, n + 1, h, graw);
        gdn_m1(F, l, h, bh * 128 + n, cur);
        gdn_compose(F, S); }
      { const int fr = F.lane & 15, fq = F.lane >> 4, role = F.wave >> 2, c = (F.wave & 3) * 16 + fr;
        if (role == 0) { bf16* qg = (bf16*)(F.ws + WS_GQG) + (size_t)(bh * 16 + seg) * 4096 + c * 64 + fq * 16;
            u32x4 w0, w1; w0.x = pk2(S[0][0], S[0][1]); w0.y = pk2(S[0][2], S[0][3]); w0.z = pk2(S[1][0], S[1][1]); w0.w = pk2(S[1][2], S[1][3]);
            w1.x = pk2(S[2][0], S[2][1]); w1.y = pk2(S[2][2], S[2][3]); w1.z = pk2(S[3][0], S[3][1]); w1.w = pk2(S[3][2], S[3][3]);
            *(u32x4*)qg = w0; *(u32x4*)(qg + 8) = w1; }
        else { bf16* pg = (bf16*)(F.ws + WS_GPG) + (size_t)(bh * 16 + seg) * 4096 + (c >> 5) * 32 + ((c & 15) >> 2) * 8 + ((c >> 4) & 1) * 4 + (c & 3);
#pragma unroll
            for (int i = 0; i < 4; ++i)
#pragma unroll
                for (int j = 0; j < 4; ++j) pg[(16 * i + 4 * fq + j) * 64] = (bf16)f2bf(S[i][j]); } } }
}
__device__ __forceinline__ void phase_mix_m2a(Frame& F, int l) { gdn_m2a(F, F.bid >> 4, F.bid & 15); }
__device__ __forceinline__ void phase_mix_m2b(Frame& F, int l) {
    if (F.bid < 16) gdn_m2b(F, F.bid);
    else if (F.bid < 144) { const int item = (F.bid - 16) * 512 + F.tid;
        if (item < 65536) { const int bh = item >> 12, e = (item >> 5) & 127, d4 = item & 31;
            const float* kv = (const float*)(F.ws + WS_HKV) + (size_t)bh * 16 * 16384 + e * 128 + d4 * 4;
            const float* dc = (const float*)(F.ws + WS_HDEC) + (size_t)bh * 16 * 128 + d4 * 4;
            float* sp = (float*)(F.ws + WS_HSP) + (size_t)bh * 16 * 16384 + e * 128 + d4 * 4;
            f32x4 S = (f32x4){0.f, 0.f, 0.f, 0.f};
            { f32x4 kb[16], db[16];
#pragma unroll
                for (int u = 0; u < 16; ++u) { kb[u] = *(const f32x4*)(kv + (size_t)u * 16384); db[u] = *(const f32x4*)(dc + u * 128); }
#pragma unroll
                for (int u = 0; u < 16; ++u) { *(f32x4*)(sp + (size_t)u * 16384) = S; S = db[u] * S + kb[u]; } }
        }
    }
    else if (F.bid < 176) { const int item = (F.bid - 144) * 512 + F.tid;
        if (item < 16384) { const int it = item, bh = it >> 10, e = (it >> 4) & 63, d4 = it & 15;
            const float* kv = (const float*)(F.ws + WS_RKV) + (size_t)bh * 16 * 4096 + e * 64 + d4 * 4;
            float* sp = (float*)(F.ws + WS_RSP) + (size_t)bh * 16 * 4096 + e * 64 + d4 * 4;
            const float dec = __expf(512.0f * log1pf(-exp2f(-5.0f - (float)(bh & 3))));
            f32x4 kb[16];
#pragma unroll
            for (int u = 0; u < 16; ++u) kb[u] = *(const f32x4*)(kv + (size_t)u * 4096);
            f32x4 S = (f32x4){0.f, 0.f, 0.f, 0.f};
#pragma unroll
            for (int u = 0; u < 16; ++u) { *(f32x4*)(sp + (size_t)u * 4096) = S; S = S * dec + kb[u]; }
        }
    }
}
__device__ __forceinline__ void phase_mix_m3(Frame& F0, int l) {
    Frame F = F0; const int NU = 2048 / F.G;
    { const int h = (F.bid >> 4) & 3;
      if (F.tid < 128) { ((LAS float*)(F.lds + GL_LB))[F.tid] = ((const float*)(F.ws + WS_LB))[l * 512 + h * 128 + F.tid]; ((LAS float*)(F.lds + GL_GNH))[F.tid] = pin(F, I_HGG)[l * 512 + h * 128 + F.tid]; }
      else if (F.tid < 192) ((LAS float*)(F.lds + GL_GNR))[F.tid - 128] = pin(F, I_RETG)[l * 256 + h * 64 + F.tid - 128];
      else if (F.tid < 256) ((LAS float*)(F.lds + GL_GNG))[F.tid - 192] = pin(F, I_GDNG)[l * 256 + h * 64 + F.tid - 192];
      lds_barrier(); }
    const int bh = F.bid >> 4, seg = F.bid & 15, b = bh >> 2, h = bh & 3;
    f32x4 rS[2]; RtRaw rraw; u32x2 rgw[2]; f32x4 gS[4]; Gd3Raw gring[2]; Gd3Gate ggate[3];
#define RT_GATES(n_) do { const int fr_ = F.lane & 15, fq_ = F.lane >> 4, tt_ = F.wave & 3, hi_ = F.wave >> 2; const bf16* zg_ = (const bf16*)(F.ws + WS_R1) + (size_t)(b * SEQ + (n_) * 64) * NZ + 2816 + h * 64; \
        _Pragma("unroll") for (int i_ = 0; i_ < 2; ++i_) rgw[i_] = __builtin_nontemporal_load((const u32x2*)(zg_ + (size_t)(tt_ * 16 + fr_) * NZ + (2 * hi_ + i_) * 16 + 4 * fq_)); } while (0)
    auto rt_entry = [&]() __attribute__((always_inline)) {
        const int fr = F.lane & 15, fq = F.lane >> 4; const float* sg = (const float*)(F.ws + WS_RSP) + (size_t)(bh * 16 + seg) * 4096 + ((F.wave & 3) * 16 + fr) * 64 + (2 * (F.wave >> 2)) * 16 + 4 * fq;
        rS[0] = *(const f32x4*)sg; rS[1] = *(const f32x4*)(sg + 16);
        rt_issue<true>(F, b, 8 * seg, h, rraw); RT_GATES(8 * seg); };
    auto gd_entry = [&]() __attribute__((always_inline)) {
        const int fr = F.lane & 15, fq = F.lane >> 4; const float* ss = (const float*)(F.ws + WS_GSS) + (size_t)(bh * 16 + seg) * 4096 + ((F.wave & 3) * 16 + fr) * 64 + 4 * fq;
#pragma unroll
        for (int i = 0; i < 4; ++i) gS[i] = *(const f32x4*)(ss + i * 16);
        gdn3_issue(F, b, 8 * seg, h, bh * 128 + 8 * seg, gring[0]); gdn3_gates(F, b, 8 * seg, h, ggate[0]); gdn3_gates(F, b, 8 * seg + 1, h, ggate[1]); };
    {
      f32x4 S[8]; bf16x8 sfd[4][4]; u32x2 gw[4];
      { const int fr = F.lane & 15, fq = F.lane >> 4; const float* sg = (const float*)(F.ws + WS_HSP) + (size_t)(bh * 16 + seg) * 16384 + (F.wave * 16 + fr) * 128 + 4 * fq;
#pragma unroll
        for (int i = 0; i < 8; ++i) S[i] = *(const f32x4*)(sg + 16 * i); }
#define HG_GATES(n_) do { const int fr_ = F.lane & 15, fq_ = F.lane >> 4, tt_ = F.wave & 3, hi_ = F.wave >> 2; const bf16* zg_ = (const bf16*)(F.ws + WS_R1) + (size_t)(b * SEQ + (n_) * 64) * NZ + 1536 + h * 128; \
        _Pragma("unroll") for (int i_ = 0; i_ < 4; ++i_) gw[i_] = __builtin_nontemporal_load((const u32x2*)(zg_ + (size_t)(tt_ * 16 + fr_) * NZ + (4 * hi_ + i_) * 16 + 4 * fq_)); } while (0)
      HgRaw raw; hg_issue<true>(F, b, 8 * seg, h, raw); HG_GATES(8 * seg);
      auto hg_chunk = [&](int k, auto next_issue, auto next_gates) __attribute__((always_inline)) { LAUNDER(); const int n = 8 * seg + k;
        { LAS bf16* STL = (LAS bf16*)(F.lds + GL_STL); const int fr = F.lane & 15, fq = F.lane >> 4;
#pragma unroll
          for (int i = 0; i < 8; ++i) { u32x2 w; w.x = pk2(S[i][0], S[i][1]); w.y = pk2(S[i][2], S[i][3]); *(LAS u32x2*)(STL + (F.wave * 16 + fr) * 136 + 16 * i + 4 * fq) = w; } }
        const HgRaw cur = raw;
        next_issue(n);
        hg_prep<2>(F, l, h, cur);
        gla_m3_mma<128, 128, true, GL_STL>(F, sfd, gw, (const LAS float*)(F.lds + GL_GNH), (bf16*)(F.ws + WS_OMIX) + (size_t)(b * SEQ + n * 64) * 1024 + h * 128, [&]() {});
        next_gates(n);
        { f32x4 kv[8]; hg_kv_acc(F, kv);
          const LAS float* DECL = (const LAS float*)(F.lds + GL_DECL); const int fq = F.lane >> 4;
#pragma unroll
          for (int i = 0; i < 8; ++i) S[i] = S[i] * *(const LAS f32x4*)(DECL + 16 * i + 4 * fq) + kv[i]; }
        lds_barrier(); };
      for (int k = 0; k < 7; ++k) hg_chunk(k, [&](int n) __attribute__((always_inline)) { hg_issue<true>(F, b, n + 1, h, raw); }, [&](int n) __attribute__((always_inline)) { HG_GATES(n + 1); });
      hg_chunk(7, [&](int) __attribute__((always_inline)) { rt_entry(); }, [&](int) __attribute__((always_inline)) {});
#undef HG_GATES
    }
    {
      const float dec = __expf(64.0f * log1pf(-exp2f(-5.0f - (float)h)));
      bf16x8 sfd[2][2];
      auto rt_chunk = [&](int k, auto next_issue, auto next_gates) __attribute__((always_inline)) { LAUNDER(); const int n = 8 * seg + k;
        { LAS bf16* STL = (LAS bf16*)(F.lds + GL_RSTL); const int fr = F.lane & 15, fq = F.lane >> 4;
#pragma unroll
          for (int i = 0; i < 2; ++i) { u32x2 w; w.x = pk2(rS[i][0], rS[i][1]); w.y = pk2(rS[i][2], rS[i][3]); *(LAS u32x2*)(STL + ((F.wave & 3) * 16 + fr) * 72 + (2 * (F.wave >> 2) + i) * 16 + 4 * fq) = w; } }
        rt_stage<true>(F, rraw); lds_barrier();
        next_issue(n);
        rt_prep<2>(F, n, h);
        gla_m3_mma<64, 64, true, GL_RSTL>(F, sfd, rgw, (const LAS float*)(F.lds + GL_GNR), (bf16*)(F.ws + WS_OMIX) + (size_t)(b * SEQ + n * 64) * 1024 + 512 + h * 64, [&]() {});
        next_gates(n);
        { f32x4 kv[2]; rt_kv_acc(F, kv);
          rS[0] = rS[0] * dec + kv[0]; rS[1] = rS[1] * dec + kv[1]; }
        lds_barrier(); };
      for (int k = 0; k < 7; ++k) rt_chunk(k, [&](int n) __attribute__((always_inline)) { rt_issue<true>(F, b, n + 1, h, rraw); }, [&](int n) __attribute__((always_inline)) { RT_GATES(n + 1); });
      rt_chunk(7, [&](int) __attribute__((always_inline)) { gd_entry(); }, [&](int) __attribute__((always_inline)) {});
    }
#undef RT_GATES
    {
#pragma unroll
      for (int k = 0; k < 8; ++k) { LAUNDER(); const int n = 8 * seg + k;
        if (k + 1 < 8) gdn3_issue(F, b, n + 1, h, bh * 128 + n + 1, gring[(k + 1) & 1]);
        if (k + 2 < 8) gdn3_gates(F, b, n + 2, h, ggate[(k + 2) % 3]);
        gdn_m3(F, l, b, n, h, gring[k & 1], ggate[k % 3], gS); } }
}

constexpr int RT_LDW = 520;
constexpr int RT_WH = 0, RT_WL = 32 * RT_LDW * 2, RT_GV = 2 * 32 * RT_LDW * 2, RT_SH = RT_GV + 4096, RT_CB = RT_SH + 4096, RT_CP = RT_CB + 128;
__device__ __forceinline__ void phase_norm2_route(Frame& F, int l) {
    LAS bf16* WH = (LAS bf16*)(F.lds + RT_WH); LAS bf16* WL = (LAS bf16*)(F.lds + RT_WL);
    LAS float* GV = (LAS float*)(F.lds + RT_GV); LAS float* SHV = (LAS float*)(F.lds + RT_SH); LAS float* CB = (LAS float*)(F.lds + RT_CB); LAS float* CP = (LAS float*)(F.lds + RT_CP);
    LAS int* lcnt = (LAS int*)(F.lds + LDS_SM); LAS int* lbase = lcnt + 32; LAS int* le = lcnt + 64; LAS int* ls = le + 512;
    const float* rw = pin(F, I_RW) + (size_t)l * 1024 * 32;
    const float* mod = (const float*)(F.ws + WS_MOD);
    const bf16* xa = (const bf16*)(F.ws + WS_XA);
    int* re = (int*)(F.ws + WS_RE); int* rs = (int*)(F.ws + WS_RS); float* rg = (float*)(F.ws + WS_RG);
    unsigned* cnt = F.ctl + CW_CNT + l * 64;
    for (int rb0 = F.bid; rb0 < NTOK / 128; rb0 += F.G) {
        int ln_ = F.lane; asm volatile("" : "+v"(ln_));
        const int fr = ln_ & 15, fq = ln_ >> 4;
        const int bb = (rb0 * 128) >> 13;
        const float* mp = mod + (size_t)(l * 4 + bb) * 6144;
        const int row = rb0 * 128 + F.wave * 16 + fr;
        bf16x8 xf[32];
#pragma unroll
        for (int ks = 0; ks < 32; ++ks) xf[ks] = *(const bf16x8*)(xa + (size_t)row * 1024 + 32 * ks + 8 * fq);
        if (F.tid < 32) lcnt[F.tid] = 0;
        for (int k = F.tid; k < 1024; k += 512) { GV[k] = pin(F, I_N2G)[l * 1024 + k] * (1.0f + mp[4096 + k]); SHV[k] = mp[3072 + k]; }
        lds_barrier();
        { const int e = F.tid & 31, part = F.tid >> 5; float s = 0.f;
#pragma unroll 8
          for (int k = part * 64; k < part * 64 + 64; ++k) s += SHV[k] * rw[k * 32 + e];
          CP[part * 32 + e] = s; }
        f32x4 acc[2] = {(f32x4){0.f, 0.f, 0.f, 0.f}, (f32x4){0.f, 0.f, 0.f, 0.f}};
#pragma unroll
        for (int hk = 0; hk < 2; ++hk) {
#pragma unroll 4
            for (int idx = F.tid; idx < 512 * 32; idx += 512) { const int k = idx >> 5, e = idx & 31;
                const float w = rw[(size_t)(512 * hk + k) * 32 + e] * GV[512 * hk + k]; const unsigned hb = f2bf(w); const float lo = w - bflo(hb);
                WH[e * RT_LDW + k] = (bf16)hb; WL[e * RT_LDW + k] = (bf16)f2bf(lo); }
            lds_barrier();
#pragma unroll
            for (int ks = 0; ks < 16; ++ks) {
                const bf16x8 y = xf[16 * hk + ks];
#pragma unroll
                for (int n = 0; n < 2; ++n) { acc[n] = MFMA16(lfrag(WH, RT_LDW, 16 * n + fr, 32 * ks + 8 * fq), y, acc[n]); acc[n] = MFMA16(lfrag(WL, RT_LDW, 16 * n + fr, 32 * ks + 8 * fq), y, acc[n]); } }
            lds_barrier();
        }
        if (F.tid < 32) { float s = pin(F, I_RB)[l * 32 + F.tid];
#pragma unroll
            for (int pz = 0; pz < 16; ++pz) s += CP[pz * 32 + F.tid];
            CB[F.tid] = s; }
        float ss = 0.f;
#pragma unroll
        for (int ks = 0; ks < 32; ++ks) { const u32x4 w = __builtin_bit_cast(u32x4, xf[ks]);
            const float a0 = bflo(w.x), a1 = bfhi(w.x), a2 = bflo(w.y), a3 = bfhi(w.y), a4 = bflo(w.z), a5 = bfhi(w.z), a6 = bflo(w.w), a7 = bfhi(w.w);
            ss += ((a0 * a0 + a1 * a1) + (a2 * a2 + a3 * a3)) + ((a4 * a4 + a5 * a5) + (a6 * a6 + a7 * a7)); }
        ss += shx(ss, 16, ln_); ss += shx(ss, 32, ln_);
        const float rinv = rsqrtf(ss * (1.0f / 1024.0f) + NORM_EPS);
        lds_barrier();
        float lg[8];
#pragma unroll
        for (int n = 0; n < 2; ++n)
#pragma unroll
            for (int j = 0; j < 4; ++j) lg[4 * n + j] = acc[n][j] * rinv + CB[16 * n + 4 * fq + j];
        int te[4]; float tv[4];
#pragma unroll
        for (int k = 0; k < 4; ++k) { float best = -3.0e38f; int bi = 0;
#pragma unroll
            for (int i = 0; i < 8; ++i) { const int e = 16 * (i >> 2) + 4 * fq + (i & 3); if (lg[i] > best) { best = lg[i]; bi = e; } }
#pragma unroll
            for (int o = 16; o <= 32; o <<= 1) { const float ob = shx(best, o, ln_); const int oi = shxi(bi, o, ln_); if (ob > best || (ob == best && oi < bi)) { best = ob; bi = oi; } }
#pragma unroll
            for (int i = 0; i < 8; ++i) { const int e = 16 * (i >> 2) + 4 * fq + (i & 3); lg[i] = (e == bi) ? -3.0e38f : lg[i]; }
            te[k] = bi; tv[k] = best; }
        { const float e1 = __expf(tv[1] - tv[0]), e2 = __expf(tv[2] - tv[0]), e3 = __expf(tv[3] - tv[0]), inv = 1.0f / (1.0f + e1 + e2 + e3);
          if (fq == 0) { const int lr = F.wave * 16 + fr;
              *(f32x4*)(rg + (size_t)row * 4) = (f32x4){inv, e1 * inv, e2 * inv, e3 * inv};
#pragma unroll
              for (int k = 0; k < 4; ++k) { le[lr * 4 + k] = te[k]; ls[lr * 4 + k] = atomicAdd((int*)&lcnt[te[k]], 1); } } }
        { unsigned char* hrow = F.ws + WS_HN + (size_t)row * 1024;
#pragma unroll
          for (int ks = 0; ks < 32; ++ks) { u32x4 w = __builtin_bit_cast(u32x4, xf[ks]); asm volatile("" : "+v"(w)); const int k0 = 32 * ks + 8 * fq;
              const f32x4 g0 = *(const LAS f32x4*)(GV + k0), g1 = *(const LAS f32x4*)(GV + k0 + 4), s0 = *(const LAS f32x4*)(SHV + k0), s1 = *(const LAS f32x4*)(SHV + k0 + 4);
              u32x2 o; o.x = pk4_fp8(bflo(w.x) * rinv * g0[0] + s0[0], bfhi(w.x) * rinv * g0[1] + s0[1], bflo(w.y) * rinv * g0[2] + s0[2], bfhi(w.y) * rinv * g0[3] + s0[3]);
              o.y = pk4_fp8(bflo(w.z) * rinv * g1[0] + s1[0], bfhi(w.z) * rinv * g1[1] + s1[1], bflo(w.w) * rinv * g1[2] + s1[2], bfhi(w.w) * rinv * g1[3] + s1[3]);
              *(u32x2*)(hrow + k0) = o; } }
        lds_barrier();
        if (F.tid < 32) lbase[F.tid] = (int)__hip_atomic_fetch_add(cnt + F.tid, (unsigned)lcnt[F.tid], __ATOMIC_RELAXED, __HIP_MEMORY_SCOPE_AGENT);
        lds_barrier();
        { const int i = F.tid, e = le[i], sl = lbase[e] + ls[i]; re[(size_t)rb0 * 512 + i] = e; rs[(size_t)rb0 * 512 + i] = sl; ((int*)(F.ws + WS_TOKE))[e * NTOK + sl] = rb0 * 128 + (i >> 2); }
        lds_barrier();
    }
}

__device__ __forceinline__ void build_rt(Frame& F, int l) {
    LAS int* rt_e = (LAS int*)(F.lds + LDS_RT); LAS int* off = rt_e + 608; LAS int* cn = off + 32;
    if (F.tid < 64) {
        const int e = F.lane, c = (e < 32) ? (int)F.ctl[CW_CNT + l * 64 + e] : 0, t = (c + 255) >> 8;
        const int incl = (int)wave_scan_incl((float)t, F.lane), n0 = incl - t;
        if (e < 32) { off[e] = n0 * 256; cn[e] = c; for (int i = 0; i < t; ++i) rt_e[n0 + i] = e; }
        if (e == 31) rt_e[600] = incl; }
    __syncthreads();
}
__device__ __forceinline__ void phase_gather(Frame& F, int l) {
    build_rt(F, l);
    const LAS int* rt_e = (const LAS int*)(F.lds + LDS_RT); const LAS int* off = rt_e + 608; const LAS int* cn = off + 32;
    const int* re = (const int*)(F.ws + WS_RE); int* rs = (int*)(F.ws + WS_RS); int* tok = (int*)(F.ws + WS_TOK);
    for (int i = F.bid * 512 + F.tid; i < NTOK * 4; i += F.G * 512) { const int pos = off[re[i]] + rs[i]; rs[i] = pos; tok[pos] = i >> 2; }
    for (int e = F.bid; e < 32; e += F.G) { const int c = cn[e], r0 = off[e] + c, r1 = off[e] + ((c + 255) >> 8) * 256;
        for (int r = r0 + F.tid; r < r1; r += 512) tok[r] = 0; }
}

__device__ __forceinline__ void phase_combine(Frame& F, int l) {
    LAS float* w8t = (LAS float*)F.lds;
    LAS float* G2 = (LAS float*)(F.lds + 32768); LAS float* GS = G2 + 1024; LAS float* SH = GS + 1024;
    const float* mod = (const float*)(F.ws + WS_MOD);
    const int gw = F.bid * 8 + F.wave, NGW = F.G * 8, RPW = NTOK / NGW, row0 = gw * RPW, rend = row0 + RPW;
    bf16* xa = (bf16*)(F.ws + WS_XA);
    const int* rs = (const int*)(F.ws + WS_RS); const int* re = (const int*)(F.ws + WS_RE); const float* rg = (const float*)(F.ws + WS_RG);
    const LAS int* offl = (const LAS int*)(F.lds + LDS_RT) + 608;
    const unsigned char* y = F.ws + WS_R1;
    int4 ren2;
    u32x2 vn[4]; int4 posn, posn2; f32x4 ggn, ggn2; unsigned yn[4][4];
    { const u32x2* xr0 = (const u32x2*)(xa + (size_t)row0 * 1024) + F.lane;
#pragma unroll
      for (int j = 0; j < 4; ++j) vn[j] = xr0[64 * j];
      posn = *(const int4*)(rs + (size_t)row0 * 4); ggn = *(const f32x4*)(rg + (size_t)row0 * 4); const int4 ren = *(const int4*)(re + (size_t)row0 * 4);
      { const size_t r2 = (row0 + 1 < rend) ? (size_t)(row0 + 1) : (size_t)row0; posn2 = *(const int4*)(rs + r2 * 4); ggn2 = *(const f32x4*)(rg + r2 * 4); ren2 = *(const int4*)(re + r2 * 4); }
      const int pk0[4] = {offl[ren.x] + posn.x, offl[ren.y] + posn.y, offl[ren.z] + posn.z, offl[ren.w] + posn.w};
#pragma unroll
      for (int k = 0; k < 4; ++k) { const unsigned* yr = (const unsigned*)(y + (size_t)pk0[k] * 1024) + F.lane;
#pragma unroll
          for (int j = 0; j < 4; ++j) yn[k][j] = __builtin_nontemporal_load(yr + 64 * j); } }
    if (l + 1 < DEPTH) load_w8t(F, l + 1, w8t);
    if (F.tid < 256) { const int bb = (F.bid * 8 * RPW) >> 13, col = 4 * F.tid;
        const float* mp = mod + (size_t)(l * 4 + bb) * 6144; const float* mq = mod + (size_t)(((l + 1 < DEPTH) ? l + 1 : l) * 4 + bb) * 6144;
        *(LAS f32x4*)(G2 + col) = *(const f32x4*)(mp + 5120 + col);
        if (l + 1 < DEPTH) { *(LAS f32x4*)(GS + col) = *(const f32x4*)(pin(F, I_N1G) + (l + 1) * 1024 + col) * (*(const f32x4*)(mq + 1024 + col) + 1.0f); *(LAS f32x4*)(SH + col) = *(const f32x4*)(mq + col); }
        else *(LAS f32x4*)(GS + col) = *(const f32x4*)(pin(F, I_FNG) + col); }
    lds_barrier();
#pragma unroll 1
    for (int row = row0; row < rend; ++row) {
        u32x2* xr = (u32x2*)(xa + (size_t)row * 1024) + F.lane;
        int ml = 4 * F.lane; asm volatile("" : "+v"(ml));
        f32x4 v[4], a[4]; unsigned yc[4][4];
#pragma unroll
        for (int j = 0; j < 4; ++j) { v[j] = unpack4(vn[j]); a[j] = (f32x4){0.f, 0.f, 0.f, 0.f}; }
        const f32x4 gg = ggn;
#pragma unroll
        for (int k = 0; k < 4; ++k)
#pragma unroll
            for (int j = 0; j < 4; ++j) yc[k][j] = yn[k][j];
        const bool more = row + 1 < rend;
        if (more) { const u32x2* xr2 = (const u32x2*)(xa + (size_t)(row + 1) * 1024) + F.lane;
#pragma unroll
            for (int j = 0; j < 4; ++j) vn[j] = xr2[64 * j];
            const int pk2_[4] = {offl[ren2.x] + posn2.x, offl[ren2.y] + posn2.y, offl[ren2.z] + posn2.z, offl[ren2.w] + posn2.w};
#pragma unroll
            for (int k = 0; k < 4; ++k) { const unsigned* yr = (const unsigned*)(y + (size_t)pk2_[k] * 1024) + F.lane;
#pragma unroll
                for (int j = 0; j < 4; ++j) yn[k][j] = __builtin_nontemporal_load(yr + 64 * j); }
            ggn = ggn2;
            { const size_t r3 = (row + 2 < rend) ? (size_t)(row + 2) : (size_t)row; posn2 = *(const int4*)(rs + r3 * 4); ggn2 = *(const f32x4*)(rg + r3 * 4); ren2 = *(const int4*)(re + r3 * 4); } }
        const float gk[4] = {gg.x, gg.y, gg.z, gg.w};
#pragma unroll
        for (int k = 0; k < 4; ++k)
#pragma unroll
            for (int j = 0; j < 4; ++j) a[j] += unpack4_fp8(yc[k][j]) * gk[k];
        float ss = 0.f;
#pragma unroll
        for (int j = 0; j < 4; ++j) { v[j] = v[j] + *(const LAS f32x4*)(G2 + 256 * j + ml) * a[j]; ss += (v[j].x * v[j].x + v[j].y * v[j].y) + (v[j].z * v[j].z + v[j].w * v[j].w); }
        const float r = rsqrtf(wave_sum(ss) * (1.0f / 1024.0f) + NORM_EPS);
        if (l + 1 < DEPTH) {
            f32x4 h[4]; bf16* hrow = (bf16*)(F.ws + WS_HN) + (size_t)row * 1024;
#pragma unroll
            for (int j = 0; j < 4; ++j) { u32x2 w; w.x = pk2(v[j].x, v[j].y); w.y = pk2(v[j].z, v[j].w); xr[64 * j] = w;
                h[j] = (v[j] * r) * *(const LAS f32x4*)(GS + 256 * j + ml) + *(const LAS f32x4*)(SH + 256 * j + ml);
                u32x2 w2; w2.x = pk2(h[j].x, h[j].y); w2.y = pk2(h[j].z, h[j].w); *(u32x2*)(hrow + 256 * j + 4 * F.lane) = w2; }
            emit_gab(h, w8t, (float*)(F.ws + WS_GAB) + (size_t)row * 8, F.lane);
        } else {
            f32x4* orow = (f32x4*)(pout(F) + (size_t)row * 1024) + F.lane;
#pragma unroll
            for (int j = 0; j < 4; ++j) orow[64 * j] = (v[j] * r) * *(const LAS f32x4*)(GS + 256 * j + ml);
        }
    }
    __syncthreads();
}

#define PHASE __device__ __forceinline__ void
PHASE ph_prologue(int w0) { Frame F = make_frame(w0); phase0(F); }
PHASE ph_norm1_first(int w0) { Frame F = make_frame(w0); phase_norm1_first(F); }
PHASE ph_gemm_in(int w0, int l_) { Frame F = make_frame(w0); const int l = __builtin_amdgcn_readfirstlane(l_);
    pg8::DenseOrder S; S.init(F.ws + WS_HN, (bf16*)(F.ws + WS_WIN) + (size_t)l * NZ * 1024, NTOK, NZ, F.G, F.bid);
    pg8::EpiZ E{(bf16*)(F.ws + WS_R1), NZ};
    pg8::gemm_phase<pg8::EpiZ, pg8::DenseOrder>(F.lds, S, E, pg8::HSTEP, F.wave0); }
PHASE ph_mix(int w0, int l_) { Frame F = make_frame(w0); const int l = __builtin_amdgcn_readfirstlane(l_); phase_mix_naive(F, l); }
PHASE ph_mix_m1(int w0, int l_) { Frame F = make_frame(w0); const int l = __builtin_amdgcn_readfirstlane(l_); phase_mix_m1(F, l); }
PHASE ph_mix_m2a(int w0, int l_) { Frame F = make_frame(w0); const int l = __builtin_amdgcn_readfirstlane(l_); phase_mix_m2a(F, l); }
PHASE ph_mix_m2b(int w0, int l_) { Frame F = make_frame(w0); const int l = __builtin_amdgcn_readfirstlane(l_); phase_mix_m2b(F, l); }
PHASE ph_mix_m3(int w0, int l_) { Frame F = make_frame(w0); const int l = __builtin_amdgcn_readfirstlane(l_); phase_mix_m3(F, l); }
PHASE ph_gemm_out(int w0, int l_) { Frame F = make_frame(w0); const int l = __builtin_amdgcn_readfirstlane(l_);
    const float* mod = (const float*)(F.ws + WS_MOD);
    pg8::DenseOrder S; S.init(F.ws + WS_OMIX, (bf16*)(F.ws + WS_WOUT) + (size_t)l * 1024 * 1024, NTOK, 1024, F.G, F.bid);
    if (l == 0) { pg8::EpiXres<false> E{(const void*)pin(F, I_X), (bf16*)(F.ws + WS_XA), mod + 2048};
        pg8::gemm_phase<pg8::EpiXres<false>, pg8::DenseOrder>(F.lds, S, E, pg8::HSTEP, F.wave0); }
    else { pg8::EpiXres<true> E{(const void*)(F.ws + WS_XA), (bf16*)(F.ws + WS_XA), mod + (size_t)l * 4 * 6144 + 2048};
        pg8::gemm_phase<pg8::EpiXres<true>, pg8::DenseOrder>(F.lds, S, E, pg8::HSTEP, F.wave0); } }
PHASE ph_route(int w0, int l_) { Frame F = make_frame(w0); const int l = __builtin_amdgcn_readfirstlane(l_); phase_norm2_route(F, l); }
PHASE ph_gather(int w0, int l_) { Frame F = make_frame(w0); const int l = __builtin_amdgcn_readfirstlane(l_); phase_gather(F, l); }
PHASE ph_moe_up(int w0, int l_) { Frame F = make_frame(w0); const int l = __builtin_amdgcn_readfirstlane(l_);
    build_rt(F, l);
    const LAS int* rt_e = (const LAS int*)(F.lds + LDS_RT); const int nrt = __builtin_amdgcn_readfirstlane(rt_e[600]);
    pg8::MoeOrder S; S.A = (const char*)(F.ws + WS_HN); S.gather = true; S.atstep = 0; S.Bt = (const char*)(F.ws + WS_W1 + (size_t)l * 32 * 2048 * 1024); S.nct = 8; S.nrt = nrt; S.ntot = nrt * 8; S.G = F.G; S.c = F.bid;
    S.estride = (size_t)2048 * 1024; S.ctstep = (size_t)128 * 1024; S.rt_e = rt_e;
    pg8::EpiAct E{F.ws + WS_R2, pin(F, I_B1) + (size_t)l * 32 * 2048};
    pg8::gemm_phase<pg8::EpiAct, pg8::MoeOrder, true, true>(F.lds, S, E, (size_t)1024 * 1024, F.wave0, (const int*)(F.ws + WS_TOKE)); }
PHASE ph_moe_down(int w0, int l_) { Frame F = make_frame(w0); const int l = __builtin_amdgcn_readfirstlane(l_);
    const LAS int* rt_e = (const LAS int*)(F.lds + LDS_RT); const int nrt = __builtin_amdgcn_readfirstlane(rt_e[600]);
    pg8::MoeOrder S; S.A = (const char*)(F.ws + WS_R2); S.gather = false; S.atstep = (size_t)256 * 1024; S.Bt = (const char*)(F.ws + WS_W2 + (size_t)l * 32 * 1024 * 1024); S.nct = 4; S.nrt = nrt; S.ntot = nrt * 4; S.G = F.G; S.c = F.bid;
    S.estride = (size_t)1024 * 1024; S.ctstep = (size_t)256 * 1024; S.rt_e = rt_e;
    pg8::EpiY E{F.ws + WS_R1, pin(F, I_B2) + (size_t)l * 32 * 1024};
    pg8::gemm_phase<pg8::EpiY, pg8::MoeOrder, false, true>(F.lds, S, E, (size_t)128 * 1024, F.wave0); }
PHASE ph_combine(int w0, int l_) { Frame F = make_frame(w0); const int l = __builtin_amdgcn_readfirstlane(l_); phase_combine(F, l); }

__global__ void __launch_bounds__(512, 2) fwd(Params p) {
    LAS unsigned char* lds = (LAS unsigned char*)lds_raw;
    const int tid = threadIdx.x;
    for (int u = tid; u < (LDS_BYTES - LDSCTL_OFF) / 4; u += 512) ((LAS unsigned*)(lds + LDSCTL_OFF))[u] = 0u;
    __syncthreads();
    if (tid == 0) {
        LAS unsigned long long* P = (LAS unsigned long long*)(lds + LDS_PAR);
#pragma unroll
        for (int i = 0; i < 22; ++i) P[i] = (unsigned long long)p.in[i];
        P[22] = (unsigned long long)p.out; P[23] = (unsigned long long)p.ws;
    }
    __syncthreads();
    (void)xcd_barrier_post((unsigned*)(p.ws + WS_CTL) + CW_BAR, (volatile LAS unsigned*)(lds + MISC_OFF) + 8);
#define GRID_BAR() do { XcdBarrier b2_; unsigned long long bp_ = ldpar(lds, 23) + WS_CTL + 4ull * CW_BAR; asm volatile("" : "+s"(bp_)); b2_.bar = (unsigned*)(GAS unsigned*)bp_; b2_.x = xb_xcc_id(); b2_.st = (volatile LAS unsigned*)(lds + MISC_OFF) + 8; xcd_barrier(b2_); } while (0)
    const int w0 = __builtin_amdgcn_readfirstlane(tid >> 6);
#ifndef DBL_P0
#define DBL_P0 1
#endif
    for (int r_ = 0; r_ < DBL_P0; ++r_) { ph_prologue(w0); GRID_BAR(); }
    ph_norm1_first(w0); GRID_BAR();
#ifndef DBL_GIN
#define DBL_GIN 1
#endif
#define DBL_M1 1
#define DBL_M2 1
#define DBL_M3 1
#ifndef DBL_MOE
#define DBL_MOE 1
#endif
#define LAYER(l) do { for (int r_ = 0; r_ < DBL_GIN; ++r_) { ph_gemm_in(w0, l); GRID_BAR(); } \
        for (int r_ = 0; r_ < DBL_M1; ++r_) { ph_mix_m1(w0, l); GRID_BAR(); } for (int r_ = 0; r_ < DBL_M2; ++r_) { ph_mix_m2b(w0, l); GRID_BAR(); } for (int r_ = 0; r_ < DBL_M3; ++r_) { ph_mix_m3(w0, l); GRID_BAR(); } \
        ph_gemm_out(w0, l); GRID_BAR(); ph_route(w0, l); GRID_BAR(); \
        for (int r_ = 0; r_ < DBL_MOE; ++r_) { ph_moe_up(w0, l); GRID_BAR(); } for (int r_ = 0; r_ < DBL_MOE; ++r_) { ph_moe_down(w0, l); GRID_BAR(); } ph_combine(w0, l); } while (0)
    LAYER(0); GRID_BAR();
    LAYER(1);
}

extern "C" void kernel_launch(void* const* d_in, const int* in_sizes, int n_in, void* d_out, int out_size, void* d_ws, size_t ws_size, hipStream_t stream) {
    static int grid = 0;
    if (grid == 0) {
        if (n_in != 22 || out_size != NTOK * D || ws_size < WS_END) { fprintf(stderr, "kernel_launch: unexpected shapes (n_in %d out %d ws %zu need %zu)\n", n_in, out_size, ws_size, (size_t)WS_END); grid = -1; return; }
        int dev = 0, cus = 0, per_cu = 0;
        if (hipGetDevice(&dev) != hipSuccess || hipDeviceGetAttribute(&cus, hipDeviceAttributeMultiprocessorCount, dev) != hipSuccess) { grid = -1; return; }
        if (hipFuncSetAttribute((const void*)fwd, hipFuncAttributeMaxDynamicSharedMemorySize, LDS_BYTES) != hipSuccess) { fprintf(stderr, "kernel_launch: hipFuncSetAttribute failed\n"); grid = -1; return; }
        if (hipOccupancyMaxActiveBlocksPerMultiprocessor(&per_cu, (const void*)fwd, 512, LDS_BYTES) != hipSuccess || per_cu < 1) fprintf(stderr, "kernel_launch: occupancy query reports %d\n", per_cu);
        (void)hipGetLastError();
        grid = cus;
    }
    if (grid < 0) return;
    if (hipMemsetAsync((char*)d_ws + WS_CTL, 0, CTL_ZERO_BYTES, stream) != hipSuccess) return;
    Params p{};
    for (int i = 0; i < 22; ++i) p.in[i] = (const float*)d_in[i];
    p.out = (float*)d_out; p.ws = (unsigned char*)d_ws;
    hipLaunchKernelGGL(fwd, dim3(grid), dim3(512), LDS_BYTES, stream, p);
}
```

```cpp
#include <hip/hip_runtime.h>
#include <cstdio>
#include <cstdint>

#define GAS __attribute__((address_space(1)))
#define LAS __attribute__((address_space(3)))
typedef unsigned short bf16;
typedef short bf16x8 __attribute__((ext_vector_type(8)));
typedef float f32x4 __attribute__((ext_vector_type(4)));
typedef float f32x2 __attribute__((ext_vector_type(2)));
typedef unsigned u32x4 __attribute__((ext_vector_type(4)));
typedef unsigned u32x2 __attribute__((ext_vector_type(2)));

constexpr int D = 1024, BATCH = 4, SEQ = 8192, NTOK = BATCH * SEQ, DEPTH = 2;
constexpr int NIN = 4104, NZ = 4096, NE = 32, TOPK = 4, FF = 1024;
constexpr int NROWS_S = NTOK * TOPK + NE * 256;
constexpr float NORM_EPS = 1e-6f;

constexpr size_t MiB = 1u << 20;
constexpr size_t WS_CTL = 0, CTL_ZERO_BYTES = 1 * MiB;
constexpr size_t WS_MOD = 1 * MiB;
constexpr size_t WS_LB = WS_MOD + 256 * 1024;
constexpr size_t WS_ROPE = WS_LB + 8192;
constexpr size_t WS_WIN = 2 * MiB;
constexpr size_t WS_WOUT = WS_WIN + 16 * MiB;
constexpr size_t WS_W1 = WS_WOUT + 4 * MiB;
constexpr size_t WS_W2 = WS_W1 + 256 * MiB;
constexpr size_t WS_XA = WS_W2 + 128 * MiB;
constexpr size_t WS_HN = WS_XA + 128 * MiB;
constexpr size_t WS_OMIX = WS_HN + 64 * MiB;
constexpr size_t WS_GAB = WS_OMIX + 64 * MiB;
constexpr size_t WS_RE = WS_GAB + 1 * MiB;
constexpr size_t WS_RS = WS_RE + 512 * 1024;
constexpr size_t WS_RG = WS_RS + 512 * 1024;
constexpr size_t WS_TOK = WS_RG + 512 * 1024;
constexpr size_t WS_R1 = WS_TOK + 1 * MiB;
constexpr size_t WS_R2 = WS_R1 + 272 * MiB;
constexpr size_t WS_HKV = WS_R2 + 272 * MiB;
constexpr size_t WS_HDEC = WS_HKV + 128 * MiB;
constexpr size_t WS_HSP = WS_HDEC + 1 * MiB;
constexpr size_t WS_RKV = WS_HSP + 64 * MiB;
constexpr size_t WS_RSP = WS_RKV + 32 * MiB;
constexpr size_t WS_GT = WS_RSP + 16 * MiB;
constexpr size_t WS_GUT = WS_GT + 16 * MiB;
constexpr size_t WS_GKC = WS_GUT + 32 * MiB;
constexpr size_t WS_GWT = WS_GKC + 16 * MiB;
constexpr size_t WS_GQK = WS_GWT + 16 * MiB;
constexpr size_t WS_GQD = WS_GQK + 16 * MiB;
constexpr size_t WS_GSP = WS_GQD + 16 * MiB;
constexpr size_t WS_TOKE = WS_GSP;
constexpr size_t WS_GPG = WS_GSP + 16 * MiB;
constexpr size_t WS_GQG = WS_GPG + 2 * MiB;
constexpr size_t WS_GSS = WS_GQG + 2 * MiB;
constexpr size_t WS_END = WS_GSS + 4 * MiB;
constexpr int CW_BAR = 4096;
constexpr int CW_CNT = 16384;

constexpr int RING_BYTES = 131072;
constexpr int LDSCTL_OFF = RING_BYTES, MISC_OFF = LDSCTL_OFF + 320;
constexpr int LDS_RT = LDSCTL_OFF + 1024;
constexpr int LDS_SM = LDSCTL_OFF + 4096;
constexpr int LDS_BYTES = 147456;

#define LDS_WAIT() asm volatile("s_waitcnt lgkmcnt(0)" ::: "memory")
__device__ __forceinline__ void lds_barrier() { asm volatile("s_waitcnt lgkmcnt(0)" ::: "memory"); __builtin_amdgcn_s_barrier(); asm volatile("" ::: "memory"); }
#define VM_WAIT() asm volatile("s_waitcnt vmcnt(0)" ::: "memory")
__device__ __forceinline__ unsigned f2bf(float f) { unsigned u = __builtin_bit_cast(unsigned, f); return (u + 0x7fffu + ((u >> 16) & 1u)) >> 16; }
typedef __bf16 bf16x2_t __attribute__((ext_vector_type(2)));
__device__ __forceinline__ unsigned pk2(float lo, float hi) { return __builtin_bit_cast(unsigned, __builtin_convertvector((f32x2){lo, hi}, bf16x2_t)); }
__device__ __forceinline__ unsigned pk2m(float lo, float hi) { return pk2(lo, hi); }
typedef int i32x8 __attribute__((ext_vector_type(8)));
__device__ __forceinline__ unsigned pk4_fp8(float a, float b, float c, float d) {
    int w = __builtin_amdgcn_cvt_pk_fp8_f32(a, b, 0, false); w = __builtin_amdgcn_cvt_pk_fp8_f32(c, d, w, true); return (unsigned)w; }
constexpr float W8_SCALE = 64.0f, W8_INV = 1.0f / 64.0f;
__device__ __forceinline__ float bf2f(bf16 v) { return __builtin_bit_cast(float, ((unsigned)v) << 16); }
__device__ __forceinline__ float bflo(unsigned w) { return __builtin_bit_cast(float, w << 16); }
__device__ __forceinline__ float bfhi(unsigned w) { return __builtin_bit_cast(float, w & 0xffff0000u); }
#define DPP_ADD(x, ctrl, rmask) x += __builtin_bit_cast(float, __builtin_amdgcn_update_dpp(0, __builtin_bit_cast(int, x), ctrl, rmask, 0xf, false))
__device__ __forceinline__ float wave_scan_incl(float x, int lane) {
    (void)lane;
    DPP_ADD(x, 0x111, 0xf); DPP_ADD(x, 0x112, 0xf); DPP_ADD(x, 0x114, 0xf); DPP_ADD(x, 0x118, 0xf);
    DPP_ADD(x, 0x142, 0xa); DPP_ADD(x, 0x143, 0xc);
    return x;
}
__device__ __forceinline__ float wave_sum(float v) {
    return __builtin_bit_cast(float, __builtin_amdgcn_readlane(__builtin_bit_cast(int, wave_scan_incl(v, 0)), 63));
}
__device__ __forceinline__ float shx(float v, int o, int lane) { return __builtin_bit_cast(float, __builtin_amdgcn_ds_bpermute((lane ^ o) << 2, __builtin_bit_cast(int, v))); }
__device__ __forceinline__ int shxi(int v, int o, int lane) { return __builtin_amdgcn_ds_bpermute((lane ^ o) << 2, v); }
__device__ __forceinline__ float sigm(float x) { return __builtin_amdgcn_rcpf(1.0f + __expf(-x)); }
__device__ __forceinline__ float siluf(float x) { return x * sigm(x); }

#define XB_TMO      128
#define XB_XCNT(j)  (256  + 64 * (j))
#define XB_XSUB(j)  (1280 + 64 * (j))
#define XB_XGEN(j)  (2304 + 64 * (j))
#define XB_TOP      3328
#define XB_TOPGEN   3392
#define XCD_BAR_WORDS 3456
#define XB_SPIN_CAP (1u << 20)

__device__ __forceinline__ unsigned xb_ld(unsigned* p)              { return __hip_atomic_load(p, __ATOMIC_RELAXED, __HIP_MEMORY_SCOPE_AGENT); }
__device__ __forceinline__ unsigned xb_add(unsigned* p, unsigned v) { return __hip_atomic_fetch_add(p, v, __ATOMIC_RELAXED, __HIP_MEMORY_SCOPE_AGENT); }
__device__ __forceinline__ unsigned xb_xcc_id() { return (unsigned)__builtin_amdgcn_s_getreg((3 << 11) | 20) & 0xFu; }
#define XB_SPIN(cond, bar) do { unsigned _sp = 0; while (cond) { __builtin_amdgcn_s_sleep(1); \
    if ((++_sp & 255u) == 0u) { if (xb_ld(&(bar)[XB_TMO])) break; if (_sp > XB_SPIN_CAP) { atomicAdd(&(bar)[XB_TMO], 1u); break; } } } } while (0)

struct XcdBarrier { unsigned* bar; unsigned x; volatile LAS unsigned* st; };

__device__ __forceinline__ XcdBarrier xcd_barrier_post(unsigned* bar, volatile LAS unsigned* st) {
    XcdBarrier b; b.bar = bar; b.x = xb_xcc_id(); b.st = st;
    if (threadIdx.x == 0) (void)xb_add(&bar[XB_XCNT(b.x)], 1u);
    return b;
}
__device__ __forceinline__ void xcd_barrier_complete(unsigned* bar, unsigned x, unsigned& nloc, unsigned& nx) {
    const unsigned G = gridDim.x * gridDim.y * gridDim.z;
    unsigned sum, cnt, mine, sp = 0u;
    for (;;) {
        sum = 0u; cnt = 0u; mine = 0u;
#pragma unroll
        for (unsigned j = 0; j < 16; ++j) { const unsigned c = xb_ld(&bar[XB_XCNT(j)]); sum += c; cnt += (c > 0u) ? 1u : 0u; mine = (j == x) ? c : mine; }
        if (sum == G) break;
        __builtin_amdgcn_s_sleep(1);
        if ((++sp & 255u) == 0u) { if (xb_ld(&bar[XB_TMO])) break; if (sp > XB_SPIN_CAP) { atomicAdd(&bar[XB_TMO], 1u); break; } }
    }
    nloc = mine > 0u ? mine : 1u; nx = cnt > 0u ? cnt : 1u;
}
__device__ __forceinline__ void xcd_barrier(const XcdBarrier& b) {
    asm volatile("s_waitcnt vmcnt(0)" ::: "memory");
    __syncthreads();
    if (threadIdx.x == 0) {
        unsigned* bar = b.bar;
        __builtin_amdgcn_s_waitcnt(0);
        unsigned nloc = b.st[0], nx = b.st[1];
        if (nloc == 0u) { xcd_barrier_complete(bar, b.x, nloc, nx); b.st[0] = nloc; b.st[1] = nx; }
        const unsigned old = xb_add(&bar[XB_XSUB(b.x)], 1u);
        const unsigned gen = old / nloc;
        if (old + 1u == (gen + 1u) * nloc) {
            __builtin_amdgcn_fence(__ATOMIC_RELEASE, "agent");
            asm volatile("s_waitcnt vmcnt(0)" ::: "memory");
            const unsigned og = xb_add(&bar[XB_TOP], 1u);
            const unsigned tg = og / nx;
            if (og + 1u == (tg + 1u) * nx) xb_add(&bar[XB_TOPGEN], 1u);
            else XB_SPIN(xb_ld(&bar[XB_TOPGEN]) == tg, bar);
            __builtin_amdgcn_fence(__ATOMIC_ACQUIRE, "agent");
            xb_add(&bar[XB_XGEN(b.x)], 1u);
            asm volatile("s_waitcnt vmcnt(0)" ::: "memory");
        } else {
            XB_SPIN(xb_ld(&bar[XB_XGEN(b.x)]) == gen, bar);
            __builtin_amdgcn_fence(__ATOMIC_ACQUIRE, "agent");
            asm volatile("s_waitcnt vmcnt(0)" ::: "memory");
        }
    }
    __syncthreads();
}

namespace pg8 {
typedef int i32x4_ __attribute__((ext_vector_type(4)));
constexpr int BM = 256, BK = 64, HALF = 128, HTB = HALF * BK * 2, STAGE_BYTES = 8 * HTB, NXCD = 8, WGM = 4, KD = 1024;
constexpr size_t HSTEP = (size_t)HALF * KD * 2, TSTEP = 2 * HSTEP;
__host__ __device__ __forceinline__ int lds_byte(int r, int c) { const int st = (r >> 4) * 2 + (c >> 5), rr = r & 15, cc = c & 31, ob = rr * 64 + cc * 2; return st * 1024 + (ob ^ (((ob >> 9) & 1) << 5)); }
__host__ __device__ __forceinline__ void stage_rc(int b, int& R, int& C) { const int st = b / 1024, sb = b % 1024, swz = sb ^ (((sb >> 9) & 1) << 5); R = (st >> 1) * 16 + swz / 64; C = (st & 1) * 32 + (swz % 64) / 2; }
__host__ __device__ __forceinline__ int perm32(int rho) { const int n = rho >> 4, i = rho & 15; return 8 * (i >> 2) + 4 * n + (i & 3); }

struct Unit { int pm, pn, e, tb; const char* a; const char* b; };

struct DenseOrder {
    const char* A; const char* Bt; int nM, nN, nwg, G, c;
    __device__ void init(const void* A_, const void* Bt_, int M, int N, int G_, int c_) { A = (const char*)A_; Bt = (const char*)Bt_; nM = M / BM; nN = N / BM; nwg = nM * nN; G = G_; c = c_; }
    __device__ __forceinline__ bool next(int i, Unit& u) const {
        const long L = (long)i * G + c; if (L >= nwg) return false;
        int wgid = (int)L; { const int q = nwg / NXCD, r = nwg % NXCD, xcd = wgid % NXCD, off = wgid / NXCD; wgid = (xcd < r ? xcd * (q + 1) : r * (q + 1) + (xcd - r) * q) + off; }
        const int nig = WGM * nN, gid = wgid / nig, fm = gid * WGM, gsz = (nM - fm) < WGM ? (nM - fm) : WGM;
        u.pm = fm + ((wgid % nig) % gsz); u.pn = (wgid % nig) / gsz; u.e = 0; u.tb = 0;
        u.a = A + (size_t)u.pm * TSTEP; u.b = Bt + (size_t)u.pn * TSTEP; return true;
    }
};
struct MoeOrder {
    const char* A; const char* Bt; int nct, nrt, ntot, G, c; size_t estride, ctstep, atstep; const LAS int* rt_e; bool gather;
    __device__ __forceinline__ bool next(int i, Unit& u) const {
        const int L = i * G + c; if (L >= ntot) return false;
        const int per = 8 * nct, grp = L / per, rem = L % per, fm = grp * 8, gsz = (nrt - fm) < 8 ? (nrt - fm) : 8;
        const int rt = fm + rem % gsz, ct = rem / gsz;
        const int e = __builtin_amdgcn_readfirstlane(rt_e[rt]);
        u.pm = rt; u.pn = ct; u.e = e; u.tb = e * 32768 + rt * 256 - __builtin_amdgcn_readfirstlane(rt_e[608 + e]);
        u.a = gather ? A : A + (size_t)rt * atstep; u.b = Bt + (size_t)e * estride + (size_t)ct * ctstep; return true;
    }
};

template <class Epi, class Sched, bool GATHER = false, bool FP8 = false>
__device__ __forceinline__ void gemm_phase(LAS unsigned char* lds, const Sched& S, const Epi& E, const size_t hstepB, const int wave0, const int* tok = nullptr) {
    int ln_; asm volatile("v_mbcnt_lo_u32_b32 %0, -1, 0\n\tv_mbcnt_hi_u32_b32 %0, -1, %0" : "=v"(ln_));
    int wid_ = wave0; asm volatile("" : "+s"(wid_));
    const int wid = wid_, lane = ln_, tid = wid * 64 + lane, wr = wid >> 2, wc = wid & 3, fr = lane & 15, fq = lane >> 4;
    constexpr int K = KD, ROWB = FP8 ? K : 2 * K, nt = FP8 ? K / 128 : K / BK;
    unsigned voffA[2], voffB[2]; int RA[2];
#pragma unroll
    for (int i = 0; i < 2; ++i) { int R, C; stage_rc(tid * 16 + i * 8192, R, C); const int Rb = Epi::PERM ? ((R & ~31) + perm32(R & 31)) : R;
        voffA[i] = GATHER ? 0u : (unsigned)(R * ROWB + C * 2); voffB[i] = (unsigned)(Rb * ROWB + C * 2); RA[i] = R; }
    unsigned va[2] = {0u, 0u}, vn[2] = {0u, 0u};
#define PG8_GOFF(dst, tb_) do { int t2_; asm volatile("v_mbcnt_lo_u32_b32 %0, -1, 0\n\tv_mbcnt_hi_u32_b32 %0, -1, %0" : "=v"(t2_)); t2_ += wid * 64; int R0_, C0_, R1_, C1_; stage_rc(t2_ * 16, R0_, C0_); stage_rc(t2_ * 16 + 8192, R1_, C1_); \
        _Pragma("unroll") for (int _h = 0; _h < 2; ++_h) dst[_h] = ((unsigned)tok[(tb_) + 128 * _h + R0_] & 32767u) | (((unsigned)tok[(tb_) + 128 * _h + R1_] & 32767u) << 16); } while (0)
#define PG8_GVOFF(p, _i) ({ int t3_; asm volatile("v_mbcnt_lo_u32_b32 %0, -1, 0\n\tv_mbcnt_hi_u32_b32 %0, -1, %0" : "=v"(t3_)); t3_ += wid * 64; int R3_, C3_; stage_rc(t3_ * 16 + (_i) * 8192, R3_, C3_); \
        (int)((((p) >> (16 * (_i))) & 0xffffu) * (unsigned)ROWB + (unsigned)C3_ * 2u); })
    const size_t kstep = (size_t)(BK * 2);
    const size_t hstep = (size_t)HALF * ROWB;
    const unsigned ldsw = (unsigned)wid * 1024u;
    const int aoff = lds_byte(wr * 64 + fr, fq * 8), boff = lds_byte(wc * 32 + fr, fq * 8);
#define PG8_SA(b, h) (((b) * 2 + (h)) * HTB)
#define PG8_SB(b, h) ((4 + (b) * 2 + (h)) * HTB)
    __amdgpu_buffer_rsrc_t rsA = __builtin_amdgcn_make_buffer_rsrc((void*)S.A, 0, 0x7fffffff, 0x00020000), rsB = __builtin_amdgcn_make_buffer_rsrc((void*)S.Bt, 0, 0x7fffffff, 0x00020000);
#define PG8_STAGE_X(bufoff, gbase, voff, RS, BASE) do { if constexpr (FP8) { _Pragma("unroll") for (int _i = 0; _i < 2; ++_i) \
        __builtin_amdgcn_raw_ptr_buffer_load_lds(RS, (LAS void*)(lds + (bufoff) + ldsw + _i * 8192), 16, (int)(voff)[_i], (int)(unsigned)((const char*)(gbase) - (BASE)), 0, 0); } \
        else { _Pragma("unroll") for (int _i = 0; _i < 2; ++_i) \
        __builtin_amdgcn_global_load_lds((const unsigned*)((const char*)(gbase) + (voff)[_i]), (LAS unsigned*)(lds + (bufoff) + ldsw + _i * 8192), 16, 0, 0); } } while (0)
#define PG8_STAGE(bufoff, gbase, voff) PG8_STAGE_X(bufoff, gbase, voff, rsB, S.Bt)
#define PG8_STAGE_A(bufoff, gbase, hh, nx) do { if constexpr (GATHER && FP8) { _Pragma("unroll") for (int _i = 0; _i < 2; ++_i) \
        __builtin_amdgcn_raw_ptr_buffer_load_lds(rsA, (LAS void*)(lds + (bufoff) + ldsw + _i * 8192), 16, PG8_GVOFF((nx) ? vn[hh] : va[hh], _i), (int)(unsigned)((const char*)(gbase) - S.A), 0, 0); } \
        else if constexpr (GATHER) { _Pragma("unroll") for (int _i = 0; _i < 2; ++_i) \
        __builtin_amdgcn_global_load_lds((const unsigned*)((const char*)(gbase) + (unsigned)PG8_GVOFF((nx) ? vn[hh] : va[hh], _i)), (LAS unsigned*)(lds + (bufoff) + ldsw + _i * 8192), 16, 0, 0); } \
        else { PG8_STAGE_X(bufoff, (gbase) + (hh) * hstep, voffA, rsA, S.A); } } while (0)
#define PG8_LDA(dst, b, h) do { if constexpr (FP8) { _Pragma("unroll") for (int m = 0; m < 4; ++m) dst##8[m] = __builtin_shufflevector(*(const LAS i32x4_*)(lds + PG8_SA(b, h) + aoff + m * 2048), *(const LAS i32x4_*)(lds + PG8_SA(b, h) + aoff + m * 2048 + 1024), 0, 1, 2, 3, 4, 5, 6, 7); } \
        else { _Pragma("unroll") for (int m = 0; m < 4; ++m) _Pragma("unroll") for (int k = 0; k < 2; ++k) dst[m][k] = *(const LAS bf16x8*)(lds + PG8_SA(b, h) + aoff + m * 2048 + k * 1024); } } while (0)
#define PG8_LDB(dst, b, h) do { if constexpr (FP8) { _Pragma("unroll") for (int n = 0; n < 2; ++n) dst##8[n] = __builtin_shufflevector(*(const LAS i32x4_*)(lds + PG8_SB(b, h) + boff + n * 2048), *(const LAS i32x4_*)(lds + PG8_SB(b, h) + boff + n * 2048 + 1024), 0, 1, 2, 3, 4, 5, 6, 7); } \
        else { _Pragma("unroll") for (int n = 0; n < 2; ++n) _Pragma("unroll") for (int k = 0; k < 2; ++k) dst[n][k] = *(const LAS bf16x8*)(lds + PG8_SB(b, h) + boff + n * 2048 + k * 1024); } } while (0)
#define PG8_MMA(ai, bj, At, Bt) do { __builtin_amdgcn_s_setprio(1); if constexpr (FP8) { _Pragma("unroll") for (int m = 0; m < 4; ++m) _Pragma("unroll") for (int n = 0; n < 2; ++n) \
        acc[ai][bj][m][n] = __builtin_amdgcn_mfma_scale_f32_16x16x128_f8f6f4(Bt##8[n], At##8[m], acc[ai][bj][m][n], 0, 0, 0, 0, 0, 0); } \
        else { _Pragma("unroll") for (int m = 0; m < 4; ++m) _Pragma("unroll") for (int n = 0; n < 2; ++n) _Pragma("unroll") for (int k = 0; k < 2; ++k) \
        acc[ai][bj][m][n] = __builtin_amdgcn_mfma_f32_16x16x32_bf16(Bt[n][k], At[m][k], acc[ai][bj][m][n], 0, 0, 0); } __builtin_amdgcn_s_setprio(0); } while (0)
#define PG8_WAIT_V(n) asm volatile("s_waitcnt vmcnt(" #n ")" ::: "memory")
#define PG8_WAIT_L(n) asm volatile("s_waitcnt lgkmcnt(" #n ")" ::: "memory")
#define PG8_BAR __builtin_amdgcn_s_barrier()
#define PG8_SCHED __builtin_amdgcn_sched_barrier(0)
    Unit cur, nxt; int ui = 0;
    if (!S.next(0, cur)) return;
    f32x4 acc[2][2][4][2];
    { f32x4 ib[2][2]; E.init(ib, cur, wc, fq);
#pragma unroll
      for (int a = 0; a < 2; ++a)
#pragma unroll
        for (int b = 0; b < 2; ++b)
#pragma unroll
            for (int m = 0; m < 4; ++m)
#pragma unroll
                for (int n = 0; n < 2; ++n) acc[a][b][m][n] = ib[b][n]; }
    bf16x8 At[4][2], B0[2][2], B1[2][2]; i32x8 At8[4], B08[2], B18[2];
    const char* cA = cur.a; const char* cB = cur.b;
    if constexpr (GATHER) { PG8_GOFF(va, cur.tb); }
    PG8_STAGE(PG8_SB(0, 0), cB, voffB); PG8_STAGE(PG8_SB(0, 1), cB + hstepB, voffB); PG8_STAGE_A(PG8_SA(0, 0), cA, 0, false); PG8_STAGE_A(PG8_SA(0, 1), cA, 1, false);
    if (wr == 1) PG8_BAR;
    PG8_WAIT_V(2); PG8_BAR;
    PG8_STAGE(PG8_SB(1, 0), cB + kstep, voffB); PG8_STAGE_A(PG8_SA(1, 0), cA + kstep, 0, false); PG8_STAGE(PG8_SB(1, 1), cB + hstepB + kstep, voffB);
    PG8_WAIT_V(6); PG8_BAR;
    for (;;) {
        const bool has_next = S.next(ui + 1, nxt);
        const char* nA = has_next ? nxt.a : cA; const char* nB = has_next ? nxt.b : cB;
        if constexpr (GATHER) { if (has_next) { PG8_GOFF(vn, nxt.tb); } else { vn[0] = va[0]; vn[1] = va[1]; } }
#pragma unroll 1
        for (int t = 0; t < nt; t += 2) {
            const bool last = (t == nt - 2);
            const char* a1 = cA + (size_t)(t + 1) * kstep;
            const char* a2 = last ? nA : cA + (size_t)(t + 2) * kstep; const char* b2 = last ? nB : cB + (size_t)(t + 2) * kstep;
            const char* a3 = a2 + kstep; const char* b3 = b2 + kstep;
            PG8_LDB(B0, 0, 0); PG8_LDB(B1, 0, 1); PG8_SCHED; PG8_LDA(At, 0, 0); PG8_STAGE_A(PG8_SA(1, 1), a1, 1, false);
            PG8_WAIT_V(8); PG8_WAIT_L(0); PG8_BAR; PG8_MMA(0, 0, At, B0); PG8_MMA(0, 1, At, B1); PG8_BAR; PG8_SCHED;
            PG8_LDA(At, 0, 1); PG8_STAGE(PG8_SB(0, 0), b2, voffB); PG8_STAGE(PG8_SB(0, 1), b2 + hstepB, voffB); PG8_STAGE_A(PG8_SA(0, 0), a2, 0, last);
            PG8_WAIT_V(8); PG8_WAIT_L(0); PG8_BAR; PG8_MMA(1, 0, At, B0); PG8_MMA(1, 1, At, B1); PG8_BAR; PG8_SCHED;
            PG8_LDB(B0, 1, 0); PG8_LDB(B1, 1, 1); PG8_SCHED; PG8_LDA(At, 1, 0); PG8_STAGE_A(PG8_SA(0, 1), a2, 1, last);
            PG8_WAIT_V(8); PG8_WAIT_L(0); PG8_BAR; PG8_MMA(0, 0, At, B0); PG8_MMA(0, 1, At, B1); PG8_BAR; PG8_SCHED;
            PG8_LDA(At, 1, 1); PG8_STAGE(PG8_SB(1, 0), b3, voffB); PG8_STAGE(PG8_SB(1, 1), b3 + hstepB, voffB); PG8_STAGE_A(PG8_SA(1, 0), a3, 0, last);
            PG8_WAIT_V(8); PG8_WAIT_L(0); PG8_BAR; PG8_MMA(1, 0, At, B0); PG8_MMA(1, 1, At, B1); PG8_BAR; PG8_SCHED;
        }
        if (wr == 0) PG8_BAR;
        f32x4 nb[2][2];
        { int l2_; asm volatile("v_mbcnt_lo_u32_b32 %0, -1, 0\n\tv_mbcnt_hi_u32_b32 %0, -1, %0" : "=v"(l2_)); E.init(nb, has_next ? nxt : cur, wc, l2_ >> 4); E(acc, cur, wr, wc, l2_ & 15, l2_ >> 4); }
        if (!has_next) break;
#pragma unroll
        for (int a = 0; a < 2; ++a)
#pragma unroll
            for (int b = 0; b < 2; ++b)
#pragma unroll
                for (int m = 0; m < 4; ++m)
#pragma unroll
                    for (int n = 0; n < 2; ++n) acc[a][b][m][n] = nb[b][n];
        cur = nxt; cA = nA; cB = nB; ++ui;
        if constexpr (GATHER) { va[0] = vn[0]; va[1] = vn[1]; }
        if (wr == 1) PG8_BAR;
    }
    PG8_WAIT_V(0);
    PG8_BAR;
#undef PG8_SA
#undef PG8_SB
#undef PG8_STAGE
#undef PG8_STAGE_X
#undef PG8_STAGE_A
#undef PG8_GOFF
#undef PG8_GVOFF
#undef PG8_LDA
#undef PG8_LDB
#undef PG8_MMA
#undef PG8_WAIT_V
#undef PG8_WAIT_L
#undef PG8_BAR
#undef PG8_SCHED
}

struct EpiZ {
    static constexpr bool PERM = true;
    bf16* O; int ldc;
    __device__ __forceinline__ void init(f32x4 (&ib)[2][2], const Unit&, int, int) const { ib[0][0] = ib[0][1] = ib[1][0] = ib[1][1] = (f32x4){0.f, 0.f, 0.f, 0.f}; }
    __device__ __forceinline__ void operator()(const f32x4 (&acc)[2][2][4][2], const Unit& u, int wr, int wc, int fr, int fq) const {
        const int row0 = u.pm * BM + wr * 64 + fr, col0 = u.pn * BM + wc * 32 + 8 * fq;
#pragma unroll
        for (int ai = 0; ai < 2; ++ai)
#pragma unroll
            for (int m = 0; m < 4; ++m) { bf16* rowp = O + (size_t)(row0 + ai * HALF + m * 16) * ldc + col0;
#pragma unroll
                for (int bj = 0; bj < 2; ++bj) { const f32x4 v0 = acc[ai][bj][m][0], v1 = acc[ai][bj][m][1];
                    u32x4 w; w.x = pk2(v0[0], v0[1]); w.y = pk2(v0[2], v0[3]); w.z = pk2(v1[0], v1[1]); w.w = pk2(v1[2], v1[3]);
                    *(u32x4*)(rowp + bj * HALF) = w; } }
    }
};
template <bool BASE_BF16>
struct EpiXres {
    static constexpr bool PERM = true;
    const void* base; bf16* out; const float* gate;
    __device__ __forceinline__ void init(f32x4 (&ib)[2][2], const Unit&, int, int) const { ib[0][0] = ib[0][1] = ib[1][0] = ib[1][1] = (f32x4){0.f, 0.f, 0.f, 0.f}; }
    __device__ __forceinline__ void operator()(const f32x4 (&acc)[2][2][4][2], const Unit& u, int wr, int wc, int fr, int fq) const {
        const int row0 = u.pm * BM + wr * 64 + fr, col0 = u.pn * BM + wc * 32 + 8 * fq;
        const float* gp = gate + (size_t)((u.pm * BM) >> 13) * 6144 + col0;
        f32x4 gv[2][2];
#pragma unroll
        for (int bj = 0; bj < 2; ++bj)
#pragma unroll
            for (int n = 0; n < 2; ++n) gv[bj][n] = *(const f32x4*)(gp + bj * HALF + 4 * n);
#pragma unroll
        for (int ai = 0; ai < 2; ++ai)
#pragma unroll
            for (int m = 0; m < 4; ++m) { const size_t off = (size_t)(row0 + ai * HALF + m * 16) * 1024 + col0;
#pragma unroll
                for (int bj = 0; bj < 2; ++bj) { f32x4 b0, b1;
                    if constexpr (BASE_BF16) { const u32x4 w = *(const u32x4*)((const bf16*)base + off + bj * HALF); b0 = (f32x4){bflo(w.x), bfhi(w.x), bflo(w.y), bfhi(w.y)}; b1 = (f32x4){bflo(w.z), bfhi(w.z), bflo(w.w), bfhi(w.w)}; }
                    else { b0 = *(const f32x4*)((const float*)base + off + bj * HALF); b1 = *(const f32x4*)((const float*)base + off + bj * HALF + 4); }
                    const f32x4 v0 = b0 + gv[bj][0] * acc[ai][bj][m][0], v1 = b1 + gv[bj][1] * acc[ai][bj][m][1];
                    u32x4 w; w.x = pk2(v0[0], v0[1]); w.y = pk2(v0[2], v0[3]); w.z = pk2(v1[0], v1[1]); w.w = pk2(v1[2], v1[3]);
                    *(u32x4*)(out + off + bj * HALF) = w; } }
    }
};
struct EpiAct {
    static constexpr bool PERM = true;
    unsigned char* O; const float* b1;
    __device__ __forceinline__ void init(f32x4 (&ib)[2][2], const Unit& u, int wc, int fq) const {
        const float* bp = b1 + (size_t)u.e * 2048 + u.pn * HALF + wc * 32 + 8 * fq;
#pragma unroll
        for (int n = 0; n < 2; ++n) { ib[0][n] = *(const f32x4*)(bp + 4 * n) * W8_SCALE; ib[1][n] = *(const f32x4*)(bp + 1024 + 4 * n) * W8_SCALE; } }
    __device__ __forceinline__ void operator()(const f32x4 (&acc)[2][2][4][2], const Unit& u, int wr, int wc, int fr, int fq) const {
        const int row0 = u.pm * BM + wr * 64 + fr, cc0 = u.pn * HALF + wc * 32 + 8 * fq;
#pragma unroll
        for (int ai = 0; ai < 2; ++ai)
#pragma unroll
            for (int m = 0; m < 4; ++m) { unsigned char* rowp = O + (size_t)(row0 + ai * HALF + m * 16) * 1024 + cc0;
                float r[8];
#pragma unroll
                for (int n = 0; n < 2; ++n)
#pragma unroll
                    for (int p = 0; p < 2; ++p) {
                        const f32x2 a2 = (f32x2){acc[ai][0][m][n][2 * p], acc[ai][0][m][n][2 * p + 1]}, c2 = (f32x2){acc[ai][1][m][n][2 * p], acc[ai][1][m][n][2 * p + 1]};
                        f32x2 m2, lc;
                        m2[0] = fminf(a2[0], 448.0f); m2[1] = fminf(a2[1], 448.0f);
                        lc[0] = __builtin_amdgcn_fmed3f(c2[0], -448.0f, 448.0f); lc[1] = __builtin_amdgcn_fmed3f(c2[1], -448.0f, 448.0f);
                        const f32x2 ea = m2 * (-1.702f * 1.4426950408889634f * W8_INV); f32x2 d;
                        d[0] = __builtin_amdgcn_exp2f(ea[0]); d[1] = __builtin_amdgcn_exp2f(ea[1]);
                        d = d + 1.0f; f32x2 rc; rc[0] = __builtin_amdgcn_rcpf(d[0]); rc[1] = __builtin_amdgcn_rcpf(d[1]);
                        const f32x2 o2 = (m2 * rc) * (lc * (W8_INV * W8_INV) + W8_INV);
                        r[4 * n + 2 * p] = o2[0]; r[4 * n + 2 * p + 1] = o2[1]; }
                u32x2 w; w.x = pk4_fp8(r[0], r[1], r[2], r[3]); w.y = pk4_fp8(r[4], r[5], r[6], r[7]);
                __builtin_nontemporal_store(w, (u32x2*)rowp); }
    }
};
struct EpiY {
    static constexpr bool PERM = true;
    unsigned char* O; const float* b2;
    __device__ __forceinline__ void init(f32x4 (&ib)[2][2], const Unit& u, int wc, int fq) const {
        const float* bp = b2 + (size_t)u.e * 1024 + u.pn * BM + wc * 32 + 8 * fq;
#pragma unroll
        for (int bj = 0; bj < 2; ++bj)
#pragma unroll
            for (int n = 0; n < 2; ++n) ib[bj][n] = *(const f32x4*)(bp + bj * HALF + 4 * n) * W8_SCALE; }
    __device__ __forceinline__ void operator()(const f32x4 (&acc)[2][2][4][2], const Unit& u, int wr, int wc, int fr, int fq) const {
        const int row0 = u.pm * BM + wr * 64 + fr, col0 = u.pn * BM + wc * 32 + 8 * fq;
#pragma unroll
        for (int ai = 0; ai < 2; ++ai)
#pragma unroll
            for (int m = 0; m < 4; ++m) { unsigned char* rowp = O + (size_t)(row0 + ai * HALF + m * 16) * 1024 + col0;
#pragma unroll
                for (int bj = 0; bj < 2; ++bj) { const f32x4 v0 = acc[ai][bj][m][0] * W8_INV, v1 = acc[ai][bj][m][1] * W8_INV;
                    u32x2 w; w.x = pk4_fp8(v0[0], v0[1], v0[2], v0[3]); w.y = pk4_fp8(v1[0], v1[1], v1[2], v1[3]);
                    *(u32x2*)(rowp + bj * HALF) = w; } }
    }
};
}

struct Params { const float* in[22]; float* out; unsigned char* ws; };
enum { I_X = 0, I_C, I_ADAW, I_ADAB, I_N1G, I_N2G, I_WIN, I_WOUT, I_LBL, I_HGG, I_RETG, I_CONVW, I_ALOG, I_DTB, I_GDNG, I_RW, I_RB, I_W1, I_B1, I_W2, I_B2, I_FNG };

struct Frame {
    LAS unsigned char* lds;
    int tid, lane, wave, wave0, G, bid;
    unsigned char* ws;
    unsigned* ctl;
};
extern __shared__ __attribute__((aligned(16))) unsigned char lds_raw[];
constexpr int LDS_PAR = LDSCTL_OFF + 512;
__device__ __forceinline__ unsigned long long ldpar(LAS unsigned char* lds, int i) {
    const u32x2 v = *(const LAS u32x2*)(lds + LDS_PAR + 8 * i);
    return ((unsigned long long)(unsigned)__builtin_amdgcn_readfirstlane((int)v.y) << 32) | (unsigned)__builtin_amdgcn_readfirstlane((int)v.x);
}
__device__ __forceinline__ const float* pin(const Frame& F, int i) { return (const float*)(const GAS float*)ldpar(F.lds, i); }
__device__ __forceinline__ float* pout(const Frame& F) { return (float*)(GAS float*)ldpar(F.lds, 22); }
__device__ __forceinline__ int lane_id_opaque() { int ln; asm volatile("v_mbcnt_lo_u32_b32 %0, -1, 0\n\tv_mbcnt_hi_u32_b32 %0, -1, %0" : "=v"(ln)); return ln; }
__device__ __forceinline__ Frame make_frame(int wave0) {
    Frame F; F.lds = (LAS unsigned char*)lds_raw;
    const int ln = lane_id_opaque();
    int w = wave0; asm volatile("" : "+s"(w));
    F.tid = w * 64 + ln; F.lane = ln; F.wave = w; F.wave0 = w;
    int g = gridDim.x, bi = blockIdx.x; asm volatile("" : "+s"(g), "+s"(bi));
    unsigned long long wsp = ldpar(F.lds, 23); asm volatile("" : "+s"(wsp));
    F.G = g; F.bid = bi; F.ws = (unsigned char*)(GAS unsigned char*)wsp; F.ctl = (unsigned*)(F.ws + WS_CTL);
    return F;
}

template <bool F8>
__device__ __forceinline__ void p0_transpose_item(const float* W, int ld, int ncol, void* WTv, LAS float* scr, int item, int lane) {
    const int nblk = ncol / 32, kb = item / nblk, nb = item % nblk, k0 = 64 * kb, n0 = 32 * nb;
    f32x4 v[8];
#pragma unroll
    for (int i = 0; i < 8; ++i) v[i] = __builtin_nontemporal_load((const f32x4*)(W + (size_t)(k0 + 8 * i + (lane >> 3)) * ld + n0 + 4 * (lane & 7)));
#pragma unroll
    for (int i = 0; i < 8; ++i) { LAS float* d = scr + (8 * i + (lane >> 3)) * 33 + 4 * (lane & 7); d[0] = v[i][0]; d[1] = v[i][1]; d[2] = v[i][2]; d[3] = v[i][3]; }
    LDS_WAIT(); asm volatile("" ::: "memory");
    const int c = lane & 7;
#pragma unroll
    for (int j = 0; j < 4; ++j) { const int n = (lane >> 3) + 8 * j; const LAS float* s = scr + (8 * c) * 33 + n;
        if constexpr (F8) { u32x2 o; o.x = pk4_fp8(s[0 * 33] * W8_SCALE, s[1 * 33] * W8_SCALE, s[2 * 33] * W8_SCALE, s[3 * 33] * W8_SCALE); o.y = pk4_fp8(s[4 * 33] * W8_SCALE, s[5 * 33] * W8_SCALE, s[6 * 33] * W8_SCALE, s[7 * 33] * W8_SCALE);
            *(u32x2*)((unsigned char*)WTv + (size_t)(n0 + n) * 1024 + k0 + 8 * c) = o; }
        else { u32x4 o; o.x = pk2(s[0 * 33], s[1 * 33]); o.y = pk2(s[2 * 33], s[3 * 33]); o.z = pk2(s[4 * 33], s[5 * 33]); o.w = pk2(s[6 * 33], s[7 * 33]);
            *(u32x4*)((bf16*)WTv + (size_t)(n0 + n) * 1024 + k0 + 8 * c) = o; } }
    LDS_WAIT(); asm volatile("" ::: "memory");
}
__device__ __forceinline__ void phase0(Frame& F) {
    if (F.bid < 96) {
        LAS float* cs = (LAS float*)(F.lds);
        LAS float* part = (LAS float*)(F.lds + 16384);
        const float* c = pin(F, I_C);
        for (int i = F.tid; i < 4096; i += 512) cs[i] = siluf(c[i]);
        __syncthreads();
        const int cb = F.bid * 128, l = cb / 6144, j0 = cb % 6144;
        const int cg = F.wave & 1, kq = F.wave >> 1, j = j0 + cg * 64 + F.lane;
        const float* aw = pin(F, I_ADAW) + (size_t)l * 1024 * 6144 + j;
        float a0 = 0.f, a1 = 0.f, a2 = 0.f, a3 = 0.f;
#pragma unroll 8
        for (int k = kq * 256; k < kq * 256 + 256; ++k) { const float w = aw[(size_t)k * 6144]; a0 += cs[k] * w; a1 += cs[1024 + k] * w; a2 += cs[2048 + k] * w; a3 += cs[3072 + k] * w; }
        part[(kq * 4 + 0) * 128 + cg * 64 + F.lane] = a0; part[(kq * 4 + 1) * 128 + cg * 64 + F.lane] = a1;
        part[(kq * 4 + 2) * 128 + cg * 64 + F.lane] = a2; part[(kq * 4 + 3) * 128 + cg * 64 + F.lane] = a3;
        __syncthreads();
        { const int b = F.tid >> 7, jj = F.tid & 127;
          const float s = part[(0 * 4 + b) * 128 + jj] + part[(1 * 4 + b) * 128 + jj] + part[(2 * 4 + b) * 128 + jj] + part[(3 * 4 + b) * 128 + jj] + pin(F, I_ADAB)[l * 6144 + j0 + jj];
          ((float*)(F.ws + WS_MOD))[(size_t)(l * 4 + b) * 6144 + j0 + jj] = s; }
        __syncthreads();
    }
    if (F.bid == 96) {
        const float* lg = pin(F, I_LBL); float* lb = (float*)(F.ws + WS_LB);
        { const int i = F.tid; const float l0 = lg[i], l1 = lg[512 + i]; lb[i] = 0.f; lb[512 + i] = fmaxf(1.0f / (1.0f + __expf(l0 - l1)), 0.f); }
    }
    if (F.bid == 97 && F.tid < 32) ((double*)(F.ws + WS_ROPE))[F.tid] = exp(-(double)F.tid / 31.0 * 9.210340371976184) * 0.15915494309189535;
    LAS float* scr = (LAS float*)(F.lds + 32768 + F.wave * 12288);
    const int gw = F.bid * 8 + F.wave, NGW = F.G * 8;
    constexpr int I_IN = 16 * 128, I_OUT = 16 * 32, I_1 = 16 * 64, I_2 = 16 * 32;
    constexpr int N_IN = 2 * I_IN, N_OUT = 2 * I_OUT, N_1 = 64 * I_1, N_2 = 64 * I_2;
    const int NMOD = 96 * 8, NFREE = NGW - NMOD, X = (NGW > NMOD) ? 6 * NFREE : 0, N_TOT = N_IN + N_OUT + N_1 + N_2;
    const int nrounds = (F.bid >= 96 ? 6 : 0) + (N_TOT - X + NGW - 1) / NGW;
    for (int q = 0; q < nrounds; ++q) {
        int it;
        if (F.bid >= 96) it = (q < 6) ? (gw - NMOD) + NFREE * q : X + gw + NGW * (q - 6); else it = X + gw + NGW * q;
        if (it >= N_TOT) break;
        int r = it;
        if (r < N_IN) { const int m = r / I_IN; p0_transpose_item<false>(pin(F, I_WIN) + (size_t)m * 1024 * NIN, NIN, NZ, (bf16*)(F.ws + WS_WIN) + (size_t)m * NZ * 1024, scr, r % I_IN, F.lane); continue; } r -= N_IN;
        if (r < N_OUT) { const int m = r / I_OUT; p0_transpose_item<false>(pin(F, I_WOUT) + (size_t)m * 1024 * 1024, 1024, 1024, (bf16*)(F.ws + WS_WOUT) + (size_t)m * 1024 * 1024, scr, r % I_OUT, F.lane); continue; } r -= N_OUT;
        if (r < N_1) { const int m = r / I_1; p0_transpose_item<true>(pin(F, I_W1) + (size_t)m * 1024 * 2048, 2048, 2048, F.ws + WS_W1 + (size_t)m * 2048 * 1024, scr, r % I_1, F.lane); continue; } r -= N_1;
        { const int m = r / I_2; p0_transpose_item<true>(pin(F, I_W2) + (size_t)m * 1024 * 1024, 1024, 1024, F.ws + WS_W2 + (size_t)m * 1024 * 1024, scr, r % I_2, F.lane); }
    }
}

__device__ __forceinline__ void load_w8t(Frame& F, int l, LAS float* w8t) {
    const float* w = pin(F, I_WIN) + (size_t)l * 1024 * NIN + NZ;
    for (int i = F.tid; i < 8192; i += 512) { const int k = i >> 3, q = i & 7; w8t[q * 1024 + k] = w[(size_t)k * NIN + q]; }
}
__device__ __forceinline__ f32x4 unpack4_fp8(unsigned w) { const f32x2 a = __builtin_amdgcn_cvt_pk_f32_fp8((int)w, false), b = __builtin_amdgcn_cvt_pk_f32_fp8((int)w, true); return (f32x4){a[0], a[1], b[0], b[1]}; }
__device__ __forceinline__ f32x4 unpack4(u32x2 w) { return (f32x4){bflo(w.x), bfhi(w.x), bflo(w.y), bfhi(w.y)}; }
template <bool F8 = false>
__device__ __forceinline__ void norm_mod_emit(const f32x4 (&v)[4], const float* g, const float* sh, const float* sc, void* hrowv, int lane, f32x4 (&h)[4]) {
    float ss = 0.f;
#pragma unroll
    for (int j = 0; j < 4; ++j) ss += (v[j].x * v[j].x + v[j].y * v[j].y) + (v[j].z * v[j].z + v[j].w * v[j].w);
    const float r = rsqrtf(wave_sum(ss) * (1.0f / 1024.0f) + NORM_EPS);
#pragma unroll
    for (int j = 0; j < 4; ++j) { const int col = 256 * j + 4 * lane;
        const f32x4 gg = *(const f32x4*)(g + col), s1 = *(const f32x4*)(sc + col), s0 = *(const f32x4*)(sh + col);
        h[j] = (v[j] * r) * gg * (s1 + 1.0f) + s0;
        if constexpr (F8) *(unsigned*)((unsigned char*)hrowv + col) = pk4_fp8(h[j].x, h[j].y, h[j].z, h[j].w);
        else { u32x2 w; w.x = pk2(h[j].x, h[j].y); w.y = pk2(h[j].z, h[j].w); *(u32x2*)((bf16*)hrowv + col) = w; } }
}
__device__ __forceinline__ void emit_gab(const f32x4 (&h)[4], const LAS float* w8t, float* gabrow, int lane) {
    float a[8];
#pragma unroll
    for (int q = 0; q < 8; ++q) { float s = 0.f;
#pragma unroll
        for (int j = 0; j < 4; ++j) { const f32x4 w = *(const LAS f32x4*)(w8t + q * 1024 + 256 * j + 4 * lane); s += (h[j].x * w.x + h[j].y * w.y) + (h[j].z * w.z + h[j].w * w.w); }
        a[q] = wave_sum(s); }
    if (lane == 0) { *(f32x4*)gabrow = (f32x4){a[0], a[1], a[2], a[3]}; *(f32x4*)(gabrow + 4) = (f32x4){a[4], a[5], a[6], a[7]}; }
}

__device__ __forceinline__ void phase_norm1_first(Frame& F) {
    LAS float* w8t = (LAS float*)F.lds;
    LAS float* GS = (LAS float*)(F.lds + 32768); LAS float* SH = GS + 1024;
    const float* mod = (const float*)(F.ws + WS_MOD);
    const int gw = F.bid * 8 + F.wave, NGW = F.G * 8, RPW = NTOK / NGW, row0 = gw * RPW, rend = row0 + RPW;
    f32x4 vn[4];
    { const f32x4* xr = (const f32x4*)(pin(F, I_X) + (size_t)row0 * 1024) + F.lane;
#pragma unroll
      for (int j = 0; j < 4; ++j) vn[j] = __builtin_nontemporal_load(xr + 64 * j); }
    load_w8t(F, 0, w8t);
    if (F.tid < 256) { const int bb = (F.bid * 8 * RPW) >> 13, col = 4 * F.tid; const float* mp = mod + (size_t)bb * 6144;
        *(LAS f32x4*)(GS + col) = *(const f32x4*)(pin(F, I_N1G) + col) * (*(const f32x4*)(mp + 1024 + col) + 1.0f); *(LAS f32x4*)(SH + col) = *(const f32x4*)(mp + col); }
    lds_barrier();
#pragma unroll 1
    for (int row = row0; row < rend; ++row) {
        int ml = 4 * F.lane; asm volatile("" : "+v"(ml));
        f32x4 v[4], h[4];
#pragma unroll
        for (int j = 0; j < 4; ++j) v[j] = vn[j];
        if (row + 1 < rend) { const f32x4* xr = (const f32x4*)(pin(F, I_X) + (size_t)(row + 1) * 1024) + F.lane;
#pragma unroll
            for (int j = 0; j < 4; ++j) vn[j] = __builtin_nontemporal_load(xr + 64 * j); }
        float ss = 0.f;
#pragma unroll
        for (int j = 0; j < 4; ++j) ss += (v[j].x * v[j].x + v[j].y * v[j].y) + (v[j].z * v[j].z + v[j].w * v[j].w);
        const float r = rsqrtf(wave_sum(ss) * (1.0f / 1024.0f) + NORM_EPS);
        bf16* hrow = (bf16*)(F.ws + WS_HN) + (size_t)row * 1024;
#pragma unroll
        for (int j = 0; j < 4; ++j) { h[j] = (v[j] * r) * *(const LAS f32x4*)(GS + 256 * j + ml) + *(const LAS f32x4*)(SH + 256 * j + ml);
            u32x2 w; w.x = pk2(h[j].x, h[j].y); w.y = pk2(h[j].z, h[j].w); *(u32x2*)(hrow + 256 * j + 4 * F.lane) = w; }
        emit_gab(h, w8t, (float*)(F.ws + WS_GAB) + (size_t)row * 8, F.lane);
    }
    __syncthreads();
}

__device__ __forceinline__ void hgrn_naive(Frame& F, int l, int b, int h) {
    LAS float* Fg = (LAS float*)F.lds;
    LAS float* Kk = Fg + 2048, *Qq = Kk + 2048, *Vv = Qq + 2048, *Gt = Vv + 2048, *Pp = Gt + 2048;
    const bf16* z = (const bf16*)(F.ws + WS_R1);
    const float* lb = (const float*)(F.ws + WS_LB) + l * 512 + h * 128;
    const float* gn = pin(F, I_HGG) + l * 512 + h * 128;
    bf16* om = (bf16*)(F.ws + WS_OMIX);
    const int e = F.tid & 127, dq = F.tid >> 7;
    float S[32];
#pragma unroll
    for (int j = 0; j < 32; ++j) S[j] = 0.f;
    for (int t0 = 0; t0 < SEQ; t0 += 16) {
#pragma unroll
        for (int i = 0; i < 4; ++i) { const int idx = F.tid + 512 * i, tt = idx >> 7, d = idx & 127;
            const bf16* zr = z + (size_t)(b * SEQ + t0 + tt) * NZ + h * 128 + d;
            const float q = bf2f(zr[0]), fl = bf2f(zr[512]), vv = bf2f(zr[1024]), gt = bf2f(zr[1536]);
            const float lbd = lb[d], f = lbd + (1.0f - lbd) * sigm(fl);
            Fg[idx] = f; Kk[idx] = 1.0f - f; Qq[idx] = siluf(q); Vv[idx] = vv; Gt[idx] = siluf(gt); }
        __syncthreads();
        for (int tt = 0; tt < 16; ++tt) { const float vv = Vv[tt * 128 + e]; float acc = 0.f;
#pragma unroll
            for (int j4 = 0; j4 < 8; ++j4) { const int d = tt * 128 + 32 * dq + 4 * j4;
                const f32x4 ff = *(const LAS f32x4*)(Fg + d), kk = *(const LAS f32x4*)(Kk + d), qq = *(const LAS f32x4*)(Qq + d);
#pragma unroll
                for (int i = 0; i < 4; ++i) { S[4 * j4 + i] = ff[i] * S[4 * j4 + i] + kk[i] * vv; acc += S[4 * j4 + i] * qq[i]; }
                if ((j4 & 1) == 1) __builtin_amdgcn_sched_barrier(0); }
            Pp[(dq * 16 + tt) * 128 + e] = acc; }
        __syncthreads();
#pragma unroll
        for (int r = 0; r < 2; ++r) { const int tt = 2 * F.wave + r;
            float o0 = 0.f, o1 = 0.f;
#pragma unroll
            for (int q = 0; q < 4; ++q) { o0 += Pp[(q * 16 + tt) * 128 + F.lane]; o1 += Pp[(q * 16 + tt) * 128 + 64 + F.lane]; }
            const float rr = rsqrtf(wave_sum(o0 * o0 + o1 * o1) * (1.0f / 128.0f) + NORM_EPS);
            bf16* orow = om + (size_t)(b * SEQ + t0 + tt) * 1024 + h * 128;
            orow[F.lane] = (bf16)f2bf(o0 * rr * gn[F.lane] * Gt[tt * 128 + F.lane]);
            orow[64 + F.lane] = (bf16)f2bf(o1 * rr * gn[64 + F.lane] * Gt[tt * 128 + 64 + F.lane]); }
        __syncthreads();
    }
}
__device__ __forceinline__ void ret_naive(Frame& F, int l, int b, int h) {
    LAS float* Kk = (LAS float*)F.lds;
    LAS float* Qq = Kk + 1024, *Vv = Qq + 1024, *Gt = Vv + 1024, *Pp = Gt + 1024;
    const bf16* z = (const bf16*)(F.ws + WS_R1);
    const float* gn = pin(F, I_RETG) + l * 256 + h * 64;
    bf16* om = (bf16*)(F.ws + WS_OMIX);
    const int e = F.tid & 63, dq = F.tid >> 6;
    const float gamma = 1.0f - exp2f(-5.0f - (float)h);
    float S[8];
#pragma unroll
    for (int j = 0; j < 8; ++j) S[j] = 0.f;
    const int ri = F.tid & 31, rtt = F.tid >> 5;
    const double inv_rev = ((const double*)(F.ws + WS_ROPE))[ri];
    for (int t0 = 0; t0 < SEQ; t0 += 16) {
        { const bf16* zr = z + (size_t)(b * SEQ + t0 + rtt) * NZ + 2048 + h * 64 + ri;
          const float q1 = bf2f(zr[0]), q2 = bf2f(zr[32]), k1 = bf2f(zr[256]) * 0.125f, k2 = bf2f(zr[256 + 32]) * 0.125f;
          double rev = (double)(t0 + rtt) * inv_rev; rev -= floor(rev);
          const float ang = (float)rev * 6.283185307179586f; float sn, cs; __sincosf(ang, &sn, &cs);
          Qq[rtt * 64 + ri] = q1 * cs - q2 * sn; Qq[rtt * 64 + 32 + ri] = q1 * sn + q2 * cs;
          Kk[rtt * 64 + ri] = k1 * cs - k2 * sn; Kk[rtt * 64 + 32 + ri] = k1 * sn + k2 * cs; }
#pragma unroll
        for (int i = 0; i < 2; ++i) { const int idx = F.tid + 512 * i, tt = idx >> 6, d = idx & 63;
            const bf16* zr = z + (size_t)(b * SEQ + t0 + tt) * NZ + 2048 + h * 64 + d;
            Vv[idx] = bf2f(zr[512]); Gt[idx] = siluf(bf2f(zr[768])); }
        __syncthreads();
        for (int tt = 0; tt < 16; ++tt) { const float vv = Vv[tt * 64 + e]; float acc = 0.f;
#pragma unroll
            for (int j4 = 0; j4 < 2; ++j4) { const int d = tt * 64 + 8 * dq + 4 * j4;
                const f32x4 kk = *(const LAS f32x4*)(Kk + d), qq = *(const LAS f32x4*)(Qq + d);
#pragma unroll
                for (int i = 0; i < 4; ++i) { S[4 * j4 + i] = gamma * S[4 * j4 + i] + kk[i] * vv; acc += S[4 * j4 + i] * qq[i]; } }
            Pp[(dq * 16 + tt) * 64 + e] = acc; }
        __syncthreads();
#pragma unroll
        for (int r = 0; r < 2; ++r) { const int tt = 2 * F.wave + r;
            float o = 0.f;
#pragma unroll
            for (int q = 0; q < 8; ++q) o += Pp[(q * 16 + tt) * 64 + F.lane];
            const float rr = rsqrtf(wave_sum(o * o) * (1.0f / 64.0f) + NORM_EPS);
            om[(size_t)(b * SEQ + t0 + tt) * 1024 + 512 + h * 64 + F.lane] = (bf16)f2bf(o * rr * gn[F.lane] * Gt[tt * 64 + F.lane]); }
        __syncthreads();
    }
}
__device__ __forceinline__ void gdn_naive(Frame& F, int l, int b, int h) {
    LAS float* Kk = (LAS float*)F.lds;
    LAS float* Qq = Kk + 1024, *Vv = Qq + 1024, *Gt = Vv + 1024, *AB = Gt + 1024;
    const bf16* z = (const bf16*)(F.ws + WS_R1);
    const float* gab = (const float*)(F.ws + WS_GAB);
    const float* gn = pin(F, I_GDNG) + l * 256 + h * 64;
    const float* cw = pin(F, I_CONVW) + (size_t)l * 4 * 768;
    const float Aexp = __expf(pin(F, I_ALOG)[l * 4 + h]), dtb = pin(F, I_DTB)[l * 4 + h];
    bf16* om = (bf16*)(F.ws + WS_OMIX);
    float S[32];
#pragma unroll
    for (int j = 0; j < 32; ++j) S[j] = 0.f;
    const int ge = 32 * (F.wave & 1) + (F.lane & 31), gdh = F.lane >> 5;
    for (int t0 = 0; t0 < SEQ; t0 += 16) {
#pragma unroll
        for (int i = 0; i < 6; ++i) { const int idx = F.tid + 512 * i, tt = idx / 192, rem = idx % 192, which = rem >> 6, d = rem & 63;
            const int ch = which * 256 + h * 64 + d, t = t0 + tt; float u = 0.f;
#pragma unroll
            for (int j = 0; j < 4; ++j) { const int ts = t - 3 + j; if (ts >= 0) u += cw[j * 768 + ch] * bf2f(z[(size_t)(b * SEQ + ts) * NZ + 3072 + ch]); }
            const float a = siluf(u);
            if (which == 0) Qq[tt * 64 + d] = a; else if (which == 1) Kk[tt * 64 + d] = a; else Vv[tt * 64 + d] = a; }
#pragma unroll
        for (int i = 0; i < 2; ++i) { const int idx = F.tid + 512 * i, tt = idx >> 6, d = idx & 63;
            Gt[idx] = siluf(bf2f(z[(size_t)(b * SEQ + t0 + tt) * NZ + 3840 + h * 64 + d])); }
        if (F.tid < 16) { const float* gr = gab + (size_t)(b * SEQ + t0 + F.tid) * 8;
            const float xa = gr[h] + dtb, sp = (xa > 20.f) ? xa : log1pf(__expf(xa));
            AB[F.tid * 2] = __expf(-Aexp * sp); AB[F.tid * 2 + 1] = sigm(gr[4 + h]); }
        __syncthreads();
#pragma unroll
        for (int r = 0; r < 4; ++r) { const int vi = F.wave * 4 + r, tt = vi & 15; LAS float* arr = (vi < 16) ? Qq : Kk;
            const float x = arr[tt * 64 + F.lane]; const float rr = rsqrtf(wave_sum(x * x) + 1e-6f);
            arr[tt * 64 + F.lane] = x * rr * ((vi < 16) ? 0.125f : 1.0f); }
        __syncthreads();
        LAS float* Oo = AB + 64;
        if (F.wave < 2) {
            for (int tt = 0; tt < 16; ++tt) { const float vv = Vv[tt * 64 + ge], al = AB[tt * 2], be = AB[tt * 2 + 1];
                float u = 0.f;
#pragma unroll
                for (int j4 = 0; j4 < 8; ++j4) { const f32x4 kk = *(const LAS f32x4*)(Kk + tt * 64 + 32 * gdh + 4 * j4);
#pragma unroll
                    for (int i = 0; i < 4; ++i) u += S[4 * j4 + i] * kk[i]; }
                u += shx(u, 32, F.lane);
                const float w = be * (vv - al * u); float o = 0.f;
#pragma unroll
                for (int j4 = 0; j4 < 8; ++j4) { const f32x4 kk = *(const LAS f32x4*)(Kk + tt * 64 + 32 * gdh + 4 * j4), qq = *(const LAS f32x4*)(Qq + tt * 64 + 32 * gdh + 4 * j4);
#pragma unroll
                    for (int i = 0; i < 4; ++i) { S[4 * j4 + i] = al * S[4 * j4 + i] + kk[i] * w; o += S[4 * j4 + i] * qq[i]; }
                    if ((j4 & 1) == 1) __builtin_amdgcn_sched_barrier(0); }
                o += shx(o, 32, F.lane);
                if (gdh == 0) Oo[tt * 64 + ge] = o; }
        }
        __syncthreads();
#pragma unroll
        for (int r = 0; r < 2; ++r) { const int tt = 2 * F.wave + r; const float o = Oo[tt * 64 + F.lane];
            const float rr = rsqrtf(wave_sum(o * o) * (1.0f / 64.0f) + NORM_EPS);
            om[(size_t)(b * SEQ + t0 + tt) * 1024 + 768 + h * 64 + F.lane] = (bf16)f2bf(o * rr * gn[F.lane] * Gt[tt * 64 + F.lane]); }
        __syncthreads();
    }
}
__device__ __forceinline__ void phase_mix_naive(Frame& F, int l) {
    if (F.bid < 48) {
        const int u = F.bid, kind = u >> 4, b = (u >> 2) & 3, h = u & 3;
#ifdef NAIVE_HG
        if (kind == 0) hgrn_naive(F, l, b, h);
#endif
#ifdef NAIVE_RT
        if (kind == 1) ret_naive(F, l, b, h);
#endif
#ifndef NO_GD
        if (kind == 2) gdn_naive(F, l, b, h);
#endif
    }
}

#define MFMA16(a, b, c) __builtin_amdgcn_mfma_f32_16x16x32_bf16((a), (b), (c), 0, 0, 0)
__device__ __forceinline__ bf16x8 lfrag(const LAS bf16* base, int ld, int row, int k) { return *(const LAS bf16x8*)(base + row * ld + k); }
__device__ __forceinline__ bf16x8 gfrag(const bf16* base, int ld, int row, int k) { return *(const bf16x8*)(base + (size_t)row * ld + k); }
constexpr int GL_QS = 0, GL_KH = 17408, GL_VT = 34816, GL_SC = 53248, GL_KDT = 62464, GL_RAW = 80896, GL_STL = 84992, GL_DECL = 121600, GL_RS = 122112;

struct HgRaw { unsigned q[8], f[8], v[8]; };
template <bool NEED_Q>
__device__ __forceinline__ void hg_issue(Frame& F, int b, int n, int h, HgRaw& r) {
    const bf16* z = (const bf16*)(F.ws + WS_R1) + (size_t)(b * SEQ + n * 64 + 8 * F.wave) * NZ + h * 128;
#pragma unroll
    for (int i = 0; i < 8; ++i) { const unsigned* zr = (const unsigned*)(z + (size_t)i * NZ) + F.lane;
        r.q[i] = NEED_Q ? __builtin_nontemporal_load(zr) : 0u; r.f[i] = __builtin_nontemporal_load(zr + 256); r.v[i] = __builtin_nontemporal_load(zr + 512); }
}
constexpr int GL_RSTL = 71680;
constexpr int GL_GNH = 122624, GL_GNR = 123136, GL_GNG = 123392, GL_LB = 123648;
constexpr int GL_BP = GL_RAW;
template <int MODE>
__device__ __forceinline__ void hg_prep(Frame& F, int l, int h, const HgRaw& r) {
    constexpr bool m3 = (MODE == 2);
    constexpr int LQ = 136, LT = 72;
    LAS bf16* QS = (LAS bf16*)(F.lds + GL_QS); LAS bf16* KH = (LAS bf16*)(F.lds + GL_KH); LAS bf16* VT = (LAS bf16*)(F.lds + GL_VT); LAS bf16* KDT = (LAS bf16*)(F.lds + GL_KDT);
    LAS float* BP = (LAS float*)(F.lds + GL_BP); LAS float* DECL = (LAS float*)(F.lds + GL_DECL);
    const int j = F.lane, w = F.wave;
    const f32x2 lb2 = *(const LAS f32x2*)(F.lds + GL_LB + 8 * j);
    float kx[2][8], pp[2][8], sx[2][8];
#pragma unroll
    for (int hh = 0; hh < 2; ++hh) { const float om = 1.0f - lb2[hh];
#pragma unroll
        for (int i = 0; i < 8; ++i) { const float fl = hh ? bfhi(r.f[i]) : bflo(r.f[i]); const float k = om * sigm(-fl); kx[hh][i] = k;
            const float f = fmaxf(1.0f - k, 4.0e-18f); pp[hh][i] = (i == 0) ? f : pp[hh][i - 1] * f; }
#pragma unroll
        for (int i = 7; i >= 0; --i) { const float fl = hh ? bfhi(r.f[i]) : bflo(r.f[i]); (void)fl; sx[hh][i] = (i == 7) ? 1.0f : sx[hh][i + 1] * fmaxf(1.0f - kx[hh][i + 1], 4.0e-18f); }
        BP[w * 128 + 2 * j + hh] = pp[hh][7]; }
    { u32x4 v0, v1;
      v0.x = (r.v[0] & 0xffffu) | (r.v[1] << 16); v0.y = (r.v[2] & 0xffffu) | (r.v[3] << 16); v0.z = (r.v[4] & 0xffffu) | (r.v[5] << 16); v0.w = (r.v[6] & 0xffffu) | (r.v[7] << 16);
      v1.x = (r.v[0] >> 16) | (r.v[1] & 0xffff0000u); v1.y = (r.v[2] >> 16) | (r.v[3] & 0xffff0000u); v1.z = (r.v[4] >> 16) | (r.v[5] & 0xffff0000u); v1.w = (r.v[6] >> 16) | (r.v[7] & 0xffff0000u);
      *(LAS u32x4*)(VT + (2 * j) * LT + 8 * w) = v0; *(LAS u32x4*)(VT + (2 * j + 1) * LT + 8 * w) = v1; }
    lds_barrier();
    float pre[2], post[2];
#pragma unroll
    for (int hh = 0; hh < 2; ++hh) { float a = 1.0f, c = 1.0f;
#pragma unroll
        for (int ww = 0; ww < 8; ++ww) { const float bp = BP[ww * 128 + 2 * j + hh]; a *= (ww < w) ? bp : 1.0f; c *= (ww > w) ? bp : 1.0f; }
        pre[hh] = a; post[hh] = c;
        if (w == 7) DECL[2 * j + hh] = a * pp[hh][7]; }
    if (m3) {
#pragma unroll
        for (int i = 0; i < 8; ++i) { float qs[2], kh[2];
#pragma unroll
            for (int hh = 0; hh < 2; ++hh) { const float q = hh ? bfhi(r.q[i]) : bflo(r.q[i]); const float P = pre[hh] * pp[hh][i];
                qs[hh] = siluf(q) * P; kh[hh] = kx[hh][i] * fminf(__builtin_amdgcn_rcpf(P), 5.5e34f); }
            *(LAS unsigned*)(QS + (8 * w + i) * LQ + 2 * j) = pk2(qs[0], qs[1]); *(LAS unsigned*)(KH + (8 * w + i) * LQ + 2 * j) = pk2(kh[0], kh[1]); }
    }
    {
#pragma unroll
        for (int hh = 0; hh < 2; ++hh) { float kd[8];
#pragma unroll
            for (int i = 0; i < 8; ++i) kd[i] = kx[hh][i] * sx[hh][i] * post[hh];
            u32x4 wv; wv.x = pk2(kd[0], kd[1]); wv.y = pk2(kd[2], kd[3]); wv.z = pk2(kd[4], kd[5]); wv.w = pk2(kd[6], kd[7]);
            *(LAS u32x4*)(KDT + (2 * j + hh) * LT + 8 * w) = wv; }
    }
    lds_barrier();
}
struct RtRaw { unsigned q[4], k[4], v[4]; };
template <bool NEED_Q>
__device__ __forceinline__ void rt_issue(Frame& F, int b, int n, int h, RtRaw& r) {
    const bf16* z = (const bf16*)(F.ws + WS_R1) + (size_t)(b * SEQ + n * 64) * NZ + 2048 + h * 64;
#pragma unroll
    for (int i = 0; i < 4; ++i) { const int idx = F.tid + 512 * i, t = idx >> 5, j = idx & 31;
        const unsigned* zr = (const unsigned*)(z + (size_t)t * NZ) + j;
        r.q[i] = NEED_Q ? __builtin_nontemporal_load(zr) : 0u; r.k[i] = __builtin_nontemporal_load(zr + 128); r.v[i] = __builtin_nontemporal_load(zr + 256); }
}
template <bool NEED_Q>
__device__ __forceinline__ void rt_stage(Frame& F, const RtRaw& r) {
    LAS unsigned* RQ = (LAS unsigned*)(F.lds + GL_RAW); LAS unsigned* RK = RQ + 64 * 33; LAS unsigned* RV = RK + 64 * 33;
#pragma unroll
    for (int i = 0; i < 4; ++i) { const int idx = F.tid + 512 * i, t = idx >> 5, j = idx & 31;
        if (NEED_Q) RQ[t * 33 + j] = r.q[i]; RK[t * 33 + j] = r.k[i]; RV[t * 33 + j] = r.v[i]; }
}
template <int MODE>
__device__ __forceinline__ void rt_prep(Frame& F, int n, int h) {
    constexpr bool m3 = (MODE == 2);
    constexpr int LQ = 72, LT = 72;
    LAS bf16* QS = (LAS bf16*)(F.lds + GL_QS); LAS bf16* KH = (LAS bf16*)(F.lds + GL_KH); LAS bf16* VT = (LAS bf16*)(F.lds + GL_VT); LAS bf16* KDT = (LAS bf16*)(F.lds + GL_KDT);
    LAS unsigned* RQ = (LAS unsigned*)(F.lds + GL_RAW); LAS unsigned* RK = RQ + 64 * 33; LAS unsigned* RV = RK + 64 * 33;
    const int t = F.lane;
    const float lg = log1pf(-exp2f(-5.0f - (float)h));
    const float bt = (float)(t + 1) * lg, eq = __expf(bt), ekh = __expf(-bt) * 0.125f, ekd = __expf(64.0f * lg - bt) * 0.125f;
    const double* ropet = (const double*)(F.ws + WS_ROPE);
    const LAS bf16* rq = (const LAS bf16*)RQ; const LAS bf16* rk = (const LAS bf16*)RK; const LAS bf16* rv = (const LAS bf16*)RV;
    float qa4[4], qb4[4], ka4[4], kb4[4];
#pragma unroll
    for (int i = 0; i < 4; ++i) { const int ri = F.wave * 4 + i;
        double rev = (double)(n * 64 + t) * ropet[ri]; rev -= floor(rev);
        float sn, cs; __sincosf((float)rev * 6.283185307179586f, &sn, &cs);
        const float q1 = bf2f(rq[t * 66 + ri]), q2 = bf2f(rq[t * 66 + 32 + ri]), k1 = bf2f(rk[t * 66 + ri]), k2 = bf2f(rk[t * 66 + 32 + ri]);
        const float qa = q1 * cs - q2 * sn, qb = q1 * sn + q2 * cs, ka = k1 * cs - k2 * sn, kb = k1 * sn + k2 * cs;
        qa4[i] = qa * eq; qb4[i] = qb * eq; ka4[i] = ka * ekh; kb4[i] = kb * ekh;
        { KDT[ri * LT + t] = (bf16)f2bf(ka * ekd); KDT[(32 + ri) * LT + t] = (bf16)f2bf(kb * ekd); }
    }
    if (m3) { u32x2 w;
        w.x = pk2(qa4[0], qa4[1]); w.y = pk2(qa4[2], qa4[3]); *(LAS u32x2*)(QS + t * LQ + 4 * F.wave) = w;
        w.x = pk2(qb4[0], qb4[1]); w.y = pk2(qb4[2], qb4[3]); *(LAS u32x2*)(QS + t * LQ + 32 + 4 * F.wave) = w;
        w.x = pk2(ka4[0], ka4[1]); w.y = pk2(ka4[2], ka4[3]); *(LAS u32x2*)(KH + t * LQ + 4 * F.wave) = w;
        w.x = pk2(kb4[0], kb4[1]); w.y = pk2(kb4[2], kb4[3]); *(LAS u32x2*)(KH + t * LQ + 32 + 4 * F.wave) = w; }
#pragma unroll
    for (int i = 0; i < 8; ++i) { const int e = F.wave * 8 + i; VT[e * LT + t] = rv[t * 66 + e]; }
    lds_barrier();
}
template <int DK, int DV>
__device__ __forceinline__ void gla_m1_mma(Frame& F, bf16* kvt  ) {
    constexpr int LT = 72, NXT = DK / 16, NYT = DV / 16, PER = NXT * NYT / 8;
    const LAS bf16* KDT = (const LAS bf16*)(F.lds + GL_KDT); const LAS bf16* VT = (const LAS bf16*)(F.lds + GL_VT);
    const int fr = F.lane & 15, fq = F.lane >> 4;
    const int yt = (NYT == 8) ? F.wave : (F.wave & 3), xt0 = (NYT == 8) ? 0 : 2 * (F.wave >> 2);
    f32x4 acc[PER];
#pragma unroll
    for (int i = 0; i < PER; ++i) acc[i] = (f32x4){0.f, 0.f, 0.f, 0.f};
#pragma unroll
    for (int ks = 0; ks < 2; ++ks) { const bf16x8 yf = lfrag(VT, LT, yt * 16 + fr, 32 * ks + 8 * fq);
#pragma unroll
        for (int i = 0; i < PER; ++i) acc[i] = MFMA16(lfrag(KDT, LT, (xt0 + i) * 16 + fr, 32 * ks + 8 * fq), yf, acc[i]); }
#pragma unroll
    for (int i = 0; i < PER; ++i) { u32x2 w; w.x = pk2(acc[i][0], acc[i][1]); w.y = pk2(acc[i][2], acc[i][3]); *(u32x2*)(kvt + (size_t)(yt * 16 + fr) * DK + (xt0 + i) * 16 + 4 * fq) = w; }
}
__device__ __forceinline__ void hg_kv_acc(Frame& F, f32x4 (&kv)[8]) {
    const LAS bf16* KDT = (const LAS bf16*)(F.lds + GL_KDT); const LAS bf16* VT = (const LAS bf16*)(F.lds + GL_VT);
    const int fr = F.lane & 15, fq = F.lane >> 4;
#pragma unroll
    for (int i = 0; i < 8; ++i) kv[i] = (f32x4){0.f, 0.f, 0.f, 0.f};
#pragma unroll
    for (int ks = 0; ks < 2; ++ks) { const bf16x8 yf = lfrag(VT, 72, F.wave * 16 + fr, 32 * ks + 8 * fq);
#pragma unroll
        for (int i = 0; i < 8; ++i) kv[i] = MFMA16(lfrag(KDT, 72, i * 16 + fr, 32 * ks + 8 * fq), yf, kv[i]); }
}
__device__ __forceinline__ void rt_kv_acc(Frame& F, f32x4 (&kv)[2]) {
    const LAS bf16* KDT = (const LAS bf16*)(F.lds + GL_KDT); const LAS bf16* VT = (const LAS bf16*)(F.lds + GL_VT);
    const int fr = F.lane & 15, fq = F.lane >> 4, yt = F.wave & 3, xt0 = 2 * (F.wave >> 2);
    kv[0] = (f32x4){0.f, 0.f, 0.f, 0.f}; kv[1] = (f32x4){0.f, 0.f, 0.f, 0.f};
#pragma unroll
    for (int ks = 0; ks < 2; ++ks) { const bf16x8 yf = lfrag(VT, 72, yt * 16 + fr, 32 * ks + 8 * fq);
#pragma unroll
        for (int i = 0; i < 2; ++i) kv[i] = MFMA16(lfrag(KDT, 72, (xt0 + i) * 16 + fr, 32 * ks + 8 * fq), yf, kv[i]); }
}
template <int PER, int DV>
__device__ __forceinline__ void mix_out_epilogue(Frame& F, const f32x4 (&acc)[PER], const LAS float* gn, const u32x2 (&gwv)[PER], bf16* om) {
    LAS float* RS = (LAS float*)(F.lds + GL_RS);
    const int fr = F.lane & 15, fq = F.lane >> 4, tt = F.wave & 3, hi = F.wave >> 2;
    float ss = 0.f;
#pragma unroll
    for (int i = 0; i < PER; ++i) ss += (acc[i][0] * acc[i][0] + acc[i][1] * acc[i][1]) + (acc[i][2] * acc[i][2] + acc[i][3] * acc[i][3]);
    ss += shx(ss, 16, F.lane); ss += shx(ss, 32, F.lane);
    if (fq == 0) RS[hi * 64 + tt * 16 + fr] = ss;
    lds_barrier();
    const int t = tt * 16 + fr;
    const float rr = rsqrtf((RS[t] + RS[64 + t]) * (1.0f / (float)DV) + NORM_EPS);
#pragma unroll
    for (int i = 0; i < PER; ++i) { const int e = (PER * hi + i) * 16 + 4 * fq;
        const u32x2 gw = gwv[i]; const f32x4 g4 = *(const LAS f32x4*)(gn + e);
        const float o0 = acc[i][0] * rr * g4[0] * siluf(bflo(gw.x)), o1 = acc[i][1] * rr * g4[1] * siluf(bfhi(gw.x)), o2 = acc[i][2] * rr * g4[2] * siluf(bflo(gw.y)), o3 = acc[i][3] * rr * g4[3] * siluf(bfhi(gw.y));
        u32x2 w; w.x = pk2(o0, o1); w.y = pk2(o2, o3); *(u32x2*)(om + (size_t)t * 1024 + e) = w; }
}
template <int DK, int DV>
__device__ __forceinline__ void gla_m3_loads(Frame& F, const bf16* spt, const bf16* zgate, bf16x8 (&sf)[DV / 32][DK / 32], u32x2 (&gw)[DV / 32]) {
    constexpr int KS = DK / 32, PER = DV / 32;
    const int fr = F.lane & 15, fq = F.lane >> 4, tt = F.wave & 3, hi = F.wave >> 2;
#pragma unroll
    for (int i = 0; i < PER; ++i) { gw[i] = *(const u32x2*)(zgate + (size_t)(tt * 16 + fr) * NZ + (PER * hi + i) * 16 + 4 * fq);
#pragma unroll
        for (int ks = 0; ks < KS; ++ks) sf[i][ks] = gfrag(spt, DK, (PER * hi + i) * 16 + fr, 32 * ks + 8 * fq); }
}
template <int DK, int DV, bool ST_LDS, int STO, class Mid>
__device__ __forceinline__ void gla_m3_mma(Frame& F, const bf16x8 (&sf)[DV / 32][DK / 32], const u32x2 (&gw)[DV / 32], const LAS float* gn  , bf16* om  , Mid mid) {
    constexpr int LQ = DK + 8, LT = 72, KS = DK / 32, PER = DV / 32;
    const LAS bf16* QS = (const LAS bf16*)(F.lds + GL_QS); const LAS bf16* KH = (const LAS bf16*)(F.lds + GL_KH); const LAS bf16* VT = (const LAS bf16*)(F.lds + GL_VT);
    LAS bf16* SC = (LAS bf16*)(F.lds + GL_SC); LAS float* RS = (LAS float*)(F.lds + GL_RS);
    const int fr = F.lane & 15, fq = F.lane >> 4, tt = F.wave & 3, hi = F.wave >> 2;
    {
        f32x4 a2[2] = {(f32x4){0.f, 0.f, 0.f, 0.f}, (f32x4){0.f, 0.f, 0.f, 0.f}};
#pragma unroll
        for (int ks = 0; ks < KS; ++ks) { const bf16x8 yf = lfrag(QS, LQ, tt * 16 + fr, 32 * ks + 8 * fq);
#pragma unroll
            for (int i = 0; i < 2; ++i) a2[i] = MFMA16(lfrag(KH, LQ, (2 * hi + i) * 16 + fr, 32 * ks + 8 * fq), yf, a2[i]); }
#pragma unroll
        for (int i = 0; i < 2; ++i) { const int t = tt * 16 + fr, s0 = (2 * hi + i) * 16 + 4 * fq; float v[4];
#pragma unroll
            for (int j = 0; j < 4; ++j) v[j] = (s0 + j <= t) ? a2[i][j] : 0.0f;
            u32x2 w; w.x = pk2(v[0], v[1]); w.y = pk2(v[2], v[3]); *(LAS u32x2*)(SC + t * LT + s0) = w; }
    }
    mid();
    lds_barrier();
    f32x4 acc[PER];
#pragma unroll
    for (int i = 0; i < PER; ++i) acc[i] = (f32x4){0.f, 0.f, 0.f, 0.f};
#pragma unroll
    for (int ks = 0; ks < 2; ++ks) { const bf16x8 yf = lfrag(SC, LT, tt * 16 + fr, 32 * ks + 8 * fq);
#pragma unroll
        for (int i = 0; i < PER; ++i) acc[i] = MFMA16(lfrag(VT, LT, (PER * hi + i) * 16 + fr, 32 * ks + 8 * fq), yf, acc[i]); }
#pragma unroll
    for (int ks = 0; ks < KS; ++ks) { const bf16x8 yf = lfrag(QS, LQ, tt * 16 + fr, 32 * ks + 8 * fq);
#pragma unroll
        for (int i = 0; i < PER; ++i) acc[i] = MFMA16(ST_LDS ? lfrag((const LAS bf16*)(F.lds + STO), DK + 8, (PER * hi + i) * 16 + fr, 32 * ks + 8 * fq) : sf[i][ks], yf, acc[i]); }
    mix_out_epilogue<PER, DV>(F, acc, gn, gw, om);
}
constexpr int GD_CW = 119552;
constexpr int GD_RAW = 0, GD_MM = 0, GD_CQ = 26112, GD_XT = 26112, GD_CK = 44544, GD_CV = 61184, GD_QN = 77824, GD_KN = 87040, GD_KDT = 96256, GD_QDL = 105472, GD_PART = 114688, GD_BV = 118784, GD_BK = 119040, GD_GC = 119296;
struct GdRaw { unsigned w[13]; float ga, gb; };
__device__ __forceinline__ void gdn_issue(Frame& F, int b, int n, int h, GdRaw& r) {
    const bf16* z = (const bf16*)(F.ws + WS_R1);
#pragma unroll
    for (int i = 0; i < 13; ++i) { const int idx = F.tid + 512 * i, rr = idx / 96, j = idx - rr * 96, seg = j >> 5, jj = j & 31, ts = n * 64 - 3 + rr;
        unsigned w = 0u; if (idx < 67 * 96 && ts >= 0) w = __builtin_nontemporal_load((const unsigned*)(z + (size_t)(b * SEQ + ts) * NZ + 3072 + seg * 256 + h * 64 + 2 * jj));
        r.w[i] = w; }
    const float* gr = (const float*)(F.ws + WS_GAB) + (size_t)(b * SEQ + n * 64 + F.lane) * 8;
    r.ga = gr[h]; r.gb = gr[4 + h];
}
__device__ __forceinline__ void gdn_stage(Frame& F, const GdRaw& r) {
    LAS unsigned* RAW = (LAS unsigned*)(F.lds + GD_RAW);
#pragma unroll
    for (int i = 0; i < 13; ++i) { const int idx = F.tid + 512 * i, rr = idx / 96, j = idx - rr * 96; if (idx < 67 * 96) RAW[rr * 97 + j] = r.w[i]; }
}
__device__ __forceinline__ void gdn_load_cw(Frame& F, int l, int h) {
    LAS float* CW = (LAS float*)(F.lds + GD_CW); const float* cw = pin(F, I_CONVW) + (size_t)l * 4 * 768;
    for (int i = F.tid; i < 768; i += 512) { const int j = i / 192, rem = i - j * 192, c = rem >> 1, p = rem & 1, seg = c >> 5, jj = c & 31; CW[i] = cw[j * 768 + seg * 256 + h * 64 + 2 * jj + p]; }
}
__device__ __forceinline__ void gdn_m1(Frame& F, int l, int h, int uid, const GdRaw& raw) {
    LAS unsigned* RAW = (LAS unsigned*)(F.lds + GD_RAW); LAS float* MM = (LAS float*)(F.lds + GD_MM);
    LAS float* CQ = (LAS float*)(F.lds + GD_CQ); LAS float* CK = (LAS float*)(F.lds + GD_CK); LAS float* CV = (LAS float*)(F.lds + GD_CV);
    LAS bf16* XT = (LAS bf16*)(F.lds + GD_XT); LAS bf16* QN = (LAS bf16*)(F.lds + GD_QN); LAS bf16* KN = (LAS bf16*)(F.lds + GD_KN);
    LAS bf16* KDT = (LAS bf16*)(F.lds + GD_KDT); LAS bf16* QDL = (LAS bf16*)(F.lds + GD_QDL);
    LAS float* PART = (LAS float*)(F.lds + GD_PART); LAS float* BV = (LAS float*)(F.lds + GD_BV); LAS float* BK = (LAS float*)(F.lds + GD_BK); LAS float* GCL = (LAS float*)(F.lds + GD_GC);
    const int t = F.lane;
    float gc, beta, gl;
    { const float Aexp = __expf(pin(F, I_ALOG)[l * 4 + h]), xa = raw.ga + pin(F, I_DTB)[l * 4 + h], sp = (xa > 20.f) ? xa : log1pf(__expf(xa));
      gc = wave_scan_incl(-Aexp * sp, F.lane); gl = __shfl(gc, 63); beta = sigm(raw.gb); }
    const LAS float* CW = (const LAS float*)(F.lds + GD_CW);
    float pq = 0.f, pk = 0.f;
#pragma unroll 2
    for (int i = 0; i < 12; ++i) { const int c = F.wave * 12 + i, seg = c >> 5, jj = c & 31;
        float u0 = 0.f, u1 = 0.f;
#pragma unroll
        for (int j = 0; j < 4; ++j) { const unsigned w = RAW[(t + j) * 97 + c]; const f32x2 cwv = *(const LAS f32x2*)(CW + (j * 96 + c) * 2); u0 += cwv[0] * bflo(w); u1 += cwv[1] * bfhi(w); }
        const float a0 = siluf(u0), a1 = siluf(u1);
        LAS float* dst = (seg == 0) ? CQ : ((seg == 1) ? CK : CV);
        dst[t * 65 + 2 * jj] = a0; dst[t * 65 + 2 * jj + 1] = a1;
        const float s2 = a0 * a0 + a1 * a1; pq += (seg == 0) ? s2 : 0.f; pk += (seg == 1) ? s2 : 0.f; }
    PART[(F.wave * 2 + 0) * 64 + t] = pq; PART[(F.wave * 2 + 1) * 64 + t] = pk;
    lds_barrier();
    { float sq = 0.f, sk = 0.f;
#pragma unroll
      for (int w = 0; w < 8; ++w) { sq += PART[(w * 2) * 64 + t]; sk += PART[(w * 2 + 1) * 64 + t]; }
      const float rq = rsqrtf(sq + 1e-6f) * 0.125f, rk = rsqrtf(sk + 1e-6f), eg = __expf(gc), ekd = __expf(gl - gc);
      float qn[8], kn[8];
#pragma unroll
      for (int i = 0; i < 8; ++i) { const int d = F.wave * 8 + i; qn[i] = CQ[t * 65 + d] * rq; kn[i] = CK[t * 65 + d] * rk; KDT[d * 72 + t] = (bf16)f2bf(kn[i] * ekd); CK[t * 65 + d] = kn[i]; }
      { u32x4 wq, wk, wd;
        wq.x = pk2(qn[0], qn[1]); wq.y = pk2(qn[2], qn[3]); wq.z = pk2(qn[4], qn[5]); wq.w = pk2(qn[6], qn[7]);
        wk.x = pk2(kn[0], kn[1]); wk.y = pk2(kn[2], kn[3]); wk.z = pk2(kn[4], kn[5]); wk.w = pk2(kn[6], kn[7]);
        wd.x = pk2(qn[0] * eg, qn[1] * eg); wd.y = pk2(qn[2] * eg, qn[3] * eg); wd.z = pk2(qn[4] * eg, qn[5] * eg); wd.w = pk2(qn[6] * eg, qn[7] * eg);
        *(LAS u32x4*)(QN + t * 72 + 8 * F.wave) = wq; *(LAS u32x4*)(KN + t * 72 + 8 * F.wave) = wk; *(LAS u32x4*)(QDL + t * 72 + 8 * F.wave) = wd; }
      if (F.wave == 0) { BV[t] = beta; BK[t] = beta * eg; GCL[t] = gc; } }
    lds_barrier();
    const int fr = F.lane & 15, fq = F.lane >> 4, tt = F.wave & 3, hi = F.wave >> 2;
    {
        const LAS bf16* Y = hi ? QN : KN;
        f32x4 a4[4];
#pragma unroll
        for (int i = 0; i < 4; ++i) a4[i] = (f32x4){0.f, 0.f, 0.f, 0.f};
#pragma unroll
        for (int ks = 0; ks < 2; ++ks) { const bf16x8 yf = lfrag(Y, 72, tt * 16 + fr, 32 * ks + 8 * fq);
#pragma unroll
            for (int i = 0; i < 4; ++i) a4[i] = MFMA16(lfrag(KN, 72, i * 16 + fr, 32 * ks + 8 * fq), yf, a4[i]); }
        const int tr = tt * 16 + fr; const float gct = GCL[tr], bt = BV[tr];
        bf16* gqk = (bf16*)(F.ws + WS_GQK) + (size_t)uid * 4096;
#pragma unroll
        for (int i = 0; i < 4; ++i) { const int s0 = i * 16 + 4 * fq; const f32x4 gs = *(const LAS f32x4*)(GCL + s0); float v[4];
#pragma unroll
            for (int j = 0; j < 4; ++j) { const bool keep = hi ? (s0 + j <= tr) : (s0 + j < tr); v[j] = keep ? a4[i][j] * __expf(gct - gs[j]) * (hi ? 1.0f : bt) : 0.0f; }
            if (hi) { u32x2 w; w.x = pk2(v[0], v[1]); w.y = pk2(v[2], v[3]); *(u32x2*)(gqk + tr * 64 + s0) = w; }
            else *(LAS f32x4*)(MM + tr * 68 + s0) = (f32x4){v[0], v[1], v[2], v[3]}; }
    }
    lds_barrier();
    {
        typedef short s16x4 __attribute__((ext_vector_type(4)));
        LAS bf16* MMb = (LAS bf16*)(F.lds + GD_QN);
        LAS bf16* LINV = (LAS bf16*)(F.lds + GD_PART);
        for (int i = F.tid; i < 128 * 72 / 8; i += 512) *(LAS u32x4*)(XT + 8 * i) = (u32x4){0u, 0u, 0u, 0u};
        { const int r = F.tid >> 3, c8 = F.tid & 7; const f32x4 a = *(const LAS f32x4*)(MM + r * 68 + 8 * c8), b2 = *(const LAS f32x4*)(MM + r * 68 + 8 * c8 + 4);
          u32x4 w; w.x = pk2(a[0], a[1]); w.y = pk2(a[2], a[3]); w.z = pk2(b2[0], b2[1]); w.w = pk2(b2[2], b2[3]); *(LAS u32x4*)(MMb + r * 72 + 8 * c8) = w; }
        if (F.wave < 4) {
            const int bq = F.wave;
            LAS bf16* Rr = (LAS bf16*)(F.lds + GD_KN) + bq * 960; LAS bf16* Cc = Rr + 320; LAS bf16* Pr = Cc + 320;
            f32x4 n4, p4;
#pragma unroll
            for (int j = 0; j < 4; ++j) { n4[j] = -MM[(16 * bq + 4 * fq + j) * 68 + 16 * bq + fr]; p4[j] = n4[j] + ((4 * fq + j == fr) ? 1.0f : 0.0f); }
            { u32x2 w; w.x = pk2(n4[0], n4[1]); w.y = pk2(n4[2], n4[3]); *(LAS u32x2*)(Cc + fr * 20 + 4 * fq) = w; }
#pragma unroll
            for (int j = 0; j < 4; ++j) { Rr[(4 * fq + j) * 20 + fr] = (bf16)f2bf(n4[j]); Pr[(4 * fq + j) * 20 + fr] = (bf16)f2bf(p4[j]); }
#pragma unroll
            for (int s = 0; s < 3; ++s) {
                asm volatile("s_waitcnt lgkmcnt(0)" ::: "memory");
                const s16x4 xr = *(const LAS s16x4*)(Rr + fr * 20 + 4 * fq), yc = *(const LAS s16x4*)(Cc + fr * 20 + 4 * fq);
                const f32x4 a2 = __builtin_amdgcn_mfma_f32_16x16x16bf16_1k(xr, yc, (f32x4){0.f, 0.f, 0.f, 0.f}, 0, 0, 0);
                const s16x4 xp = *(const LAS s16x4*)(Pr + fr * 20 + 4 * fq);
                asm volatile("s_waitcnt lgkmcnt(0)" ::: "memory");
                { u32x2 w; w.x = pk2(a2[0], a2[1]); w.y = pk2(a2[2], a2[3]); *(LAS u32x2*)(Cc + fr * 20 + 4 * fq) = w; }
#pragma unroll
                for (int j = 0; j < 4; ++j) Rr[(4 * fq + j) * 20 + fr] = (bf16)f2bf(a2[j]);
                asm volatile("s_waitcnt lgkmcnt(0)" ::: "memory");
                const s16x4 yc2 = *(const LAS s16x4*)(Cc + fr * 20 + 4 * fq);
                p4 = __builtin_amdgcn_mfma_f32_16x16x16bf16_1k(xp, yc2, p4, 0, 0, 0);
#pragma unroll
                for (int j = 0; j < 4; ++j) Pr[(4 * fq + j) * 20 + fr] = (bf16)f2bf(p4[j]);
            }
#pragma unroll
            for (int j = 0; j < 4; ++j) LINV[bq * 320 + (4 * fq + j) * 20 + fr] = (bf16)f2bf(p4[j]);
        }
        lds_barrier();
        const int cw = 16 * F.wave + fr;
        const LAS float* SRCw = (cw < 64) ? (CV + cw) : (CK + (cw - 64)); const LAS float* COEFw = (cw < 64) ? BV : BK;
#pragma unroll 1
        for (int bt = 0; bt < 4; ++bt) {
            f32x4 acc = (f32x4){0.f, 0.f, 0.f, 0.f};
            if (bt > 0) acc = MFMA16(lfrag(MMb, 72, 16 * bt + fr, 8 * fq), lfrag(XT, 72, cw, 8 * fq), acc);
            if (bt == 3) acc = MFMA16(lfrag(MMb, 72, 16 * bt + fr, 32 + 8 * fq), lfrag(XT, 72, cw, 32 + 8 * fq), acc);
            float y[4];
#pragma unroll
            for (int j = 0; j < 4; ++j) { const int t2 = 16 * bt + 4 * fq + j; y[j] = SRCw[t2 * 65] * COEFw[t2] - acc[j]; }
            u32x2 yw; yw.x = pk2m(y[0], y[1]); yw.y = pk2m(y[2], y[3]);
            const s16x4 li = *(const LAS s16x4*)(LINV + bt * 320 + fr * 20 + 4 * fq);
            const f32x4 x4 = __builtin_amdgcn_mfma_f32_16x16x16bf16_1k(li, __builtin_bit_cast(s16x4, yw), (f32x4){0.f, 0.f, 0.f, 0.f}, 0, 0, 0);
            { u32x2 w; w.x = pk2(x4[0], x4[1]); w.y = pk2(x4[2], x4[3]); *(LAS u32x2*)(XT + cw * 72 + 16 * bt + 4 * fq) = w; }
            lds_barrier();
        }
    }
    {
        const LAS bf16* X = hi ? KDT : (XT + 64 * 72); const LAS bf16* Y = hi ? XT : KDT;
        f32x4 a4[4];
#pragma unroll
        for (int i = 0; i < 4; ++i) a4[i] = (f32x4){0.f, 0.f, 0.f, 0.f};
#pragma unroll
        for (int ks = 0; ks < 2; ++ks) { const bf16x8 yf = lfrag(Y, 72, tt * 16 + fr, 32 * ks + 8 * fq);
#pragma unroll
            for (int i = 0; i < 4; ++i) a4[i] = MFMA16(lfrag(X, 72, i * 16 + fr, 32 * ks + 8 * fq), yf, a4[i]); }
        const int yr = tt * 16 + fr;
        if (hi) { bf16* ut = (bf16*)(F.ws + WS_GUT) + (size_t)uid * 4096 + yr * 64 + fq * 16;
            u32x4 w0, w1; w0.x = pk2(a4[0][0], a4[0][1]); w0.y = pk2(a4[0][2], a4[0][3]); w0.z = pk2(a4[1][0], a4[1][1]); w0.w = pk2(a4[1][2], a4[1][3]);
            w1.x = pk2(a4[2][0], a4[2][1]); w1.y = pk2(a4[2][2], a4[2][3]); w1.z = pk2(a4[3][0], a4[3][1]); w1.w = pk2(a4[3][2], a4[3][3]);
            *(u32x4*)ut = w0; *(u32x4*)(ut + 8) = w1;
            LAS bf16* ul = (LAS bf16*)(F.lds + GD_KN) + yr * 64; *(LAS u32x4*)(ul + (((2 * fq) ^ (yr & 7)) << 3)) = w0; *(LAS u32x4*)(ul + (((2 * fq + 1) ^ (yr & 7)) << 3)) = w1; }
        else { bf16* gt = (bf16*)(F.ws + WS_GT) + (size_t)uid * 4096 + yr * 64; const float last = __expf(gl);
            unsigned pw[4][2];
#pragma unroll
            for (int i = 0; i < 4; ++i) { const int d0 = i * 16 + 4 * fq; float v[4];
#pragma unroll
                for (int j = 0; j < 4; ++j) v[j] = ((d0 + j == yr) ? last : 0.0f) - a4[i][j];
                pw[i][0] = pk2(v[0], v[1]); pw[i][1] = pk2(v[2], v[3]); }
#pragma unroll
            for (int ks = 0; ks < 2; ++ks) { u32x4 w; w.x = pw[2 * ks][0]; w.y = pw[2 * ks][1]; w.z = pw[2 * ks + 1][0]; w.w = pw[2 * ks + 1][1]; *(u32x4*)(gt + ks * 32 + fq * 8) = w;
                *(LAS u32x4*)((LAS bf16*)(F.lds + GD_QN) + yr * 64 + (((ks * 4 + fq) ^ (yr & 7)) << 3)) = w; } }
        { const int tq = F.tid & 63, dg = F.tid >> 6; u32x4 w; unsigned short e8[8];
#pragma unroll
          for (int i = 0; i < 8; ++i) e8[i] = XT[(64 + 8 * dg + i) * 72 + tq];
          w.x = e8[0] | ((unsigned)e8[1] << 16); w.y = e8[2] | ((unsigned)e8[3] << 16); w.z = e8[4] | ((unsigned)e8[5] << 16); w.w = e8[6] | ((unsigned)e8[7] << 16);
          *(u32x4*)((bf16*)(F.ws + WS_GKC) + (size_t)uid * 4096 + tq * 64 + 8 * dg) = w; }
        { const int r = F.tid >> 3, c8 = F.tid & 7;
          *(u32x4*)((bf16*)(F.ws + WS_GWT) + (size_t)uid * 4096 + r * 64 + 8 * c8) = *(const LAS u32x4*)(XT + r * 72 + 8 * c8);
          *(u32x4*)((bf16*)(F.ws + WS_GQD) + (size_t)uid * 4096 + r * 64 + 8 * c8) = *(const LAS u32x4*)(QDL + r * 72 + 8 * c8); }
    }
    lds_barrier();
}
struct GdnStep { u32x4 T[4][2]; u32x4 U[2]; };
__device__ __forceinline__ void gdn_m2_load(GdnStep& s, const bf16* gt, const bf16* ut, int n, int fr, int fq) {
    s.U[0] = *(const u32x4*)(ut + (size_t)n * 4096); s.U[1] = *(const u32x4*)(ut + (size_t)n * 4096 + 8);
#pragma unroll
    for (int i = 0; i < 4; ++i)
#pragma unroll
        for (int ks = 0; ks < 2; ++ks) s.T[i][ks] = *(const u32x4*)(gt + (size_t)n * 4096 + (i * 16 + fr) * 64 + ks * 32 + fq * 8);
}
__device__ __forceinline__ void gdn_step(f32x4 (&S)[4], const GdnStep& st, float us) {
    bf16x8 sf[2];
#pragma unroll
    for (int ks = 0; ks < 2; ++ks) { u32x4 w; w.x = pk2m(S[2 * ks][0], S[2 * ks][1]); w.y = pk2m(S[2 * ks][2], S[2 * ks][3]); w.z = pk2m(S[2 * ks + 1][0], S[2 * ks + 1][1]); w.w = pk2m(S[2 * ks + 1][2], S[2 * ks + 1][3]);
        sf[ks] = __builtin_bit_cast(bf16x8, w); }
#pragma unroll
    for (int i = 0; i < 4; ++i) { const unsigned u0 = (i & 1) ? st.U[i >> 1].z : st.U[i >> 1].x, u1 = (i & 1) ? st.U[i >> 1].w : st.U[i >> 1].y;
        f32x4 a = (f32x4){bflo(u0), bfhi(u0), bflo(u1), bfhi(u1)} * us;
#pragma unroll
        for (int ks = 0; ks < 2; ++ks) a = MFMA16(__builtin_bit_cast(bf16x8, st.T[i][ks]), sf[ks], a);
        S[i] = a; }
}
__device__ __forceinline__ void gdn_m2a(Frame& F, int bh, int seg) {
    const int fr = F.lane & 15, fq = F.lane >> 4, role = F.wave >> 2, c = (F.wave & 3) * 16 + fr;
    const bf16* gt = (const bf16*)(F.ws + WS_GT) + (size_t)(bh * 128 + seg * 8) * 4096;
    const bf16* ut = (const bf16*)(F.ws + WS_GUT) + (size_t)(bh * 128 + seg * 8) * 4096 + c * 64 + 16 * fq;
    const float us = role ? 0.0f : 1.0f;
    f32x4 S[4];
#pragma unroll
    for (int i = 0; i < 4; ++i)
#pragma unroll
        for (int j = 0; j < 4; ++j) S[i][j] = (role && (16 * i + 4 * fq + j == c)) ? 1.0f : 0.0f;
    GdnStep st[4];
#pragma unroll
    for (int r = 0; r < 4; ++r) gdn_m2_load(st[r], gt, ut, r, fr, fq);
    for (int n0 = 0; n0 < 8; n0 += 4) {
#pragma unroll
        for (int r = 0; r < 4; ++r) { const int n = n0 + r; gdn_step(S, st[r], us); gdn_m2_load(st[r], gt, ut, (n + 4 < 8) ? n + 4 : 7, fr, fq); } }
    if (role == 0) { bf16* qg = (bf16*)(F.ws + WS_GQG) + (size_t)(bh * 16 + seg) * 4096 + c * 64 + fq * 16;
        u32x4 w0, w1; w0.x = pk2(S[0][0], S[0][1]); w0.y = pk2(S[0][2], S[0][3]); w0.z = pk2(S[1][0], S[1][1]); w0.w = pk2(S[1][2], S[1][3]);
        w1.x = pk2(S[2][0], S[2][1]); w1.y = pk2(S[2][2], S[2][3]); w1.z = pk2(S[3][0], S[3][1]); w1.w = pk2(S[3][2], S[3][3]);
        *(u32x4*)qg = w0; *(u32x4*)(qg + 8) = w1; }
    else { bf16* pg = (bf16*)(F.ws + WS_GPG) + (size_t)(bh * 16 + seg) * 4096 + (c >> 5) * 32 + ((c & 15) >> 2) * 8 + ((c >> 4) & 1) * 4 + (c & 3);
#pragma unroll
        for (int i = 0; i < 4; ++i)
#pragma unroll
            for (int j = 0; j < 4; ++j) pg[(16 * i + 4 * fq + j) * 64] = (bf16)f2bf(S[i][j]); }
}
__device__ __forceinline__ void gdn_m2b(Frame& F, int bh) {
    const int fr = F.lane & 15, fq = F.lane >> 4, c = (F.wave & 3) * 16 + fr;
    const bf16* pg = (const bf16*)(F.ws + WS_GPG) + (size_t)bh * 16 * 4096;
    const bf16* qg = (const bf16*)(F.ws + WS_GQG) + (size_t)bh * 16 * 4096 + c * 64 + 16 * fq;
    float* ss = (float*)(F.ws + WS_GSS) + (size_t)bh * 16 * 4096 + c * 64 + 4 * fq;
    { u32x4 pv[16]; const int r = F.tid >> 3, sl = F.tid & 7;
#pragma unroll
      for (int g = 0; g < 16; ++g) pv[g] = *(const u32x4*)(pg + (size_t)g * 4096 + r * 64 + ((sl ^ (r & 7)) << 3));
#pragma unroll
      for (int g = 0; g < 16; ++g) *(LAS u32x4*)(F.lds + g * 8192 + F.tid * 16) = pv[g]; }
    u32x4 qv[16][2];
    if (F.wave < 4) {
#pragma unroll
        for (int g = 0; g < 16; ++g) { qv[g][0] = *(const u32x4*)(qg + (size_t)g * 4096); qv[g][1] = *(const u32x4*)(qg + (size_t)g * 4096 + 8); } }
    lds_barrier();
    if (F.wave < 4) {
        f32x4 S[4];
#pragma unroll
        for (int i = 0; i < 4; ++i) S[i] = (f32x4){0.f, 0.f, 0.f, 0.f};
#pragma unroll
        for (int g = 0; g < 16; ++g) {
#pragma unroll
            for (int i = 0; i < 4; ++i) *(f32x4*)(ss + (size_t)g * 4096 + i * 16) = S[i];
            GdnStep st; st.U[0] = qv[g][0]; st.U[1] = qv[g][1];
#pragma unroll
            for (int i = 0; i < 4; ++i)
#pragma unroll
                for (int ks = 0; ks < 2; ++ks) st.T[i][ks] = *(const LAS u32x4*)(F.lds + g * 8192 + (i * 16 + fr) * 128 + (((ks * 4 + fq) ^ (fr & 7)) << 4));
            gdn_step(S, st, 1.0f); } }
    lds_barrier();
}
__device__ __forceinline__ void gdn_compose(Frame& F, f32x4 (&S)[4]) {
    const int fr = F.lane & 15, fq = F.lane >> 4, c = (F.wave & 3) * 16 + fr;
    const LAS bf16* TL = (const LAS bf16*)(F.lds + GD_QN); const LAS bf16* UL = (const LAS bf16*)(F.lds + GD_KN) + c * 64;
    GdnStep st; st.U[0] = *(const LAS u32x4*)(UL + (((2 * fq) ^ (c & 7)) << 3)); st.U[1] = *(const LAS u32x4*)(UL + (((2 * fq + 1) ^ (c & 7)) << 3));
#pragma unroll
    for (int i = 0; i < 4; ++i)
#pragma unroll
        for (int ks = 0; ks < 2; ++ks) st.T[i][ks] = *(const LAS u32x4*)(TL + (i * 16 + fr) * 64 + (((ks * 4 + fq) ^ (fr & 7)) << 3));
    gdn_step(S, st, (F.wave >> 2) ? 0.0f : 1.0f);
}
struct Gd3Raw { u32x4 kc, qk, qd; u32x2 wwv[2]; GdnStep st; };
struct Gd3Gate { u32x2 gw[2]; };
__device__ __forceinline__ void gdn3_gates(Frame& F, int b, int n, int h, Gd3Gate& g) {
    const int fr = F.lane & 15, fq = F.lane >> 4, tt = F.wave & 3, hi = F.wave >> 2;
    const bf16* zg = (const bf16*)(F.ws + WS_R1) + (size_t)(b * SEQ + n * 64) * NZ + 3840 + h * 64;
#pragma unroll
    for (int i = 0; i < 2; ++i) g.gw[i] = __builtin_nontemporal_load((const u32x2*)(zg + (size_t)(tt * 16 + fr) * NZ + (2 * hi + i) * 16 + 4 * fq));
}
__device__ __forceinline__ void gdn3_issue(Frame& F, int b, int n, int h, int uid, Gd3Raw& r) {
    const size_t row0 = (size_t)(b * SEQ + n * 64);
    const int fr = F.lane & 15, fq = F.lane >> 4, tt = F.wave & 3, hi = F.wave >> 2;
    const bf16* zg = (const bf16*)(F.ws + WS_R1) + row0 * NZ + 3840 + h * 64; const bf16* wt = (const bf16*)(F.ws + WS_GWT) + (size_t)uid * 4096 + (tt * 16 + fr) * 64;
    { const int rr = F.tid >> 3, c8 = F.tid & 7; const size_t go = (size_t)uid * 4096 + rr * 64 + 8 * c8;
      r.kc = __builtin_nontemporal_load((const u32x4*)((const bf16*)(F.ws + WS_GKC) + go)); r.qk = __builtin_nontemporal_load((const u32x4*)((const bf16*)(F.ws + WS_GQK) + go)); r.qd = __builtin_nontemporal_load((const u32x4*)((const bf16*)(F.ws + WS_GQD) + go)); }
#pragma unroll
    for (int i = 0; i < 2; ++i) r.wwv[i] = __builtin_nontemporal_load((const u32x2*)(wt + (2 * hi + i) * 16 + 4 * fq));
    gdn_m2_load(r.st, (const bf16*)(F.ws + WS_GT) + (size_t)uid * 4096, (const bf16*)(F.ws + WS_GUT) + (size_t)uid * 4096 + ((F.wave & 3) * 16 + fr) * 64 + 16 * fq, 0, fr, fq);
}
__device__ __forceinline__ void gdn_m3(Frame& F, int l, int b, int n, int h, const Gd3Raw& r, const Gd3Gate& gt_, f32x4 (&S)[4]) {
    LAS bf16* KCL = (LAS bf16*)(F.lds + GL_QS); LAS bf16* QKL = KCL + 64 * 72; LAS bf16* QDL = QKL + 64 * 72; LAS bf16* VNT = QDL + 64 * 72; LAS bf16* STL = VNT + 64 * 72;
    const size_t row0 = (size_t)(b * SEQ + n * 64);
    const int fr = F.lane & 15, fq = F.lane >> 4, tt = F.wave & 3, hi = F.wave >> 2;
    { const int rr = F.tid >> 3, c8 = F.tid & 7;
      *(LAS u32x4*)(KCL + rr * 72 + 8 * c8) = r.kc; *(LAS u32x4*)(QKL + rr * 72 + 8 * c8) = r.qk; *(LAS u32x4*)(QDL + rr * 72 + 8 * c8) = r.qd; }
    if (F.wave < 4) {
#pragma unroll
        for (int i = 0; i < 4; ++i) { u32x2 w; w.x = pk2(S[i][0], S[i][1]); w.y = pk2(S[i][2], S[i][3]); *(LAS u32x2*)(STL + (F.wave * 16 + fr) * 72 + 16 * i + 4 * fq) = w; } }
    u32x2 gw[2], wwv[2];
#pragma unroll
    for (int i = 0; i < 2; ++i) { gw[i] = gt_.gw[i]; wwv[i] = r.wwv[i]; }
    lds_barrier();
    {
        f32x4 a2[2] = {(f32x4){0.f, 0.f, 0.f, 0.f}, (f32x4){0.f, 0.f, 0.f, 0.f}};
#pragma unroll
        for (int ks = 0; ks < 2; ++ks) { const bf16x8 yf = lfrag(STL, 72, tt * 16 + fr, 32 * ks + 8 * fq);
#pragma unroll
            for (int i = 0; i < 2; ++i) a2[i] = MFMA16(lfrag(KCL, 72, (2 * hi + i) * 16 + fr, 32 * ks + 8 * fq), yf, a2[i]); }
        const int e = tt * 16 + fr;
#pragma unroll
        for (int i = 0; i < 2; ++i) { const int t0 = (2 * hi + i) * 16 + 4 * fq; const u32x2 ww = wwv[i];
            u32x2 w; w.x = pk2(bflo(ww.x) - a2[i][0], bfhi(ww.x) - a2[i][1]); w.y = pk2(bflo(ww.y) - a2[i][2], bfhi(ww.y) - a2[i][3]);
            *(LAS u32x2*)(VNT + e * 72 + t0) = w; }
    }
    lds_barrier();
    f32x4 acc[2] = {(f32x4){0.f, 0.f, 0.f, 0.f}, (f32x4){0.f, 0.f, 0.f, 0.f}};
#pragma unroll
    for (int ks = 0; ks < 2; ++ks) { const bf16x8 yf = lfrag(QKL, 72, tt * 16 + fr, 32 * ks + 8 * fq);
#pragma unroll
        for (int i = 0; i < 2; ++i) acc[i] = MFMA16(lfrag(VNT, 72, (2 * hi + i) * 16 + fr, 32 * ks + 8 * fq), yf, acc[i]); }
#pragma unroll
    for (int ks = 0; ks < 2; ++ks) { const bf16x8 yf = lfrag(QDL, 72, tt * 16 + fr, 32 * ks + 8 * fq);
#pragma unroll
        for (int i = 0; i < 2; ++i) acc[i] = MFMA16(lfrag(STL, 72, (2 * hi + i) * 16 + fr, 32 * ks + 8 * fq), yf, acc[i]); }
    mix_out_epilogue<2, 64>(F, acc, (const LAS float*)(F.lds + GL_GNG), gw, (bf16*)(F.ws + WS_OMIX) + row0 * 1024 + 768 + h * 64);
    gdn_step(S, r.st, 1.0f);
}
#define LAUNDER() do { F.lane = F0.lane; asm volatile("" : "+v"(F.lane)); F.tid = F.wave * 64 + F.lane; } while (0)
#define UNIT_IDX(k) const int idx = F.bid + F.G * (k), b = idx >> 9, n = (idx >> 2) & 127, h = idx & 3, uid = ((b * 4 + h) << 7) | n
__device__ __forceinline__ void phase_mix_m1(Frame& F0, int l) {
    Frame F = F0; const int NU = 2048 / F.G;
    if (F.tid < 128) ((LAS float*)(F.lds + GL_LB))[F.tid] = ((const float*)(F.ws + WS_LB))[l * 512 + ((F.bid >> 4) & 3) * 128 + F.tid];
    lds_barrier();
    const int bh = F.bid >> 4, seg = F.bid & 15, b = bh >> 2, h = bh & 3;
    RtRaw rraw; GdRaw graw;
    {
      f32x4 S[8];
#pragma unroll
      for (int i = 0; i < 8; ++i) S[i] = (f32x4){0.f, 0.f, 0.f, 0.f};
      float dseg = 1.0f;
      HgRaw raw; hg_issue<false>(F, b, 8 * seg, h, raw);
      auto hg_chunk = [&](int k, auto next_issue) __attribute__((always_inline)) { LAUNDER();
        const HgRaw cur = raw;
        next_issue(k);
        hg_prep<0>(F, l, h, cur);
        f32x4 kv[8]; hg_kv_acc(F, kv);
        const LAS float* DECL = (const LAS float*)(F.lds + GL_DECL); const int fq = F.lane >> 4;
#pragma unroll
        for (int i = 0; i < 8; ++i) S[i] = S[i] * *(const LAS f32x4*)(DECL + 16 * i + 4 * fq) + kv[i];
        if (F.tid < 128) dseg *= DECL[F.tid];
        lds_barrier(); };
      for (int k = 0; k < 7; ++k) hg_chunk(k, [&](int kk) __attribute__((always_inline)) { hg_issue<false>(F, b, 8 * seg + kk + 1, h, raw); });
      hg_chunk(7, [&](int) __attribute__((always_inline)) { rt_issue<false>(F, b, 8 * seg, h, rraw); });
      { const int fr = F.lane & 15, fq = F.lane >> 4; float* kvg = (float*)(F.ws + WS_HKV) + (size_t)(bh * 16 + seg) * 16384 + (F.wave * 16 + fr) * 128 + 4 * fq;
#pragma unroll
        for (int i = 0; i < 8; ++i) *(f32x4*)(kvg + 16 * i) = S[i];
        if (F.tid < 128) ((float*)(F.ws + WS_HDEC))[(size_t)(bh * 16 + seg) * 128 + F.tid] = dseg; } }
    {
      const float dec = __expf(64.0f * log1pf(-exp2f(-5.0f - (float)h)));
      f32x4 S[2] = {(f32x4){0.f, 0.f, 0.f, 0.f}, (f32x4){0.f, 0.f, 0.f, 0.f}};
      auto rt_chunk = [&](int k, auto next_issue) __attribute__((always_inline)) { LAUNDER();
        rt_stage<false>(F, rraw); lds_barrier();
        next_issue(k);
        rt_prep<0>(F, 8 * seg + k, h);
        f32x4 kv[2]; rt_kv_acc(F, kv);
        S[0] = S[0] * dec + kv[0]; S[1] = S[1] * dec + kv[1];
        lds_barrier(); };
      for (int k = 0; k < 7; ++k) rt_chunk(k, [&](int kk) __attribute__((always_inline)) { rt_issue<false>(F, b, 8 * seg + kk + 1, h, rraw); });
      rt_chunk(7, [&](int) __attribute__((always_inline)) { gdn_issue(F, b, 8 * seg, h, graw); gdn_load_cw(F, l, h); });
      { const int fr = F.lane & 15, fq = F.lane >> 4; float* kvg = (float*)(F.ws + WS_RKV) + (size_t)(bh * 16 + seg) * 4096 + ((F.wave & 3) * 16 + fr) * 64 + (2 * (F.wave >> 2)) * 16 + 4 * fq;
        *(f32x4*)kvg = S[0]; *(f32x4*)(kvg + 16) = S[1]; } }
    {
      f32x4 S[4];
      { const int fr = F.lane & 15, fq = F.lane >> 4, role = F.wave >> 2, c = (F.wave & 3) * 16 + fr;
#pragma unroll
        for (int i = 0; i < 4; ++i)
#pragma unroll
            for (int j = 0; j < 4; ++j) S[i][j] = (role && (16 * i + 4 * fq + j == c)) ? 1.0f : 0.0f; }
      for (int k = 0; k < 8; ++k) { LAUNDER(); const int n = 8 * seg + k;
        gdn_stage(F, graw); const GdRaw cur = graw; lds_barrier();
        if (k + 1 < 8) gdn_issue(F, b, n + 1, h, graw);
        gdn_m1(F, l, h, bh * 128 + n, cur);
        gdn_compose(F, S); }
      { const int fr = F.lane & 15, fq = F.lane >> 4, role = F.wave >> 2, c = (F.wave & 3) * 16 + fr;
        if (role == 0) { bf16* qg = (bf16*)(F.ws + WS_GQG) + (size_t)(bh * 16 + seg) * 4096 + c * 64 + fq * 16;
            u32x4 w0, w1; w0.x = pk2(S[0][0], S[0][1]); w0.y = pk2(S[0][2], S[0][3]); w0.z = pk2(S[1][0], S[1][1]); w0.w = pk2(S[1][2], S[1][3]);
            w1.x = pk2(S[2][0], S[2][1]); w1.y = pk2(S[2][2], S[2][3]); w1.z = pk2(S[3][0], S[3][1]); w1.w = pk2(S[3][2], S[3][3]);
            *(u32x4*)qg = w0; *(u32x4*)(qg + 8) = w1; }
        else { bf16* pg = (bf16*)(F.ws + WS_GPG) + (size_t)(bh * 16 + seg) * 4096 + (c >> 5) * 32 + ((c & 15) >> 2) * 8 + ((c >> 4) & 1) * 4 + (c & 3);
#pragma unroll
            for (int i = 0; i < 4; ++i)
#pragma unroll
                for (int j = 0; j < 4; ++j) pg[(16 * i + 4 * fq + j) * 64] = (bf16)f2bf(S[i][j]); } } }
}
__device__ __forceinline__ void phase_mix_m2a(Frame& F, int l) { gdn_m2a(F, F.bid >> 4, F.bid & 15); }
__device__ __forceinline__ void phase_mix_m2b(Frame& F, int l) {
    if (F.bid < 16) gdn_m2b(F, F.bid);
    else if (F.bid < 144) { const int item = (F.bid - 16) * 512 + F.tid;
        if (item < 65536) { const int bh = item >> 12, e = (item >> 5) & 127, d4 = item & 31;
            const float* kv = (const float*)(F.ws + WS_HKV) + (size_t)bh * 16 * 16384 + e * 128 + d4 * 4;
            const float* dc = (const float*)(F.ws + WS_HDEC) + (size_t)bh * 16 * 128 + d4 * 4;
            float* sp = (float*)(F.ws + WS_HSP) + (size_t)bh * 16 * 16384 + e * 128 + d4 * 4;
            f32x4 S = (f32x4){0.f, 0.f, 0.f, 0.f};
            { f32x4 kb[16], db[16];
#pragma unroll
                for (int u = 0; u < 16; ++u) { kb[u] = *(const f32x4*)(kv + (size_t)u * 16384); db[u] = *(const f32x4*)(dc + u * 128); }
#pragma unroll
                for (int u = 0; u < 16; ++u) { *(f32x4*)(sp + (size_t)u * 16384) = S; S = db[u] * S + kb[u]; } }
        }
    }
    else if (F.bid < 176) { const int item = (F.bid - 144) * 512 + F.tid;
        if (item < 16384) { const int it = item, bh = it >> 10, e = (it >> 4) & 63, d4 = it & 15;
            const float* kv = (const float*)(F.ws + WS_RKV) + (size_t)bh * 16 * 4096 + e * 64 + d4 * 4;
            float* sp = (float*)(F.ws + WS_RSP) + (size_t)bh * 16 * 4096 + e * 64 + d4 * 4;
            const float dec = __expf(512.0f * log1pf(-exp2f(-5.0f - (float)(bh & 3))));
            f32x4 kb[16];
#pragma unroll
            for (int u = 0; u < 16; ++u) kb[u] = *(const f32x4*)(kv + (size_t)u * 4096);
            f32x4 S = (f32x4){0.f, 0.f, 0.f, 0.f};
#pragma unroll
            for (int u = 0; u < 16; ++u) { *(f32x4*)(sp + (size_t)u * 4096) = S; S = S * dec + kb[u]; }
        }
    }
}
__device__ __forceinline__ void phase_mix_m3(Frame& F0, int l) {
    Frame F = F0; const int NU = 2048 / F.G;
    { const int h = (F.bid >> 4) & 3;
      if (F.tid < 128) { ((LAS float*)(F.lds + GL_LB))[F.tid] = ((const float*)(F.ws + WS_LB))[l * 512 + h * 128 + F.tid]; ((LAS float*)(F.lds + GL_GNH))[F.tid] = pin(F, I_HGG)[l * 512 + h * 128 + F.tid]; }
      else if (F.tid < 192) ((LAS float*)(F.lds + GL_GNR))[F.tid - 128] = pin(F, I_RETG)[l * 256 + h * 64 + F.tid - 128];
      else if (F.tid < 256) ((LAS float*)(F.lds + GL_GNG))[F.tid - 192] = pin(F, I_GDNG)[l * 256 + h * 64 + F.tid - 192];
      lds_barrier(); }
    const int bh = F.bid >> 4, seg = F.bid & 15, b = bh >> 2, h = bh & 3;
    f32x4 rS[2]; RtRaw rraw; u32x2 rgw[2]; f32x4 gS[4]; Gd3Raw gring[2]; Gd3Gate ggate[3];
#define RT_GATES(n_) do { const int fr_ = F.lane & 15, fq_ = F.lane >> 4, tt_ = F.wave & 3, hi_ = F.wave >> 2; const bf16* zg_ = (const bf16*)(F.ws + WS_R1) + (size_t)(b * SEQ + (n_) * 64) * NZ + 2816 + h * 64; \
        _Pragma("unroll") for (int i_ = 0; i_ < 2; ++i_) rgw[i_] = __builtin_nontemporal_load((const u32x2*)(zg_ + (size_t)(tt_ * 16 + fr_) * NZ + (2 * hi_ + i_) * 16 + 4 * fq_)); } while (0)
    auto rt_entry = [&]() __attribute__((always_inline)) {
        const int fr = F.lane & 15, fq = F.lane >> 4; const float* sg = (const float*)(F.ws + WS_RSP) + (size_t)(bh * 16 + seg) * 4096 + ((F.wave & 3) * 16 + fr) * 64 + (2 * (F.wave >> 2)) * 16 + 4 * fq;
        rS[0] = *(const f32x4*)sg; rS[1] = *(const f32x4*)(sg + 16);
        rt_issue<true>(F, b, 8 * seg, h, rraw); RT_GATES(8 * seg); };
    auto gd_entry = [&]() __attribute__((always_inline)) {
        const int fr = F.lane & 15, fq = F.lane >> 4; const float* ss = (const float*)(F.ws + WS_GSS) + (size_t)(bh * 16 + seg) * 4096 + ((F.wave & 3) * 16 + fr) * 64 + 4 * fq;
#pragma unroll
        for (int i = 0; i < 4; ++i) gS[i] = *(const f32x4*)(ss + i * 16);
        gdn3_issue(F, b, 8 * seg, h, bh * 128 + 8 * seg, gring[0]); gdn3_gates(F, b, 8 * seg, h, ggate[0]); gdn3_gates(F, b, 8 * seg + 1, h, ggate[1]); };
    {
      f32x4 S[8]; bf16x8 sfd[4][4]; u32x2 gw[4];
      { const int fr = F.lane & 15, fq = F.lane >> 4; const float* sg = (const float*)(F.ws + WS_HSP) + (size_t)(bh * 16 + seg) * 16384 + (F.wave * 16 + fr) * 128 + 4 * fq;
#pragma unroll
        for (int i = 0; i < 8; ++i) S[i] = *(const f32x4*)(sg + 16 * i); }
#define HG_GATES(n_) do { const int fr_ = F.lane & 15, fq_ = F.lane >> 4, tt_ = F.wave & 3, hi_ = F.wave >> 2; const bf16* zg_ = (const bf16*)(F.ws + WS_R1) + (size_t)(b * SEQ + (n_) * 64) * NZ + 1536 + h * 128; \
        _Pragma("unroll") for (int i_ = 0; i_ < 4; ++i_) gw[i_] = __builtin_nontemporal_load((const u32x2*)(zg_ + (size_t)(tt_ * 16 + fr_) * NZ + (4 * hi_ + i_) * 16 + 4 * fq_)); } while (0)
      HgRaw raw; hg_issue<true>(F, b, 8 * seg, h, raw); HG_GATES(8 * seg);
      auto hg_chunk = [&](int k, auto next_issue, auto next_gates) __attribute__((always_inline)) { LAUNDER(); const int n = 8 * seg + k;
        { LAS bf16* STL = (LAS bf16*)(F.lds + GL_STL); const int fr = F.lane & 15, fq = F.lane >> 4;
#pragma unroll
          for (int i = 0; i < 8; ++i) { u32x2 w; w.x = pk2(S[i][0], S[i][1]); w.y = pk2(S[i][2], S[i][3]); *(LAS u32x2*)(STL + (F.wave * 16 + fr) * 136 + 16 * i + 4 * fq) = w; } }
        const HgRaw cur = raw;
        next_issue(n);
        hg_prep<2>(F, l, h, cur);
        gla_m3_mma<128, 128, true, GL_STL>(F, sfd, gw, (const LAS float*)(F.lds + GL_GNH), (bf16*)(F.ws + WS_OMIX) + (size_t)(b * SEQ + n * 64) * 1024 + h * 128, [&]() {});
        next_gates(n);
        { f32x4 kv[8]; hg_kv_acc(F, kv);
          const LAS float* DECL = (const LAS float*)(F.lds + GL_DECL); const int fq = F.lane >> 4;
#pragma unroll
          for (int i = 0; i < 8; ++i) S[i] = S[i] * *(const LAS f32x4*)(DECL + 16 * i + 4 * fq) + kv[i]; }
        lds_barrier(); };
      for (int k = 0; k < 7; ++k) hg_chunk(k, [&](int n) __attribute__((always_inline)) { hg_issue<true>(F, b, n + 1, h, raw); }, [&](int n) __attribute__((always_inline)) { HG_GATES(n + 1); });
      hg_chunk(7, [&](int) __attribute__((always_inline)) { rt_entry(); }, [&](int) __attribute__((always_inline)) {});
#undef HG_GATES
    }
    {
      const float dec = __expf(64.0f * log1pf(-exp2f(-5.0f - (float)h)));
      bf16x8 sfd[2][2];
      auto rt_chunk = [&](int k, auto next_issue, auto next_gates) __attribute__((always_inline)) { LAUNDER(); const int n = 8 * seg + k;
        { LAS bf16* STL = (LAS bf16*)(F.lds + GL_RSTL); const int fr = F.lane & 15, fq = F.lane >> 4;
#pragma unroll
          for (int i = 0; i < 2; ++i) { u32x2 w; w.x = pk2(rS[i][0], rS[i][1]); w.y = pk2(rS[i][2], rS[i][3]); *(LAS u32x2*)(STL + ((F.wave & 3) * 16 + fr) * 72 + (2 * (F.wave >> 2) + i) * 16 + 4 * fq) = w; } }
        rt_stage<true>(F, rraw); lds_barrier();
        next_issue(n);
        rt_prep<2>(F, n, h);
        gla_m3_mma<64, 64, true, GL_RSTL>(F, sfd, rgw, (const LAS float*)(F.lds + GL_GNR), (bf16*)(F.ws + WS_OMIX) + (size_t)(b * SEQ + n * 64) * 1024 + 512 + h * 64, [&]() {});
        next_gates(n);
        { f32x4 kv[2]; rt_kv_acc(F, kv);
          rS[0] = rS[0] * dec + kv[0]; rS[1] = rS[1] * dec + kv[1]; }
        lds_barrier(); };
      for (int k = 0; k < 7; ++k) rt_chunk(k, [&](int n) __attribute__((always_inline)) { rt_issue<true>(F, b, n + 1, h, rraw); }, [&](int n) __attribute__((always_inline)) { RT_GATES(n + 1); });
      rt_chunk(7, [&](int) __attribute__((always_inline)) { gd_entry(); }, [&](int) __attribute__((always_inline)) {});
    }
#undef RT_GATES
    {
#pragma unroll
      for (int k = 0; k < 8; ++k) { LAUNDER(); const int n = 8 * seg + k;
        if (k + 1 < 8) gdn3_issue(F, b, n + 1, h, bh * 128 + n + 1, gring[(k + 1) & 1]);
        if (k + 2 < 8) gdn3_gates(F, b, n + 2, h, ggate[(k + 2) % 3]);
        gdn_m3(F, l, b, n, h, gring[k & 1], ggate[k % 3], gS); } }
}

constexpr int RT_LDW = 520;
constexpr int RT_WH = 0, RT_WL = 32 * RT_LDW * 2, RT_GV = 2 * 32 * RT_LDW * 2, RT_SH = RT_GV + 4096, RT_CB = RT_SH + 4096, RT_CP = RT_CB + 128;
__device__ __forceinline__ void phase_norm2_route(Frame& F, int l) {
    LAS bf16* WH = (LAS bf16*)(F.lds + RT_WH); LAS bf16* WL = (LAS bf16*)(F.lds + RT_WL);
    LAS float* GV = (LAS float*)(F.lds + RT_GV); LAS float* SHV = (LAS float*)(F.lds + RT_SH); LAS float* CB = (LAS float*)(F.lds + RT_CB); LAS float* CP = (LAS float*)(F.lds + RT_CP);
    LAS int* lcnt = (LAS int*)(F.lds + LDS_SM); LAS int* lbase = lcnt + 32; LAS int* le = lcnt + 64; LAS int* ls = le + 512;
    const float* rw = pin(F, I_RW) + (size_t)l * 1024 * 32;
    const float* mod = (const float*)(F.ws + WS_MOD);
    const bf16* xa = (const bf16*)(F.ws + WS_XA);
    int* re = (int*)(F.ws + WS_RE); int* rs = (int*)(F.ws + WS_RS); float* rg = (float*)(F.ws + WS_RG);
    unsigned* cnt = F.ctl + CW_CNT + l * 64;
    for (int rb0 = F.bid; rb0 < NTOK / 128; rb0 += F.G) {
        int ln_ = F.lane; asm volatile("" : "+v"(ln_));
        const int fr = ln_ & 15, fq = ln_ >> 4;
        const int bb = (rb0 * 128) >> 13;
        const float* mp = mod + (size_t)(l * 4 + bb) * 6144;
        const int row = rb0 * 128 + F.wave * 16 + fr;
        bf16x8 xf[32];
#pragma unroll
        for (int ks = 0; ks < 32; ++ks) xf[ks] = *(const bf16x8*)(xa + (size_t)row * 1024 + 32 * ks + 8 * fq);
        if (F.tid < 32) lcnt[F.tid] = 0;
        for (int k = F.tid; k < 1024; k += 512) { GV[k] = pin(F, I_N2G)[l * 1024 + k] * (1.0f + mp[4096 + k]); SHV[k] = mp[3072 + k]; }
        lds_barrier();
        { const int e = F.tid & 31, part = F.tid >> 5; float s = 0.f;
#pragma unroll 8
          for (int k = part * 64; k < part * 64 + 64; ++k) s += SHV[k] * rw[k * 32 + e];
          CP[part * 32 + e] = s; }
        f32x4 acc[2] = {(f32x4){0.f, 0.f, 0.f, 0.f}, (f32x4){0.f, 0.f, 0.f, 0.f}};
#pragma unroll
        for (int hk = 0; hk < 2; ++hk) {
#pragma unroll 4
            for (int idx = F.tid; idx < 512 * 32; idx += 512) { const int k = idx >> 5, e = idx & 31;
                const float w = rw[(size_t)(512 * hk + k) * 32 + e] * GV[512 * hk + k]; const unsigned hb = f2bf(w); const float lo = w - bflo(hb);
                WH[e * RT_LDW + k] = (bf16)hb; WL[e * RT_LDW + k] = (bf16)f2bf(lo); }
            lds_barrier();
#pragma unroll
            for (int ks = 0; ks < 16; ++ks) {
                const bf16x8 y = xf[16 * hk + ks];
#pragma unroll
                for (int n = 0; n < 2; ++n) { acc[n] = MFMA16(lfrag(WH, RT_LDW, 16 * n + fr, 32 * ks + 8 * fq), y, acc[n]); acc[n] = MFMA16(lfrag(WL, RT_LDW, 16 * n + fr, 32 * ks + 8 * fq), y, acc[n]); } }
            lds_barrier();
        }
        if (F.tid < 32) { float s = pin(F, I_RB)[l * 32 + F.tid];
#pragma unroll
            for (int pz = 0; pz < 16; ++pz) s += CP[pz * 32 + F.tid];
            CB[F.tid] = s; }
        float ss = 0.f;
#pragma unroll
        for (int ks = 0; ks < 32; ++ks) { const u32x4 w = __builtin_bit_cast(u32x4, xf[ks]);
            const float a0 = bflo(w.x), a1 = bfhi(w.x), a2 = bflo(w.y), a3 = bfhi(w.y), a4 = bflo(w.z), a5 = bfhi(w.z), a6 = bflo(w.w), a7 = bfhi(w.w);
            ss += ((a0 * a0 + a1 * a1) + (a2 * a2 + a3 * a3)) + ((a4 * a4 + a5 * a5) + (a6 * a6 + a7 * a7)); }
        ss += shx(ss, 16, ln_); ss += shx(ss, 32, ln_);
        const float rinv = rsqrtf(ss * (1.0f / 1024.0f) + NORM_EPS);
        lds_barrier();
        float lg[8];
#pragma unroll
        for (int n = 0; n < 2; ++n)
#pragma unroll
            for (int j = 0; j < 4; ++j) lg[4 * n + j] = acc[n][j] * rinv + CB[16 * n + 4 * fq + j];
        int te[4]; float tv[4];
#pragma unroll
        for (int k = 0; k < 4; ++k) { float best = -3.0e38f; int bi = 0;
#pragma unroll
            for (int i = 0; i < 8; ++i) { const int e = 16 * (i >> 2) + 4 * fq + (i & 3); if (lg[i] > best) { best = lg[i]; bi = e; } }
#pragma unroll
            for (int o = 16; o <= 32; o <<= 1) { const float ob = shx(best, o, ln_); const int oi = shxi(bi, o, ln_); if (ob > best || (ob == best && oi < bi)) { best = ob; bi = oi; } }
#pragma unroll
            for (int i = 0; i < 8; ++i) { const int e = 16 * (i >> 2) + 4 * fq + (i & 3); lg[i] = (e == bi) ? -3.0e38f : lg[i]; }
            te[k] = bi; tv[k] = best; }
        { const float e1 = __expf(tv[1] - tv[0]), e2 = __expf(tv[2] - tv[0]), e3 = __expf(tv[3] - tv[0]), inv = 1.0f / (1.0f + e1 + e2 + e3);
          if (fq == 0) { const int lr = F.wave * 16 + fr;
              *(f32x4*)(rg + (size_t)row * 4) = (f32x4){inv, e1 * inv, e2 * inv, e3 * inv};
#pragma unroll
              for (int k = 0; k < 4; ++k) { le[lr * 4 + k] = te[k]; ls[lr * 4 + k] = atomicAdd((int*)&lcnt[te[k]], 1); } } }
        { unsigned char* hrow = F.ws + WS_HN + (size_t)row * 1024;
#pragma unroll
          for (int ks = 0; ks < 32; ++ks) { u32x4 w = __builtin_bit_cast(u32x4, xf[ks]); asm volatile("" : "+v"(w)); const int k0 = 32 * ks + 8 * fq;
              const f32x4 g0 = *(const LAS f32x4*)(GV + k0), g1 = *(const LAS f32x4*)(GV + k0 + 4), s0 = *(const LAS f32x4*)(SHV + k0), s1 = *(const LAS f32x4*)(SHV + k0 + 4);
              u32x2 o; o.x = pk4_fp8(bflo(w.x) * rinv * g0[0] + s0[0], bfhi(w.x) * rinv * g0[1] + s0[1], bflo(w.y) * rinv * g0[2] + s0[2], bfhi(w.y) * rinv * g0[3] + s0[3]);
              o.y = pk4_fp8(bflo(w.z) * rinv * g1[0] + s1[0], bfhi(w.z) * rinv * g1[1] + s1[1], bflo(w.w) * rinv * g1[2] + s1[2], bfhi(w.w) * rinv * g1[3] + s1[3]);
              *(u32x2*)(hrow + k0) = o; } }
        lds_barrier();
        if (F.tid < 32) lbase[F.tid] = (int)__hip_atomic_fetch_add(cnt + F.tid, (unsigned)lcnt[F.tid], __ATOMIC_RELAXED, __HIP_MEMORY_SCOPE_AGENT);
        lds_barrier();
        { const int i = F.tid, e = le[i], sl = lbase[e] + ls[i]; re[(size_t)rb0 * 512 + i] = e; rs[(size_t)rb0 * 512 + i] = sl; ((int*)(F.ws + WS_TOKE))[e * NTOK + sl] = rb0 * 128 + (i >> 2); }
        lds_barrier();
    }
}

__device__ __forceinline__ void build_rt(Frame& F, int l) {
    LAS int* rt_e = (LAS int*)(F.lds + LDS_RT); LAS int* off = rt_e + 608; LAS int* cn = off + 32;
    if (F.tid < 64) {
        const int e = F.lane, c = (e < 32) ? (int)F.ctl[CW_CNT + l * 64 + e] : 0, t = (c + 255) >> 8;
        const int incl = (int)wave_scan_incl((float)t, F.lane), n0 = incl - t;
        if (e < 32) { off[e] = n0 * 256; cn[e] = c; for (int i = 0; i < t; ++i) rt_e[n0 + i] = e; }
        if (e == 31) rt_e[600] = incl; }
    __syncthreads();
}
__device__ __forceinline__ void phase_gather(Frame& F, int l) {
    build_rt(F, l);
    const LAS int* rt_e = (const LAS int*)(F.lds + LDS_RT); const LAS int* off = rt_e + 608; const LAS int* cn = off + 32;
    const int* re = (const int*)(F.ws + WS_RE); int* rs = (int*)(F.ws + WS_RS); int* tok = (int*)(F.ws + WS_TOK);
    for (int i = F.bid * 512 + F.tid; i < NTOK * 4; i += F.G * 512) { const int pos = off[re[i]] + rs[i]; rs[i] = pos; tok[pos] = i >> 2; }
    for (int e = F.bid; e < 32; e += F.G) { const int c = cn[e], r0 = off[e] + c, r1 = off[e] + ((c + 255) >> 8) * 256;
        for (int r = r0 + F.tid; r < r1; r += 512) tok[r] = 0; }
}

__device__ __forceinline__ void phase_combine(Frame& F, int l) {
    LAS float* w8t = (LAS float*)F.lds;
    LAS float* G2 = (LAS float*)(F.lds + 32768); LAS float* GS = G2 + 1024; LAS float* SH = GS + 1024;
    const float* mod = (const float*)(F.ws + WS_MOD);
    const int gw = F.bid * 8 + F.wave, NGW = F.G * 8, RPW = NTOK / NGW, row0 = gw * RPW, rend = row0 + RPW;
    bf16* xa = (bf16*)(F.ws + WS_XA);
    const int* rs = (const int*)(F.ws + WS_RS); const int* re = (const int*)(F.ws + WS_RE); const float* rg = (const float*)(F.ws + WS_RG);
    const LAS int* offl = (const LAS int*)(F.lds + LDS_RT) + 608;
    const unsigned char* y = F.ws + WS_R1;
    int4 ren2;
    u32x2 vn[4]; int4 posn, posn2; f32x4 ggn, ggn2; unsigned yn[4][4];
    { const u32x2* xr0 = (const u32x2*)(xa + (size_t)row0 * 1024) + F.lane;
#pragma unroll
      for (int j = 0; j < 4; ++j) vn[j] = xr0[64 * j];
      posn = *(const int4*)(rs + (size_t)row0 * 4); ggn = *(const f32x4*)(rg + (size_t)row0 * 4); const int4 ren = *(const int4*)(re + (size_t)row0 * 4);
      { const size_t r2 = (row0 + 1 < rend) ? (size_t)(row0 + 1) : (size_t)row0; posn2 = *(const int4*)(rs + r2 * 4); ggn2 = *(const f32x4*)(rg + r2 * 4); ren2 = *(const int4*)(re + r2 * 4); }
      const int pk0[4] = {offl[ren.x] + posn.x, offl[ren.y] + posn.y, offl[ren.z] + posn.z, offl[ren.w] + posn.w};
#pragma unroll
      for (int k = 0; k < 4; ++k) { const unsigned* yr = (const unsigned*)(y + (size_t)pk0[k] * 1024) + F.lane;
#pragma unroll
          for (int j = 0; j < 4; ++j) yn[k][j] = __builtin_nontemporal_load(yr + 64 * j); } }
    if (l + 1 < DEPTH) load_w8t(F, l + 1, w8t);
    if (F.tid < 256) { const int bb = (F.bid * 8 * RPW) >> 13, col = 4 * F.tid;
        const float* mp = mod + (size_t)(l * 4 + bb) * 6144; const float* mq = mod + (size_t)(((l + 1 < DEPTH) ? l + 1 : l) * 4 + bb) * 6144;
        *(LAS f32x4*)(G2 + col) = *(const f32x4*)(mp + 5120 + col);
        if (l + 1 < DEPTH) { *(LAS f32x4*)(GS + col) = *(const f32x4*)(pin(F, I_N1G) + (l + 1) * 1024 + col) * (*(const f32x4*)(mq + 1024 + col) + 1.0f); *(LAS f32x4*)(SH + col) = *(const f32x4*)(mq + col); }
        else *(LAS f32x4*)(GS + col) = *(const f32x4*)(pin(F, I_FNG) + col); }
    lds_barrier();
#pragma unroll 1
    for (int row = row0; row < rend; ++row) {
        u32x2* xr = (u32x2*)(xa + (size_t)row * 1024) + F.lane;
        int ml = 4 * F.lane; asm volatile("" : "+v"(ml));
        f32x4 v[4], a[4]; unsigned yc[4][4];
#pragma unroll
        for (int j = 0; j < 4; ++j) { v[j] = unpack4(vn[j]); a[j] = (f32x4){0.f, 0.f, 0.f, 0.f}; }
        const f32x4 gg = ggn;
#pragma unroll
        for (int k = 0; k < 4; ++k)
#pragma unroll
            for (int j = 0; j < 4; ++j) yc[k][j] = yn[k][j];
        const bool more = row + 1 < rend;
        if (more) { const u32x2* xr2 = (const u32x2*)(xa + (size_t)(row + 1) * 1024) + F.lane;
#pragma unroll
            for (int j = 0; j < 4; ++j) vn[j] = xr2[64 * j];
            const int pk2_[4] = {offl[ren2.x] + posn2.x, offl[ren2.y] + posn2.y, offl[ren2.z] + posn2.z, offl[ren2.w] + posn2.w};
#pragma unroll
            for (int k = 0; k < 4; ++k) { const unsigned* yr = (const unsigned*)(y + (size_t)pk2_[k] * 1024) + F.lane;
#pragma unroll
                for (int j = 0; j < 4; ++j) yn[k][j] = __builtin_nontemporal_load(yr + 64 * j); }
            ggn = ggn2;
            { const size_t r3 = (row + 2 < rend) ? (size_t)(row + 2) : (size_t)row; posn2 = *(const int4*)(rs + r3 * 4); ggn2 = *(const f32x4*)(rg + r3 * 4); ren2 = *(const int4*)(re + r3 * 4); } }
        const float gk[4] = {gg.x, gg.y, gg.z, gg.w};
#pragma unroll
        for (int k = 0; k < 4; ++k)
#pragma unroll
            for (int j = 0; j < 4; ++j) a[j] += unpack4_fp8(yc[k][j]) * gk[k];
        float ss = 0.f;
#pragma unroll
        for (int j = 0; j < 4; ++j) { v[j] = v[j] + *(const LAS f32x4*)(G2 + 256 * j + ml) * a[j]; ss += (v[j].x * v[j].x + v[j].y * v[j].y) + (v[j].z * v[j].z + v[j].w * v[j].w); }
        const float r = rsqrtf(wave_sum(ss) * (1.0f / 1024.0f) + NORM_EPS);
        if (l + 1 < DEPTH) {
            f32x4 h[4]; bf16* hrow = (bf16*)(F.ws + WS_HN) + (size_t)row * 1024;
#pragma unroll
            for (int j = 0; j < 4; ++j) { u32x2 w; w.x = pk2(v[j].x, v[j].y); w.y = pk2(v[j].z, v[j].w); xr[64 * j] = w;
                h[j] = (v[j] * r) * *(const LAS f32x4*)(GS + 256 * j + ml) + *(const LAS f32x4*)(SH + 256 * j + ml);
                u32x2 w2; w2.x = pk2(h[j].x, h[j].y); w2.y = pk2(h[j].z, h[j].w); *(u32x2*)(hrow + 256 * j + 4 * F.lane) = w2; }
            emit_gab(h, w8t, (float*)(F.ws + WS_GAB) + (size_t)row * 8, F.lane);
        } else {
            f32x4* orow = (f32x4*)(pout(F) + (size_t)row * 1024) + F.lane;
#pragma unroll
            for (int j = 0; j < 4; ++j) orow[64 * j] = (v[j] * r) * *(const LAS f32x4*)(GS + 256 * j + ml);
        }
    }
    __syncthreads();
}

#define PHASE __device__ __forceinline__ void
PHASE ph_prologue(int w0) { Frame F = make_frame(w0); phase0(F); }
PHASE ph_norm1_first(int w0) { Frame F = make_frame(w0); phase_norm1_first(F); }
PHASE ph_gemm_in(int w0, int l_) { Frame F = make_frame(w0); const int l = __builtin_amdgcn_readfirstlane(l_);
    pg8::DenseOrder S; S.init(F.ws + WS_HN, (bf16*)(F.ws + WS_WIN) + (size_t)l * NZ * 1024, NTOK, NZ, F.G, F.bid);
    pg8::EpiZ E{(bf16*)(F.ws + WS_R1), NZ};
    pg8::gemm_phase<pg8::EpiZ, pg8::DenseOrder>(F.lds, S, E, pg8::HSTEP, F.wave0); }
PHASE ph_mix(int w0, int l_) { Frame F = make_frame(w0); const int l = __builtin_amdgcn_readfirstlane(l_); phase_mix_naive(F, l); }
PHASE ph_mix_m1(int w0, int l_) { Frame F = make_frame(w0); const int l = __builtin_amdgcn_readfirstlane(l_); phase_mix_m1(F, l); }
PHASE ph_mix_m2a(int w0, int l_) { Frame F = make_frame(w0); const int l = __builtin_amdgcn_readfirstlane(l_); phase_mix_m2a(F, l); }
PHASE ph_mix_m2b(int w0, int l_) { Frame F = make_frame(w0); const int l = __builtin_amdgcn_readfirstlane(l_); phase_mix_m2b(F, l); }
PHASE ph_mix_m3(int w0, int l_) { Frame F = make_frame(w0); const int l = __builtin_amdgcn_readfirstlane(l_); phase_mix_m3(F, l); }
PHASE ph_gemm_out(int w0, int l_) { Frame F = make_frame(w0); const int l = __builtin_amdgcn_readfirstlane(l_);
    const float* mod = (const float*)(F.ws + WS_MOD);
    pg8::DenseOrder S; S.init(F.ws + WS_OMIX, (bf16*)(F.ws + WS_WOUT) + (size_t)l * 1024 * 1024, NTOK, 1024, F.G, F.bid);
    if (l == 0) { pg8::EpiXres<false> E{(const void*)pin(F, I_X), (bf16*)(F.ws + WS_XA), mod + 2048};
        pg8::gemm_phase<pg8::EpiXres<false>, pg8::DenseOrder>(F.lds, S, E, pg8::HSTEP, F.wave0); }
    else { pg8::EpiXres<true> E{(const void*)(F.ws + WS_XA), (bf16*)(F.ws + WS_XA), mod + (size_t)l * 4 * 6144 + 2048};
        pg8::gemm_phase<pg8::EpiXres<true>, pg8::DenseOrder>(F.lds, S, E, pg8::HSTEP, F.wave0); } }
PHASE ph_route(int w0, int l_) { Frame F = make_frame(w0); const int l = __builtin_amdgcn_readfirstlane(l_); phase_norm2_route(F, l); }
PHASE ph_gather(int w0, int l_) { Frame F = make_frame(w0); const int l = __builtin_amdgcn_readfirstlane(l_); phase_gather(F, l); }
PHASE ph_moe_up(int w0, int l_) { Frame F = make_frame(w0); const int l = __builtin_amdgcn_readfirstlane(l_);
    build_rt(F, l);
    const LAS int* rt_e = (const LAS int*)(F.lds + LDS_RT); const int nrt = __builtin_amdgcn_readfirstlane(rt_e[600]);
    pg8::MoeOrder S; S.A = (const char*)(F.ws + WS_HN); S.gather = true; S.atstep = 0; S.Bt = (const char*)(F.ws + WS_W1 + (size_t)l * 32 * 2048 * 1024); S.nct = 8; S.nrt = nrt; S.ntot = nrt * 8; S.G = F.G; S.c = F.bid;
    S.estride = (size_t)2048 * 1024; S.ctstep = (size_t)128 * 1024; S.rt_e = rt_e;
    pg8::EpiAct E{F.ws + WS_R2, pin(F, I_B1) + (size_t)l * 32 * 2048};
    pg8::gemm_phase<pg8::EpiAct, pg8::MoeOrder, true, true>(F.lds, S, E, (size_t)1024 * 1024, F.wave0, (const int*)(F.ws + WS_TOKE)); }
PHASE ph_moe_down(int w0, int l_) { Frame F = make_frame(w0); const int l = __builtin_amdgcn_readfirstlane(l_);
    const LAS int* rt_e = (const LAS int*)(F.lds + LDS_RT); const int nrt = __builtin_amdgcn_readfirstlane(rt_e[600]);
    pg8::MoeOrder S; S.A = (const char*)(F.ws + WS_R2); S.gather = false; S.atstep = (size_t)256 * 1024; S.Bt = (const char*)(F.ws + WS_W2 + (size_t)l * 32 * 1024 * 1024); S.nct = 4; S.nrt = nrt; S.ntot = nrt * 4; S.G = F.G; S.c = F.bid;
    S.estride = (size_t)1024 * 1024; S.ctstep = (size_t)256 * 1024; S.rt_e = rt_e;
    pg8::EpiY E{F.ws + WS_R1, pin(F, I_B2) + (size_t)l * 32 * 1024};
    pg8::gemm_phase<pg8::EpiY, pg8::MoeOrder, false, true>(F.lds, S, E, (size_t)128 * 1024, F.wave0); }
PHASE ph_combine(int w0, int l_) { Frame F = make_frame(w0); const int l = __builtin_amdgcn_readfirstlane(l_); phase_combine(F, l); }

__global__ void __launch_bounds__(512, 2) fwd(Params p) {
    LAS unsigned char* lds = (LAS unsigned char*)lds_raw;
    const int tid = threadIdx.x;
    for (int u = tid; u < (LDS_BYTES - LDSCTL_OFF) / 4; u += 512) ((LAS unsigned*)(lds + LDSCTL_OFF))[u] = 0u;
    __syncthreads();
    if (tid == 0) {
        LAS unsigned long long* P = (LAS unsigned long long*)(lds + LDS_PAR);
#pragma unroll
        for (int i = 0; i < 22; ++i) P[i] = (unsigned long long)p.in[i];
        P[22] = (unsigned long long)p.out; P[23] = (unsigned long long)p.ws;
    }
    __syncthreads();
    (void)xcd_barrier_post((unsigned*)(p.ws + WS_CTL) + CW_BAR, (volatile LAS unsigned*)(lds + MISC_OFF) + 8);
#define GRID_BAR() do { XcdBarrier b2_; unsigned long long bp_ = ldpar(lds, 23) + WS_CTL + 4ull * CW_BAR; asm volatile("" : "+s"(bp_)); b2_.bar = (unsigned*)(GAS unsigned*)bp_; b2_.x = xb_xcc_id(); b2_.st = (volatile LAS unsigned*)(lds + MISC_OFF) + 8; xcd_barrier(b2_); } while (0)
    const int w0 = __builtin_amdgcn_readfirstlane(tid >> 6);
#ifndef DBL_P0
#define DBL_P0 1
#endif
    for (int r_ = 0; r_ < DBL_P0; ++r_) { ph_prologue(w0); GRID_BAR(); }
    ph_norm1_first(w0); GRID_BAR();
#ifndef DBL_GIN
#define DBL_GIN 1
#endif
#define DBL_M1 1
#define DBL_M2 1
#define DBL_M3 1
#ifndef DBL_MOE
#define DBL_MOE 1
#endif
#define LAYER(l) do { for (int r_ = 0; r_ < DBL_GIN; ++r_) { ph_gemm_in(w0, l); GRID_BAR(); } \
        for (int r_ = 0; r_ < DBL_M1; ++r_) { ph_mix_m1(w0, l); GRID_BAR(); } for (int r_ = 0; r_ < DBL_M2; ++r_) { ph_mix_m2b(w0, l); GRID_BAR(); } for (int r_ = 0; r_ < DBL_M3; ++r_) { ph_mix_m3(w0, l); GRID_BAR(); } \
        ph_gemm_out(w0, l); GRID_BAR(); ph_route(w0, l); GRID_BAR(); \
        for (int r_ = 0; r_ < DBL_MOE; ++r_) { ph_moe_up(w0, l); GRID_BAR(); } for (int r_ = 0; r_ < DBL_MOE; ++r_) { ph_moe_down(w0, l); GRID_BAR(); } ph_combine(w0, l); } while (0)
    LAYER(0); GRID_BAR();
    LAYER(1);
}

extern "C" void kernel_launch(void* const* d_in, const int* in_sizes, int n_in, void* d_out, int out_size, void* d_ws, size_t ws_size, hipStream_t stream) {
    static int grid = 0;
    if (grid == 0) {
        if (n_in != 22 || out_size != NTOK * D || ws_size < WS_END) { fprintf(stderr, "kernel_launch: unexpected shapes (n_in %d out %d ws %zu need %zu)\n", n_in, out_size, ws_size, (size_t)WS_END); grid = -1; return; }
        int dev = 0, cus = 0, per_cu = 0;
        if (hipGetDevice(&dev) != hipSuccess || hipDeviceGetAttribute(&cus, hipDeviceAttributeMultiprocessorCount, dev) != hipSuccess) { grid = -1; return; }
        if (hipFuncSetAttribute((const void*)fwd, hipFuncAttributeMaxDynamicSharedMemorySize, LDS_BYTES) != hipSuccess) { fprintf(stderr, "kernel_launch: hipFuncSetAttribute failed\n"); grid = -1; return; }
        if (hipOccupancyMaxActiveBlocksPerMultiprocessor(&per_cu, (const void*)fwd, 512, LDS_BYTES) != hipSuccess || per_cu < 1) fprintf(stderr, "kernel_launch: occupancy query reports %d\n", per_cu);
        (void)hipGetLastError();
        grid = cus;
    }
    if (grid < 0) return;
    if (hipMemsetAsync((char*)d_ws + WS_CTL, 0, CTL_ZERO_BYTES, stream) != hipSuccess) return;
    Params p{};
    for (int i = 0; i < 22; ++i) p.in[i] = (const float*)d_in[i];
    p.out = (float*)d_out; p.ws = (unsigned char*)d_ws;
    hipLaunchKernelGGL(fwd, dim3(grid), dim3(512), LDS_BYTES, stream, p);
}
```

```cpp
#include <hip/hip_runtime.h>
#include <cstdio>
#include <cstdint>

#define GAS __attribute__((address_space(1)))
#define LAS __attribute__((address_space(3)))
typedef unsigned short bf16;
typedef short bf16x8 __attribute__((ext_vector_type(8)));
typedef float f32x4 __attribute__((ext_vector_type(4)));
typedef float f32x2 __attribute__((ext_vector_type(2)));
typedef unsigned u32x4 __attribute__((ext_vector_type(4)));
typedef unsigned u32x2 __attribute__((ext_vector_type(2)));

constexpr int D = 1024, BATCH = 4, SEQ = 8192, NTOK = BATCH * SEQ, DEPTH = 2;
constexpr int NIN = 4104, NZ = 4096, NE = 32, TOPK = 4, FF = 1024;
constexpr int NROWS_S = NTOK * TOPK + NE * 256;
constexpr float NORM_EPS = 1e-6f;

constexpr size_t MiB = 1u << 20;
constexpr size_t WS_CTL = 0, CTL_ZERO_BYTES = 1 * MiB;
constexpr size_t WS_MOD = 1 * MiB;
constexpr size_t WS_LB = WS_MOD + 256 * 1024;
constexpr size_t WS_ROPE = WS_LB + 8192;
constexpr size_t WS_WIN = 2 * MiB;
constexpr size_t WS_WOUT = WS_WIN + 16 * MiB;
constexpr size_t WS_W1 = WS_WOUT + 4 * MiB;
constexpr size_t WS_W2 = WS_W1 + 256 * MiB;
constexpr size_t WS_XA = WS_W2 + 128 * MiB;
constexpr size_t WS_HN = WS_XA + 128 * MiB;
constexpr size_t WS_OMIX = WS_HN + 64 * MiB;
constexpr size_t WS_GAB = WS_OMIX + 64 * MiB;
constexpr size_t WS_RE = WS_GAB + 1 * MiB;
constexpr size_t WS_RS = WS_RE + 512 * 1024;
constexpr size_t WS_RG = WS_RS + 512 * 1024;
constexpr size_t WS_TOK = WS_RG + 512 * 1024;
constexpr size_t WS_R1 = WS_TOK + 1 * MiB;
constexpr size_t WS_R2 = WS_R1 + 272 * MiB;
constexpr size_t WS_HKV = WS_R2 + 272 * MiB;
constexpr size_t WS_HDEC = WS_HKV + 128 * MiB;
constexpr size_t WS_HSP = WS_HDEC + 1 * MiB;
constexpr size_t WS_RKV = WS_HSP + 64 * MiB;
constexpr size_t WS_RSP = WS_RKV + 32 * MiB;
constexpr size_t WS_GT = WS_RSP + 16 * MiB;
constexpr size_t WS_GUT = WS_GT + 16 * MiB;
constexpr size_t WS_GKC = WS_GUT + 32 * MiB;
constexpr size_t WS_GWT = WS_GKC + 16 * MiB;
constexpr size_t WS_GQK = WS_GWT + 16 * MiB;
constexpr size_t WS_GQD = WS_GQK + 16 * MiB;
constexpr size_t WS_GSP = WS_GQD + 16 * MiB;
constexpr size_t WS_TOKE = WS_GSP;
constexpr size_t WS_GPG = WS_GSP + 16 * MiB;
constexpr size_t WS_GQG = WS_GPG + 2 * MiB;
constexpr size_t WS_GSS = WS_GQG + 2 * MiB;
constexpr size_t WS_END = WS_GSS + 4 * MiB;
constexpr int CW_BAR = 4096;
constexpr int CW_PAN = 65536, PAN_LAYER = 544 * 64;
constexpr int CW_UPFIN = 16384 + 256;
constexpr int CW_CNT = 16384;

constexpr int RING_BYTES = 131072;
constexpr int LDSCTL_OFF = RING_BYTES, MISC_OFF = LDSCTL_OFF + 320;
constexpr int LDS_RT = LDSCTL_OFF + 1024;
constexpr int LDS_SM = LDSCTL_OFF + 4096;
constexpr int LDS_BYTES = 147456;

#define LDS_WAIT() asm volatile("s_waitcnt lgkmcnt(0)" ::: "memory")
__device__ __forceinline__ void lds_barrier() { asm volatile("s_waitcnt lgkmcnt(0)" ::: "memory"); __builtin_amdgcn_s_barrier(); asm volatile("" ::: "memory"); }
#define VM_WAIT() asm volatile("s_waitcnt vmcnt(0)" ::: "memory")
__device__ __forceinline__ void wt_store128(void* base, int off, u32x4 w) { __builtin_amdgcn_raw_buffer_store_b128(w, __builtin_amdgcn_make_buffer_rsrc(base, 0, 0x7fffffff, 0x00020000), off, 0, 16); }
__device__ __forceinline__ unsigned f2bf(float f) { unsigned u = __builtin_bit_cast(unsigned, f); return (u + 0x7fffu + ((u >> 16) & 1u)) >> 16; }
typedef __bf16 bf16x2_t __attribute__((ext_vector_type(2)));
__device__ __forceinline__ unsigned pk2(float lo, float hi) { return __builtin_bit_cast(unsigned, __builtin_convertvector((f32x2){lo, hi}, bf16x2_t)); }
__device__ __forceinline__ unsigned pk2m(float lo, float hi) { return pk2(lo, hi); }
typedef int i32x8 __attribute__((ext_vector_type(8)));
__device__ __forceinline__ unsigned pk4_fp8(float a, float b, float c, float d) {
    int w = __builtin_amdgcn_cvt_pk_fp8_f32(a, b, 0, false); w = __builtin_amdgcn_cvt_pk_fp8_f32(c, d, w, true); return (unsigned)w; }
constexpr float W8_SCALE = 64.0f, W8_INV = 1.0f / 64.0f;
__device__ __forceinline__ float bf2f(bf16 v) { return __builtin_bit_cast(float, ((unsigned)v) << 16); }
__device__ __forceinline__ float bflo(unsigned w) { return __builtin_bit_cast(float, w << 16); }
__device__ __forceinline__ float bfhi(unsigned w) { return __builtin_bit_cast(float, w & 0xffff0000u); }
#define DPP_ADD(x, ctrl, rmask) x += __builtin_bit_cast(float, __builtin_amdgcn_update_dpp(0, __builtin_bit_cast(int, x), ctrl, rmask, 0xf, false))
__device__ __forceinline__ float wave_scan_incl(float x, int lane) {
    (void)lane;
    DPP_ADD(x, 0x111, 0xf); DPP_ADD(x, 0x112, 0xf); DPP_ADD(x, 0x114, 0xf); DPP_ADD(x, 0x118, 0xf);
    DPP_ADD(x, 0x142, 0xa); DPP_ADD(x, 0x143, 0xc);
    return x;
}
__device__ __forceinline__ float wave_sum(float v) {
    return __builtin_bit_cast(float, __builtin_amdgcn_readlane(__builtin_bit_cast(int, wave_scan_incl(v, 0)), 63));
}
__device__ __forceinline__ float shx(float v, int o, int lane) { return __builtin_bit_cast(float, __builtin_amdgcn_ds_bpermute((lane ^ o) << 2, __builtin_bit_cast(int, v))); }
__device__ __forceinline__ int shxi(int v, int o, int lane) { return __builtin_amdgcn_ds_bpermute((lane ^ o) << 2, v); }
__device__ __forceinline__ float sigm(float x) { return __builtin_amdgcn_rcpf(1.0f + __expf(-x)); }
__device__ __forceinline__ float siluf(float x) { return x * sigm(x); }

#define XB_TMO      128
#define XB_XCNT(j)  (256  + 64 * (j))
#define XB_XSUB(j)  (1280 + 64 * (j))
#define XB_XGEN(j)  (2304 + 64 * (j))
#define XB_TOP      3328
#define XB_TOPGEN   3392
#define XCD_BAR_WORDS 3456
#define XB_SPIN_CAP (1u << 20)

__device__ __forceinline__ unsigned xb_ld(unsigned* p)              { return __hip_atomic_load(p, __ATOMIC_RELAXED, __HIP_MEMORY_SCOPE_AGENT); }
__device__ __forceinline__ unsigned xb_add(unsigned* p, unsigned v) { return __hip_atomic_fetch_add(p, v, __ATOMIC_RELAXED, __HIP_MEMORY_SCOPE_AGENT); }
__device__ __forceinline__ unsigned xb_xcc_id() { return (unsigned)__builtin_amdgcn_s_getreg((3 << 11) | 20) & 0xFu; }
#define XB_SPIN(cond, bar) do { unsigned _sp = 0; while (cond) { __builtin_amdgcn_s_sleep(1); \
    if ((++_sp & 255u) == 0u) { if (xb_ld(&(bar)[XB_TMO])) break; if (_sp > XB_SPIN_CAP) { atomicAdd(&(bar)[XB_TMO], 1u); break; } } } } while (0)

struct XcdBarrier { unsigned* bar; unsigned x; volatile LAS unsigned* st; };

__device__ __forceinline__ XcdBarrier xcd_barrier_post(unsigned* bar, volatile LAS unsigned* st) {
    XcdBarrier b; b.bar = bar; b.x = xb_xcc_id(); b.st = st;
    if (threadIdx.x == 0) (void)xb_add(&bar[XB_XCNT(b.x)], 1u);
    return b;
}
__device__ __forceinline__ void xcd_barrier_complete(unsigned* bar, unsigned x, unsigned& nloc, unsigned& nx) {
    const unsigned G = gridDim.x * gridDim.y * gridDim.z;
    unsigned sum, cnt, mine, sp = 0u;
    for (;;) {
        sum = 0u; cnt = 0u; mine = 0u;
#pragma unroll
        for (unsigned j = 0; j < 16; ++j) { const unsigned c = xb_ld(&bar[XB_XCNT(j)]); sum += c; cnt += (c > 0u) ? 1u : 0u; mine = (j == x) ? c : mine; }
        if (sum == G) break;
        __builtin_amdgcn_s_sleep(1);
        if ((++sp & 255u) == 0u) { if (xb_ld(&bar[XB_TMO])) break; if (sp > XB_SPIN_CAP) { atomicAdd(&bar[XB_TMO], 1u); break; } }
    }
    nloc = mine > 0u ? mine : 1u; nx = cnt > 0u ? cnt : 1u;
}
__device__ __forceinline__ void xcd_barrier(const XcdBarrier& b) {
    asm volatile("s_waitcnt vmcnt(0)" ::: "memory");
    __syncthreads();
    if (threadIdx.x == 0) {
        unsigned* bar = b.bar;
        __builtin_amdgcn_s_waitcnt(0);
        unsigned nloc = b.st[0], nx = b.st[1];
        if (nloc == 0u) { xcd_barrier_complete(bar, b.x, nloc, nx); b.st[0] = nloc; b.st[1] = nx; }
        const unsigned old = xb_add(&bar[XB_XSUB(b.x)], 1u);
        const unsigned gen = old / nloc;
        if (old + 1u == (gen + 1u) * nloc) {
            __builtin_amdgcn_fence(__ATOMIC_RELEASE, "agent");
            asm volatile("s_waitcnt vmcnt(0)" ::: "memory");
            const unsigned og = xb_add(&bar[XB_TOP], 1u);
            const unsigned tg = og / nx;
            if (og + 1u == (tg + 1u) * nx) xb_add(&bar[XB_TOPGEN], 1u);
            else XB_SPIN(xb_ld(&bar[XB_TOPGEN]) == tg, bar);
            __builtin_amdgcn_fence(__ATOMIC_ACQUIRE, "agent");
            xb_add(&bar[XB_XGEN(b.x)], 1u);
            asm volatile("s_waitcnt vmcnt(0)" ::: "memory");
        } else {
            XB_SPIN(xb_ld(&bar[XB_XGEN(b.x)]) == gen, bar);
            __builtin_amdgcn_fence(__ATOMIC_ACQUIRE, "agent");
            asm volatile("s_waitcnt vmcnt(0)" ::: "memory");
        }
    }
    __syncthreads();
}

namespace pg8 {
typedef int i32x4_ __attribute__((ext_vector_type(4)));
constexpr int BM = 256, BK = 64, HALF = 128, HTB = HALF * BK * 2, STAGE_BYTES = 8 * HTB, NXCD = 8, WGM = 8, KD = 1024;
constexpr size_t HSTEP = (size_t)HALF * KD * 2, TSTEP = 2 * HSTEP;
__host__ __device__ __forceinline__ int lds_byte(int r, int c) { const int st = (r >> 4) * 2 + (c >> 5), rr = r & 15, cc = c & 31, ob = rr * 64 + cc * 2; return st * 1024 + (ob ^ (((ob >> 9) & 1) << 5)); }
__host__ __device__ __forceinline__ void stage_rc(int b, int& R, int& C) { const int st = b / 1024, sb = b % 1024, swz = sb ^ (((sb >> 9) & 1) << 5); R = (st >> 1) * 16 + swz / 64; C = (st & 1) * 32 + (swz % 64) / 2; }
__host__ __device__ __forceinline__ int perm32(int rho) { const int n = rho >> 4, i = rho & 15; return 8 * (i >> 2) + 4 * n + (i & 3); }

struct Unit { int pm, pn, e, tb; const char* a; const char* b; };

struct DenseOrder {
    const char* A; const char* Bt; int nM, nN, nwg, G, c;
    __device__ __forceinline__ void a_ready(const Unit&, int, bool&) const {}
    __device__ void init(const void* A_, const void* Bt_, int M, int N, int G_, int c_) { A = (const char*)A_; Bt = (const char*)Bt_; nM = M / BM; nN = N / BM; nwg = nM * nN; G = G_; c = c_; }
    __device__ __forceinline__ bool next(int i, Unit& u) const {
        const long L = (long)i * G + c; if (L >= nwg) return false;
        int wgid = (int)L; { const int q = nwg / NXCD, r = nwg % NXCD, xcd = wgid % NXCD, off = wgid / NXCD; wgid = (xcd < r ? xcd * (q + 1) : r * (q + 1) + (xcd - r) * q) + off; }
        const int nig = WGM * nN, gid = wgid / nig, fm = gid * WGM, gsz = (nM - fm) < WGM ? (nM - fm) : WGM;
        u.pm = fm + ((wgid % nig) % gsz); u.pn = (wgid % nig) / gsz; u.e = 0; u.tb = 0;
        u.a = A + (size_t)u.pm * TSTEP; u.b = Bt + (size_t)u.pn * TSTEP; return true;
    }
};
struct MoeOrder {
    const char* A; const char* Bt; int nct, nrt, ntot, G, c; size_t estride, ctstep, atstep; const LAS int* rt_e; bool gather;
    const unsigned* upfin; unsigned nwgs;
    const unsigned* ready; unsigned need;
    __device__ __forceinline__ void a_ready(const Unit& u, int wid, bool& alldone) const {
        if (ready == nullptr) return;
        if (wid == 0 && !alldone) { unsigned spins = 0;
            alldone = (unsigned)__builtin_amdgcn_readfirstlane((int)__hip_atomic_load(upfin, __ATOMIC_RELAXED, __HIP_MEMORY_SCOPE_AGENT)) >= nwgs;
            if (!alldone) while ((unsigned)__builtin_amdgcn_readfirstlane((int)__hip_atomic_load(ready + 64 * u.pm, __ATOMIC_RELAXED, __HIP_MEMORY_SCOPE_AGENT)) < need) { if (++spins > (1u << 22)) break; __builtin_amdgcn_s_sleep(2); }
            __builtin_amdgcn_fence(__ATOMIC_ACQUIRE, "agent");
            asm volatile("s_waitcnt vmcnt(0)" ::: "memory"); }
        asm volatile("" ::: "memory"); __builtin_amdgcn_s_barrier(); asm volatile("" ::: "memory");
    }
    __device__ __forceinline__ bool next(int i, Unit& u) const {
        const int L = i * G + c; if (L >= ntot) return false;
        const int per = 8 * nct, grp = L / per, rem = L % per, fm = grp * 8, gsz = (nrt - fm) < 8 ? (nrt - fm) : 8;
        const int rt = fm + rem % gsz, ct = rem / gsz;
        const int e = __builtin_amdgcn_readfirstlane(rt_e[rt]);
        u.pm = rt; u.pn = ct; u.e = e; u.tb = e * 32768 + rt * 256 - __builtin_amdgcn_readfirstlane(rt_e[608 + e]);
        u.a = gather ? A : A + (size_t)rt * atstep; u.b = Bt + (size_t)e * estride + (size_t)ct * ctstep; return true;
    }
};

template <class Epi, class Sched, bool GATHER = false, bool FP8 = false>
__device__ __forceinline__ void gemm_phase(LAS unsigned char* lds, const Sched& S, const Epi& E, const size_t hstepB, const int wave0, const int* tok = nullptr) {
    int ln_; asm volatile("v_mbcnt_lo_u32_b32 %0, -1, 0\n\tv_mbcnt_hi_u32_b32 %0, -1, %0" : "=v"(ln_));
    int wid_ = wave0; asm volatile("" : "+s"(wid_));
    const int wid = wid_, lane = ln_, tid = wid * 64 + lane, wr = wid >> 2, wc = wid & 3, fr = lane & 15, fq = lane >> 4;
    constexpr int K = KD, ROWB = FP8 ? K : 2 * K, nt = FP8 ? K / 128 : K / BK;
    unsigned voffA[2], voffB[2]; int RA[2];
#pragma unroll
    for (int i = 0; i < 2; ++i) { int R, C; stage_rc(tid * 16 + i * 8192, R, C); const int Rb = Epi::PERM ? ((R & ~31) + perm32(R & 31)) : R;
        const int Rg = Epi::ILV8 ? (16 * (Rb >> 3) + (Rb & 7)) : Rb;
        voffA[i] = GATHER ? 0u : (Epi::ATILE ? (unsigned)((((R >> 4) * 32 + (C >> 4)) * 512) + (R & 15) * 32 + ((C >> 3) & 1) * 16) : Epi::ATILE64 ? (unsigned)((((R >> 4) * 32 + (C >> 5)) * 1024) + (R & 15) * 64 + ((C >> 3) & 3) * 16) : (unsigned)(R * ROWB + C * 2)); voffB[i] = (unsigned)(Rg * ROWB + C * 2); RA[i] = R; }
    unsigned va[2] = {0u, 0u}, vn[2] = {0u, 0u};
#define PG8_GOFF(dst, tb_) do { int t2_; asm volatile("v_mbcnt_lo_u32_b32 %0, -1, 0\n\tv_mbcnt_hi_u32_b32 %0, -1, %0" : "=v"(t2_)); t2_ += wid * 64; int R0_, C0_, R1_, C1_; stage_rc(t2_ * 16, R0_, C0_); stage_rc(t2_ * 16 + 8192, R1_, C1_); \
        _Pragma("unroll") for (int _h = 0; _h < 2; ++_h) dst[_h] = ((unsigned)tok[(tb_) + 128 * _h + R0_] & 32767u) | (((unsigned)tok[(tb_) + 128 * _h + R1_] & 32767u) << 16); } while (0)
#define PG8_GVOFF(p, _i) ({ int t3_; asm volatile("v_mbcnt_lo_u32_b32 %0, -1, 0\n\tv_mbcnt_hi_u32_b32 %0, -1, %0" : "=v"(t3_)); t3_ += wid * 64; int R3_, C3_; stage_rc(t3_ * 16 + (_i) * 8192, R3_, C3_); \
        (int)((((p) >> (16 * (_i))) & 0xffffu) * (unsigned)ROWB + (unsigned)C3_ * 2u); })
    const size_t kstep = (size_t)(BK * 2), kstepA = (Epi::ATILE || Epi::ATILE64) ? (size_t)2048 : kstep;
    const size_t hstep = (size_t)HALF * ROWB;
    const unsigned ldsw = (unsigned)wid * 1024u;
    const int aoff = lds_byte(wr * 64 + fr, fq * 8), boff = lds_byte(wc * 32 + fr, fq * 8);
#define PG8_SA(b, h) (((b) * 2 + (h)) * HTB)
#define PG8_SB(b, h) ((4 + (b) * 2 + (h)) * HTB)
    __amdgpu_buffer_rsrc_t rsA = __builtin_amdgcn_make_buffer_rsrc((void*)S.A, 0, 0x7fffffff, 0x00020000), rsB = __builtin_amdgcn_make_buffer_rsrc((void*)S.Bt, 0, 0x7fffffff, 0x00020000);
#define PG8_STAGE_X(bufoff, gbase, voff, RS, BASE) do { if constexpr (FP8) { _Pragma("unroll") for (int _i = 0; _i < 2; ++_i) \
        __builtin_amdgcn_raw_ptr_buffer_load_lds(RS, (LAS void*)(lds + (bufoff) + ldsw + _i * 8192), 16, (int)(voff)[_i], (int)(unsigned)((const char*)(gbase) - (BASE)), 0, 0); } \
        else { _Pragma("unroll") for (int _i = 0; _i < 2; ++_i) \
        __builtin_amdgcn_global_load_lds((const unsigned*)((const char*)(gbase) + (voff)[_i]), (LAS unsigned*)(lds + (bufoff) + ldsw + _i * 8192), 16, 0, 0); } } while (0)
#define PG8_STAGE(bufoff, gbase, voff) PG8_STAGE_X(bufoff, gbase, voff, rsB, S.Bt)
#define PG8_STAGE_A(bufoff, gbase, hh, nx) do { if constexpr (GATHER && FP8) { _Pragma("unroll") for (int _i = 0; _i < 2; ++_i) \
        __builtin_amdgcn_raw_ptr_buffer_load_lds(rsA, (LAS void*)(lds + (bufoff) + ldsw + _i * 8192), 16, PG8_GVOFF((nx) ? vn[hh] : va[hh], _i), (int)(unsigned)((const char*)(gbase) - S.A), 0, 0); } \
        else if constexpr (GATHER) { _Pragma("unroll") for (int _i = 0; _i < 2; ++_i) \
        __builtin_amdgcn_global_load_lds((const unsigned*)((const char*)(gbase) + (unsigned)PG8_GVOFF((nx) ? vn[hh] : va[hh], _i)), (LAS unsigned*)(lds + (bufoff) + ldsw + _i * 8192), 16, 0, 0); } \
        else { PG8_STAGE_X(bufoff, (gbase) + (hh) * hstep, voffA, rsA, S.A); } } while (0)
#define PG8_LDA(dst, b, h) do { if constexpr (FP8) { _Pragma("unroll") for (int m = 0; m < 4; ++m) dst##8[m] = __builtin_shufflevector(*(const LAS i32x4_*)(lds + PG8_SA(b, h) + aoff + m * 2048), *(const LAS i32x4_*)(lds + PG8_SA(b, h) + aoff + m * 2048 + 1024), 0, 1, 2, 3, 4, 5, 6, 7); } \
        else { _Pragma("unroll") for (int m = 0; m < 4; ++m) _Pragma("unroll") for (int k = 0; k < 2; ++k) dst[m][k] = *(const LAS bf16x8*)(lds + PG8_SA(b, h) + aoff + m * 2048 + k * 1024); } } while (0)
#define PG8_LDB(dst, b, h) do { if constexpr (FP8) { _Pragma("unroll") for (int n = 0; n < 2; ++n) dst##8[n] = __builtin_shufflevector(*(const LAS i32x4_*)(lds + PG8_SB(b, h) + boff + n * 2048), *(const LAS i32x4_*)(lds + PG8_SB(b, h) + boff + n * 2048 + 1024), 0, 1, 2, 3, 4, 5, 6, 7); } \
        else { _Pragma("unroll") for (int n = 0; n < 2; ++n) _Pragma("unroll") for (int k = 0; k < 2; ++k) dst[n][k] = *(const LAS bf16x8*)(lds + PG8_SB(b, h) + boff + n * 2048 + k * 1024); } } while (0)
#define PG8_MMA(ai, bj, At, Bt) do { __builtin_amdgcn_s_setprio(1); if constexpr (FP8) { _Pragma("unroll") for (int m = 0; m < 4; ++m) _Pragma("unroll") for (int n = 0; n < 2; ++n) \
        acc[ai][bj][m][n] = __builtin_amdgcn_mfma_scale_f32_16x16x128_f8f6f4(Bt##8[n], At##8[m], acc[ai][bj][m][n], 0, 0, 0, 0, 0, 0); } \
        else { _Pragma("unroll") for (int m = 0; m < 4; ++m) _Pragma("unroll") for (int n = 0; n < 2; ++n) _Pragma("unroll") for (int k = 0; k < 2; ++k) \
        acc[ai][bj][m][n] = __builtin_amdgcn_mfma_f32_16x16x32_bf16(Bt[n][k], At[m][k], acc[ai][bj][m][n], 0, 0, 0); } __builtin_amdgcn_s_setprio(0); } while (0)
#define PG8_WAIT_V(n) asm volatile("s_waitcnt vmcnt(" #n ")" ::: "memory")
#define PG8_WAIT_L(n) asm volatile("s_waitcnt lgkmcnt(" #n ")" ::: "memory")
#define PG8_BAR __builtin_amdgcn_s_barrier()
#define PG8_SCHED __builtin_amdgcn_sched_barrier(0)
    Unit cur, nxt; int ui = 0, pend = -1;
    if (!S.next(0, cur)) return;
    f32x4 acc[2][2][4][2];
    { f32x4 ib[2][2]; E.init(ib, cur, wc, fq);
#pragma unroll
      for (int a = 0; a < 2; ++a)
#pragma unroll
        for (int b = 0; b < 2; ++b)
#pragma unroll
            for (int m = 0; m < 4; ++m)
#pragma unroll
                for (int n = 0; n < 2; ++n) acc[a][b][m][n] = ib[b][n]; }
    bf16x8 At[4][2], B0[2][2], B1[2][2]; i32x8 At8[4], B08[2], B18[2];
    const char* cA = cur.a; const char* cB = cur.b;
    if constexpr (GATHER) { PG8_GOFF(va, cur.tb); }
    bool adone = false;
    S.a_ready(cur, wid, adone);
    PG8_STAGE(PG8_SB(0, 0), cB, voffB); PG8_STAGE(PG8_SB(0, 1), cB + hstepB, voffB); PG8_STAGE_A(PG8_SA(0, 0), cA, 0, false); PG8_STAGE_A(PG8_SA(0, 1), cA, 1, false);
    if (wr == 1) PG8_BAR;
    PG8_WAIT_V(2); PG8_BAR;
    PG8_STAGE(PG8_SB(1, 0), cB + kstep, voffB); PG8_STAGE_A(PG8_SA(1, 0), cA + kstepA, 0, false); PG8_STAGE(PG8_SB(1, 1), cB + hstepB + kstep, voffB);
    PG8_WAIT_V(6); PG8_BAR;
    for (;;) {
        const bool has_next = S.next(ui + 1, nxt);
        const char* nA = has_next ? nxt.a : cA; const char* nB = has_next ? nxt.b : cB;
        if constexpr (GATHER) { if (has_next) { PG8_GOFF(vn, nxt.tb); } else { vn[0] = va[0]; vn[1] = va[1]; } }
#pragma unroll 1
        for (int t = 0; t < nt; t += 2) {
            const bool last = (t == nt - 2);
            if (last && has_next) S.a_ready(nxt, wid, adone);
            const char* a1 = cA + (size_t)(t + 1) * kstepA;
            const char* a2 = last ? nA : cA + (size_t)(t + 2) * kstepA; const char* b2 = last ? nB : cB + (size_t)(t + 2) * kstep;
            const char* a3 = a2 + kstepA; const char* b3 = b2 + kstep;
            PG8_LDB(B0, 0, 0); PG8_LDB(B1, 0, 1); PG8_SCHED; PG8_LDA(At, 0, 0); PG8_STAGE_A(PG8_SA(1, 1), a1, 1, false);
            PG8_WAIT_V(8); PG8_WAIT_L(0); PG8_BAR; PG8_MMA(0, 0, At, B0); PG8_MMA(0, 1, At, B1); PG8_BAR; PG8_SCHED;
            PG8_LDA(At, 0, 1); PG8_STAGE(PG8_SB(0, 0), b2, voffB); PG8_STAGE(PG8_SB(0, 1), b2 + hstepB, voffB); PG8_STAGE_A(PG8_SA(0, 0), a2, 0, last);
            PG8_WAIT_V(8); PG8_WAIT_L(0); PG8_BAR; PG8_MMA(1, 0, At, B0); PG8_MMA(1, 1, At, B1); PG8_BAR; PG8_SCHED;
            PG8_LDB(B0, 1, 0); PG8_LDB(B1, 1, 1); PG8_SCHED; PG8_LDA(At, 1, 0); PG8_STAGE_A(PG8_SA(0, 1), a2, 1, last);
            PG8_WAIT_V(8); PG8_WAIT_L(0); PG8_BAR; PG8_MMA(0, 0, At, B0); PG8_MMA(0, 1, At, B1); PG8_BAR; PG8_SCHED;
            PG8_LDA(At, 1, 1); PG8_STAGE(PG8_SB(1, 0), b3, voffB); PG8_STAGE(PG8_SB(1, 1), b3 + hstepB, voffB); PG8_STAGE_A(PG8_SA(1, 0), a3, 0, last);
            PG8_WAIT_V(8); PG8_WAIT_L(0); PG8_BAR; PG8_MMA(1, 0, At, B0); PG8_MMA(1, 1, At, B1); PG8_BAR; PG8_SCHED;
        }
        if (wr == 0) PG8_BAR;
        f32x4 nb[2][2];
        { int l2_; asm volatile("v_mbcnt_lo_u32_b32 %0, -1, 0\n\tv_mbcnt_hi_u32_b32 %0, -1, %0" : "=v"(l2_)); E.done(pend, l2_, true); pend = cur.pm; E.init(nb, has_next ? nxt : cur, wc, l2_ >> 4); E(acc, cur, wr, wc, l2_ & 15, l2_ >> 4); }
        if (!has_next) break;
#pragma unroll
        for (int a = 0; a < 2; ++a)
#pragma unroll
            for (int b = 0; b < 2; ++b)
#pragma unroll
                for (int m = 0; m < 4; ++m)
#pragma unroll
                    for (int n = 0; n < 2; ++n) acc[a][b][m][n] = nb[b][n];
        cur = nxt; cA = nA; cB = nB; ++ui;
        if constexpr (GATHER) { va[0] = vn[0]; va[1] = vn[1]; }
        if (wr == 1) PG8_BAR;
    }
    PG8_WAIT_V(0);
    { int l3_; asm volatile("v_mbcnt_lo_u32_b32 %0, -1, 0\n\tv_mbcnt_hi_u32_b32 %0, -1, %0" : "=v"(l3_)); E.done(pend, l3_, false); }
    PG8_BAR;
#undef PG8_SA
#undef PG8_SB
#undef PG8_STAGE
#undef PG8_STAGE_X
#undef PG8_STAGE_A
#undef PG8_GOFF
#undef PG8_GVOFF
#undef PG8_LDA
#undef PG8_LDB
#undef PG8_MMA
#undef PG8_WAIT_V
#undef PG8_WAIT_L
#undef PG8_BAR
#undef PG8_SCHED
}

struct EpiZ {
    static constexpr bool PERM = true; static constexpr bool ILV8 = false; static constexpr bool ATILE = false; static constexpr bool ATILE64 = false;
    bf16* O; int ldc;
    __device__ __forceinline__ void done(int, int, bool) const {}
    __device__ __forceinline__ void init(f32x4 (&ib)[2][2], const Unit&, int, int) const { ib[0][0] = ib[0][1] = ib[1][0] = ib[1][1] = (f32x4){0.f, 0.f, 0.f, 0.f}; }
    __device__ __forceinline__ void operator()(const f32x4 (&acc)[2][2][4][2], const Unit& u, int wr, int wc, int fr, int fq) const {
        const int row0 = u.pm * BM + wr * 64 + fr, col0 = u.pn * BM + wc * 32 + 8 * fq;
        const __amdgpu_buffer_rsrc_t rsO = __builtin_amdgcn_make_buffer_rsrc((void*)O, 0, 0x7fffffff, 0x00020000);
#pragma unroll
        for (int ai = 0; ai < 2; ++ai)
#pragma unroll
            for (int m = 0; m < 4; ++m) { const int rr_ = row0 + ai * HALF + m * 16; const int ro = (((rr_ >> 4) * 128 + (col0 >> 5)) * 512 + (rr_ & 15) * 32 + (col0 & 31)) * 2;
#pragma unroll
                for (int bj = 0; bj < 2; ++bj) { const f32x4 v0 = acc[ai][bj][m][0], v1 = acc[ai][bj][m][1];
                    u32x4 w; w.x = pk2(v0[0], v0[1]); w.y = pk2(v0[2], v0[3]); w.z = pk2(v1[0], v1[1]); w.w = pk2(v1[2], v1[3]);
                    __builtin_amdgcn_raw_buffer_store_b128(w, rsO, ro + bj * 4 * 512 * 2, 0, 16); } }
    }
};
template <bool BASE_BF16>
struct EpiXres {
    static constexpr bool PERM = true; static constexpr bool ILV8 = false; static constexpr bool ATILE = false; static constexpr bool ATILE64 = true;
    const void* base; bf16* out; const float* gate;
    __device__ __forceinline__ void done(int, int, bool) const {}
    __device__ __forceinline__ void init(f32x4 (&ib)[2][2], const Unit&, int, int) const { ib[0][0] = ib[0][1] = ib[1][0] = ib[1][1] = (f32x4){0.f, 0.f, 0.f, 0.f}; }
    __device__ __forceinline__ void operator()(const f32x4 (&acc)[2][2][4][2], const Unit& u, int wr, int wc, int fr, int fq) const {
        const int row0 = u.pm * BM + wr * 64 + fr, col0 = u.pn * BM + wc * 32 + 8 * fq;
        const float* gp = gate + (size_t)((u.pm * BM) >> 13) * 6144 + col0;
        f32x4 gv[2][2];
#pragma unroll
        for (int bj = 0; bj < 2; ++bj)
#pragma unroll
            for (int n = 0; n < 2; ++n) gv[bj][n] = *(const f32x4*)(gp + bj * HALF + 4 * n);
#pragma unroll
        for (int ai = 0; ai < 2; ++ai)
#pragma unroll
            for (int m = 0; m < 4; ++m) { const size_t off = (size_t)(row0 + ai * HALF + m * 16) * 1024 + col0;
#pragma unroll
                for (int bj = 0; bj < 2; ++bj) { f32x4 b0, b1;
                    if constexpr (BASE_BF16) { const u32x4 w = *(const u32x4*)((const bf16*)base + off + bj * HALF); b0 = (f32x4){bflo(w.x), bfhi(w.x), bflo(w.y), bfhi(w.y)}; b1 = (f32x4){bflo(w.z), bfhi(w.z), bflo(w.w), bfhi(w.w)}; }
                    else { b0 = *(const f32x4*)((const float*)base + off + bj * HALF); b1 = *(const f32x4*)((const float*)base + off + bj * HALF + 4); }
                    const f32x4 v0 = b0 + gv[bj][0] * acc[ai][bj][m][0], v1 = b1 + gv[bj][1] * acc[ai][bj][m][1];
                    u32x4 w; w.x = pk2(v0[0], v0[1]); w.y = pk2(v0[2], v0[3]); w.z = pk2(v1[0], v1[1]); w.w = pk2(v1[2], v1[3]);
                    *(u32x4*)(out + off + bj * HALF) = w; } }
    }
};
struct EpiAct {
    static constexpr bool PERM = true; static constexpr bool ILV8 = false; static constexpr bool ATILE = false; static constexpr bool ATILE64 = false;
    unsigned char* O; const float* b1; unsigned* pan;
    __device__ __forceinline__ void init(f32x4 (&ib)[2][2], const Unit& u, int wc, int fq) const {
        const float* bp = b1 + (size_t)u.e * 2048 + u.pn * HALF + wc * 32 + 8 * fq;
#pragma unroll
        for (int n = 0; n < 2; ++n) { ib[0][n] = *(const f32x4*)(bp + 4 * n) * W8_SCALE; ib[1][n] = *(const f32x4*)(bp + 1024 + 4 * n) * W8_SCALE; } }
    __device__ __forceinline__ void operator()(const f32x4 (&acc)[2][2][4][2], const Unit& u, int wr, int wc, int fr, int fq) const {
        const int row0 = u.pm * BM + wr * 64 + fr, cc0 = u.pn * HALF + wc * 32 + 8 * fq;
        const __amdgpu_buffer_rsrc_t rsO = __builtin_amdgcn_make_buffer_rsrc((void*)O, 0, 0x7fffffff, 0x00020000);
#pragma unroll
        for (int ai = 0; ai < 2; ++ai)
#pragma unroll
            for (int m = 0; m < 4; ++m) { const int rowo = ((((u.pm * BM + ai * HALF + wr * 64 + m * 16) >> 4) * 32 + u.pn * 4 + wc) * 512) + fr * 32 + 8 * fq;
                float r[8];
#pragma unroll
                for (int n = 0; n < 2; ++n)
#pragma unroll
                    for (int p = 0; p < 2; ++p) {
                        const f32x2 a2 = (f32x2){acc[ai][0][m][n][2 * p], acc[ai][0][m][n][2 * p + 1]}, c2 = (f32x2){acc[ai][1][m][n][2 * p], acc[ai][1][m][n][2 * p + 1]};
                        f32x2 m2, lc;
                        m2[0] = fminf(a2[0], 448.0f); m2[1] = fminf(a2[1], 448.0f);
                        lc[0] = __builtin_amdgcn_fmed3f(c2[0], -448.0f, 448.0f); lc[1] = __builtin_amdgcn_fmed3f(c2[1], -448.0f, 448.0f);
                        const f32x2 ea = m2 * (-1.702f * 1.4426950408889634f * W8_INV); f32x2 d;
                        d[0] = __builtin_amdgcn_exp2f(ea[0]); d[1] = __builtin_amdgcn_exp2f(ea[1]);
                        d = d + 1.0f; f32x2 rc; rc[0] = __builtin_amdgcn_rcpf(d[0]); rc[1] = __builtin_amdgcn_rcpf(d[1]);
                        const f32x2 o2 = (m2 * rc) * (lc * (W8_INV * W8_INV) + W8_INV);
                        r[4 * n + 2 * p] = o2[0]; r[4 * n + 2 * p + 1] = o2[1]; }
                u32x2 w; w.x = pk4_fp8(r[0], r[1], r[2], r[3]); w.y = pk4_fp8(r[4], r[5], r[6], r[7]);
                __builtin_amdgcn_raw_buffer_store_b64(w, rsO, rowo, 0, 16); }
    }
    __device__ __forceinline__ void done(int pm, int lane, bool drain) const {
        if (pm < 0) return;
        if (drain) asm volatile("s_waitcnt vmcnt(0)" ::: "memory");
        if (lane == 0) __hip_atomic_fetch_add(pan + 64 * pm, 1u, __ATOMIC_RELAXED, __HIP_MEMORY_SCOPE_AGENT);
    }
};
struct EpiY {
    static constexpr bool PERM = true; static constexpr bool ILV8 = true; static constexpr bool ATILE = true; static constexpr bool ATILE64 = false;
    unsigned char* O; const float* b2;
    __device__ __forceinline__ void done(int, int, bool) const {}
    __device__ __forceinline__ void epi(const f32x4 (&acc)[2][2][4][2], const Unit& u, int wr, int wc, int fr, int fq, int, int) const { (*this)(acc, u, wr, wc, fr, fq); }
    __device__ __forceinline__ void init(f32x4 (&ib)[2][2], const Unit& u, int wc, int fq) const {
        const float* bp = b2 + (size_t)u.e * 1024 + u.pn * BM + wc * 64 + 16 * fq;
#pragma unroll
        for (int bj = 0; bj < 2; ++bj)
#pragma unroll
            for (int n = 0; n < 2; ++n) ib[bj][n] = *(const f32x4*)(bp + 8 * bj + 4 * n) * W8_SCALE; }
    __device__ __forceinline__ void operator()(const f32x4 (&acc)[2][2][4][2], const Unit& u, int wr, int wc, int fr, int fq) const {
        const int row0 = u.pm * BM + wr * 64 + fr, col0 = u.pn * BM + wc * 64 + 16 * fq;
#pragma unroll
        for (int ai = 0; ai < 2; ++ai)
#pragma unroll
            for (int m = 0; m < 4; ++m) { u32x4 w;
                { const f32x4 v0 = acc[ai][0][m][0] * W8_INV, v1 = acc[ai][0][m][1] * W8_INV; w.x = pk4_fp8(v0[0], v0[1], v0[2], v0[3]); w.y = pk4_fp8(v1[0], v1[1], v1[2], v1[3]); }
                { const f32x4 v0 = acc[ai][1][m][0] * W8_INV, v1 = acc[ai][1][m][1] * W8_INV; w.z = pk4_fp8(v0[0], v0[1], v0[2], v0[3]); w.w = pk4_fp8(v1[0], v1[1], v1[2], v1[3]); }
                *(u32x4*)(O + (size_t)(row0 + ai * HALF + m * 16) * 1024 + col0) = w; }
    }
};
}

struct Params { const float* in[22]; float* out; unsigned char* ws; };
enum { I_X = 0, I_C, I_ADAW, I_ADAB, I_N1G, I_N2G, I_WIN, I_WOUT, I_LBL, I_HGG, I_RETG, I_CONVW, I_ALOG, I_DTB, I_GDNG, I_RW, I_RB, I_W1, I_B1, I_W2, I_B2, I_FNG };

struct Frame {
    LAS unsigned char* lds;
    int tid, lane, wave, wave0, G, bid;
    unsigned char* ws;
    unsigned* ctl;
};
extern __shared__ __attribute__((aligned(16))) unsigned char lds_raw[];
constexpr int LDS_PAR = LDSCTL_OFF + 512;
__device__ __forceinline__ unsigned long long ldpar(LAS unsigned char* lds, int i) {
    const u32x2 v = *(const LAS u32x2*)(lds + LDS_PAR + 8 * i);
    return ((unsigned long long)(unsigned)__builtin_amdgcn_readfirstlane((int)v.y) << 32) | (unsigned)__builtin_amdgcn_readfirstlane((int)v.x);
}
__device__ __forceinline__ const float* pin(const Frame& F, int i) { return (const float*)(const GAS float*)ldpar(F.lds, i); }
__device__ __forceinline__ float* pout(const Frame& F) { return (float*)(GAS float*)ldpar(F.lds, 22); }
__device__ __forceinline__ int lane_id_opaque() { int ln; asm volatile("v_mbcnt_lo_u32_b32 %0, -1, 0\n\tv_mbcnt_hi_u32_b32 %0, -1, %0" : "=v"(ln)); return ln; }
__device__ __forceinline__ Frame make_frame(int wave0) {
    Frame F; F.lds = (LAS unsigned char*)lds_raw;
    const int ln = lane_id_opaque();
    int w = wave0; asm volatile("" : "+s"(w));
    F.tid = w * 64 + ln; F.lane = ln; F.wave = w; F.wave0 = w;
    int g = gridDim.x, bi = blockIdx.x; asm volatile("" : "+s"(g), "+s"(bi));
    unsigned long long wsp = ldpar(F.lds, 23); asm volatile("" : "+s"(wsp));
    F.G = g; F.bid = bi; F.ws = (unsigned char*)(GAS unsigned char*)wsp; F.ctl = (unsigned*)(F.ws + WS_CTL);
    return F;
}

template <bool F8>
__device__ __forceinline__ void p0_transpose_item(const float* W, int ld, int ncol, void* WTv, LAS float* scr, int item, int lane) {
    const int nblk = ncol / 32, kb = item / nblk, nb = item % nblk, k0 = 64 * kb, n0 = 32 * nb;
    f32x4 v[8];
#pragma unroll
    for (int i = 0; i < 8; ++i) v[i] = __builtin_nontemporal_load((const f32x4*)(W + (size_t)(k0 + 8 * i + (lane >> 3)) * ld + n0 + 4 * (lane & 7)));
#pragma unroll
    for (int i = 0; i < 8; ++i) { LAS float* d = scr + (8 * i + (lane >> 3)) * 33 + 4 * (lane & 7); d[0] = v[i][0]; d[1] = v[i][1]; d[2] = v[i][2]; d[3] = v[i][3]; }
    LDS_WAIT(); asm volatile("" ::: "memory");
    const int c = lane & 7;
#pragma unroll
    for (int j = 0; j < 4; ++j) { const int n = (lane >> 3) + 8 * j; const LAS float* s = scr + (8 * c) * 33 + n;
        if constexpr (F8) { u32x2 o; o.x = pk4_fp8(s[0 * 33] * W8_SCALE, s[1 * 33] * W8_SCALE, s[2 * 33] * W8_SCALE, s[3 * 33] * W8_SCALE); o.y = pk4_fp8(s[4 * 33] * W8_SCALE, s[5 * 33] * W8_SCALE, s[6 * 33] * W8_SCALE, s[7 * 33] * W8_SCALE);
            *(u32x2*)((unsigned char*)WTv + (size_t)(n0 + n) * 1024 + k0 + 8 * c) = o; }
        else { u32x4 o; o.x = pk2(s[0 * 33], s[1 * 33]); o.y = pk2(s[2 * 33], s[3 * 33]); o.z = pk2(s[4 * 33], s[5 * 33]); o.w = pk2(s[6 * 33], s[7 * 33]);
            *(u32x4*)((bf16*)WTv + (size_t)(n0 + n) * 1024 + k0 + 8 * c) = o; } }
    LDS_WAIT(); asm volatile("" ::: "memory");
}
__device__ __forceinline__ void p0_transpose_item8(const float* W, int ld, int ncol, unsigned char* WT, LAS float* scr, int item, int lane) {
    const int nblk = ncol / 32, kb = item / nblk, nb = item % nblk, k0 = 128 * kb, n0 = 32 * nb;
    f32x4 v[16];
#pragma unroll
    for (int i = 0; i < 16; ++i) v[i] = __builtin_nontemporal_load((const f32x4*)(W + (size_t)(k0 + 16 * (i & 7) + 8 * (i >> 3) + (lane >> 3)) * ld + n0 + 4 * (lane & 7)));
    const int c = lane & 7;
    u32x2 o[2][4];
#pragma unroll
    for (int p = 0; p < 2; ++p) {
#pragma unroll
        for (int i = 0; i < 8; ++i) { LAS float* d = scr + (8 * i + (lane >> 3)) * 33 + 4 * (lane & 7); d[0] = v[8 * p + i][0]; d[1] = v[8 * p + i][1]; d[2] = v[8 * p + i][2]; d[3] = v[8 * p + i][3]; }
        LDS_WAIT(); asm volatile("" ::: "memory");
#pragma unroll
        for (int j = 0; j < 4; ++j) { const int n = (lane >> 3) + 8 * j; const LAS float* s = scr + (8 * c) * 33 + n;
            o[p][j].x = pk4_fp8(s[0 * 33] * W8_SCALE, s[1 * 33] * W8_SCALE, s[2 * 33] * W8_SCALE, s[3 * 33] * W8_SCALE); o[p][j].y = pk4_fp8(s[4 * 33] * W8_SCALE, s[5 * 33] * W8_SCALE, s[6 * 33] * W8_SCALE, s[7 * 33] * W8_SCALE); }
        LDS_WAIT(); asm volatile("" ::: "memory"); }
#pragma unroll
    for (int j = 0; j < 4; ++j) { const int n = (lane >> 3) + 8 * j; u32x4 w; w.x = o[0][j].x; w.y = o[0][j].y; w.z = o[1][j].x; w.w = o[1][j].y;
        __builtin_nontemporal_store(w, (u32x4*)(WT + (size_t)(n0 + n) * 1024 + k0 + 16 * c)); }
}
__device__ __forceinline__ void phase0(Frame& F) {
    if (F.bid < 96) {
        LAS float* cs = (LAS float*)(F.lds);
        LAS float* part = (LAS float*)(F.lds + 16384);
        const float* c = pin(F, I_C);
        for (int i = F.tid; i < 4096; i += 512) cs[i] = siluf(c[i]);
        __syncthreads();
        const int cb = F.bid * 128, l = cb / 6144, j0 = cb % 6144;
        const int cg = F.wave & 1, kq = F.wave >> 1, j = j0 + cg * 64 + F.lane;
        const float* aw = pin(F, I_ADAW) + (size_t)l * 1024 * 6144 + j;
        float a0 = 0.f, a1 = 0.f, a2 = 0.f, a3 = 0.f;
#pragma unroll 8
        for (int k = kq * 256; k < kq * 256 + 256; ++k) { const float w = aw[(size_t)k * 6144]; a0 += cs[k] * w; a1 += cs[1024 + k] * w; a2 += cs[2048 + k] * w; a3 += cs[3072 + k] * w; }
        part[(kq * 4 + 0) * 128 + cg * 64 + F.lane] = a0; part[(kq * 4 + 1) * 128 + cg * 64 + F.lane] = a1;
        part[(kq * 4 + 2) * 128 + cg * 64 + F.lane] = a2; part[(kq * 4 + 3) * 128 + cg * 64 + F.lane] = a3;
        __syncthreads();
        { const int b = F.tid >> 7, jj = F.tid & 127;
          const float s = part[(0 * 4 + b) * 128 + jj] + part[(1 * 4 + b) * 128 + jj] + part[(2 * 4 + b) * 128 + jj] + part[(3 * 4 + b) * 128 + jj] + pin(F, I_ADAB)[l * 6144 + j0 + jj];
          ((float*)(F.ws + WS_MOD))[(size_t)(l * 4 + b) * 6144 + j0 + jj] = s; }
        __syncthreads();
    }
    if (F.bid == 96) {
        const float* lg = pin(F, I_LBL); float* lb = (float*)(F.ws + WS_LB);
        { const int i = F.tid; const float l0 = lg[i], l1 = lg[512 + i]; lb[i] = 0.f; lb[512 + i] = fmaxf(1.0f / (1.0f + __expf(l0 - l1)), 0.f); }
    }
    if (F.bid == 97 && F.tid < 32) ((double*)(F.ws + WS_ROPE))[F.tid] = exp(-(double)F.tid / 31.0 * 9.210340371976184) * 0.15915494309189535;
    LAS float* scr = (LAS float*)(F.lds + 32768 + F.wave * 12288);
    const int gw = F.bid * 8 + F.wave, NGW = F.G * 8;
    constexpr int I_IN = 16 * 128, I_OUT = 16 * 32, I_1 = 8 * 64, I_2 = 8 * 32;
    constexpr int N_IN = 2 * I_IN, N_OUT = 2 * I_OUT, N_1 = 64 * I_1, N_2 = 64 * I_2;
    const int NMOD = 96 * 8, NFREE = NGW - NMOD, X = (NGW > NMOD) ? 6 * NFREE : 0, N_TOT = N_IN + N_OUT + N_1 + N_2;
    const int nrounds = (F.bid >= 96 ? 6 : 0) + (N_TOT - X + NGW - 1) / NGW;
    for (int q = 0; q < nrounds; ++q) {
        int it;
        if (F.bid >= 96) it = (q < 6) ? (gw - NMOD) + NFREE * q : X + gw + NGW * (q - 6); else it = X + gw + NGW * q;
        if (it >= N_TOT) break;
        int r = it;
        if (r < N_IN) { const int m = r / I_IN; p0_transpose_item<false>(pin(F, I_WIN) + (size_t)m * 1024 * NIN, NIN, NZ, (bf16*)(F.ws + WS_WIN) + (size_t)m * NZ * 1024, scr, r % I_IN, F.lane); continue; } r -= N_IN;
        if (r < N_OUT) { const int m = r / I_OUT; p0_transpose_item<false>(pin(F, I_WOUT) + (size_t)m * 1024 * 1024, 1024, 1024, (bf16*)(F.ws + WS_WOUT) + (size_t)m * 1024 * 1024, scr, r % I_OUT, F.lane); continue; } r -= N_OUT;
        if (r < N_1) { const int m = r / I_1; p0_transpose_item8(pin(F, I_W1) + (size_t)m * 1024 * 2048, 2048, 2048, F.ws + WS_W1 + (size_t)m * 2048 * 1024, scr, r % I_1, F.lane); continue; } r -= N_1;
        { const int m = r / I_2; p0_transpose_item8(pin(F, I_W2) + (size_t)m * 1024 * 1024, 1024, 1024, F.ws + WS_W2 + (size_t)m * 1024 * 1024, scr, r % I_2, F.lane); }
    }
}

__device__ __forceinline__ void load_w8t(Frame& F, int l, LAS float* w8t) {
    const float* w = pin(F, I_WIN) + (size_t)l * 1024 * NIN + NZ;
    for (int i = F.tid; i < 8192; i += 512) { const int k = i >> 3, q = i & 7; w8t[q * 1024 + k] = w[(size_t)k * NIN + q]; }
}
__device__ __forceinline__ f32x4 unpack4_fp8(unsigned w) { const f32x2 a = __builtin_amdgcn_cvt_pk_f32_fp8((int)w, false), b = __builtin_amdgcn_cvt_pk_f32_fp8((int)w, true); return (f32x4){a[0], a[1], b[0], b[1]}; }
__device__ __forceinline__ f32x4 unpack4(u32x2 w) { return (f32x4){bflo(w.x), bfhi(w.x), bflo(w.y), bfhi(w.y)}; }
template <bool F8 = false>
__device__ __forceinline__ void norm_mod_emit(const f32x4 (&v)[4], const float* g, const float* sh, const float* sc, void* hrowv, int lane, f32x4 (&h)[4]) {
    float ss = 0.f;
#pragma unroll
    for (int j = 0; j < 4; ++j) ss += (v[j].x * v[j].x + v[j].y * v[j].y) + (v[j].z * v[j].z + v[j].w * v[j].w);
    const float r = rsqrtf(wave_sum(ss) * (1.0f / 1024.0f) + NORM_EPS);
#pragma unroll
    for (int j = 0; j < 4; ++j) { const int col = 256 * j + 4 * lane;
        const f32x4 gg = *(const f32x4*)(g + col), s1 = *(const f32x4*)(sc + col), s0 = *(const f32x4*)(sh + col);
        h[j] = (v[j] * r) * gg * (s1 + 1.0f) + s0;
        if constexpr (F8) *(unsigned*)((unsigned char*)hrowv + col) = pk4_fp8(h[j].x, h[j].y, h[j].z, h[j].w);
        else { u32x2 w; w.x = pk2(h[j].x, h[j].y); w.y = pk2(h[j].z, h[j].w); *(u32x2*)((bf16*)hrowv + col) = w; } }
}
__device__ __forceinline__ void emit_gab(const f32x4 (&h)[4], const LAS float* w8t, float* gabrow, int lane) {
    float a[8];
#pragma unroll
    for (int q = 0; q < 8; ++q) { float s = 0.f;
#pragma unroll
        for (int j = 0; j < 4; ++j) { const f32x4 w = *(const LAS f32x4*)(w8t + q * 1024 + 256 * j + 4 * lane); s += (h[j].x * w.x + h[j].y * w.y) + (h[j].z * w.z + h[j].w * w.w); }
        a[q] = wave_sum(s); }
    if (lane == 0) { *(f32x4*)gabrow = (f32x4){a[0], a[1], a[2], a[3]}; *(f32x4*)(gabrow + 4) = (f32x4){a[4], a[5], a[6], a[7]}; }
}

__device__ __forceinline__ void phase_norm1_first(Frame& F) {
    LAS float* w8t = (LAS float*)F.lds;
    LAS float* GS = (LAS float*)(F.lds + 32768); LAS float* SH = GS + 1024;
    const float* mod = (const float*)(F.ws + WS_MOD);
    const int gw = F.bid * 8 + F.wave, NGW = F.G * 8, RPW = NTOK / NGW, row0 = gw * RPW, rend = row0 + RPW;
    f32x4 vn[4];
    { const f32x4* xr = (const f32x4*)(pin(F, I_X) + (size_t)row0 * 1024) + F.lane;
#pragma unroll
      for (int j = 0; j < 4; ++j) vn[j] = __builtin_nontemporal_load(xr + 64 * j); }
    load_w8t(F, 0, w8t);
    if (F.tid < 256) { const int bb = (F.bid * 8 * RPW) >> 13, col = 4 * F.tid; const float* mp = mod + (size_t)bb * 6144;
        *(LAS f32x4*)(GS + col) = *(const f32x4*)(pin(F, I_N1G) + col) * (*(const f32x4*)(mp + 1024 + col) + 1.0f); *(LAS f32x4*)(SH + col) = *(const f32x4*)(mp + col); }
    lds_barrier();
#pragma unroll 1
    for (int row = row0; row < rend; ++row) {
        int ml = 4 * F.lane; asm volatile("" : "+v"(ml));
        f32x4 v[4], h[4];
#pragma unroll
        for (int j = 0; j < 4; ++j) v[j] = vn[j];
        if (row + 1 < rend) { const f32x4* xr = (const f32x4*)(pin(F, I_X) + (size_t)(row + 1) * 1024) + F.lane;
#pragma unroll
            for (int j = 0; j < 4; ++j) vn[j] = __builtin_nontemporal_load(xr + 64 * j); }
        float ss = 0.f;
#pragma unroll
        for (int j = 0; j < 4; ++j) ss += (v[j].x * v[j].x + v[j].y * v[j].y) + (v[j].z * v[j].z + v[j].w * v[j].w);
        const float r = rsqrtf(wave_sum(ss) * (1.0f / 1024.0f) + NORM_EPS);
        bf16* hrow = (bf16*)(F.ws + WS_HN) + (size_t)row * 1024;
#pragma unroll
        for (int j = 0; j < 4; ++j) { h[j] = (v[j] * r) * *(const LAS f32x4*)(GS + 256 * j + ml) + *(const LAS f32x4*)(SH + 256 * j + ml);
            u32x2 w; w.x = pk2(h[j].x, h[j].y); w.y = pk2(h[j].z, h[j].w); *(u32x2*)(hrow + 256 * j + 4 * F.lane) = w; }
        emit_gab(h, w8t, (float*)(F.ws + WS_GAB) + (size_t)row * 8, F.lane);
    }
    __syncthreads();
}

__device__ __forceinline__ void hgrn_naive(Frame& F, int l, int b, int h) {
    LAS float* Fg = (LAS float*)F.lds;
    LAS float* Kk = Fg + 2048, *Qq = Kk + 2048, *Vv = Qq + 2048, *Gt = Vv + 2048, *Pp = Gt + 2048;
    const bf16* z = (const bf16*)(F.ws + WS_R1);
    const float* lb = (const float*)(F.ws + WS_LB) + l * 512 + h * 128;
    const float* gn = pin(F, I_HGG) + l * 512 + h * 128;
    bf16* om = (bf16*)(F.ws + WS_OMIX);
    const int e = F.tid & 127, dq = F.tid >> 7;
    float S[32];
#pragma unroll
    for (int j = 0; j < 32; ++j) S[j] = 0.f;
    for (int t0 = 0; t0 < SEQ; t0 += 16) {
#pragma unroll
        for (int i = 0; i < 4; ++i) { const int idx = F.tid + 512 * i, tt = idx >> 7, d = idx & 127;
            const bf16* zr = z + (size_t)(b * SEQ + t0 + tt) * NZ + h * 128 + d;
            const float q = bf2f(zr[0]), fl = bf2f(zr[512]), vv = bf2f(zr[1024]), gt = bf2f(zr[1536]);
            const float lbd = lb[d], f = lbd + (1.0f - lbd) * sigm(fl);
            Fg[idx] = f; Kk[idx] = 1.0f - f; Qq[idx] = siluf(q); Vv[idx] = vv; Gt[idx] = siluf(gt); }
        __syncthreads();
        for (int tt = 0; tt < 16; ++tt) { const float vv = Vv[tt * 128 + e]; float acc = 0.f;
#pragma unroll
            for (int j4 = 0; j4 < 8; ++j4) { const int d = tt * 128 + 32 * dq + 4 * j4;
                const f32x4 ff = *(const LAS f32x4*)(Fg + d), kk = *(const LAS f32x4*)(Kk + d), qq = *(const LAS f32x4*)(Qq + d);
#pragma unroll
                for (int i = 0; i < 4; ++i) { S[4 * j4 + i] = ff[i] * S[4 * j4 + i] + kk[i] * vv; acc += S[4 * j4 + i] * qq[i]; }
                if ((j4 & 1) == 1) __builtin_amdgcn_sched_barrier(0); }
            Pp[(dq * 16 + tt) * 128 + e] = acc; }
        __syncthreads();
#pragma unroll
        for (int r = 0; r < 2; ++r) { const int tt = 2 * F.wave + r;
            float o0 = 0.f, o1 = 0.f;
#pragma unroll
            for (int q = 0; q < 4; ++q) { o0 += Pp[(q * 16 + tt) * 128 + F.lane]; o1 += Pp[(q * 16 + tt) * 128 + 64 + F.lane]; }
            const float rr = rsqrtf(wave_sum(o0 * o0 + o1 * o1) * (1.0f / 128.0f) + NORM_EPS);
            bf16* orow = om + (size_t)(b * SEQ + t0 + tt) * 1024 + h * 128;
            orow[F.lane] = (bf16)f2bf(o0 * rr * gn[F.lane] * Gt[tt * 128 + F.lane]);
            orow[64 + F.lane] = (bf16)f2bf(o1 * rr * gn[64 + F.lane] * Gt[tt * 128 + 64 + F.lane]); }
        __syncthreads();
    }
}
__device__ __forceinline__ void ret_naive(Frame& F, int l, int b, int h) {
    LAS float* Kk = (LAS float*)F.lds;
    LAS float* Qq = Kk + 1024, *Vv = Qq + 1024, *Gt = Vv + 1024, *Pp = Gt + 1024;
    const bf16* z = (const bf16*)(F.ws + WS_R1);
    const float* gn = pin(F, I_RETG) + l * 256 + h * 64;
    bf16* om = (bf16*)(F.ws + WS_OMIX);
    const int e = F.tid & 63, dq = F.tid >> 6;
    const float gamma = 1.0f - exp2f(-5.0f - (float)h);
    float S[8];
#pragma unroll
    for (int j = 0; j < 8; ++j) S[j] = 0.f;
    const int ri = F.tid & 31, rtt = F.tid >> 5;
    const double inv_rev = ((const double*)(F.ws + WS_ROPE))[ri];
    for (int t0 = 0; t0 < SEQ; t0 += 16) {
        { const bf16* zr = z + (size_t)(b * SEQ + t0 + rtt) * NZ + 2048 + h * 64 + ri;
          const float q1 = bf2f(zr[0]), q2 = bf2f(zr[32]), k1 = bf2f(zr[256]) * 0.125f, k2 = bf2f(zr[256 + 32]) * 0.125f;
          double rev = (double)(t0 + rtt) * inv_rev; rev -= floor(rev);
          const float ang = (float)rev * 6.283185307179586f; float sn, cs; __sincosf(ang, &sn, &cs);
          Qq[rtt * 64 + ri] = q1 * cs - q2 * sn; Qq[rtt * 64 + 32 + ri] = q1 * sn + q2 * cs;
          Kk[rtt * 64 + ri] = k1 * cs - k2 * sn; Kk[rtt * 64 + 32 + ri] = k1 * sn + k2 * cs; }
#pragma unroll
        for (int i = 0; i < 2; ++i) { const int idx = F.tid + 512 * i, tt = idx >> 6, d = idx & 63;
            const bf16* zr = z + (size_t)(b * SEQ + t0 + tt) * NZ + 2048 + h * 64 + d;
            Vv[idx] = bf2f(zr[512]); Gt[idx] = siluf(bf2f(zr[768])); }
        __syncthreads();
        for (int tt = 0; tt < 16; ++tt) { const float vv = Vv[tt * 64 + e]; float acc = 0.f;
#pragma unroll
            for (int j4 = 0; j4 < 2; ++j4) { const int d = tt * 64 + 8 * dq + 4 * j4;
                const f32x4 kk = *(const LAS f32x4*)(Kk + d), qq = *(const LAS f32x4*)(Qq + d);
#pragma unroll
                for (int i = 0; i < 4; ++i) { S[4 * j4 + i] = gamma * S[4 * j4 + i] + kk[i] * vv; acc += S[4 * j4 + i] * qq[i]; } }
            Pp[(dq * 16 + tt) * 64 + e] = acc; }
        __syncthreads();
#pragma unroll
        for (int r = 0; r < 2; ++r) { const int tt = 2 * F.wave + r;
            float o = 0.f;
#pragma unroll
            for (int q = 0; q < 8; ++q) o += Pp[(q * 16 + tt) * 64 + F.lane];
            const float rr = rsqrtf(wave_sum(o * o) * (1.0f / 64.0f) + NORM_EPS);
            om[(size_t)(b * SEQ + t0 + tt) * 1024 + 512 + h * 64 + F.lane] = (bf16)f2bf(o * rr * gn[F.lane] * Gt[tt * 64 + F.lane]); }
        __syncthreads();
    }
}
__device__ __forceinline__ void gdn_naive(Frame& F, int l, int b, int h) {
    LAS float* Kk = (LAS float*)F.lds;
    LAS float* Qq = Kk + 1024, *Vv = Qq + 1024, *Gt = Vv + 1024, *AB = Gt + 1024;
    const bf16* z = (const bf16*)(F.ws + WS_R1);
    const float* gab = (const float*)(F.ws + WS_GAB);
    const float* gn = pin(F, I_GDNG) + l * 256 + h * 64;
    const float* cw = pin(F, I_CONVW) + (size_t)l * 4 * 768;
    const float Aexp = __expf(pin(F, I_ALOG)[l * 4 + h]), dtb = pin(F, I_DTB)[l * 4 + h];
    bf16* om = (bf16*)(F.ws + WS_OMIX);
    float S[32];
#pragma unroll
    for (int j = 0; j < 32; ++j) S[j] = 0.f;
    const int ge = 32 * (F.wave & 1) + (F.lane & 31), gdh = F.lane >> 5;
    for (int t0 = 0; t0 < SEQ; t0 += 16) {
#pragma unroll
        for (int i = 0; i < 6; ++i) { const int idx = F.tid + 512 * i, tt = idx / 192, rem = idx % 192, which = rem >> 6, d = rem & 63;
            const int ch = which * 256 + h * 64 + d, t = t0 + tt; float u = 0.f;
#pragma unroll
            for (int j = 0; j < 4; ++j) { const int ts = t - 3 + j; if (ts >= 0) u += cw[j * 768 + ch] * bf2f(z[(size_t)(b * SEQ + ts) * NZ + 3072 + ch]); }
            const float a = siluf(u);
            if (which == 0) Qq[tt * 64 + d] = a; else if (which == 1) Kk[tt * 64 + d] = a; else Vv[tt * 64 + d] = a; }
#pragma unroll
        for (int i = 0; i < 2; ++i) { const int idx = F.tid + 512 * i, tt = idx >> 6, d = idx & 63;
            Gt[idx] = siluf(bf2f(z[(size_t)(b * SEQ + t0 + tt) * NZ + 3840 + h * 64 + d])); }
        if (F.tid < 16) { const float* gr = gab + (size_t)(b * SEQ + t0 + F.tid) * 8;
            const float xa = gr[h] + dtb, sp = (xa > 20.f) ? xa : log1pf(__expf(xa));
            AB[F.tid * 2] = __expf(-Aexp * sp); AB[F.tid * 2 + 1] = sigm(gr[4 + h]); }
        __syncthreads();
#pragma unroll
        for (int r = 0; r < 4; ++r) { const int vi = F.wave * 4 + r, tt = vi & 15; LAS float* arr = (vi < 16) ? Qq : Kk;
            const float x = arr[tt * 64 + F.lane]; const float rr = rsqrtf(wave_sum(x * x) + 1e-6f);
            arr[tt * 64 + F.lane] = x * rr * ((vi < 16) ? 0.125f : 1.0f); }
        __syncthreads();
        LAS float* Oo = AB + 64;
        if (F.wave < 2) {
            for (int tt = 0; tt < 16; ++tt) { const float vv = Vv[tt * 64 + ge], al = AB[tt * 2], be = AB[tt * 2 + 1];
                float u = 0.f;
#pragma unroll
                for (int j4 = 0; j4 < 8; ++j4) { const f32x4 kk = *(const LAS f32x4*)(Kk + tt * 64 + 32 * gdh + 4 * j4);
#pragma unroll
                    for (int i = 0; i < 4; ++i) u += S[4 * j4 + i] * kk[i]; }
                u += shx(u, 32, F.lane);
                const float w = be * (vv - al * u); float o = 0.f;
#pragma unroll
                for (int j4 = 0; j4 < 8; ++j4) { const f32x4 kk = *(const LAS f32x4*)(Kk + tt * 64 + 32 * gdh + 4 * j4), qq = *(const LAS f32x4*)(Qq + tt * 64 + 32 * gdh + 4 * j4);
#pragma unroll
                    for (int i = 0; i < 4; ++i) { S[4 * j4 + i] = al * S[4 * j4 + i] + kk[i] * w; o += S[4 * j4 + i] * qq[i]; }
                    if ((j4 & 1) == 1) __builtin_amdgcn_sched_barrier(0); }
                o += shx(o, 32, F.lane);
                if (gdh == 0) Oo[tt * 64 + ge] = o; }
        }
        __syncthreads();
#pragma unroll
        for (int r = 0; r < 2; ++r) { const int tt = 2 * F.wave + r; const float o = Oo[tt * 64 + F.lane];
            const float rr = rsqrtf(wave_sum(o * o) * (1.0f / 64.0f) + NORM_EPS);
            om[(size_t)(b * SEQ + t0 + tt) * 1024 + 768 + h * 64 + F.lane] = (bf16)f2bf(o * rr * gn[F.lane] * Gt[tt * 64 + F.lane]); }
        __syncthreads();
    }
}
__device__ __forceinline__ void phase_mix_naive(Frame& F, int l) {
    if (F.bid < 48) {
        const int u = F.bid, kind = u >> 4, b = (u >> 2) & 3, h = u & 3;
#ifdef NAIVE_HG
        if (kind == 0) hgrn_naive(F, l, b, h);
#endif
#ifdef NAIVE_RT
        if (kind == 1) ret_naive(F, l, b, h);
#endif
#ifndef NO_GD
        if (kind == 2) gdn_naive(F, l, b, h);
#endif
    }
}

#define MFMA16(a, b, c) __builtin_amdgcn_mfma_f32_16x16x32_bf16((a), (b), (c), 0, 0, 0)
__device__ __forceinline__ bf16x8 lfrag(const LAS bf16* base, int ld, int row, int k) { return *(const LAS bf16x8*)(base + row * ld + k); }
__device__ __forceinline__ bf16x8 gfrag(const bf16* base, int ld, int row, int k) { return *(const bf16x8*)(base + (size_t)row * ld + k); }
constexpr int GL_QS = 0, GL_KH = 17408, GL_VT = 34816, GL_SC = 53248, GL_KDT = 62464, GL_RAW = 80896, GL_STL = 84992, GL_DECL = 121600, GL_RS = 122112;

struct HgRaw { unsigned q[8], f[8], v[8]; };
__device__ __forceinline__ size_t zoff(int r, int c) { return ((size_t)(r >> 4) * 128 + (size_t)(c >> 5)) * 512 + (size_t)((r & 15) * 32 + (c & 31)); }
template <bool NEED_Q>
__device__ __forceinline__ void hg_issue(Frame& F, int b, int n, int h, HgRaw& r) {
    const bf16* z = (const bf16*)(F.ws + WS_R1) + zoff(b * SEQ + n * 64 + 8 * F.wave, h * 128 + 2 * F.lane);
#pragma unroll
    for (int i = 0; i < 8; ++i) { const unsigned* zr = (const unsigned*)(z + 32 * i);
        r.q[i] = NEED_Q ? __builtin_nontemporal_load(zr) : 0u; r.f[i] = __builtin_nontemporal_load(zr + 4096); r.v[i] = __builtin_nontemporal_load(zr + 8192); }
}
constexpr int GL_RSTL = 71680;
constexpr int GL_GNH = 122624, GL_GNR = 123136, GL_GNG = 123392, GL_LB = 123648;
constexpr int GL_BP = GL_RAW;
template <int MODE>
__device__ __forceinline__ void hg_prep(Frame& F, int l, int h, const HgRaw& r) {
    constexpr bool m3 = (MODE == 2);
    constexpr int LQ = 136, LT = 72;
    LAS bf16* QS = (LAS bf16*)(F.lds + GL_QS); LAS bf16* KH = (LAS bf16*)(F.lds + GL_KH); LAS bf16* VT = (LAS bf16*)(F.lds + GL_VT); LAS bf16* KDT = (LAS bf16*)(F.lds + GL_KDT);
    LAS float* BP = (LAS float*)(F.lds + GL_BP); LAS float* DECL = (LAS float*)(F.lds + GL_DECL);
    const int j = F.lane, w = F.wave;
    const f32x2 lb2 = *(const LAS f32x2*)(F.lds + GL_LB + 8 * j);
    float kx[2][8], pp[2][8], sx[2][8];
#pragma unroll
    for (int hh = 0; hh < 2; ++hh) { const float om = 1.0f - lb2[hh];
#pragma unroll
        for (int i = 0; i < 8; ++i) { const float fl = hh ? bfhi(r.f[i]) : bflo(r.f[i]); const float k = om * sigm(-fl); kx[hh][i] = k;
            const float f = fmaxf(1.0f - k, 4.0e-18f); pp[hh][i] = (i == 0) ? f : pp[hh][i - 1] * f; }
#pragma unroll
        for (int i = 7; i >= 0; --i) { const float fl = hh ? bfhi(r.f[i]) : bflo(r.f[i]); (void)fl; sx[hh][i] = (i == 7) ? 1.0f : sx[hh][i + 1] * fmaxf(1.0f - kx[hh][i + 1], 4.0e-18f); }
        BP[w * 128 + 2 * j + hh] = pp[hh][7]; }
    { u32x4 v0, v1;
      v0.x = (r.v[0] & 0xffffu) | (r.v[1] << 16); v0.y = (r.v[2] & 0xffffu) | (r.v[3] << 16); v0.z = (r.v[4] & 0xffffu) | (r.v[5] << 16); v0.w = (r.v[6] & 0xffffu) | (r.v[7] << 16);
      v1.x = (r.v[0] >> 16) | (r.v[1] & 0xffff0000u); v1.y = (r.v[2] >> 16) | (r.v[3] & 0xffff0000u); v1.z = (r.v[4] >> 16) | (r.v[5] & 0xffff0000u); v1.w = (r.v[6] >> 16) | (r.v[7] & 0xffff0000u);
      *(LAS u32x4*)(VT + (2 * j) * LT + 8 * w) = v0; *(LAS u32x4*)(VT + (2 * j + 1) * LT + 8 * w) = v1; }
    lds_barrier();
    float pre[2], post[2];
#pragma unroll
    for (int hh = 0; hh < 2; ++hh) { float a = 1.0f, c = 1.0f;
#pragma unroll
        for (int ww = 0; ww < 8; ++ww) { const float bp = BP[ww * 128 + 2 * j + hh]; a *= (ww < w) ? bp : 1.0f; c *= (ww > w) ? bp : 1.0f; }
        pre[hh] = a; post[hh] = c;
        if (w == 7) DECL[2 * j + hh] = a * pp[hh][7]; }
    if (m3) {
#pragma unroll
        for (int i = 0; i < 8; ++i) { float qs[2], kh[2];
#pragma unroll
            for (int hh = 0; hh < 2; ++hh) { const float q = hh ? bfhi(r.q[i]) : bflo(r.q[i]); const float P = pre[hh] * pp[hh][i];
                qs[hh] = siluf(q) * P; kh[hh] = kx[hh][i] * fminf(__builtin_amdgcn_rcpf(P), 5.5e34f); }
            *(LAS unsigned*)(QS + (8 * w + i) * LQ + 2 * j) = pk2(qs[0], qs[1]); *(LAS unsigned*)(KH + (8 * w + i) * LQ + 2 * j) = pk2(kh[0], kh[1]); }
    }
    {
#pragma unroll
        for (int hh = 0; hh < 2; ++hh) { float kd[8];
#pragma unroll
            for (int i = 0; i < 8; ++i) kd[i] = kx[hh][i] * sx[hh][i] * post[hh];
            u32x4 wv; wv.x = pk2(kd[0], kd[1]); wv.y = pk2(kd[2], kd[3]); wv.z = pk2(kd[4], kd[5]); wv.w = pk2(kd[6], kd[7]);
            *(LAS u32x4*)(KDT + (2 * j + hh) * LT + 8 * w) = wv; }
    }
    lds_barrier();
}
struct RtRaw { unsigned q[4], k[4], v[4]; };
template <bool NEED_Q>
__device__ __forceinline__ void rt_issue(Frame& F, int b, int n, int h, RtRaw& r) {
    const bf16* z = (const bf16*)(F.ws + WS_R1);
#pragma unroll
    for (int i = 0; i < 4; ++i) { const int idx = F.tid + 512 * i, t = idx >> 5, j = idx & 31;
        const unsigned* zr = (const unsigned*)(z + zoff(b * SEQ + n * 64 + t, 2048 + h * 64 + 2 * j));
        r.q[i] = NEED_Q ? __builtin_nontemporal_load(zr) : 0u; r.k[i] = __builtin_nontemporal_load(zr + 2048); r.v[i] = __builtin_nontemporal_load(zr + 4096); }
}
template <bool NEED_Q>
__device__ __forceinline__ void rt_stage(Frame& F, const RtRaw& r) {
    LAS unsigned* RQ = (LAS unsigned*)(F.lds + GL_RAW); LAS unsigned* RK = RQ + 64 * 33; LAS unsigned* RV = RK + 64 * 33;
#pragma unroll
    for (int i = 0; i < 4; ++i) { const int idx = F.tid + 512 * i, t = idx >> 5, j = idx & 31;
        if (NEED_Q) RQ[t * 33 + j] = r.q[i]; RK[t * 33 + j] = r.k[i]; RV[t * 33 + j] = r.v[i]; }
}
template <int MODE>
__device__ __forceinline__ void rt_prep(Frame& F, int n, int h) {
    constexpr bool m3 = (MODE == 2);
    constexpr int LQ = 72, LT = 72;
    LAS bf16* QS = (LAS bf16*)(F.lds + GL_QS); LAS bf16* KH = (LAS bf16*)(F.lds + GL_KH); LAS bf16* VT = (LAS bf16*)(F.lds + GL_VT); LAS bf16* KDT = (LAS bf16*)(F.lds + GL_KDT);
    LAS unsigned* RQ = (LAS unsigned*)(F.lds + GL_RAW); LAS unsigned* RK = RQ + 64 * 33; LAS unsigned* RV = RK + 64 * 33;
    const int t = F.lane;
    const float lg = log1pf(-exp2f(-5.0f - (float)h));
    const float bt = (float)(t + 1) * lg, eq = __expf(bt), ekh = __expf(-bt) * 0.125f, ekd = __expf(64.0f * lg - bt) * 0.125f;
    const double* ropet = (const double*)(F.ws + WS_ROPE);
    const LAS bf16* rq = (const LAS bf16*)RQ; const LAS bf16* rk = (const LAS bf16*)RK; const LAS bf16* rv = (const LAS bf16*)RV;
    float qa4[4], qb4[4], ka4[4], kb4[4];
#pragma unroll
    for (int i = 0; i < 4; ++i) { const int ri = F.wave * 4 + i;
        double rev = (double)(n * 64 + t) * ropet[ri]; rev -= floor(rev);
        float sn, cs; __sincosf((float)rev * 6.283185307179586f, &sn, &cs);
        const float q1 = bf2f(rq[t * 66 + ri]), q2 = bf2f(rq[t * 66 + 32 + ri]), k1 = bf2f(rk[t * 66 + ri]), k2 = bf2f(rk[t * 66 + 32 + ri]);
        const float qa = q1 * cs - q2 * sn, qb = q1 * sn + q2 * cs, ka = k1 * cs - k2 * sn, kb = k1 * sn + k2 * cs;
        qa4[i] = qa * eq; qb4[i] = qb * eq; ka4[i] = ka * ekh; kb4[i] = kb * ekh;
        { KDT[ri * LT + t] = (bf16)f2bf(ka * ekd); KDT[(32 + ri) * LT + t] = (bf16)f2bf(kb * ekd); }
    }
    if (m3) { u32x2 w;
        w.x = pk2(qa4[0], qa4[1]); w.y = pk2(qa4[2], qa4[3]); *(LAS u32x2*)(QS + t * LQ + 4 * F.wave) = w;
        w.x = pk2(qb4[0], qb4[1]); w.y = pk2(qb4[2], qb4[3]); *(LAS u32x2*)(QS + t * LQ + 32 + 4 * F.wave) = w;
        w.x = pk2(ka4[0], ka4[1]); w.y = pk2(ka4[2], ka4[3]); *(LAS u32x2*)(KH + t * LQ + 4 * F.wave) = w;
        w.x = pk2(kb4[0], kb4[1]); w.y = pk2(kb4[2], kb4[3]); *(LAS u32x2*)(KH + t * LQ + 32 + 4 * F.wave) = w; }
#pragma unroll
    for (int i = 0; i < 8; ++i) { const int e = F.wave * 8 + i; VT[e * LT + t] = rv[t * 66 + e]; }
    lds_barrier();
}
template <int DK, int DV>
__device__ __forceinline__ void gla_m1_mma(Frame& F, bf16* kvt  ) {
    constexpr int LT = 72, NXT = DK / 16, NYT = DV / 16, PER = NXT * NYT / 8;
    const LAS bf16* KDT = (const LAS bf16*)(F.lds + GL_KDT); const LAS bf16* VT = (const LAS bf16*)(F.lds + GL_VT);
    const int fr = F.lane & 15, fq = F.lane >> 4;
    const int yt = (NYT == 8) ? F.wave : (F.wave & 3), xt0 = (NYT == 8) ? 0 : 2 * (F.wave >> 2);
    f32x4 acc[PER];
#pragma unroll
    for (int i = 0; i < PER; ++i) acc[i] = (f32x4){0.f, 0.f, 0.f, 0.f};
#pragma unroll
    for (int ks = 0; ks < 2; ++ks) { const bf16x8 yf = lfrag(VT, LT, yt * 16 + fr, 32 * ks + 8 * fq);
#pragma unroll
        for (int i = 0; i < PER; ++i) acc[i] = MFMA16(lfrag(KDT, LT, (xt0 + i) * 16 + fr, 32 * ks + 8 * fq), yf, acc[i]); }
#pragma unroll
    for (int i = 0; i < PER; ++i) { u32x2 w; w.x = pk2(acc[i][0], acc[i][1]); w.y = pk2(acc[i][2], acc[i][3]); *(u32x2*)(kvt + (size_t)(yt * 16 + fr) * DK + (xt0 + i) * 16 + 4 * fq) = w; }
}
__device__ __forceinline__ void hg_kv_acc(Frame& F, f32x4 (&kv)[8]) {
    const LAS bf16* KDT = (const LAS bf16*)(F.lds + GL_KDT); const LAS bf16* VT = (const LAS bf16*)(F.lds + GL_VT);
    const int fr = F.lane & 15, fq = F.lane >> 4;
#pragma unroll
    for (int i = 0; i < 8; ++i) kv[i] = (f32x4){0.f, 0.f, 0.f, 0.f};
#pragma unroll
    for (int ks = 0; ks < 2; ++ks) { const bf16x8 yf = lfrag(VT, 72, F.wave * 16 + fr, 32 * ks + 8 * fq);
#pragma unroll
        for (int i = 0; i < 8; ++i) kv[i] = MFMA16(lfrag(KDT, 72, i * 16 + fr, 32 * ks + 8 * fq), yf, kv[i]); }
}
__device__ __forceinline__ void rt_kv_acc(Frame& F, f32x4 (&kv)[2]) {
    const LAS bf16* KDT = (const LAS bf16*)(F.lds + GL_KDT); const LAS bf16* VT = (const LAS bf16*)(F.lds + GL_VT);
    const int fr = F.lane & 15, fq = F.lane >> 4, yt = F.wave & 3, xt0 = 2 * (F.wave >> 2);
    kv[0] = (f32x4){0.f, 0.f, 0.f, 0.f}; kv[1] = (f32x4){0.f, 0.f, 0.f, 0.f};
#pragma unroll
    for (int ks = 0; ks < 2; ++ks) { const bf16x8 yf = lfrag(VT, 72, yt * 16 + fr, 32 * ks + 8 * fq);
#pragma unroll
        for (int i = 0; i < 2; ++i) kv[i] = MFMA16(lfrag(KDT, 72, (xt0 + i) * 16 + fr, 32 * ks + 8 * fq), yf, kv[i]); }
}
__device__ __forceinline__ int xrow(int PER, int hi, int i, int r) { return PER * hi * 16 + 32 * (i >> 1) + 8 * (r >> 2) + 4 * (i & 1) + (r & 3); }
template <int PER, int DV>
__device__ __forceinline__ void mix_out_epilogue(Frame& F, const f32x4 (&acc)[PER], const LAS float* gn, const u32x4 (&gqv)[PER / 2], bf16* om) {
    LAS float* RS = (LAS float*)(F.lds + GL_RS);
    const int fr = F.lane & 15, fq = F.lane >> 4, tt = F.wave & 3, hi = F.wave >> 2;
    float ss = 0.f;
#pragma unroll
    for (int i = 0; i < PER; ++i) ss += (acc[i][0] * acc[i][0] + acc[i][1] * acc[i][1]) + (acc[i][2] * acc[i][2] + acc[i][3] * acc[i][3]);
    ss += shx(ss, 16, F.lane); ss += shx(ss, 32, F.lane);
    if (fq == 0) RS[hi * 64 + tt * 16 + fr] = ss;
    lds_barrier();
    const int t = tt * 16 + fr;
    const float rr = rsqrtf((RS[t] + RS[64 + t]) * (1.0f / (float)DV) + NORM_EPS);
#pragma unroll
    for (int p = 0; p < PER / 2; ++p) { const int e0 = PER * hi * 16 + 32 * p + 8 * fq; u32x4 wo;
#pragma unroll
        for (int q = 0; q < 2; ++q) { const int i = 2 * p + q, e = e0 + 4 * q;
            const unsigned gx = q ? gqv[p].z : gqv[p].x, gy = q ? gqv[p].w : gqv[p].y; const f32x4 g4 = *(const LAS f32x4*)(gn + e);
            const float o0 = acc[i][0] * rr * g4[0] * siluf(bflo(gx)), o1 = acc[i][1] * rr * g4[1] * siluf(bfhi(gx)), o2 = acc[i][2] * rr * g4[2] * siluf(bflo(gy)), o3 = acc[i][3] * rr * g4[3] * siluf(bfhi(gy));
            if (q) { wo.z = pk2(o0, o1); wo.w = pk2(o2, o3); } else { wo.x = pk2(o0, o1); wo.y = pk2(o2, o3); } }
        __builtin_amdgcn_raw_buffer_store_b128(wo, __builtin_amdgcn_make_buffer_rsrc((void*)om, 0, 0x7fffffff, 0x00020000), ((t >> 4) * 16384 + (e0 >> 5) * 512 + (t & 15) * 32 + (e0 & 31)) * 2, 0, 16); }
}
template <int DK, int DV>
__device__ __forceinline__ void gla_m3_loads(Frame& F, const bf16* spt, const bf16* zgate, bf16x8 (&sf)[DV / 32][DK / 32], u32x2 (&gw)[DV / 32]) {
    constexpr int KS = DK / 32, PER = DV / 32;
    const int fr = F.lane & 15, fq = F.lane >> 4, tt = F.wave & 3, hi = F.wave >> 2;
#pragma unroll
    for (int i = 0; i < PER; ++i) { gw[i] = *(const u32x2*)(zgate + (size_t)(tt * 16 + fr) * NZ + (PER * hi + i) * 16 + 4 * fq);
#pragma unroll
        for (int ks = 0; ks < KS; ++ks) sf[i][ks] = gfrag(spt, DK, (PER * hi + i) * 16 + fr, 32 * ks + 8 * fq); }
}
template <int DK, int DV, bool ST_LDS, int STO, class Mid>
__device__ __forceinline__ void gla_m3_mma(Frame& F, const bf16x8 (&sf)[DV / 32][DK / 32], const u32x4 (&gw)[DV / 64], const LAS float* gn  , bf16* om  , Mid mid) {
    constexpr int LQ = DK + 8, LT = 72, KS = DK / 32, PER = DV / 32;
    const LAS bf16* QS = (const LAS bf16*)(F.lds + GL_QS); const LAS bf16* KH = (const LAS bf16*)(F.lds + GL_KH); const LAS bf16* VT = (const LAS bf16*)(F.lds + GL_VT);
    LAS bf16* SC = (LAS bf16*)(F.lds + GL_SC); LAS float* RS = (LAS float*)(F.lds + GL_RS);
    const int fr = F.lane & 15, fq = F.lane >> 4, tt = F.wave & 3, hi = F.wave >> 2;
    {
        f32x4 a2[2] = {(f32x4){0.f, 0.f, 0.f, 0.f}, (f32x4){0.f, 0.f, 0.f, 0.f}};
#pragma unroll
        for (int ks = 0; ks < KS; ++ks) { const bf16x8 yf = lfrag(QS, LQ, tt * 16 + fr, 32 * ks + 8 * fq);
#pragma unroll
            for (int i = 0; i < 2; ++i) a2[i] = MFMA16(lfrag(KH, LQ, (2 * hi + i) * 16 + fr, 32 * ks + 8 * fq), yf, a2[i]); }
#pragma unroll
        for (int i = 0; i < 2; ++i) { const int t = tt * 16 + fr, s0 = (2 * hi + i) * 16 + 4 * fq; float v[4];
#pragma unroll
            for (int j = 0; j < 4; ++j) v[j] = (s0 + j <= t) ? a2[i][j] : 0.0f;
            u32x2 w; w.x = pk2(v[0], v[1]); w.y = pk2(v[2], v[3]); *(LAS u32x2*)(SC + t * LT + s0) = w; }
    }
    mid();
    lds_barrier();
    f32x4 acc[PER];
#pragma unroll
    for (int i = 0; i < PER; ++i) acc[i] = (f32x4){0.f, 0.f, 0.f, 0.f};
#pragma unroll
    for (int ks = 0; ks < 2; ++ks) { const bf16x8 yf = lfrag(SC, LT, tt * 16 + fr, 32 * ks + 8 * fq);
#pragma unroll
        for (int i = 0; i < PER; ++i) acc[i] = MFMA16(lfrag(VT, LT, xrow(PER, hi, i, fr), 32 * ks + 8 * fq), yf, acc[i]); }
#pragma unroll
    for (int ks = 0; ks < KS; ++ks) { const bf16x8 yf = lfrag(QS, LQ, tt * 16 + fr, 32 * ks + 8 * fq);
#pragma unroll
        for (int i = 0; i < PER; ++i) acc[i] = MFMA16(ST_LDS ? lfrag((const LAS bf16*)(F.lds + STO), DK + 8, xrow(PER, hi, i, fr), 32 * ks + 8 * fq) : sf[i][ks], yf, acc[i]); }
    mix_out_epilogue<PER, DV>(F, acc, gn, gw, om);
}
constexpr int GD_CW = 119552;
constexpr int GD_RAW = 0, GD_MM = 0, GD_CQ = 26112, GD_XT = 26112, GD_CK = 44544, GD_CV = 61184, GD_QN = 77824, GD_KN = 87040, GD_KDT = 96256, GD_QDL = 105472, GD_PART = 114688, GD_BV = 118784, GD_BK = 119040, GD_GC = 119296;
struct GdRaw { unsigned w[13]; float ga, gb; };
__device__ __forceinline__ void gdn_issue(Frame& F, int b, int n, int h, GdRaw& r) {
    const bf16* z = (const bf16*)(F.ws + WS_R1);
#pragma unroll
    for (int i = 0; i < 13; ++i) { const int idx = F.tid + 512 * i, rr = idx / 96, j = idx - rr * 96, seg = j >> 5, jj = j & 31, ts = n * 64 - 3 + rr;
        unsigned w = 0u; if (idx < 67 * 96 && ts >= 0) w = __builtin_nontemporal_load((const unsigned*)(z + zoff(b * SEQ + ts, 3072 + seg * 256 + h * 64 + 2 * jj)));
        r.w[i] = w; }
    const float* gr = (const float*)(F.ws + WS_GAB) + (size_t)(b * SEQ + n * 64 + F.lane) * 8;
    r.ga = gr[h]; r.gb = gr[4 + h];
}
__device__ __forceinline__ void gdn_stage(Frame& F, const GdRaw& r) {
    LAS unsigned* RAW = (LAS unsigned*)(F.lds + GD_RAW);
#pragma unroll
    for (int i = 0; i < 13; ++i) { const int idx = F.tid + 512 * i, rr = idx / 96, j = idx - rr * 96; if (idx < 67 * 96) RAW[rr * 97 + j] = r.w[i]; }
}
__device__ __forceinline__ void gdn_load_cw(Frame& F, int l, int h) {
    LAS float* CW = (LAS float*)(F.lds + GD_CW); const float* cw = pin(F, I_CONVW) + (size_t)l * 4 * 768;
    for (int i = F.tid; i < 768; i += 512) { const int j = i / 192, rem = i - j * 192, c = rem >> 1, p = rem & 1, seg = c >> 5, jj = c & 31; CW[i] = cw[j * 768 + seg * 256 + h * 64 + 2 * jj + p]; }
}
__device__ __forceinline__ void gdn_m1(Frame& F, int l, int h, int uid, const GdRaw& raw) {
    LAS unsigned* RAW = (LAS unsigned*)(F.lds + GD_RAW); LAS float* MM = (LAS float*)(F.lds + GD_MM);
    LAS float* CQ = (LAS float*)(F.lds + GD_CQ); LAS float* CK = (LAS float*)(F.lds + GD_CK); LAS float* CV = (LAS float*)(F.lds + GD_CV);
    LAS bf16* XT = (LAS bf16*)(F.lds + GD_XT); LAS bf16* QN = (LAS bf16*)(F.lds + GD_QN); LAS bf16* KN = (LAS bf16*)(F.lds + GD_KN);
    LAS bf16* KDT = (LAS bf16*)(F.lds + GD_KDT); LAS bf16* QDL = (LAS bf16*)(F.lds + GD_QDL);
    LAS float* PART = (LAS float*)(F.lds + GD_PART); LAS float* BV = (LAS float*)(F.lds + GD_BV); LAS float* BK = (LAS float*)(F.lds + GD_BK); LAS float* GCL = (LAS float*)(F.lds + GD_GC);
    const int t = F.lane;
    float gc, beta, gl;
    { const float Aexp = __expf(pin(F, I_ALOG)[l * 4 + h]), xa = raw.ga + pin(F, I_DTB)[l * 4 + h], sp = (xa > 20.f) ? xa : log1pf(__expf(xa));
      gc = wave_scan_incl(-Aexp * sp, F.lane); gl = __shfl(gc, 63); beta = sigm(raw.gb); }
    const LAS float* CW = (const LAS float*)(F.lds + GD_CW);
    float pq = 0.f, pk = 0.f;
#pragma unroll 2
    for (int i = 0; i < 12; ++i) { const int c = F.wave * 12 + i, seg = c >> 5, jj = c & 31;
        float u0 = 0.f, u1 = 0.f;
#pragma unroll
        for (int j = 0; j < 4; ++j) { const unsigned w = RAW[(t + j) * 97 + c]; const f32x2 cwv = *(const LAS f32x2*)(CW + (j * 96 + c) * 2); u0 += cwv[0] * bflo(w); u1 += cwv[1] * bfhi(w); }
        const float a0 = siluf(u0), a1 = siluf(u1);
        LAS float* dst = (seg == 0) ? CQ : ((seg == 1) ? CK : CV);
        dst[t * 65 + 2 * jj] = a0; dst[t * 65 + 2 * jj + 1] = a1;
        const float s2 = a0 * a0 + a1 * a1; pq += (seg == 0) ? s2 : 0.f; pk += (seg == 1) ? s2 : 0.f; }
    PART[(F.wave * 2 + 0) * 64 + t] = pq; PART[(F.wave * 2 + 1) * 64 + t] = pk;
    lds_barrier();
    { float sq = 0.f, sk = 0.f;
#pragma unroll
      for (int w = 0; w < 8; ++w) { sq += PART[(w * 2) * 64 + t]; sk += PART[(w * 2 + 1) * 64 + t]; }
      const float rq = rsqrtf(sq + 1e-6f) * 0.125f, rk = rsqrtf(sk + 1e-6f), eg = __expf(gc), ekd = __expf(gl - gc);
      float qn[8], kn[8];
#pragma unroll
      for (int i = 0; i < 8; ++i) { const int d = F.wave * 8 + i; qn[i] = CQ[t * 65 + d] * rq; kn[i] = CK[t * 65 + d] * rk; KDT[d * 72 + t] = (bf16)f2bf(kn[i] * ekd); CK[t * 65 + d] = kn[i]; }
      { u32x4 wq, wk, wd;
        wq.x = pk2(qn[0], qn[1]); wq.y = pk2(qn[2], qn[3]); wq.z = pk2(qn[4], qn[5]); wq.w = pk2(qn[6], qn[7]);
        wk.x = pk2(kn[0], kn[1]); wk.y = pk2(kn[2], kn[3]); wk.z = pk2(kn[4], kn[5]); wk.w = pk2(kn[6], kn[7]);
        wd.x = pk2(qn[0] * eg, qn[1] * eg); wd.y = pk2(qn[2] * eg, qn[3] * eg); wd.z = pk2(qn[4] * eg, qn[5] * eg); wd.w = pk2(qn[6] * eg, qn[7] * eg);
        *(LAS u32x4*)(QN + t * 72 + 8 * F.wave) = wq; *(LAS u32x4*)(KN + t * 72 + 8 * F.wave) = wk; *(LAS u32x4*)(QDL + t * 72 + 8 * F.wave) = wd; }
      if (F.wave == 0) { BV[t] = beta; BK[t] = beta * eg; GCL[t] = gc; } }
    lds_barrier();
    const int fr = F.lane & 15, fq = F.lane >> 4, tt = F.wave & 3, hi = F.wave >> 2;
    {
        const LAS bf16* Y = hi ? QN : KN;
        f32x4 a4[4];
#pragma unroll
        for (int i = 0; i < 4; ++i) a4[i] = (f32x4){0.f, 0.f, 0.f, 0.f};
#pragma unroll
        for (int ks = 0; ks < 2; ++ks) { const bf16x8 yf = lfrag(Y, 72, tt * 16 + fr, 32 * ks + 8 * fq);
#pragma unroll
            for (int i = 0; i < 4; ++i) a4[i] = MFMA16(lfrag(KN, 72, xrow(4, 0, i, fr), 32 * ks + 8 * fq), yf, a4[i]); }
        const int tr = tt * 16 + fr; const float gct = GCL[tr], bt = BV[tr];
        bf16* gqk = (bf16*)(F.ws + WS_GQK) + (size_t)uid * 4096;
        u32x4 wq[2];
#pragma unroll
        for (int i = 0; i < 4; ++i) { const int s0 = 32 * (i >> 1) + 8 * fq + 4 * (i & 1); const f32x4 gs = *(const LAS f32x4*)(GCL + s0); float v[4];
#pragma unroll
            for (int j = 0; j < 4; ++j) { const bool keep = hi ? (s0 + j <= tr) : (s0 + j < tr); v[j] = keep ? a4[i][j] * __expf(gct - gs[j]) * (hi ? 1.0f : bt) : 0.0f; }
            if (hi) { if (i & 1) { wq[i >> 1].z = pk2(v[0], v[1]); wq[i >> 1].w = pk2(v[2], v[3]); } else { wq[i >> 1].x = pk2(v[0], v[1]); wq[i >> 1].y = pk2(v[2], v[3]); } }
            else *(LAS f32x4*)(MM + tr * 68 + s0) = (f32x4){v[0], v[1], v[2], v[3]}; }
        if (hi) {
#pragma unroll
            for (int p = 0; p < 2; ++p) wt_store128((void*)gqk, (p * 2048 + tr * 32 + 8 * fq) * 2, wq[p]); }
    }
    lds_barrier();
    {
        typedef short s16x4 __attribute__((ext_vector_type(4)));
        LAS bf16* MMb = (LAS bf16*)(F.lds + GD_QN);
        LAS bf16* LINV = (LAS bf16*)(F.lds + GD_PART);
        for (int i = F.tid; i < 128 * 72 / 8; i += 512) *(LAS u32x4*)(XT + 8 * i) = (u32x4){0u, 0u, 0u, 0u};
        { const int r = F.tid >> 3, c8 = F.tid & 7; const f32x4 a = *(const LAS f32x4*)(MM + r * 68 + 8 * c8), b2 = *(const LAS f32x4*)(MM + r * 68 + 8 * c8 + 4);
          u32x4 w; w.x = pk2(a[0], a[1]); w.y = pk2(a[2], a[3]); w.z = pk2(b2[0], b2[1]); w.w = pk2(b2[2], b2[3]); *(LAS u32x4*)(MMb + r * 72 + 8 * c8) = w; }
        if (F.wave < 4) {
            const int bq = F.wave;
            LAS bf16* Rr = (LAS bf16*)(F.lds + GD_KN) + bq * 960; LAS bf16* Cc = Rr + 320; LAS bf16* Pr = Cc + 320;
            f32x4 n4, p4;
#pragma unroll
            for (int j = 0; j < 4; ++j) { n4[j] = -MM[(16 * bq + 4 * fq + j) * 68 + 16 * bq + fr]; p4[j] = n4[j] + ((4 * fq + j == fr) ? 1.0f : 0.0f); }
            { u32x2 w; w.x = pk2(n4[0], n4[1]); w.y = pk2(n4[2], n4[3]); *(LAS u32x2*)(Cc + fr * 20 + 4 * fq) = w; }
#pragma unroll
            for (int j = 0; j < 4; ++j) { Rr[(4 * fq + j) * 20 + fr] = (bf16)f2bf(n4[j]); Pr[(4 * fq + j) * 20 + fr] = (bf16)f2bf(p4[j]); }
#pragma unroll
            for (int s = 0; s < 3; ++s) {
                asm volatile("s_waitcnt lgkmcnt(0)" ::: "memory");
                const s16x4 xr = *(const LAS s16x4*)(Rr + fr * 20 + 4 * fq), yc = *(const LAS s16x4*)(Cc + fr * 20 + 4 * fq);
                const f32x4 a2 = __builtin_amdgcn_mfma_f32_16x16x16bf16_1k(xr, yc, (f32x4){0.f, 0.f, 0.f, 0.f}, 0, 0, 0);
                const s16x4 xp = *(const LAS s16x4*)(Pr + fr * 20 + 4 * fq);
                asm volatile("s_waitcnt lgkmcnt(0)" ::: "memory");
                { u32x2 w; w.x = pk2(a2[0], a2[1]); w.y = pk2(a2[2], a2[3]); *(LAS u32x2*)(Cc + fr * 20 + 4 * fq) = w; }
#pragma unroll
                for (int j = 0; j < 4; ++j) Rr[(4 * fq + j) * 20 + fr] = (bf16)f2bf(a2[j]);
                asm volatile("s_waitcnt lgkmcnt(0)" ::: "memory");
                const s16x4 yc2 = *(const LAS s16x4*)(Cc + fr * 20 + 4 * fq);
                p4 = __builtin_amdgcn_mfma_f32_16x16x16bf16_1k(xp, yc2, p4, 0, 0, 0);
#pragma unroll
                for (int j = 0; j < 4; ++j) Pr[(4 * fq + j) * 20 + fr] = (bf16)f2bf(p4[j]);
            }
#pragma unroll
            for (int j = 0; j < 4; ++j) LINV[bq * 320 + (4 * fq + j) * 20 + fr] = (bf16)f2bf(p4[j]);
        }
        lds_barrier();
        const int cw = 16 * F.wave + fr;
        const LAS float* SRCw = (cw < 64) ? (CV + cw) : (CK + (cw - 64)); const LAS float* COEFw = (cw < 64) ? BV : BK;
#pragma unroll 1
        for (int bt = 0; bt < 4; ++bt) {
            f32x4 acc = (f32x4){0.f, 0.f, 0.f, 0.f};
            if (bt > 0) acc = MFMA16(lfrag(MMb, 72, 16 * bt + fr, 8 * fq), lfrag(XT, 72, cw, 8 * fq), acc);
            if (bt == 3) acc = MFMA16(lfrag(MMb, 72, 16 * bt + fr, 32 + 8 * fq), lfrag(XT, 72, cw, 32 + 8 * fq), acc);
            float y[4];
#pragma unroll
            for (int j = 0; j < 4; ++j) { const int t2 = 16 * bt + 4 * fq + j; y[j] = SRCw[t2 * 65] * COEFw[t2] - acc[j]; }
            u32x2 yw; yw.x = pk2m(y[0], y[1]); yw.y = pk2m(y[2], y[3]);
            const s16x4 li = *(const LAS s16x4*)(LINV + bt * 320 + fr * 20 + 4 * fq);
            const f32x4 x4 = __builtin_amdgcn_mfma_f32_16x16x16bf16_1k(li, __builtin_bit_cast(s16x4, yw), (f32x4){0.f, 0.f, 0.f, 0.f}, 0, 0, 0);
            { u32x2 w; w.x = pk2(x4[0], x4[1]); w.y = pk2(x4[2], x4[3]); *(LAS u32x2*)(XT + cw * 72 + 16 * bt + 4 * fq) = w; }
            lds_barrier();
        }
    }
    {
        const LAS bf16* X = hi ? KDT : (XT + 64 * 72); const LAS bf16* Y = hi ? XT : KDT;
        f32x4 a4[4];
#pragma unroll
        for (int i = 0; i < 4; ++i) a4[i] = (f32x4){0.f, 0.f, 0.f, 0.f};
#pragma unroll
        for (int ks = 0; ks < 2; ++ks) { const bf16x8 yf = lfrag(Y, 72, tt * 16 + fr, 32 * ks + 8 * fq);
#pragma unroll
            for (int i = 0; i < 4; ++i) a4[i] = MFMA16(lfrag(X, 72, i * 16 + fr, 32 * ks + 8 * fq), yf, a4[i]); }
        const int yr = tt * 16 + fr;
        if (hi) { bf16* ut = (bf16*)(F.ws + WS_GUT) + (size_t)uid * 4096;
            u32x4 w0, w1; w0.x = pk2(a4[0][0], a4[0][1]); w0.y = pk2(a4[0][2], a4[0][3]); w0.z = pk2(a4[1][0], a4[1][1]); w0.w = pk2(a4[1][2], a4[1][3]);
            w1.x = pk2(a4[2][0], a4[2][1]); w1.y = pk2(a4[2][2], a4[2][3]); w1.z = pk2(a4[3][0], a4[3][1]); w1.w = pk2(a4[3][2], a4[3][3]);
            wt_store128((void*)ut, (yr * 32 + fq * 8) * 2, w0); wt_store128((void*)ut, (2048 + yr * 32 + fq * 8) * 2, w1);
            LAS bf16* ul = (LAS bf16*)(F.lds + GD_KN) + yr * 64; *(LAS u32x4*)(ul + (((2 * fq) ^ (yr & 7)) << 3)) = w0; *(LAS u32x4*)(ul + (((2 * fq + 1) ^ (yr & 7)) << 3)) = w1; }
        else { bf16* gt = (bf16*)(F.ws + WS_GT) + (size_t)uid * 4096; const float last = __expf(gl);
            unsigned pw[4][2];
#pragma unroll
            for (int i = 0; i < 4; ++i) { const int d0 = i * 16 + 4 * fq; float v[4];
#pragma unroll
                for (int j = 0; j < 4; ++j) v[j] = ((d0 + j == yr) ? last : 0.0f) - a4[i][j];
                pw[i][0] = pk2(v[0], v[1]); pw[i][1] = pk2(v[2], v[3]); }
#pragma unroll
            for (int ks = 0; ks < 2; ++ks) { u32x4 w; w.x = pw[2 * ks][0]; w.y = pw[2 * ks][1]; w.z = pw[2 * ks + 1][0]; w.w = pw[2 * ks + 1][1]; wt_store128((void*)gt, (ks * 2048 + yr * 32 + fq * 8) * 2, w);
                *(LAS u32x4*)((LAS bf16*)(F.lds + GD_QN) + yr * 64 + (((ks * 4 + fq) ^ (yr & 7)) << 3)) = w; } }
        {
            f32x4 kt[2] = {(f32x4){0.f, 0.f, 0.f, 0.f}, (f32x4){0.f, 0.f, 0.f, 0.f}};
#pragma unroll
            for (int ks = 0; ks < 2; ++ks) { const int p = 16 * tt + fr - 32 * ks - 8 * fq;
                u32x4 idw; idw.x = (p == 0) ? 0x3F80u : (p == 1) ? 0x3F800000u : 0u; idw.y = (p == 2) ? 0x3F80u : (p == 3) ? 0x3F800000u : 0u;
                idw.z = (p == 4) ? 0x3F80u : (p == 5) ? 0x3F800000u : 0u; idw.w = (p == 6) ? 0x3F80u : (p == 7) ? 0x3F800000u : 0u;
                const bf16x8 yf = __builtin_bit_cast(bf16x8, idw);
#pragma unroll
                for (int i = 0; i < 2; ++i) kt[i] = MFMA16(lfrag(XT, 72, 64 + xrow(2, hi, i, fr), 32 * ks + 8 * fq), yf, kt[i]); }
            u32x4 w; w.x = pk2(kt[0][0], kt[0][1]); w.y = pk2(kt[0][2], kt[0][3]); w.z = pk2(kt[1][0], kt[1][1]); w.w = pk2(kt[1][2], kt[1][3]);
            wt_store128((void*)((bf16*)(F.ws + WS_GKC) + (size_t)uid * 4096), (hi * 2048 + (16 * tt + fr) * 32 + 8 * fq) * 2, w); }
        { const int r = F.tid >> 3, c8 = F.tid & 7;
          wt_store128((void*)((bf16*)(F.ws + WS_GWT) + (size_t)uid * 4096), (r * 64 + 8 * c8) * 2, *(const LAS u32x4*)(XT + r * 72 + 8 * c8));
          wt_store128((void*)((bf16*)(F.ws + WS_GQD) + (size_t)uid * 4096), (r * 64 + 8 * c8) * 2, *(const LAS u32x4*)(QDL + r * 72 + 8 * c8)); }
    }
    lds_barrier();
}
struct GdnStep { u32x4 T[4][2]; u32x4 U[2]; };
__device__ __forceinline__ void gdn_m2_load(GdnStep& s, const bf16* gt, const bf16* ut, int n, int fr, int fq) {
    s.U[0] = *(const u32x4*)(ut + (size_t)n * 4096); s.U[1] = *(const u32x4*)(ut + (size_t)n * 4096 + 2048);
#pragma unroll
    for (int i = 0; i < 4; ++i)
#pragma unroll
        for (int ks = 0; ks < 2; ++ks) s.T[i][ks] = *(const u32x4*)(gt + (size_t)n * 4096 + ks * 2048 + (i * 16 + fr) * 32 + fq * 8);
}
__device__ __forceinline__ void gdn_step(f32x4 (&S)[4], const GdnStep& st, float us) {
    bf16x8 sf[2];
#pragma unroll
    for (int ks = 0; ks < 2; ++ks) { u32x4 w; w.x = pk2m(S[2 * ks][0], S[2 * ks][1]); w.y = pk2m(S[2 * ks][2], S[2 * ks][3]); w.z = pk2m(S[2 * ks + 1][0], S[2 * ks + 1][1]); w.w = pk2m(S[2 * ks + 1][2], S[2 * ks + 1][3]);
        sf[ks] = __builtin_bit_cast(bf16x8, w); }
#pragma unroll
    for (int i = 0; i < 4; ++i) { const unsigned u0 = (i & 1) ? st.U[i >> 1].z : st.U[i >> 1].x, u1 = (i & 1) ? st.U[i >> 1].w : st.U[i >> 1].y;
        f32x4 a = (f32x4){bflo(u0), bfhi(u0), bflo(u1), bfhi(u1)} * us;
#pragma unroll
        for (int ks = 0; ks < 2; ++ks) a = MFMA16(__builtin_bit_cast(bf16x8, st.T[i][ks]), sf[ks], a);
        S[i] = a; }
}
__device__ __forceinline__ void gdn_m2a(Frame& F, int bh, int seg) {
    const int fr = F.lane & 15, fq = F.lane >> 4, role = F.wave >> 2, c = (F.wave & 3) * 16 + fr;
    const bf16* gt = (const bf16*)(F.ws + WS_GT) + (size_t)(bh * 128 + seg * 8) * 4096;
    const bf16* ut = (const bf16*)(F.ws + WS_GUT) + (size_t)(bh * 128 + seg * 8) * 4096 + c * 64 + 8 * fq;
    const float us = role ? 0.0f : 1.0f;
    f32x4 S[4];
#pragma unroll
    for (int i = 0; i < 4; ++i)
#pragma unroll
        for (int j = 0; j < 4; ++j) S[i][j] = (role && (16 * i + 4 * fq + j == c)) ? 1.0f : 0.0f;
    GdnStep st[4];
#pragma unroll
    for (int r = 0; r < 4; ++r) gdn_m2_load(st[r], gt, ut, r, fr, fq);
    for (int n0 = 0; n0 < 8; n0 += 4) {
#pragma unroll
        for (int r = 0; r < 4; ++r) { const int n = n0 + r; gdn_step(S, st[r], us); gdn_m2_load(st[r], gt, ut, (n + 4 < 8) ? n + 4 : 7, fr, fq); } }
    if (role == 0) { bf16* qg = (bf16*)(F.ws + WS_GQG) + (size_t)(bh * 16 + seg) * 4096 + c * 64 + fq * 8;
        u32x4 w0, w1; w0.x = pk2(S[0][0], S[0][1]); w0.y = pk2(S[0][2], S[0][3]); w0.z = pk2(S[1][0], S[1][1]); w0.w = pk2(S[1][2], S[1][3]);
        w1.x = pk2(S[2][0], S[2][1]); w1.y = pk2(S[2][2], S[2][3]); w1.z = pk2(S[3][0], S[3][1]); w1.w = pk2(S[3][2], S[3][3]);
        *(u32x4*)qg = w0; *(u32x4*)(qg + 32) = w1; }
    else { bf16* pg = (bf16*)(F.ws + WS_GPG) + (size_t)(bh * 16 + seg) * 4096 + (c >> 5) * 32 + ((c & 15) >> 2) * 8 + ((c >> 4) & 1) * 4 + (c & 3);
#pragma unroll
        for (int i = 0; i < 4; ++i)
#pragma unroll
            for (int j = 0; j < 4; ++j) pg[(16 * i + 4 * fq + j) * 64] = (bf16)f2bf(S[i][j]); }
}
__device__ __forceinline__ void gdn_m2b(Frame& F, int bh) {
    const int fr = F.lane & 15, fq = F.lane >> 4, c = (F.wave & 3) * 16 + fr;
    const bf16* pg = (const bf16*)(F.ws + WS_GPG) + (size_t)bh * 16 * 4096;
    const bf16* qg = (const bf16*)(F.ws + WS_GQG) + (size_t)bh * 16 * 4096 + c * 64 + 8 * fq;
    float* ss = (float*)(F.ws + WS_GSS) + (size_t)bh * 16 * 4096 + c * 64 + 4 * fq;
    { u32x4 pv[16]; const int r = F.tid >> 3, sl = F.tid & 7;
#pragma unroll
      for (int g = 0; g < 16; ++g) pv[g] = *(const u32x4*)(pg + (size_t)g * 4096 + r * 64 + ((sl ^ (r & 7)) << 3));
#pragma unroll
      for (int g = 0; g < 16; ++g) *(LAS u32x4*)(F.lds + g * 8192 + F.tid * 16) = pv[g]; }
    u32x4 qv[16][2];
    if (F.wave < 4) {
#pragma unroll
        for (int g = 0; g < 16; ++g) { qv[g][0] = *(const u32x4*)(qg + (size_t)g * 4096); qv[g][1] = *(const u32x4*)(qg + (size_t)g * 4096 + 32); } }
    lds_barrier();
    if (F.wave < 4) {
        f32x4 S[4];
#pragma unroll
        for (int i = 0; i < 4; ++i) S[i] = (f32x4){0.f, 0.f, 0.f, 0.f};
#pragma unroll
        for (int g = 0; g < 16; ++g) {
#pragma unroll
            for (int i = 0; i < 4; ++i) *(f32x4*)(ss + (size_t)g * 4096 + i * 16) = S[i];
            GdnStep st; st.U[0] = qv[g][0]; st.U[1] = qv[g][1];
#pragma unroll
            for (int i = 0; i < 4; ++i)
#pragma unroll
                for (int ks = 0; ks < 2; ++ks) st.T[i][ks] = *(const LAS u32x4*)(F.lds + g * 8192 + (i * 16 + fr) * 128 + (((ks * 4 + fq) ^ (fr & 7)) << 4));
            gdn_step(S, st, 1.0f); } }
    lds_barrier();
}
__device__ __forceinline__ void gdn_compose(Frame& F, f32x4 (&S)[4]) {
    const int fr = F.lane & 15, fq = F.lane >> 4, c = (F.wave & 3) * 16 + fr;
    const LAS bf16* TL = (const LAS bf16*)(F.lds + GD_QN); const LAS bf16* UL = (const LAS bf16*)(F.lds + GD_KN) + c * 64;
    GdnStep st; st.U[0] = *(const LAS u32x4*)(UL + (((2 * fq) ^ (c & 7)) << 3)); st.U[1] = *(const LAS u32x4*)(UL + (((2 * fq + 1) ^ (c & 7)) << 3));
#pragma unroll
    for (int i = 0; i < 4; ++i)
#pragma unroll
        for (int ks = 0; ks < 2; ++ks) st.T[i][ks] = *(const LAS u32x4*)(TL + (i * 16 + fr) * 64 + (((ks * 4 + fq) ^ (fr & 7)) << 3));
    gdn_step(S, st, (F.wave >> 2) ? 0.0f : 1.0f);
}
struct Gd3Raw { u32x4 kc, qk, qd; u32x4 wwq; GdnStep st; };
struct Gd3Gate { u32x4 gw; };
__device__ __forceinline__ void gdn3_gates(Frame& F, int b, int n, int h, Gd3Gate& g) {
    const int fr = F.lane & 15, fq = F.lane >> 4, tt = F.wave & 3, hi = F.wave >> 2;
    g.gw = __builtin_nontemporal_load((const u32x4*)((const bf16*)(F.ws + WS_R1) + zoff(b * SEQ + n * 64 + tt * 16 + fr, 3840 + h * 64 + 32 * hi + 8 * fq)));
}
__device__ __forceinline__ void gdn3_issue(Frame& F, int b, int n, int h, int uid, Gd3Raw& r) {
    const size_t row0 = (size_t)(b * SEQ + n * 64);
    const int fr = F.lane & 15, fq = F.lane >> 4, tt = F.wave & 3, hi = F.wave >> 2;
    const bf16* zg = (const bf16*)(F.ws + WS_R1) + row0 * NZ + 3840 + h * 64; const bf16* wt = (const bf16*)(F.ws + WS_GWT) + (size_t)uid * 4096 + (tt * 16 + fr) * 64;
    { const int rr = F.tid >> 3, c8 = F.tid & 7; const size_t go = (size_t)uid * 4096 + rr * 64 + 8 * c8, gh = (size_t)uid * 4096 + (c8 >> 2) * 2048 + rr * 32 + (c8 & 3) * 8;
      r.kc = __builtin_nontemporal_load((const u32x4*)((const bf16*)(F.ws + WS_GKC) + gh)); r.qk = __builtin_nontemporal_load((const u32x4*)((const bf16*)(F.ws + WS_GQK) + gh)); r.qd = __builtin_nontemporal_load((const u32x4*)((const bf16*)(F.ws + WS_GQD) + go)); }
    r.wwq = __builtin_nontemporal_load((const u32x4*)(wt + 32 * hi + 8 * fq));
    gdn_m2_load(r.st, (const bf16*)(F.ws + WS_GT) + (size_t)uid * 4096, (const bf16*)(F.ws + WS_GUT) + (size_t)uid * 4096 + ((F.wave & 3) * 16 + fr) * 32 + 8 * fq, 0, fr, fq);
}
__device__ __forceinline__ void gdn_m3(Frame& F, int l, int b, int n, int h, const Gd3Raw& r, const Gd3Gate& gt_, f32x4 (&S)[4]) {
    LAS bf16* KCL = (LAS bf16*)(F.lds + GL_QS); LAS bf16* QKL = KCL + 64 * 72; LAS bf16* QDL = QKL + 64 * 72; LAS bf16* VNT = QDL + 64 * 72; LAS bf16* STL = VNT + 64 * 72;
    const size_t row0 = (size_t)(b * SEQ + n * 64);
    const int fr = F.lane & 15, fq = F.lane >> 4, tt = F.wave & 3, hi = F.wave >> 2;
    { const int rr = F.tid >> 3, c8 = F.tid & 7;
      *(LAS u32x4*)(KCL + rr * 72 + 8 * c8) = r.kc; *(LAS u32x4*)(QKL + rr * 72 + 8 * c8) = r.qk; *(LAS u32x4*)(QDL + rr * 72 + 8 * c8) = r.qd; }
    if (F.wave < 4) {
#pragma unroll
        for (int i = 0; i < 4; ++i) { u32x2 w; w.x = pk2(S[i][0], S[i][1]); w.y = pk2(S[i][2], S[i][3]); *(LAS u32x2*)(STL + (F.wave * 16 + fr) * 72 + 16 * i + 4 * fq) = w; } }
    u32x4 gw[1]; gw[0] = gt_.gw; const u32x4 wwq = r.wwq;
    lds_barrier();
    {
        f32x4 a2[2] = {(f32x4){0.f, 0.f, 0.f, 0.f}, (f32x4){0.f, 0.f, 0.f, 0.f}};
#pragma unroll
        for (int ks = 0; ks < 2; ++ks) { const bf16x8 yf = lfrag(STL, 72, tt * 16 + fr, 32 * ks + 8 * fq);
#pragma unroll
            for (int i = 0; i < 2; ++i) a2[i] = MFMA16(lfrag(KCL, 72, xrow(2, hi, i, fr), 32 * ks + 8 * fq), yf, a2[i]); }
        const int e = tt * 16 + fr;
        { u32x4 w; w.x = pk2(bflo(wwq.x) - a2[0][0], bfhi(wwq.x) - a2[0][1]); w.y = pk2(bflo(wwq.y) - a2[0][2], bfhi(wwq.y) - a2[0][3]);
          w.z = pk2(bflo(wwq.z) - a2[1][0], bfhi(wwq.z) - a2[1][1]); w.w = pk2(bflo(wwq.w) - a2[1][2], bfhi(wwq.w) - a2[1][3]);
          *(LAS u32x4*)(VNT + e * 72 + 32 * hi + 8 * fq) = w; }
    }
    lds_barrier();
    f32x4 acc[2] = {(f32x4){0.f, 0.f, 0.f, 0.f}, (f32x4){0.f, 0.f, 0.f, 0.f}};
#pragma unroll
    for (int ks = 0; ks < 2; ++ks) { const bf16x8 yf = lfrag(QKL, 72, tt * 16 + fr, 32 * ks + 8 * fq);
#pragma unroll
        for (int i = 0; i < 2; ++i) acc[i] = MFMA16(lfrag(VNT, 72, xrow(2, hi, i, fr), 32 * ks + 8 * fq), yf, acc[i]); }
#pragma unroll
    for (int ks = 0; ks < 2; ++ks) { const bf16x8 yf = lfrag(QDL, 72, tt * 16 + fr, 32 * ks + 8 * fq);
#pragma unroll
        for (int i = 0; i < 2; ++i) acc[i] = MFMA16(lfrag(STL, 72, xrow(2, hi, i, fr), 32 * ks + 8 * fq), yf, acc[i]); }
    mix_out_epilogue<2, 64>(F, acc, (const LAS float*)(F.lds + GL_GNG), gw, (bf16*)(F.ws + WS_OMIX) + row0 * 1024 + (768 + h * 64) * 16);
    gdn_step(S, r.st, 1.0f);
}
#define LAUNDER() do { F.lane = F0.lane; asm volatile("" : "+v"(F.lane)); F.tid = F.wave * 64 + F.lane; } while (0)
#define UNIT_IDX(k) const int idx = F.bid + F.G * (k), b = idx >> 9, n = (idx >> 2) & 127, h = idx & 3, uid = ((b * 4 + h) << 7) | n
__device__ __forceinline__ void phase_mix_m1(Frame& F0, int l) {
    Frame F = F0; const int NU = 2048 / F.G;
    if (F.tid < 128) ((LAS float*)(F.lds + GL_LB))[F.tid] = ((const float*)(F.ws + WS_LB))[l * 512 + ((F.bid >> 4) & 3) * 128 + F.tid];
    lds_barrier();
    const int bh = F.bid >> 4, seg = F.bid & 15, b = bh >> 2, h = bh & 3;
    RtRaw rraw; GdRaw graw;
    {
      f32x4 S[8];
#pragma unroll
      for (int i = 0; i < 8; ++i) S[i] = (f32x4){0.f, 0.f, 0.f, 0.f};
      float dseg = 1.0f;
      HgRaw raw; hg_issue<false>(F, b, 8 * seg, h, raw);
      auto hg_chunk = [&](int k, auto next_issue) __attribute__((always_inline)) { LAUNDER();
        const HgRaw cur = raw;
        next_issue(k);
        hg_prep<0>(F, l, h, cur);
        f32x4 kv[8]; hg_kv_acc(F, kv);
        const LAS float* DECL = (const LAS float*)(F.lds + GL_DECL); const int fq = F.lane >> 4;
#pragma unroll
        for (int i = 0; i < 8; ++i) S[i] = S[i] * *(const LAS f32x4*)(DECL + 16 * i + 4 * fq) + kv[i];
        if (F.tid < 128) dseg *= DECL[F.tid];
        lds_barrier(); };
      for (int k = 0; k < 7; ++k) hg_chunk(k, [&](int kk) __attribute__((always_inline)) { hg_issue<false>(F, b, 8 * seg + kk + 1, h, raw); });
      hg_chunk(7, [&](int) __attribute__((always_inline)) { rt_issue<false>(F, b, 8 * seg, h, rraw); });
      { const int fr = F.lane & 15, fq = F.lane >> 4; float* kvg = (float*)(F.ws + WS_HKV) + (size_t)(bh * 16 + seg) * 16384 + (F.wave * 16 + fr) * 128 + 4 * fq;
#pragma unroll
        for (int i = 0; i < 8; ++i) *(f32x4*)(kvg + 16 * i) = S[i];
        if (F.tid < 128) ((float*)(F.ws + WS_HDEC))[(size_t)(bh * 16 + seg) * 128 + F.tid] = dseg; } }
    {
      const float dec = __expf(64.0f * log1pf(-exp2f(-5.0f - (float)h)));
      f32x4 S[2] = {(f32x4){0.f, 0.f, 0.f, 0.f}, (f32x4){0.f, 0.f, 0.f, 0.f}};
      auto rt_chunk = [&](int k, auto next_issue) __attribute__((always_inline)) { LAUNDER();
        rt_stage<false>(F, rraw); lds_barrier();
        next_issue(k);
        rt_prep<0>(F, 8 * seg + k, h);
        f32x4 kv[2]; rt_kv_acc(F, kv);
        S[0] = S[0] * dec + kv[0]; S[1] = S[1] * dec + kv[1];
        lds_barrier(); };
      for (int k = 0; k < 7; ++k) rt_chunk(k, [&](int kk) __attribute__((always_inline)) { rt_issue<false>(F, b, 8 * seg + kk + 1, h, rraw); });
      rt_chunk(7, [&](int) __attribute__((always_inline)) { gdn_issue(F, b, 8 * seg, h, graw); gdn_load_cw(F, l, h); });
      { const int fr = F.lane & 15, fq = F.lane >> 4; float* kvg = (float*)(F.ws + WS_RKV) + (size_t)(bh * 16 + seg) * 4096 + ((F.wave & 3) * 16 + fr) * 64 + (2 * (F.wave >> 2)) * 16 + 4 * fq;
        *(f32x4*)kvg = S[0]; *(f32x4*)(kvg + 16) = S[1]; } }
    {
      f32x4 S[4];
      { const int fr = F.lane & 15, fq = F.lane >> 4, role = F.wave >> 2, c = (F.wave & 3) * 16 + fr;
#pragma unroll
        for (int i = 0; i < 4; ++i)
#pragma unroll
            for (int j = 0; j < 4; ++j) S[i][j] = (role && (16 * i + 4 * fq + j == c)) ? 1.0f : 0.0f; }
      for (int k = 0; k < 8; ++k) { LAUNDER(); const int n = 8 * seg + k;
        gdn_stage(F, graw); const GdRaw cur = graw; lds_barrier();
        if (k + 1 < 8) gdn_issue(F, b, n + 1, h, graw);
        gdn_m1(F, l, h, bh * 128 + n, cur);
        gdn_compose(F, S); }
      { const int fr = F.lane & 15, fq = F.lane >> 4, role = F.wave >> 2, c = (F.wave & 3) * 16 + fr;
        if (role == 0) { bf16* qg = (bf16*)(F.ws + WS_GQG) + (size_t)(bh * 16 + seg) * 4096 + c * 64 + fq * 8;
            u32x4 w0, w1; w0.x = pk2(S[0][0], S[0][1]); w0.y = pk2(S[0][2], S[0][3]); w0.z = pk2(S[1][0], S[1][1]); w0.w = pk2(S[1][2], S[1][3]);
            w1.x = pk2(S[2][0], S[2][1]); w1.y = pk2(S[2][2], S[2][3]); w1.z = pk2(S[3][0], S[3][1]); w1.w = pk2(S[3][2], S[3][3]);
            *(u32x4*)qg = w0; *(u32x4*)(qg + 32) = w1; }
        else { bf16* pg = (bf16*)(F.ws + WS_GPG) + (size_t)(bh * 16 + seg) * 4096 + (c >> 5) * 32 + ((c & 15) >> 2) * 8 + ((c >> 4) & 1) * 4 + (c & 3);
#pragma unroll
            for (int i = 0; i < 4; ++i)
#pragma unroll
                for (int j = 0; j < 4; ++j) pg[(16 * i + 4 * fq + j) * 64] = (bf16)f2bf(S[i][j]); } } }
}
__device__ __forceinline__ void phase_mix_m2a(Frame& F, int l) { gdn_m2a(F, F.bid >> 4, F.bid & 15); }
__device__ __forceinline__ void phase_mix_m2b(Frame& F, int l) {
    if (F.bid < 16) gdn_m2b(F, F.bid);
    else if (F.bid < 144) { const int item = (F.bid - 16) * 512 + F.tid;
        if (item < 65536) { const int bh = item >> 12, e = (item >> 5) & 127, d4 = item & 31;
            const float* kv = (const float*)(F.ws + WS_HKV) + (size_t)bh * 16 * 16384 + e * 128 + d4 * 4;
            const float* dc = (const float*)(F.ws + WS_HDEC) + (size_t)bh * 16 * 128 + d4 * 4;
            float* sp = (float*)(F.ws + WS_HSP) + (size_t)bh * 16 * 16384 + e * 128 + d4 * 4;
            f32x4 S = (f32x4){0.f, 0.f, 0.f, 0.f};
            { f32x4 kb[16], db[16];
#pragma unroll
                for (int u = 0; u < 16; ++u) { kb[u] = *(const f32x4*)(kv + (size_t)u * 16384); db[u] = *(const f32x4*)(dc + u * 128); }
#pragma unroll
                for (int u = 0; u < 16; ++u) { *(f32x4*)(sp + (size_t)u * 16384) = S; S = db[u] * S + kb[u]; } }
        }
    }
    else if (F.bid < 176) { const int item = (F.bid - 144) * 512 + F.tid;
        if (item < 16384) { const int it = item, bh = it >> 10, e = (it >> 4) & 63, d4 = it & 15;
            const float* kv = (const float*)(F.ws + WS_RKV) + (size_t)bh * 16 * 4096 + e * 64 + d4 * 4;
            float* sp = (float*)(F.ws + WS_RSP) + (size_t)bh * 16 * 4096 + e * 64 + d4 * 4;
            const float dec = __expf(512.0f * log1pf(-exp2f(-5.0f - (float)(bh & 3))));
            f32x4 kb[16];
#pragma unroll
            for (int u = 0; u < 16; ++u) kb[u] = *(const f32x4*)(kv + (size_t)u * 4096);
            f32x4 S = (f32x4){0.f, 0.f, 0.f, 0.f};
#pragma unroll
            for (int u = 0; u < 16; ++u) { *(f32x4*)(sp + (size_t)u * 4096) = S; S = S * dec + kb[u]; }
        }
    }
}
__device__ __forceinline__ void phase_mix_m3(Frame& F0, int l) {
    Frame F = F0; const int NU = 2048 / F.G;
    { const int h = (F.bid >> 4) & 3;
      if (F.tid < 128) { ((LAS float*)(F.lds + GL_LB))[F.tid] = ((const float*)(F.ws + WS_LB))[l * 512 + h * 128 + F.tid]; ((LAS float*)(F.lds + GL_GNH))[F.tid] = pin(F, I_HGG)[l * 512 + h * 128 + F.tid]; }
      else if (F.tid < 192) ((LAS float*)(F.lds + GL_GNR))[F.tid - 128] = pin(F, I_RETG)[l * 256 + h * 64 + F.tid - 128];
      else if (F.tid < 256) ((LAS float*)(F.lds + GL_GNG))[F.tid - 192] = pin(F, I_GDNG)[l * 256 + h * 64 + F.tid - 192];
      lds_barrier(); }
    const int bh = F.bid >> 4, seg = F.bid & 15, b = bh >> 2, h = bh & 3;
    f32x4 rS[2]; RtRaw rraw; u32x4 rgw[1]; f32x4 gS[4]; Gd3Raw gring[2]; Gd3Gate ggate[3];
#define RT_GATES(n_) do { const int fr_ = F.lane & 15, fq_ = F.lane >> 4, tt_ = F.wave & 3, hi_ = F.wave >> 2; const bf16* zg_ = (const bf16*)(F.ws + WS_R1); \
        rgw[0] = __builtin_nontemporal_load((const u32x4*)(zg_ + zoff(b * SEQ + (n_) * 64 + tt_ * 16 + fr_, 2816 + h * 64 + 32 * hi_ + 8 * fq_))); } while (0)
    auto rt_entry = [&]() __attribute__((always_inline)) {
        const int fr = F.lane & 15, fq = F.lane >> 4; const float* sg = (const float*)(F.ws + WS_RSP) + (size_t)(bh * 16 + seg) * 4096 + ((F.wave & 3) * 16 + fr) * 64 + (2 * (F.wave >> 2)) * 16 + 4 * fq;
        rS[0] = *(const f32x4*)sg; rS[1] = *(const f32x4*)(sg + 16);
        rt_issue<true>(F, b, 8 * seg, h, rraw); RT_GATES(8 * seg); };
    auto gd_entry = [&]() __attribute__((always_inline)) {
        const int fr = F.lane & 15, fq = F.lane >> 4; const float* ss = (const float*)(F.ws + WS_GSS) + (size_t)(bh * 16 + seg) * 4096 + ((F.wave & 3) * 16 + fr) * 64 + 4 * fq;
#pragma unroll
        for (int i = 0; i < 4; ++i) gS[i] = *(const f32x4*)(ss + i * 16);
        gdn3_issue(F, b, 8 * seg, h, bh * 128 + 8 * seg, gring[0]); gdn3_gates(F, b, 8 * seg, h, ggate[0]); gdn3_gates(F, b, 8 * seg + 1, h, ggate[1]); };
    {
      f32x4 S[8]; bf16x8 sfd[4][4]; u32x4 gw[2];
      { const int fr = F.lane & 15, fq = F.lane >> 4; const float* sg = (const float*)(F.ws + WS_HSP) + (size_t)(bh * 16 + seg) * 16384 + (F.wave * 16 + fr) * 128 + 4 * fq;
#pragma unroll
        for (int i = 0; i < 8; ++i) S[i] = *(const f32x4*)(sg + 16 * i); }
#define HG_GATES(n_) do { const int fr_ = F.lane & 15, fq_ = F.lane >> 4, tt_ = F.wave & 3, hi_ = F.wave >> 2; const bf16* zg_ = (const bf16*)(F.ws + WS_R1); \
        _Pragma("unroll") for (int p_ = 0; p_ < 2; ++p_) gw[p_] = __builtin_nontemporal_load((const u32x4*)(zg_ + zoff(b * SEQ + (n_) * 64 + tt_ * 16 + fr_, 1536 + h * 128 + 64 * hi_ + 32 * p_ + 8 * fq_))); } while (0)
      HgRaw raw; hg_issue<true>(F, b, 8 * seg, h, raw); HG_GATES(8 * seg);
      auto hg_chunk = [&](int k, auto next_issue, auto next_gates) __attribute__((always_inline)) { LAUNDER(); const int n = 8 * seg + k;
        { LAS bf16* STL = (LAS bf16*)(F.lds + GL_STL); const int fr = F.lane & 15, fq = F.lane >> 4;
#pragma unroll
          for (int i = 0; i < 8; ++i) { u32x2 w; w.x = pk2(S[i][0], S[i][1]); w.y = pk2(S[i][2], S[i][3]); *(LAS u32x2*)(STL + (F.wave * 16 + fr) * 136 + 16 * i + 4 * fq) = w; } }
        const HgRaw cur = raw;
        next_issue(n);
        hg_prep<2>(F, l, h, cur);
        gla_m3_mma<128, 128, true, GL_STL>(F, sfd, gw, (const LAS float*)(F.lds + GL_GNH), (bf16*)(F.ws + WS_OMIX) + (size_t)(b * SEQ + n * 64) * 1024 + h * 128 * 16, [&]() {});
        next_gates(n);
        { f32x4 kv[8]; hg_kv_acc(F, kv);
          const LAS float* DECL = (const LAS float*)(F.lds + GL_DECL); const int fq = F.lane >> 4;
#pragma unroll
          for (int i = 0; i < 8; ++i) S[i] = S[i] * *(const LAS f32x4*)(DECL + 16 * i + 4 * fq) + kv[i]; }
        lds_barrier(); };
      for (int k = 0; k < 7; ++k) hg_chunk(k, [&](int n) __attribute__((always_inline)) { hg_issue<true>(F, b, n + 1, h, raw); }, [&](int n) __attribute__((always_inline)) { HG_GATES(n + 1); });
      hg_chunk(7, [&](int) __attribute__((always_inline)) { rt_entry(); }, [&](int) __attribute__((always_inline)) {});
#undef HG_GATES
    }
    {
      const float dec = __expf(64.0f * log1pf(-exp2f(-5.0f - (float)h)));
      bf16x8 sfd[2][2];
      auto rt_chunk = [&](int k, auto next_issue, auto next_gates) __attribute__((always_inline)) { LAUNDER(); const int n = 8 * seg + k;
        { LAS bf16* STL = (LAS bf16*)(F.lds + GL_RSTL); const int fr = F.lane & 15, fq = F.lane >> 4;
#pragma unroll
          for (int i = 0; i < 2; ++i) { u32x2 w; w.x = pk2(rS[i][0], rS[i][1]); w.y = pk2(rS[i][2], rS[i][3]); *(LAS u32x2*)(STL + ((F.wave & 3) * 16 + fr) * 72 + (2 * (F.wave >> 2) + i) * 16 + 4 * fq) = w; } }
        rt_stage<true>(F, rraw); lds_barrier();
        next_issue(n);
        rt_prep<2>(F, n, h);
        gla_m3_mma<64, 64, true, GL_RSTL>(F, sfd, rgw, (const LAS float*)(F.lds + GL_GNR), (bf16*)(F.ws + WS_OMIX) + (size_t)(b * SEQ + n * 64) * 1024 + (512 + h * 64) * 16, [&]() {});
        next_gates(n);
        { f32x4 kv[2]; rt_kv_acc(F, kv);
          rS[0] = rS[0] * dec + kv[0]; rS[1] = rS[1] * dec + kv[1]; }
        lds_barrier(); };
      for (int k = 0; k < 7; ++k) rt_chunk(k, [&](int n) __attribute__((always_inline)) { rt_issue<true>(F, b, n + 1, h, rraw); }, [&](int n) __attribute__((always_inline)) { RT_GATES(n + 1); });
      rt_chunk(7, [&](int) __attribute__((always_inline)) { gd_entry(); }, [&](int) __attribute__((always_inline)) {});
    }
#undef RT_GATES
    {
#pragma unroll
      for (int k = 0; k < 8; ++k) { LAUNDER(); const int n = 8 * seg + k;
        if (k + 1 < 8) gdn3_issue(F, b, n + 1, h, bh * 128 + n + 1, gring[(k + 1) & 1]);
        if (k + 2 < 8) gdn3_gates(F, b, n + 2, h, ggate[(k + 2) % 3]);
        gdn_m3(F, l, b, n, h, gring[k & 1], ggate[k % 3], gS); } }
}

constexpr int RT_LDW = 520;
constexpr int RT_WH = 0, RT_WL = 32 * RT_LDW * 2, RT_GV = 2 * 32 * RT_LDW * 2, RT_SH = RT_GV + 4096, RT_CB = RT_SH + 4096, RT_CP = RT_CB + 128;
__device__ __forceinline__ void phase_norm2_route(Frame& F, int l) {
    LAS bf16* WH = (LAS bf16*)(F.lds + RT_WH); LAS bf16* WL = (LAS bf16*)(F.lds + RT_WL);
    LAS float* GV = (LAS float*)(F.lds + RT_GV); LAS float* SHV = (LAS float*)(F.lds + RT_SH); LAS float* CB = (LAS float*)(F.lds + RT_CB); LAS float* CP = (LAS float*)(F.lds + RT_CP);
    LAS int* lcnt = (LAS int*)(F.lds + LDS_SM); LAS int* lbase = lcnt + 32; LAS int* le = lcnt + 64; LAS int* ls = le + 512;
    const float* rw = pin(F, I_RW) + (size_t)l * 1024 * 32;
    const float* mod = (const float*)(F.ws + WS_MOD);
    const bf16* xa = (const bf16*)(F.ws + WS_XA);
    int* re = (int*)(F.ws + WS_RE); int* rs = (int*)(F.ws + WS_RS); float* rg = (float*)(F.ws + WS_RG);
    unsigned* cnt = F.ctl + CW_CNT + l * 64;
    for (int rb0 = F.bid; rb0 < NTOK / 128; rb0 += F.G) {
        int ln_ = F.lane; asm volatile("" : "+v"(ln_));
        const int fr = ln_ & 15, fq = ln_ >> 4;
        const int bb = (rb0 * 128) >> 13;
        const float* mp = mod + (size_t)(l * 4 + bb) * 6144;
        const int row = rb0 * 128 + F.wave * 16 + fr;
        bf16x8 xf[32];
#pragma unroll
        for (int ks = 0; ks < 32; ++ks) xf[ks] = *(const bf16x8*)(xa + (size_t)row * 1024 + 32 * ks + 8 * fq);
        if (F.tid < 32) lcnt[F.tid] = 0;
        for (int k = F.tid; k < 1024; k += 512) { GV[k] = pin(F, I_N2G)[l * 1024 + k] * (1.0f + mp[4096 + k]); SHV[k] = mp[3072 + k]; }
        lds_barrier();
        { const int e = F.tid & 31, part = F.tid >> 5; float s = 0.f;
#pragma unroll 8
          for (int k = part * 64; k < part * 64 + 64; ++k) s += SHV[k] * rw[k * 32 + e];
          CP[part * 32 + e] = s; }
        f32x4 acc[2] = {(f32x4){0.f, 0.f, 0.f, 0.f}, (f32x4){0.f, 0.f, 0.f, 0.f}};
#pragma unroll
        for (int hk = 0; hk < 2; ++hk) {
#pragma unroll 4
            for (int idx = F.tid; idx < 512 * 32; idx += 512) { const int k = idx >> 5, e = idx & 31;
                const float w = rw[(size_t)(512 * hk + k) * 32 + e] * GV[512 * hk + k]; const unsigned hb = f2bf(w); const float lo = w - bflo(hb);
                WH[e * RT_LDW + k] = (bf16)hb; WL[e * RT_LDW + k] = (bf16)f2bf(lo); }
            lds_barrier();
#pragma unroll
            for (int ks = 0; ks < 16; ++ks) {
                const bf16x8 y = xf[16 * hk + ks];
#pragma unroll
                for (int n = 0; n < 2; ++n) { acc[n] = MFMA16(lfrag(WH, RT_LDW, 16 * n + fr, 32 * ks + 8 * fq), y, acc[n]); acc[n] = MFMA16(lfrag(WL, RT_LDW, 16 * n + fr, 32 * ks + 8 * fq), y, acc[n]); } }
            lds_barrier();
        }
        if (F.tid < 32) { float s = pin(F, I_RB)[l * 32 + F.tid];
#pragma unroll
            for (int pz = 0; pz < 16; ++pz) s += CP[pz * 32 + F.tid];
            CB[F.tid] = s; }
        float ss = 0.f;
#pragma unroll
        for (int ks = 0; ks < 32; ++ks) { const u32x4 w = __builtin_bit_cast(u32x4, xf[ks]);
            const float a0 = bflo(w.x), a1 = bfhi(w.x), a2 = bflo(w.y), a3 = bfhi(w.y), a4 = bflo(w.z), a5 = bfhi(w.z), a6 = bflo(w.w), a7 = bfhi(w.w);
            ss += ((a0 * a0 + a1 * a1) + (a2 * a2 + a3 * a3)) + ((a4 * a4 + a5 * a5) + (a6 * a6 + a7 * a7)); }
        ss += shx(ss, 16, ln_); ss += shx(ss, 32, ln_);
        const float rinv = rsqrtf(ss * (1.0f / 1024.0f) + NORM_EPS);
        lds_barrier();
        float lg[8];
#pragma unroll
        for (int n = 0; n < 2; ++n)
#pragma unroll
            for (int j = 0; j < 4; ++j) lg[4 * n + j] = acc[n][j] * rinv + CB[16 * n + 4 * fq + j];
        int te[4]; float tv[4];
#pragma unroll
        for (int k = 0; k < 4; ++k) { float best = -3.0e38f; int bi = 0;
#pragma unroll
            for (int i = 0; i < 8; ++i) { const int e = 16 * (i >> 2) + 4 * fq + (i & 3); if (lg[i] > best) { best = lg[i]; bi = e; } }
#pragma unroll
            for (int o = 16; o <= 32; o <<= 1) { const float ob = shx(best, o, ln_); const int oi = shxi(bi, o, ln_); if (ob > best || (ob == best && oi < bi)) { best = ob; bi = oi; } }
#pragma unroll
            for (int i = 0; i < 8; ++i) { const int e = 16 * (i >> 2) + 4 * fq + (i & 3); lg[i] = (e == bi) ? -3.0e38f : lg[i]; }
            te[k] = bi; tv[k] = best; }
        { const float e1 = __expf(tv[1] - tv[0]), e2 = __expf(tv[2] - tv[0]), e3 = __expf(tv[3] - tv[0]), inv = 1.0f / (1.0f + e1 + e2 + e3);
          if (fq == 0) { const int lr = F.wave * 16 + fr;
              *(f32x4*)(rg + (size_t)row * 4) = (f32x4){inv, e1 * inv, e2 * inv, e3 * inv};
#pragma unroll
              for (int k = 0; k < 4; ++k) { le[lr * 4 + k] = te[k]; ls[lr * 4 + k] = atomicAdd((int*)&lcnt[te[k]], 1); } } }
        { unsigned char* hrow = F.ws + WS_HN + (size_t)row * 1024;
#pragma unroll
          for (int ks = 0; ks < 32; ++ks) { u32x4 w = __builtin_bit_cast(u32x4, xf[ks]); asm volatile("" : "+v"(w)); const int k0 = 32 * ks + 8 * fq;
              const f32x4 g0 = *(const LAS f32x4*)(GV + k0), g1 = *(const LAS f32x4*)(GV + k0 + 4), s0 = *(const LAS f32x4*)(SHV + k0), s1 = *(const LAS f32x4*)(SHV + k0 + 4);
              u32x2 o; o.x = pk4_fp8(bflo(w.x) * rinv * g0[0] + s0[0], bfhi(w.x) * rinv * g0[1] + s0[1], bflo(w.y) * rinv * g0[2] + s0[2], bfhi(w.y) * rinv * g0[3] + s0[3]);
              o.y = pk4_fp8(bflo(w.z) * rinv * g1[0] + s1[0], bfhi(w.z) * rinv * g1[1] + s1[1], bflo(w.w) * rinv * g1[2] + s1[2], bfhi(w.w) * rinv * g1[3] + s1[3]);
              *(u32x2*)(hrow + k0) = o; } }
        lds_barrier();
        if (F.tid < 32) lbase[F.tid] = (int)__hip_atomic_fetch_add(cnt + F.tid, (unsigned)lcnt[F.tid], __ATOMIC_RELAXED, __HIP_MEMORY_SCOPE_AGENT);
        lds_barrier();
        { const int i = F.tid, e = le[i], sl = lbase[e] + ls[i]; re[(size_t)rb0 * 512 + i] = e; rs[(size_t)rb0 * 512 + i] = sl; ((int*)(F.ws + WS_TOKE))[e * NTOK + sl] = rb0 * 128 + (i >> 2); }
        lds_barrier();
    }
}

__device__ __forceinline__ void build_rt(Frame& F, int l) {
    LAS int* rt_e = (LAS int*)(F.lds + LDS_RT); LAS int* off = rt_e + 608; LAS int* cn = off + 32;
    if (F.tid < 64) {
        const int e = F.lane, c = (e < 32) ? (int)F.ctl[CW_CNT + l * 64 + e] : 0, t = (c + 255) >> 8;
        const int incl = (int)wave_scan_incl((float)t, F.lane), n0 = incl - t;
        if (e < 32) { off[e] = n0 * 256; cn[e] = c; for (int i = 0; i < t; ++i) rt_e[n0 + i] = e; }
        if (e == 31) rt_e[600] = incl; }
    __syncthreads();
}
__device__ __forceinline__ void phase_gather(Frame& F, int l) {
    build_rt(F, l);
    const LAS int* rt_e = (const LAS int*)(F.lds + LDS_RT); const LAS int* off = rt_e + 608; const LAS int* cn = off + 32;
    const int* re = (const int*)(F.ws + WS_RE); int* rs = (int*)(F.ws + WS_RS); int* tok = (int*)(F.ws + WS_TOK);
    for (int i = F.bid * 512 + F.tid; i < NTOK * 4; i += F.G * 512) { const int pos = off[re[i]] + rs[i]; rs[i] = pos; tok[pos] = i >> 2; }
    for (int e = F.bid; e < 32; e += F.G) { const int c = cn[e], r0 = off[e] + c, r1 = off[e] + ((c + 255) >> 8) * 256;
        for (int r = r0 + F.tid; r < r1; r += 512) tok[r] = 0; }
}

__device__ __forceinline__ void phase_combine(Frame& F, int l) {
    LAS float* w8t = (LAS float*)F.lds;
    LAS float* G2 = (LAS float*)(F.lds + 32768); LAS float* GS = G2 + 1024; LAS float* SH = GS + 1024;
    const float* mod = (const float*)(F.ws + WS_MOD);
    const int gw = F.bid * 8 + F.wave, NGW = F.G * 8, RPW = NTOK / NGW, row0 = gw * RPW, rend = row0 + RPW;
    bf16* xa = (bf16*)(F.ws + WS_XA);
    const int* rs = (const int*)(F.ws + WS_RS); const int* re = (const int*)(F.ws + WS_RE); const float* rg = (const float*)(F.ws + WS_RG);
    const LAS int* offl = (const LAS int*)(F.lds + LDS_RT) + 608;
    const unsigned char* y = F.ws + WS_R1;
    int4 ren2;
    u32x2 vn[4]; int4 posn, posn2; f32x4 ggn, ggn2; unsigned yn[4][4];
    { const u32x2* xr0 = (const u32x2*)(xa + (size_t)row0 * 1024) + F.lane;
#pragma unroll
      for (int j = 0; j < 4; ++j) vn[j] = xr0[64 * j];
      posn = *(const int4*)(rs + (size_t)row0 * 4); ggn = *(const f32x4*)(rg + (size_t)row0 * 4); const int4 ren = *(const int4*)(re + (size_t)row0 * 4);
      { const size_t r2 = (row0 + 1 < rend) ? (size_t)(row0 + 1) : (size_t)row0; posn2 = *(const int4*)(rs + r2 * 4); ggn2 = *(const f32x4*)(rg + r2 * 4); ren2 = *(const int4*)(re + r2 * 4); }
      const int pk0[4] = {offl[ren.x] + posn.x, offl[ren.y] + posn.y, offl[ren.z] + posn.z, offl[ren.w] + posn.w};
#pragma unroll
      for (int k = 0; k < 4; ++k) { const unsigned* yr = (const unsigned*)(y + (size_t)pk0[k] * 1024) + F.lane;
#pragma unroll
          for (int j = 0; j < 4; ++j) yn[k][j] = __builtin_nontemporal_load(yr + 64 * j); } }
    if (l + 1 < DEPTH) load_w8t(F, l + 1, w8t);
    if (F.tid < 256) { const int bb = (F.bid * 8 * RPW) >> 13, col = 4 * F.tid;
        const float* mp = mod + (size_t)(l * 4 + bb) * 6144; const float* mq = mod + (size_t)(((l + 1 < DEPTH) ? l + 1 : l) * 4 + bb) * 6144;
        *(LAS f32x4*)(G2 + col) = *(const f32x4*)(mp + 5120 + col);
        if (l + 1 < DEPTH) { *(LAS f32x4*)(GS + col) = *(const f32x4*)(pin(F, I_N1G) + (l + 1) * 1024 + col) * (*(const f32x4*)(mq + 1024 + col) + 1.0f); *(LAS f32x4*)(SH + col) = *(const f32x4*)(mq + col); }
        else *(LAS f32x4*)(GS + col) = *(const f32x4*)(pin(F, I_FNG) + col); }
    lds_barrier();
#pragma unroll 1
    for (int row = row0; row < rend; ++row) {
        u32x2* xr = (u32x2*)(xa + (size_t)row * 1024) + F.lane;
        int ml = 4 * F.lane; asm volatile("" : "+v"(ml));
        f32x4 v[4], a[4]; unsigned yc[4][4];
#pragma unroll
        for (int j = 0; j < 4; ++j) { v[j] = unpack4(vn[j]); a[j] = (f32x4){0.f, 0.f, 0.f, 0.f}; }
        const f32x4 gg = ggn;
#pragma unroll
        for (int k = 0; k < 4; ++k)
#pragma unroll
            for (int j = 0; j < 4; ++j) yc[k][j] = yn[k][j];
        const bool more = row + 1 < rend;
        if (more) { const u32x2* xr2 = (const u32x2*)(xa + (size_t)(row + 1) * 1024) + F.lane;
#pragma unroll
            for (int j = 0; j < 4; ++j) vn[j] = xr2[64 * j];
            const int pk2_[4] = {offl[ren2.x] + posn2.x, offl[ren2.y] + posn2.y, offl[ren2.z] + posn2.z, offl[ren2.w] + posn2.w};
#pragma unroll
            for (int k = 0; k < 4; ++k) { const unsigned* yr = (const unsigned*)(y + (size_t)pk2_[k] * 1024) + F.lane;
#pragma unroll
                for (int j = 0; j < 4; ++j) yn[k][j] = __builtin_nontemporal_load(yr + 64 * j); }
            ggn = ggn2;
            { const size_t r3 = (row + 2 < rend) ? (size_t)(row + 2) : (size_t)row; posn2 = *(const int4*)(rs + r3 * 4); ggn2 = *(const f32x4*)(rg + r3 * 4); ren2 = *(const int4*)(re + r3 * 4); } }
        const float gk[4] = {gg.x, gg.y, gg.z, gg.w};
#pragma unroll
        for (int k = 0; k < 4; ++k)
#pragma unroll
            for (int j = 0; j < 4; ++j) a[j] += unpack4_fp8(yc[k][j]) * gk[k];
        float ss = 0.f;
#pragma unroll
        for (int j = 0; j < 4; ++j) { v[j] = v[j] + *(const LAS f32x4*)(G2 + 256 * j + ml) * a[j]; ss += (v[j].x * v[j].x + v[j].y * v[j].y) + (v[j].z * v[j].z + v[j].w * v[j].w); }
        const float r = rsqrtf(wave_sum(ss) * (1.0f / 1024.0f) + NORM_EPS);
        if (l + 1 < DEPTH) {
            f32x4 h[4]; bf16* hrow = (bf16*)(F.ws + WS_HN) + (size_t)row * 1024;
#pragma unroll
            for (int j = 0; j < 4; ++j) { u32x2 w; w.x = pk2(v[j].x, v[j].y); w.y = pk2(v[j].z, v[j].w); xr[64 * j] = w;
                h[j] = (v[j] * r) * *(const LAS f32x4*)(GS + 256 * j + ml) + *(const LAS f32x4*)(SH + 256 * j + ml);
                u32x2 w2; w2.x = pk2(h[j].x, h[j].y); w2.y = pk2(h[j].z, h[j].w); *(u32x2*)(hrow + 256 * j + 4 * F.lane) = w2; }
            emit_gab(h, w8t, (float*)(F.ws + WS_GAB) + (size_t)row * 8, F.lane);
        } else {
            f32x4* orow = (f32x4*)(pout(F) + (size_t)row * 1024) + F.lane;
#pragma unroll
            for (int j = 0; j < 4; ++j) orow[64 * j] = (v[j] * r) * *(const LAS f32x4*)(GS + 256 * j + ml);
        }
    }
    __syncthreads();
}

#define PHASE __device__ __forceinline__ void
PHASE ph_prologue(int w0) { Frame F = make_frame(w0); phase0(F); }
PHASE ph_norm1_first(int w0) { Frame F = make_frame(w0); phase_norm1_first(F); }
PHASE ph_gemm_in(int w0, int l_) { Frame F = make_frame(w0); const int l = __builtin_amdgcn_readfirstlane(l_);
    pg8::DenseOrder S; S.init(F.ws + WS_HN, (bf16*)(F.ws + WS_WIN) + (size_t)l * NZ * 1024, NTOK, NZ, F.G, F.bid);
    pg8::EpiZ E{(bf16*)(F.ws + WS_R1), NZ};
    pg8::gemm_phase<pg8::EpiZ, pg8::DenseOrder>(F.lds, S, E, pg8::HSTEP, F.wave0); }
PHASE ph_mix(int w0, int l_) { Frame F = make_frame(w0); const int l = __builtin_amdgcn_readfirstlane(l_); phase_mix_naive(F, l); }
PHASE ph_mix_m1(int w0, int l_) { Frame F = make_frame(w0); const int l = __builtin_amdgcn_readfirstlane(l_); phase_mix_m1(F, l); }
PHASE ph_mix_m2a(int w0, int l_) { Frame F = make_frame(w0); const int l = __builtin_amdgcn_readfirstlane(l_); phase_mix_m2a(F, l); }
PHASE ph_mix_m2b(int w0, int l_) { Frame F = make_frame(w0); const int l = __builtin_amdgcn_readfirstlane(l_); phase_mix_m2b(F, l); }
PHASE ph_mix_m3(int w0, int l_) { Frame F = make_frame(w0); const int l = __builtin_amdgcn_readfirstlane(l_); phase_mix_m3(F, l); }
PHASE ph_gemm_out(int w0, int l_) { Frame F = make_frame(w0); const int l = __builtin_amdgcn_readfirstlane(l_);
    const float* mod = (const float*)(F.ws + WS_MOD);
    pg8::DenseOrder S; S.init(F.ws + WS_OMIX, (bf16*)(F.ws + WS_WOUT) + (size_t)l * 1024 * 1024, NTOK, 1024, F.G, F.bid);
    if (l == 0) { pg8::EpiXres<false> E{(const void*)pin(F, I_X), (bf16*)(F.ws + WS_XA), mod + 2048};
        pg8::gemm_phase<pg8::EpiXres<false>, pg8::DenseOrder>(F.lds, S, E, pg8::HSTEP, F.wave0); }
    else { pg8::EpiXres<true> E{(const void*)(F.ws + WS_XA), (bf16*)(F.ws + WS_XA), mod + (size_t)l * 4 * 6144 + 2048};
        pg8::gemm_phase<pg8::EpiXres<true>, pg8::DenseOrder>(F.lds, S, E, pg8::HSTEP, F.wave0); } }
PHASE ph_route(int w0, int l_) { Frame F = make_frame(w0); const int l = __builtin_amdgcn_readfirstlane(l_); phase_norm2_route(F, l); }
PHASE ph_gather(int w0, int l_) { Frame F = make_frame(w0); const int l = __builtin_amdgcn_readfirstlane(l_); phase_gather(F, l); }
PHASE ph_moe_up(int w0, int l_) { Frame F = make_frame(w0); const int l = __builtin_amdgcn_readfirstlane(l_);
    build_rt(F, l);
    const LAS int* rt_e = (const LAS int*)(F.lds + LDS_RT); const int nrt = __builtin_amdgcn_readfirstlane(rt_e[600]);
    pg8::MoeOrder S; S.A = (const char*)(F.ws + WS_HN); S.gather = true; S.atstep = 0; S.Bt = (const char*)(F.ws + WS_W1 + (size_t)l * 32 * 2048 * 1024); S.nct = 8; S.nrt = nrt; S.ntot = nrt * 8; S.G = F.G; S.c = F.bid;
    S.estride = (size_t)2048 * 1024; S.ctstep = (size_t)128 * 1024; S.rt_e = rt_e; S.ready = nullptr; S.need = 0; S.upfin = nullptr; S.nwgs = 0;
    pg8::EpiAct E{F.ws + WS_R2, pin(F, I_B1) + (size_t)l * 32 * 2048, F.ctl + CW_PAN + l * PAN_LAYER};
    pg8::gemm_phase<pg8::EpiAct, pg8::MoeOrder, true, true>(F.lds, S, E, (size_t)1024 * 1024, F.wave0, (const int*)(F.ws + WS_TOKE));
    if (F.tid == 0) __hip_atomic_fetch_add(F.ctl + CW_UPFIN + l * 64, 1u, __ATOMIC_RELAXED, __HIP_MEMORY_SCOPE_AGENT); }
PHASE ph_moe_down(int w0, int l_) { Frame F = make_frame(w0); const int l = __builtin_amdgcn_readfirstlane(l_);
    const LAS int* rt_e = (const LAS int*)(F.lds + LDS_RT); const int nrt = __builtin_amdgcn_readfirstlane(rt_e[600]);
    pg8::MoeOrder S; S.A = (const char*)(F.ws + WS_R2); S.gather = false; S.atstep = (size_t)256 * 1024; S.Bt = (const char*)(F.ws + WS_W2 + (size_t)l * 32 * 1024 * 1024); S.nct = 4; S.nrt = nrt; S.ntot = nrt * 4; S.G = F.G;
    { const int rup = (nrt * 8) % F.G; S.c = (F.bid - rup + F.G) % F.G; }
    S.estride = (size_t)1024 * 1024; S.ctstep = (size_t)256 * 1024; S.rt_e = rt_e; S.ready = F.ctl + CW_PAN + l * PAN_LAYER; S.need = 64;
    S.upfin = F.ctl + CW_UPFIN + l * 64; S.nwgs = (unsigned)F.G;
    pg8::EpiY E{F.ws + WS_R1, pin(F, I_B2) + (size_t)l * 32 * 1024};
    pg8::gemm_phase<pg8::EpiY, pg8::MoeOrder, false, true>(F.lds, S, E, (size_t)8 * 1024, F.wave0); }
PHASE ph_combine(int w0, int l_) { Frame F = make_frame(w0); const int l = __builtin_amdgcn_readfirstlane(l_); phase_combine(F, l); }

__global__ void __launch_bounds__(512, 2) fwd(Params p) {
    LAS unsigned char* lds = (LAS unsigned char*)lds_raw;
    const int tid = threadIdx.x;
    for (int u = tid; u < (LDS_BYTES - LDSCTL_OFF) / 4; u += 512) ((LAS unsigned*)(lds + LDSCTL_OFF))[u] = 0u;
    __syncthreads();
    if (tid == 0) {
        LAS unsigned long long* P = (LAS unsigned long long*)(lds + LDS_PAR);
#pragma unroll
        for (int i = 0; i < 22; ++i) P[i] = (unsigned long long)p.in[i];
        P[22] = (unsigned long long)p.out; P[23] = (unsigned long long)p.ws;
    }
    __syncthreads();
    (void)xcd_barrier_post((unsigned*)(p.ws + WS_CTL) + CW_BAR, (volatile LAS unsigned*)(lds + MISC_OFF) + 8);
#define GRID_BAR() do { XcdBarrier b2_; unsigned long long bp_ = ldpar(lds, 23) + WS_CTL + 4ull * CW_BAR; asm volatile("" : "+s"(bp_)); b2_.bar = (unsigned*)(GAS unsigned*)bp_; b2_.x = xb_xcc_id(); b2_.st = (volatile LAS unsigned*)(lds + MISC_OFF) + 8; xcd_barrier(b2_); } while (0)
    const int w0 = __builtin_amdgcn_readfirstlane(tid >> 6);
#ifndef DBL_P0
#define DBL_P0 1
#endif
    for (int r_ = 0; r_ < DBL_P0; ++r_) { ph_prologue(w0); GRID_BAR(); }
    ph_norm1_first(w0); GRID_BAR();
#ifndef DBL_GIN
#define DBL_GIN 1
#endif
#define DBL_M1 1
#define DBL_M2 1
#define DBL_M3 1
#ifndef DBL_MOE
#define DBL_MOE 1
#endif
#define LAYER(l) do { for (int r_ = 0; r_ < DBL_GIN; ++r_) { ph_gemm_in(w0, l); GRID_BAR(); } \
        for (int r_ = 0; r_ < DBL_M1; ++r_) { ph_mix_m1(w0, l); GRID_BAR(); } for (int r_ = 0; r_ < DBL_M2; ++r_) { ph_mix_m2b(w0, l); GRID_BAR(); } for (int r_ = 0; r_ < DBL_M3; ++r_) { ph_mix_m3(w0, l); GRID_BAR(); } \
        ph_gemm_out(w0, l); GRID_BAR(); ph_route(w0, l); GRID_BAR(); \
        ph_moe_up(w0, l); ph_moe_down(w0, l); GRID_BAR(); ph_combine(w0, l); } while (0)
    LAYER(0); GRID_BAR();
    LAYER(1);
}

extern "C" void kernel_launch(void* const* d_in, const int* in_sizes, int n_in, void* d_out, int out_size, void* d_ws, size_t ws_size, hipStream_t stream) {
    static int grid = 0;
    if (grid == 0) {
        if (n_in != 22 || out_size != NTOK * D || ws_size < WS_END) { fprintf(stderr, "kernel_launch: unexpected shapes (n_in %d out %d ws %zu need %zu)\n", n_in, out_size, ws_size, (size_t)WS_END); grid = -1; return; }
        int dev = 0, cus = 0, per_cu = 0;
        if (hipGetDevice(&dev) != hipSuccess || hipDeviceGetAttribute(&cus, hipDeviceAttributeMultiprocessorCount, dev) != hipSuccess) { grid = -1; return; }
        if (hipFuncSetAttribute((const void*)fwd, hipFuncAttributeMaxDynamicSharedMemorySize, LDS_BYTES) != hipSuccess) { fprintf(stderr, "kernel_launch: hipFuncSetAttribute failed\n"); grid = -1; return; }
        if (hipOccupancyMaxActiveBlocksPerMultiprocessor(&per_cu, (const void*)fwd, 512, LDS_BYTES) != hipSuccess || per_cu < 1) fprintf(stderr, "kernel_launch: occupancy query reports %d\n", per_cu);
        (void)hipGetLastError();
        grid = cus;
    }
    if (grid < 0) return;
    if (hipMemsetAsync((char*)d_ws + WS_CTL, 0, CTL_ZERO_BYTES, stream) != hipSuccess) return;
    Params p{};
    for (int i = 0; i < 22; ++i) p.in[i] = (const float*)d_in[i];
    p.out = (float*)d_out; p.ws = (unsigned char*)d_ws;
    hipLaunchKernelGGL(fwd, dim3(grid), dim3(512), LDS_BYTES, stream, p);
}
```
